# Optimizing an MI355X kernel written in HIP

```python
import math
import jax, jax.numpy as jnp
from jax import lax
import numpy as np

D_MODEL = 2048
BATCH = 4
SEQ = 2048
DEPTH = 2
DEC_BATCH = 128
DEC_SEQ = 1
PAST_LEN = 8192
PAGE_SIZE = 128

D_MIX = D_MODEL
EPS = 1e-6
ATT_HEAD_DIM = 64
ATT_HEADS = D_MIX // (4 * ATT_HEAD_DIM)
ATT_KV_HEADS = max(1, ATT_HEADS // 4)
ATT_GROUP = ATT_HEADS // ATT_KV_HEADS
D_ATT = ATT_HEADS * ATT_HEAD_DIM
WINDOW = 128
ROPE_THETA = 500000.0
ROPE_DIM = ATT_HEAD_DIM // 4
SSM_HEAD_DIM = 64
SSM_HEADS = D_MIX // (2 * SSM_HEAD_DIM)
D_SSM = SSM_HEADS * SSM_HEAD_DIM
SSM_GROUPS = 2
D_STATE = 128
CONV_WIDTH = 4
CONV_DIM = D_SSM + 2 * SSM_GROUPS * D_STATE
SSM_CHUNK = 128
MLSTM_HEADS = 4
MLSTM_HEAD_DIM = D_MIX // (4 * MLSTM_HEADS)
D_MLSTM = MLSTM_HEADS * MLSTM_HEAD_DIM
MLSTM_CHUNK = 128
D_FF = 4 * D_MODEL
IN_WIDTH = D_ATT + 2 * ATT_KV_HEADS * ATT_HEAD_DIM + D_SSM + CONV_DIM + SSM_HEADS + 4 * D_MLSTM + 2 * MLSTM_HEADS

kernel_name = 'hybrid_swa_ssd_mlstm_step'


def rms_norm(x, w):
    xf = x.astype(jnp.float32)
    y = xf * lax.rsqrt(jnp.mean(xf * xf, axis=-1, keepdims=True) + EPS)
    return (y * w.astype(jnp.float32)).astype(x.dtype)


def _split_points():
    widths = (D_ATT, ATT_KV_HEADS * ATT_HEAD_DIM, ATT_KV_HEADS * ATT_HEAD_DIM, D_SSM, CONV_DIM, SSM_HEADS,
              D_MLSTM, D_MLSTM, D_MLSTM, D_MLSTM, MLSTM_HEADS, MLSTM_HEADS)
    pts, acc = [], 0
    for w in widths[:-1]:
        acc += w
        pts.append(acc)
    return pts


def partial_rope(x, pos):
    half = ROPE_DIM // 2
    inv = jnp.power(jnp.float32(ROPE_THETA), -jnp.arange(half, dtype=jnp.float32) / half)
    ang = pos.astype(jnp.float32)[:, None] * inv[None, :]
    cos = jnp.cos(ang)[None, :, None, :]
    sin = jnp.sin(ang)[None, :, None, :]
    xr = x[..., :ROPE_DIM].astype(jnp.float32)
    x1, x2 = xr[..., :half], xr[..., half:]
    rot = jnp.concatenate([x1 * cos - x2 * sin, x2 * cos + x1 * sin], axis=-1).astype(x.dtype)
    return jnp.concatenate([rot, x[..., ROPE_DIM:]], axis=-1)


def sink_attention(q, k, v, mask, sinks):
    s = jnp.einsum('...qhgd,...khd->...hgqk', q, k).astype(jnp.float32) * (ATT_HEAD_DIM ** -0.5)
    s = jnp.where(mask, s, -jnp.inf)
    sink = jnp.broadcast_to(sinks.astype(jnp.float32)[:, :, None, None], s.shape[:-1] + (1,))
    p = jax.nn.softmax(jnp.concatenate([s, sink], axis=-1), axis=-1)[..., :-1]
    return jnp.einsum('...hgqk,...khd->...qhgd', p.astype(v.dtype), v)


def swa_prompt(q, k, v, sinks):
    B, S = q.shape[0], q.shape[1]
    nb = S // WINDOW
    qb = q.reshape(B, nb, WINDOW, ATT_KV_HEADS, ATT_GROUP, ATT_HEAD_DIM)
    kb = k.reshape(B, nb, WINDOW, ATT_KV_HEADS, ATT_HEAD_DIM)
    vb = v.reshape(B, nb, WINDOW, ATT_KV_HEADS, ATT_HEAD_DIM)
    pad = ((0, 0), (1, 0), (0, 0), (0, 0), (0, 0))
    kk = jnp.concatenate([jnp.pad(kb, pad)[:, :-1], kb], axis=2)
    vv = jnp.concatenate([jnp.pad(vb, pad)[:, :-1], vb], axis=2)
    blk = jnp.arange(nb)[:, None]
    qpos = blk * WINDOW + jnp.arange(WINDOW)[None, :]
    kpos = (blk - 1) * WINDOW + jnp.arange(2 * WINDOW)[None, :]
    diff = qpos[:, :, None] - kpos[:, None, :]
    mask = (diff >= 0) & (diff <= WINDOW) & (kpos[:, None, :] >= 0)
    o = sink_attention(qb, kk, vv, mask[None, :, None, None], sinks)
    return o.reshape(B, S, D_ATT)


def swa_sample(q, k, v, k_buf, v_buf, sinks):
    Bd, T = q.shape[0], q.shape[1]
    wb = k_buf.shape[1]
    kk = jnp.concatenate([k_buf, k], axis=1)
    vv = jnp.concatenate([v_buf, v], axis=1)
    qpos = PAST_LEN + jnp.arange(T)
    kpos = PAST_LEN - wb + jnp.arange(wb + T)
    diff = qpos[:, None] - kpos[None, :]
    mask = (diff >= 0) & (diff <= WINDOW)
    qg = q.reshape(Bd, T, ATT_KV_HEADS, ATT_GROUP, ATT_HEAD_DIM)
    o = sink_attention(qg, kk, vv, mask[None, None, None], sinks)
    return o.reshape(Bd, T, D_ATT), kk[:, -wb:], vv[:, -wb:]


def causal_conv(xbc, buf, w, b):
    L = xbc.shape[1]
    xp = jnp.concatenate([buf, xbc], axis=1)
    y = sum(xp[:, j:j + L] * w[j] for j in range(CONV_WIDTH)) + b
    return jax.nn.silu(y), xp[:, -(CONV_WIDTH - 1):]


def ssd_scan(x, dt, A, Bm, Cm, S0):
    f32 = jnp.float32
    Bsz, L, H, P = x.shape
    G, N = Bm.shape[2], Bm.shape[3]
    R = H // G
    Q = SSM_CHUNK if L % SSM_CHUNK == 0 else L
    nc = L // Q

    def chunks(t):
        t = t.astype(f32).reshape((Bsz, nc, Q) + t.shape[2:])
        return jnp.moveaxis(t, 1, 0)

    xs = (chunks(x.reshape(Bsz, L, G, R, P)), chunks(dt.reshape(Bsz, L, G, R)), chunks(Bm), chunks(Cm))
    A_gr = A.astype(f32).reshape(G, R)
    tril = jnp.tril(jnp.ones((Q, Q), dtype=bool))

    def step(S, inp):
        xq, dq, bq, cq = inp
        a = jnp.cumsum(dq * A_gr, axis=1)
        at = jnp.moveaxis(a, 1, -1)
        dk = jnp.moveaxis(dq, 1, -1)
        seg = jnp.where(tril, at[..., :, None] - at[..., None, :], -jnp.inf)
        cb = jnp.einsum('bqgn,bkgn->bgqk', cq, bq)
        w = jnp.exp(seg) * cb[:, :, None] * dk[..., None, :]
        y = jnp.einsum('bgrqk,bkgrp->bqgrp', w, xq)
        y = y + jnp.einsum('bqgn,bgrpn->bqgrp', cq, S) * jnp.exp(a)[..., None]
        wk = jnp.exp(at[..., -1:] - at) * dk
        S = S * jnp.exp(at[..., -1])[..., None, None] + jnp.einsum('bgrk,bkgrp,bkgn->bgrpn', wk, xq, bq)
        return S, y

    S, ys = lax.scan(step, S0.astype(f32).reshape(Bsz, G, R, P, N), xs)
    y = jnp.moveaxis(ys, 0, 1).reshape(Bsz, L, H, P)
    return y, S.reshape(Bsz, H, P, N)


def mlstm_scan(q, k, v, ig, fg, C0, n0, m0):
    f32 = jnp.float32
    Bsz, L, H, _ = q.shape
    Q = MLSTM_CHUNK if L % MLSTM_CHUNK == 0 else L
    nc = L // Q

    def chunks(t):
        t = t.astype(f32).reshape((Bsz, nc, Q) + t.shape[2:])
        return jnp.moveaxis(t, 1, 0)

    xs = (chunks(q), chunks(k), chunks(v), chunks(ig), chunks(fg))
    tril = jnp.tril(jnp.ones((Q, Q), dtype=bool))

    def step(carry, inp):
        C, n, m = carry
        qc, kc, vc, ic, fc = inp
        b = jnp.moveaxis(jnp.cumsum(jax.nn.log_sigmoid(fc), axis=1), 1, -1)
        it = jnp.moveaxis(ic, 1, -1)
        logw = jnp.where(tril, b[..., :, None] - b[..., None, :] + it[..., None, :], -jnp.inf)
        log_inter = b + m[..., None]
        mt = jnp.maximum(log_inter, jnp.max(logw, axis=-1))
        sw = jnp.exp(logw - mt[..., None]) * jnp.einsum('bqhd,bkhd->bhqk', qc, kc)
        g = jnp.exp(log_inter - mt)
        gq = jnp.moveaxis(g, -1, 1)[..., None]
        num = jnp.einsum('bhqk,bkhe->bqhe', sw, vc) + jnp.einsum('bqhd,bhde->bqhe', qc, C) * gq
        den = jnp.sum(sw, axis=-1) + jnp.einsum('bqhd,bhd->bhq', qc, n) * g
        h = num / jnp.moveaxis(jnp.maximum(jnp.abs(den), jnp.exp(-mt)), -1, 1)[..., None]
        m_new = mt[..., -1]
        wk = jnp.exp(b[..., -1:] - b + it - m_new[..., None])
        g_end = jnp.exp(b[..., -1] + m - m_new)
        C = C * g_end[..., None, None] + jnp.einsum('bhk,bkhd,bkhe->bhde', wk, kc, vc)
        n = n * g_end[..., None] + jnp.einsum('bhk,bkhd->bhd', wk, kc)
        return (C, n, m_new), h

    (C, n, m), hs = lax.scan(step, (C0.astype(f32), n0.astype(f32), m0.astype(f32)), xs)
    return jnp.moveaxis(hs, 0, 1).reshape(Bsz, L, H, v.shape[-1]), C, n, m


def token_mixers(u, lp, kv_buf, conv_buf, ssm0, C0, n0, m0):
    f32 = jnp.float32
    Bsz, L, _ = u.shape
    prompt = kv_buf is None
    proj = u @ lp['w_in']
    (q, k, v, z, xbc, dt, mq, mk, mv, mo, mi, mf) = jnp.split(proj, _split_points(), axis=-1)

    pos = jnp.arange(L, dtype=jnp.int32) + (0 if prompt else PAST_LEN)
    q = partial_rope(q.reshape(Bsz, L, ATT_HEADS, ATT_HEAD_DIM), pos)
    k = partial_rope(k.reshape(Bsz, L, ATT_KV_HEADS, ATT_HEAD_DIM), pos)
    v = v.reshape(Bsz, L, ATT_KV_HEADS, ATT_HEAD_DIM)
    if prompt:
        att = swa_prompt(q, k, v, lp['sinks'])
        keep = min(WINDOW, L)
        k_new, v_new = k[:, L - keep:], v[:, L - keep:]
    else:
        att, k_new, v_new = swa_sample(q, k, v, kv_buf[0], kv_buf[1], lp['sinks'])

    if prompt:
        conv_buf = jnp.zeros((Bsz, CONV_WIDTH - 1, CONV_DIM), xbc.dtype)
        ssm0 = jnp.zeros((Bsz, SSM_HEADS, SSM_HEAD_DIM, D_STATE), f32)
    xbc, conv_new = causal_conv(xbc, conv_buf, lp['conv_w'], lp['conv_b'])
    xs, bm, cm = jnp.split(xbc, [D_SSM, D_SSM + SSM_GROUPS * D_STATE], axis=-1)
    xs = xs.reshape(Bsz, L, SSM_HEADS, SSM_HEAD_DIM)
    dt = jax.nn.softplus(dt.astype(f32) + lp['dt_bias'].astype(f32))
    A = -jnp.exp(lp['a_log'].astype(f32))
    y, ssm_new = ssd_scan(xs, dt, A, bm.reshape(Bsz, L, SSM_GROUPS, D_STATE),
                          cm.reshape(Bsz, L, SSM_GROUPS, D_STATE), ssm0)
    y = y + lp['d_skip'].astype(f32)[:, None] * xs.astype(f32)
    y = y.reshape(Bsz, L, D_SSM) * jax.nn.silu(z.astype(f32))
    y = rms_norm(y.reshape(Bsz, L, SSM_GROUPS, D_SSM // SSM_GROUPS),
                 lp['ssm_norm'].reshape(SSM_GROUPS, D_SSM // SSM_GROUPS)).reshape(Bsz, L, D_SSM)

    if prompt:
        C0 = jnp.zeros((Bsz, MLSTM_HEADS, MLSTM_HEAD_DIM, MLSTM_HEAD_DIM), f32)
        n0 = jnp.zeros((Bsz, MLSTM_HEADS, MLSTM_HEAD_DIM), f32)
        m0 = jnp.zeros((Bsz, MLSTM_HEADS), f32)
    hd = (Bsz, L, MLSTM_HEADS, MLSTM_HEAD_DIM)
    h, C_new, n_new, m_new = mlstm_scan(
        mq.reshape(hd), mk.reshape(hd) * (MLSTM_HEAD_DIM ** -0.5), mv.reshape(hd),
        mi.astype(f32) + lp['igate_b'].astype(f32), mf.astype(f32) + lp['fgate_b'].astype(f32), C0, n0, m0)
    h = rms_norm(h, lp['mlstm_norm'].reshape(MLSTM_HEADS, MLSTM_HEAD_DIM)).reshape(Bsz, L, D_MLSTM)
    h = h * jax.nn.sigmoid(mo.astype(f32))

    mix = jnp.concatenate([att, y.astype(u.dtype), h.astype(u.dtype)], axis=-1) @ lp['w_out']
    return mix, (k_new, v_new, conv_new, ssm_new, C_new, n_new, m_new)


def decoder_layer(x, lp, kv_buf, conv_buf, ssm0, C0, n0, m0):
    mix, new_state = token_mixers(rms_norm(x, lp['norm_mix']), lp, kv_buf, conv_buf, ssm0, C0, n0, m0)
    x = x + mix
    u = rms_norm(x, lp['norm_mlp'])
    x = x + jnp.square(jax.nn.relu(u @ lp['w_up'])) @ lp['w_down']
    return x, new_state


def setup_inputs(seed: int = 0) -> dict:
    key = jax.random.key(seed)
    ks = jax.random.split(key, 32)
    f32 = jnp.float32
    win = min(WINDOW, PAST_LEN)

    def nrm(k, shape, s):
        return jax.random.normal(k, shape, f32) * s

    dt0 = jnp.exp(jax.random.uniform(ks[14], (DEPTH, SSM_HEADS), f32, math.log(1e-3), math.log(1e-1)))
    return {
        'x_prompt': nrm(ks[0], (BATCH, SEQ, D_MODEL), 1.0),
        'x_sample': nrm(ks[1], (DEC_BATCH, DEC_SEQ, D_MODEL), 1.0),
        'cache_swa_k': nrm(ks[2], (DEPTH, DEC_BATCH, win, ATT_KV_HEADS, ATT_HEAD_DIM), 1.0),
        'cache_swa_v': nrm(ks[3], (DEPTH, DEC_BATCH, win, ATT_KV_HEADS, ATT_HEAD_DIM), 1.0),
        'state_conv': nrm(ks[4], (DEPTH, DEC_BATCH, CONV_WIDTH - 1, CONV_DIM), 1.0),
        'state_ssm': nrm(ks[5], (DEPTH, DEC_BATCH, SSM_HEADS, SSM_HEAD_DIM, D_STATE), 0.3),
        'state_mlstm_C': nrm(ks[6], (DEPTH, DEC_BATCH, MLSTM_HEADS, MLSTM_HEAD_DIM, MLSTM_HEAD_DIM), 0.3),
        'state_mlstm_n': nrm(ks[7], (DEPTH, DEC_BATCH, MLSTM_HEADS, MLSTM_HEAD_DIM), 0.3),
        'state_mlstm_m': nrm(ks[8], (DEPTH, DEC_BATCH, MLSTM_HEADS), 1.0),
        'w_norm_mix': 1.0 + nrm(ks[9], (DEPTH, D_MODEL), 0.02),
        'w_in': nrm(ks[10], (DEPTH, D_MODEL, IN_WIDTH), D_MODEL ** -0.5),
        'attn_sinks': nrm(ks[11], (DEPTH, ATT_KV_HEADS, ATT_GROUP), 0.5),
        'conv_w': nrm(ks[12], (DEPTH, CONV_WIDTH, CONV_DIM), CONV_WIDTH ** -0.5),
        'conv_b': nrm(ks[13], (DEPTH, CONV_DIM), 0.02),
        'dt_bias': dt0 + jnp.log(-jnp.expm1(-dt0)),
        'a_log': jnp.log(jax.random.uniform(ks[15], (DEPTH, SSM_HEADS), f32, 1.0, 16.0)),
        'd_skip': 1.0 + nrm(ks[16], (DEPTH, SSM_HEADS), 0.1),
        'w_norm_ssm': 1.0 + nrm(ks[17], (DEPTH, D_SSM), 0.02),
        'igate_b': nrm(ks[18], (DEPTH, MLSTM_HEADS), 0.1),
        'fgate_b': jnp.linspace(3.0, 6.0, MLSTM_HEADS, dtype=f32)[None, :] + nrm(ks[19], (DEPTH, MLSTM_HEADS), 0.1),
        'w_norm_mlstm': 1.0 + nrm(ks[20], (DEPTH, D_MLSTM), 0.02),
        'w_out': nrm(ks[21], (DEPTH, D_MIX, D_MODEL), D_MIX ** -0.5),
        'w_norm_mlp': 1.0 + nrm(ks[22], (DEPTH, D_MODEL), 0.02),
        'w_up': nrm(ks[23], (DEPTH, D_MODEL, D_FF), D_MODEL ** -0.5),
        'w_down': nrm(ks[24], (DEPTH, D_FF, D_MODEL), D_FF ** -0.5),
        'w_norm_final': 1.0 + nrm(ks[25], (D_MODEL,), 0.02),
    }


def reference(x_prompt, x_sample, cache_swa_k, cache_swa_v, state_conv, state_ssm, state_mlstm_C,
              state_mlstm_n, state_mlstm_m, w_norm_mix, w_in, attn_sinks, conv_w, conv_b, dt_bias, a_log,
              d_skip, w_norm_ssm, igate_b, fgate_b, w_norm_mlstm, w_out, w_norm_mlp, w_up, w_down,
              w_norm_final):
    hp, hs = x_prompt, x_sample
    st_p, st_s = [], []
    for l in range(DEPTH):
        lp = {'norm_mix': w_norm_mix[l], 'w_in': w_in[l], 'sinks': attn_sinks[l], 'conv_w': conv_w[l],
              'conv_b': conv_b[l], 'dt_bias': dt_bias[l], 'a_log': a_log[l], 'd_skip': d_skip[l],
              'ssm_norm': w_norm_ssm[l], 'igate_b': igate_b[l], 'fgate_b': fgate_b[l],
              'mlstm_norm': w_norm_mlstm[l], 'w_out': w_out[l], 'norm_mlp': w_norm_mlp[l],
              'w_up': w_up[l], 'w_down': w_down[l]}
        hp, sp = decoder_layer(hp, lp, None, None, None, None, None, None)
        hs, ss = decoder_layer(hs, lp, (cache_swa_k[l], cache_swa_v[l]), state_conv[l], state_ssm[l],
                               state_mlstm_C[l], state_mlstm_n[l], state_mlstm_m[l])
        st_p.append(sp)
        st_s.append(ss)
    y_prompt = rms_norm(hp, w_norm_final)
    y_sample = rms_norm(hs, w_norm_final)
    p_k, p_v, p_conv, p_ssm, p_C, p_n, p_m = [jnp.stack([s[i] for s in st_p]) for i in range(7)]
    s_k, s_v, s_conv, s_ssm, s_C, s_n, s_m = [jnp.stack([s[i] for s in st_s]) for i in range(7)]
    return (y_prompt, y_sample, p_k, p_v, p_conv, p_ssm, p_C, p_n, p_m,
            s_k, s_v, s_conv, s_ssm, s_C, s_n, s_m)
```

```cpp
#include <hip/hip_runtime.h>
#include <cstdio>
#include <cstdint>
namespace pg8 {
#define PG8_LAS __attribute__((address_space(3)))
typedef unsigned short bf16_t;
typedef short bf16x8 __attribute__((ext_vector_type(8)));
typedef float f32x4 __attribute__((ext_vector_type(4)));
typedef unsigned u32x4 __attribute__((ext_vector_type(4)));
constexpr int BM = 256, BK = 64, HALF = 128, HTB = HALF * BK * 2  , STAGE_BYTES = 8 * HTB, NXCD = 8, WGM = 8;

__host__ __device__ __forceinline__ int lds_byte(int r, int c) { const int st = (r >> 4) * 2 + (c >> 5), rr = r & 15, cc = c & 31, ob = rr * 64 + cc * 2; return st * 1024 + (ob ^ (((ob >> 9) & 1) << 5)); }
__host__ __device__ __forceinline__ void stage_rc(int b, int& R, int& C) { const int st = b / 1024, sb = b % 1024, swz = sb ^ (((sb >> 9) & 1) << 5); R = (st >> 1) * 16 + swz / 64; C = (st & 1) * 32 + (swz % 64) / 2; }
__host__ __device__ __forceinline__ int perm32(int rho) { const int n = rho >> 4, i = rho & 15; return 8 * (i >> 2) + 4 * n + (i & 3); }

struct Unit { int pm, pn; };
struct Gemm { const bf16_t* A; const bf16_t* Bt; int M, N, K; };

struct StaticOrder {
    int nM, nN, nwg, G, c;
    __host__ __device__ void init(int M, int N, int G_, int c_) { nM = M / BM; nN = N / BM; nwg = nM * nN; G = G_; c = c_; }
    __host__ __device__ bool next(int i, Unit& u) const {
        const long L = (long)i * G + c; if (L >= nwg) return false;
        int wgid = (int)L; { const int q = nwg / NXCD, r = nwg % NXCD, xcd = wgid % NXCD, off = wgid / NXCD; wgid = (xcd < r ? xcd * (q + 1) : r * (q + 1) + (xcd - r) * q) + off; }
        const int nig = WGM * nN, gid = wgid / nig, fm = gid * WGM, gsz = (nM - fm) < WGM ? (nM - fm) : WGM;
        u.pm = fm + ((wgid % nig) % gsz); u.pn = (wgid % nig) / gsz; return true;
    }
    __device__ __forceinline__ void a_ready(const Unit&) const {}
    __device__ __forceinline__ void done(const Unit&) const {}
};


__device__ __forceinline__ unsigned cvt_pk_bf16(float lo, float hi) { unsigned r; asm volatile("v_cvt_pk_bf16_f32 %0, %1, %2" : "=v"(r) : "v"(lo), "v"(hi)); return r; }

template <int ACT> struct EpiScaleBf16 {
    static constexpr bool PERM = true, AFTER_DRAIN = false;
    bf16_t* O; int ldc; const float* ssq;
    __device__ __forceinline__ void operator()(const f32x4 (&acc)[2][2][4][2], const Unit& u, int wr, int wc, int fr, int fq) const {
        const int row0 = u.pm * BM + wr * 64 + fr, col0 = u.pn * BM + wc * 32 + 8 * fq;
#pragma unroll
        for (int ai = 0; ai < 2; ++ai)
#pragma unroll
            for (int m = 0; m < 4; ++m) { const int row = row0 + ai * HALF + m * 16;
                const f32x4 p0 = *(const f32x4*)(ssq + (size_t)row * 8), p1 = *(const f32x4*)(ssq + (size_t)row * 8 + 4);
                const float ss = ((p0[0] + p0[1]) + (p0[2] + p0[3])) + ((p1[0] + p1[1]) + (p1[2] + p1[3]));
                const float rs = 1.0f / sqrtf(ss * (1.0f / 2048.0f) + 1e-6f);
                bf16_t* rowp = O + (size_t)row * ldc + col0;
#pragma unroll
                for (int bj = 0; bj < 2; ++bj) { f32x4 v0 = acc[ai][bj][m][0] * rs, v1 = acc[ai][bj][m][1] * rs;
                    if (ACT == 1) {
#pragma unroll
                        for (int e = 0; e < 4; ++e) { const float a = fmaxf(v0[e], 0.f), b = fmaxf(v1[e], 0.f); v0[e] = a * a; v1[e] = b * b; } }
                    u32x4 w; w.x = cvt_pk_bf16(v0[0], v0[1]); w.y = cvt_pk_bf16(v0[2], v0[3]); w.z = cvt_pk_bf16(v1[0], v1[1]); w.w = cvt_pk_bf16(v1[2], v1[3]);
                    *(u32x4*)(rowp + bj * HALF) = w; } }
    }
};

struct EpiResid {
    static constexpr bool PERM = false, AFTER_DRAIN = true;
    const float* base; float* out; bf16_t* xb; float* ssq; int ld;
    __device__ __forceinline__ void fused(f32x4 (&acc)[2][2][4][2], const Unit& u, int wr, int wc, int fr, int fq, PG8_LAS unsigned char* lds, int wid, int lane) const {
        typedef unsigned u32x2v __attribute__((ext_vector_type(2)));
        PG8_LAS float* P = (PG8_LAS float*)lds;
        const int col0 = u.pn * BM + wc * 32 + 4 * fq;
#pragma unroll
        for (int ai = 0; ai < 2; ++ai)
#pragma unroll
            for (int m = 0; m < 4; ++m) { const int r = ai * HALF + wr * 64 + m * 16 + fr; const size_t off = (size_t)(u.pm * BM + r) * ld + col0; float s = 0.f;
#pragma unroll
                for (int bj = 0; bj < 2; ++bj)
#pragma unroll
                    for (int n = 0; n < 2; ++n) { const f32x4 bs = *(const f32x4*)(base + off + bj * HALF + n * 16); const f32x4 o = bs + acc[ai][bj][m][n];
                        *(f32x4*)(out + off + bj * HALF + n * 16) = o;
                        if (xb) { u32x2v w; w.x = cvt_pk_bf16(o[0], o[1]); w.y = cvt_pk_bf16(o[2], o[3]); *(u32x2v*)(xb + off + bj * HALF + n * 16) = w; }
                        s += (o[0] * o[0] + o[1] * o[1]) + (o[2] * o[2] + o[3] * o[3]); }
                s += __shfl_xor(s, 16); s += __shfl_xor(s, 32);
                if (fq == 0) P[r * 4 + wc] = s;
                if (m & 1) asm volatile("" ::: "memory"); }
        asm volatile("s_waitcnt lgkmcnt(0)" ::: "memory"); __builtin_amdgcn_s_barrier(); asm volatile("" ::: "memory");
        const int t = wid * 64 + lane;
        if (t < 256) { const float s = (P[t * 4 + 0] + P[t * 4 + 1]) + (P[t * 4 + 2] + P[t * 4 + 3]); ssq[(size_t)(u.pm * BM + t) * 8 + u.pn] = s; }
        asm volatile("s_waitcnt lgkmcnt(0)" ::: "memory"); __builtin_amdgcn_s_barrier(); asm volatile("" ::: "memory");
    }
};
template <class Epi, class Sched, bool ALIGN_EPI = false, bool SP2 = false>
__device__ __forceinline__ void gemm_phase(PG8_LAS unsigned char* lds, const Gemm g, const Sched& S, const Epi& E, const int tid) {
    const int  wid = __builtin_amdgcn_readfirstlane(tid >> 6), lane = tid & 63, wr = wid >> 2, wc = wid & 3, fr = lane & 15, fq = lane >> 4;
    const int K = g.K, nt = K / BK;
    unsigned voffA[2], voffB[2];
#pragma unroll
    for (int i = 0; i < 2; ++i) { int R, C; stage_rc(tid * 16 + i * 8192, R, C); const int Rb = Epi::PERM ? ((R & ~31) + perm32(R & 31)) : R;
        voffA[i] = (unsigned)(R * K + C) * 2u; voffB[i] = (unsigned)(Rb * K + C) * 2u; }
    const size_t kstep = (size_t)(BK * 2);
    const size_t hstep = (size_t)HALF * K * 2;
    const size_t tstep = 2 * hstep;
    const unsigned ldsw = (unsigned)wid * 1024u;
    const int aoff = lds_byte(wr * 64 + fr, fq * 8), boff = lds_byte(wc * 32 + fr, fq * 8);
#define PG8_SA(b, h) (((b) * 2 + (h)) * HTB)
#define PG8_SB(b, h) ((4 + (b) * 2 + (h)) * HTB)
#define PG8_STAGE(bufoff, gbase, voff) do { _Pragma("unroll") for (int _i = 0; _i < 2; ++_i) \
        __builtin_amdgcn_global_load_lds((const unsigned*)((const char*)(gbase) + (voff)[_i]), (PG8_LAS unsigned*)(lds + (bufoff) + ldsw + _i * 8192), 16, 0, 0); } while (0)
#define PG8_LDA(dst, b, h) do { _Pragma("unroll") for (int m = 0; m < 4; ++m) _Pragma("unroll") for (int k = 0; k < 2; ++k) dst[m][k] = *(const PG8_LAS bf16x8*)(lds + PG8_SA(b, h) + aoff + m * 2048 + k * 1024); } while (0)
#define PG8_LDB(dst, b, h) do { _Pragma("unroll") for (int n = 0; n < 2; ++n) _Pragma("unroll") for (int k = 0; k < 2; ++k) dst[n][k] = *(const PG8_LAS bf16x8*)(lds + PG8_SB(b, h) + boff + n * 2048 + k * 1024); } while (0)
#define PG8_MMA(ai, bj, At, Bt) do { __builtin_amdgcn_s_setprio(1); _Pragma("unroll") for (int m = 0; m < 4; ++m) _Pragma("unroll") for (int n = 0; n < 2; ++n) _Pragma("unroll") for (int k = 0; k < 2; ++k) \
        acc[ai][bj][m][n] = __builtin_amdgcn_mfma_f32_16x16x32_bf16(Bt[n][k], At[m][k], acc[ai][bj][m][n], 0, 0, 0); __builtin_amdgcn_s_setprio(0); } while (0)
#define PG8_WAIT_V(n) asm volatile("s_waitcnt vmcnt(" #n ")" ::: "memory")
#define PG8_WAIT_L(n) asm volatile("s_waitcnt lgkmcnt(" #n ")" ::: "memory")
#define PG8_BAR __builtin_amdgcn_s_barrier()
#define PG8_SCHED __builtin_amdgcn_sched_barrier(0)
    Unit cur, nxt; int ui = 0;
    if (!S.next(0, cur)) return;
    f32x4 acc[2][2][4][2];
#pragma unroll
    for (int a = 0; a < 2; ++a)
#pragma unroll
        for (int b = 0; b < 2; ++b)
#pragma unroll
            for (int m = 0; m < 4; ++m)
#pragma unroll
                for (int n = 0; n < 2; ++n) acc[a][b][m][n] = (f32x4){0.f, 0.f, 0.f, 0.f};
    bf16x8 At[4][2], B0[2][2], B1[2][2];
    const char* cA = (const char*)g.A + (size_t)cur.pm * tstep; const char* cB = (const char*)g.Bt + (size_t)cur.pn * tstep;
    S.a_ready(cur);
    if constexpr (SP2) {
        PG8_STAGE(PG8_SB(0, 0), cB, voffB); PG8_STAGE(PG8_SB(0, 1), cB + hstep, voffB); PG8_STAGE(PG8_SA(0, 0), cA, voffA); PG8_STAGE(PG8_SA(0, 1), cA + hstep, voffA);
        if (wr == 1) PG8_BAR;
        PG8_WAIT_V(2); PG8_BAR;
        PG8_STAGE(PG8_SB(1, 0), cB + kstep, voffB); PG8_STAGE(PG8_SA(1, 0), cA + kstep, voffA); PG8_STAGE(PG8_SB(1, 1), cB + hstep + kstep, voffB);
        PG8_WAIT_V(6); PG8_BAR;
    } else {
        PG8_STAGE(PG8_SB(0, 0), cB, voffB); PG8_STAGE(PG8_SA(0, 0), cA, voffA); PG8_STAGE(PG8_SB(0, 1), cB + hstep, voffB); PG8_STAGE(PG8_SA(0, 1), cA + hstep, voffA);
        if (wr == 1) PG8_BAR;
        PG8_WAIT_V(4); PG8_BAR;
        PG8_STAGE(PG8_SB(1, 0), cB + kstep, voffB); PG8_STAGE(PG8_SA(1, 0), cA + kstep, voffA); PG8_STAGE(PG8_SB(1, 1), cB + hstep + kstep, voffB);
        PG8_WAIT_V(6); PG8_BAR;
    }
    for (;;) {
        const bool has_next = S.next(ui + 1, nxt);
        const char* nA = has_next ? (const char*)g.A + (size_t)nxt.pm * tstep : cA; const char* nB = has_next ? (const char*)g.Bt + (size_t)nxt.pn * tstep : cB;
        for (int t = 0; t < nt; t += 2) {
            const bool last = (t == nt - 2);
            const char* a1 = cA + (size_t)(t + 1) * kstep;
            const char* a2 = last ? nA : cA + (size_t)(t + 2) * kstep; const char* b2 = last ? nB : cB + (size_t)(t + 2) * kstep;
            const char* a3 = a2 + kstep; const char* b3 = b2 + kstep;
            if (last && has_next) S.a_ready(nxt);
            if constexpr (SP2) {
            PG8_LDB(B0, 0, 0); PG8_LDB(B1, 0, 1); PG8_SCHED; PG8_LDA(At, 0, 0); PG8_STAGE(PG8_SA(1, 1), a1 + hstep, voffA);
            PG8_WAIT_V(8); PG8_WAIT_L(0); PG8_BAR; PG8_MMA(0, 0, At, B0); PG8_MMA(0, 1, At, B1); PG8_BAR; PG8_SCHED;
            PG8_LDA(At, 0, 1); PG8_STAGE(PG8_SB(0, 0), b2, voffB); PG8_STAGE(PG8_SB(0, 1), b2 + hstep, voffB); PG8_STAGE(PG8_SA(0, 0), a2, voffA);
            PG8_WAIT_V(8); PG8_WAIT_L(0); PG8_BAR; PG8_MMA(1, 0, At, B0); PG8_MMA(1, 1, At, B1); PG8_BAR; PG8_SCHED;
            PG8_LDB(B0, 1, 0); PG8_LDB(B1, 1, 1); PG8_SCHED; PG8_LDA(At, 1, 0); PG8_STAGE(PG8_SA(0, 1), a2 + hstep, voffA);
            PG8_WAIT_V(8); PG8_WAIT_L(0); PG8_BAR; PG8_MMA(0, 0, At, B0); PG8_MMA(0, 1, At, B1); PG8_BAR; PG8_SCHED;
            PG8_LDA(At, 1, 1); PG8_STAGE(PG8_SB(1, 0), b3, voffB); PG8_STAGE(PG8_SB(1, 1), b3 + hstep, voffB); PG8_STAGE(PG8_SA(1, 0), a3, voffA);
            PG8_WAIT_V(8); PG8_WAIT_L(0); PG8_BAR; PG8_MMA(1, 0, At, B0); PG8_MMA(1, 1, At, B1); PG8_BAR; PG8_SCHED;
            } else {
            PG8_LDB(B0, 0, 0); PG8_SCHED; PG8_LDA(At, 0, 0); PG8_STAGE(PG8_SA(1, 1), a1 + hstep, voffA);
            PG8_WAIT_L(8); PG8_BAR; PG8_WAIT_L(0); PG8_MMA(0, 0, At, B0); PG8_BAR; PG8_SCHED;
            PG8_LDB(B1, 0, 1); PG8_STAGE(PG8_SB(0, 0), b2, voffB);
            PG8_BAR; PG8_WAIT_L(0); PG8_MMA(0, 1, At, B1); PG8_BAR;
            PG8_LDA(At, 0, 1); PG8_STAGE(PG8_SA(0, 0), a2, voffA);
            PG8_BAR; PG8_WAIT_L(0); PG8_MMA(1, 0, At, B0); PG8_BAR; PG8_SCHED;
            PG8_STAGE(PG8_SB(0, 1), b2 + hstep, voffB);
            PG8_WAIT_V(6); PG8_BAR; PG8_MMA(1, 1, At, B1); PG8_BAR;
            PG8_LDB(B0, 1, 0); PG8_SCHED; PG8_LDA(At, 1, 0); PG8_STAGE(PG8_SA(0, 1), a2 + hstep, voffA);
            PG8_WAIT_L(8); PG8_BAR; PG8_WAIT_L(0); PG8_MMA(0, 0, At, B0); PG8_BAR; PG8_SCHED;
            PG8_LDB(B1, 1, 1); PG8_STAGE(PG8_SB(1, 0), b3, voffB);
            PG8_BAR; PG8_WAIT_L(0); PG8_MMA(0, 1, At, B1); PG8_BAR;
            PG8_LDA(At, 1, 1); PG8_STAGE(PG8_SA(1, 0), a3, voffA);
            PG8_BAR; PG8_WAIT_L(0); PG8_MMA(1, 0, At, B0); PG8_BAR; PG8_SCHED;
            PG8_STAGE(PG8_SB(1, 1), b3 + hstep, voffB);
            PG8_WAIT_V(6); PG8_BAR; PG8_MMA(1, 1, At, B1); PG8_BAR;
            }
        }
        if constexpr (ALIGN_EPI) { if (wr == 0) PG8_BAR; }
        if constexpr (!Epi::AFTER_DRAIN) { E(acc, cur, wr, wc, fr, fq); S.done(cur); }
        if (!has_next) break;
#pragma unroll
        for (int a = 0; a < 2; ++a)
#pragma unroll
            for (int b = 0; b < 2; ++b)
#pragma unroll
                for (int m = 0; m < 4; ++m)
#pragma unroll
                    for (int n = 0; n < 2; ++n) acc[a][b][m][n] = (f32x4){0.f, 0.f, 0.f, 0.f};
        cur = nxt; cA = nA; cB = nB; ++ui;
        if constexpr (ALIGN_EPI) { if (wr == 1) PG8_BAR; }
    }
    PG8_WAIT_V(0);
    if constexpr (!ALIGN_EPI) { if (wr == 0) PG8_BAR; }
    PG8_BAR;
    if constexpr (Epi::AFTER_DRAIN) { E.fused(acc, cur, wr, wc, fr, fq, lds, wid, lane); S.done(cur); }
#undef PG8_SA
#undef PG8_SB
#undef PG8_STAGE
#undef PG8_LDA
#undef PG8_LDB
#undef PG8_MMA
#undef PG8_WAIT_V
#undef PG8_WAIT_L
#undef PG8_BAR
#undef PG8_SCHED
}
}

#ifndef PG8_SP2
#define PG8_SP2 true
#endif
#ifndef PG8_ALIGN
#define PG8_ALIGN true
#endif
#define GAS __attribute__((address_space(1)))
#define LAS __attribute__((address_space(3)))
typedef unsigned short bf16;
typedef unsigned v4u __attribute__((ext_vector_type(4)));
typedef float f32x4 __attribute__((ext_vector_type(4)));
typedef short bf16x8 __attribute__((ext_vector_type(8)));
typedef GAS unsigned gu32;
typedef GAS unsigned long long gu64;
#define RLX_AGENT __ATOMIC_RELAXED, __HIP_MEMORY_SCOPE_AGENT
#define LDS_WAIT() asm volatile("s_waitcnt lgkmcnt(0)" ::: "memory")
#define VM_WAIT() asm volatile("s_waitcnt vmcnt(0)" ::: "memory")
__device__ __forceinline__ unsigned long long rt() { return __builtin_amdgcn_s_memrealtime(); }
__device__ __forceinline__ unsigned f2bf(float f) { unsigned u = __builtin_bit_cast(unsigned, f); return (u + 0x7fffu + ((u >> 16) & 1u)) >> 16; }
__device__ __forceinline__ unsigned pk2(float lo, float hi) { return f2bf(lo) | (f2bf(hi) << 16); }

#define XB_TMO      128
#define XB_XCNT(j)  (256  + 64 * (j))
#define XB_XSUB(j)  (1280 + 64 * (j))
#define XB_XGEN(j)  (2304 + 64 * (j))
#define XB_TOP      3328
#define XB_TOPGEN   3392
#define XCD_BAR_WORDS 3456
#define XB_SPIN_CAP (1u << 18)

__device__ __forceinline__ unsigned xb_ld(unsigned* p)              { return __hip_atomic_load(p, __ATOMIC_RELAXED, __HIP_MEMORY_SCOPE_AGENT); }
__device__ __forceinline__ unsigned xb_add(unsigned* p, unsigned v) { return __hip_atomic_fetch_add(p, v, __ATOMIC_RELAXED, __HIP_MEMORY_SCOPE_AGENT); }
__device__ __forceinline__ unsigned xb_xcc_id() { return (unsigned)__builtin_amdgcn_s_getreg((3 << 11) | 20) & 0xFu; }
#define XB_SPIN(cond, bar) do { unsigned _sp = 0; while (cond) { __builtin_amdgcn_s_sleep(1); \
    if ((++_sp & 255u) == 0u) { if (xb_ld(&(bar)[XB_TMO])) break; if (_sp > XB_SPIN_CAP) { atomicAdd(&(bar)[XB_TMO], 1u); break; } } } } while (0)

struct XcdBarrier {
    unsigned* bar; unsigned x;
    volatile LAS unsigned* st;
};

__device__ __forceinline__ XcdBarrier xcd_barrier_post(unsigned* bar, volatile LAS unsigned* st) {
    XcdBarrier b; b.bar = bar; b.x = xb_xcc_id(); b.st = st;
    if (threadIdx.x == 0) (void)xb_add(&bar[XB_XCNT(b.x)], 1u);
    return b;
}
__device__ __forceinline__ void xcd_barrier_complete(unsigned* bar, unsigned x, unsigned& nloc, unsigned& nx) {
    const unsigned G = gridDim.x * gridDim.y * gridDim.z;
    unsigned sum, cnt, mine, sp = 0u;
    for (;;) {
        sum = 0u; cnt = 0u; mine = 0u;
#pragma unroll
        for (unsigned j = 0; j < 16; ++j) { const unsigned c = xb_ld(&bar[XB_XCNT(j)]); sum += c; cnt += (c > 0u) ? 1u : 0u; mine = (j == x) ? c : mine; }
        if (sum == G) break;
        __builtin_amdgcn_s_sleep(1);
        if ((++sp & 255u) == 0u) { if (xb_ld(&bar[XB_TMO])) break; if (sp > XB_SPIN_CAP) { atomicAdd(&bar[XB_TMO], 1u); break; } }
    }
    nloc = mine > 0u ? mine : 1u; nx = cnt > 0u ? cnt : 1u;
}

__device__ __forceinline__ void xcd_barrier(const XcdBarrier& b) {
    asm volatile("s_waitcnt vmcnt(0)" ::: "memory");
    __syncthreads();
    if (threadIdx.x == 0) {
        unsigned* bar = b.bar;
        __builtin_amdgcn_s_waitcnt(0);
        unsigned nloc = b.st[0], nx = b.st[1];
        if (nloc == 0u) { xcd_barrier_complete(bar, b.x, nloc, nx); b.st[0] = nloc; b.st[1] = nx; }
        const unsigned old = xb_add(&bar[XB_XSUB(b.x)], 1u);
        const unsigned gen = old / nloc;
        if (old + 1u == (gen + 1u) * nloc) {
            __builtin_amdgcn_fence(__ATOMIC_RELEASE, "agent");
            asm volatile("s_waitcnt vmcnt(0)" ::: "memory");
            const unsigned og = xb_add(&bar[XB_TOP], 1u);
            const unsigned tg = og / nx;
            if (og + 1u == (tg + 1u) * nx) xb_add(&bar[XB_TOPGEN], 1u);
            else XB_SPIN(xb_ld(&bar[XB_TOPGEN]) == tg, bar);
            __builtin_amdgcn_fence(__ATOMIC_ACQUIRE, "agent");
            xb_add(&bar[XB_XGEN(b.x)], 1u);
            asm volatile("s_waitcnt vmcnt(0)" ::: "memory");
        } else {
            XB_SPIN(xb_ld(&bar[XB_XGEN(b.x)]) == gen, bar);
            __builtin_amdgcn_fence(__ATOMIC_ACQUIRE, "agent");
            asm volatile("s_waitcnt vmcnt(0)" ::: "memory");
        }
    }
    __syncthreads();
}

constexpr int NWAVES = 8, NTHR = 512;
constexpr int DM = 2048, SEQL = 2048, NB = 4, MP = NB * SEQL  , MS = 128  , MT = MP + MS, MPAD = 8448;
constexpr int NIN = 5400, NINP = 5632, FF = 8192, DEPTH = 2;
constexpr int C_Q = 0, C_K = 512, C_V = 640, C_Z = 768, C_XBC = 1792, C_MQ = 3328, C_MK = 3840, C_MV = 4352, C_MO = 4864, C_DT = 5376, C_MI = 5392, C_MF = 5396;
constexpr int XCW = 1536;
constexpr size_t O_Y = 0, O_PK = 17039360, O_PV = 17170432, O_PCONV = 17301504, O_PSSM = 17338368, O_PC = 18386944, O_PN = 18911232, O_PM = 18915328,
                 O_SK = 18915360, O_SV = 23109664, O_SCONV = 27303968, O_SSSM = 28483616, O_SC = 62038048, O_SN = 78815264, O_SM = 78946336, O_END = 78947360;

constexpr size_t MiB = 1u << 20;
constexpr size_t WS_CTL = 0, CTL_ZERO_BYTES = 1 * MiB;
constexpr size_t WS_SSQA = 1 * MiB, WS_SSQB = 1 * MiB + 512 * 1024;
constexpr size_t WS_WIN = 2 * MiB, WIN_BYTES = 22 * MiB;
constexpr size_t WS_WOUT = 46 * MiB, WOUT_BYTES = 8 * MiB;
constexpr size_t WS_WUP = 62 * MiB, WUP_BYTES = 32 * MiB;
constexpr size_t WS_WDN = 126 * MiB, WDN_BYTES = 32 * MiB;
constexpr size_t WS_XB = 190 * MiB;
constexpr size_t WS_XRES = 223 * MiB;
constexpr size_t WS_HBUF = 289 * MiB;
constexpr size_t WS_PROJ = 289 * MiB;
constexpr size_t WS_MIXED = 380 * MiB;
constexpr size_t WS_XC = 421 * MiB;
constexpr size_t WS_YG = 446 * MiB;
constexpr size_t WS_HR = 479 * MiB;
constexpr size_t WS_END = 496 * MiB;
static_assert(WS_PROJ + (size_t)MPAD * NINP * 2 <= WS_MIXED && WS_MIXED + (size_t)MPAD * DM * 2 <= WS_XC && WS_HBUF + (size_t)MPAD * FF * 2 <= WS_XC, "ws map");
constexpr int CW_BAR = 4096;
constexpr int CW_QUEUE = 16384;

constexpr int RING_OFF = 0, RING_BYTES = 131072;
constexpr int LDSCTL_OFF = RING_BYTES, MISC_OFF = LDSCTL_OFF + 320;
constexpr int LDS_BYTES = 147456;

struct Args { const float* in[26]; float* out; unsigned char* ws; int ph_lo, ph_hi; };
typedef const __attribute__((address_space(4))) unsigned long long* karg_t;
__device__ __forceinline__ unsigned long long karg_u64(int idx) { int j = idx; asm volatile("" : "+s"(j)); return ((karg_t)__builtin_amdgcn_kernarg_segment_ptr())[j]; }
#define ARGIN(i) ((const float*)karg_u64(i))
#define ARGOUT() ((float*)karg_u64(26))
#define ARGWS() ((unsigned char*)karg_u64(27))

struct Frame {
    LAS unsigned char* lds;
    volatile LAS unsigned* MISC;
    gu32* ctl;
    int tid, lane, wave, vcu, G;
};

__device__ __forceinline__ float bf2f(unsigned short u) { return __builtin_bit_cast(float, (unsigned)u << 16); }
__device__ __forceinline__ float bflo(unsigned u) { return __builtin_bit_cast(float, u << 16); }
__device__ __forceinline__ float bfhi(unsigned u) { return __builtin_bit_cast(float, u & 0xffff0000u); }
__device__ __forceinline__ void unpack8(const v4u w, float (&f)[8]) { f[0] = bflo(w.x); f[1] = bfhi(w.x); f[2] = bflo(w.y); f[3] = bfhi(w.y); f[4] = bflo(w.z); f[5] = bfhi(w.z); f[6] = bflo(w.w); f[7] = bfhi(w.w); }
__device__ __forceinline__ v4u pack8(const float (&f)[8]) { v4u w; w.x = pk2(f[0], f[1]); w.y = pk2(f[2], f[3]); w.z = pk2(f[4], f[5]); w.w = pk2(f[6], f[7]); return w; }
__device__ __forceinline__ float wave_sum(float v) {
#pragma unroll
    for (int o = 1; o < 64; o <<= 1) v += __shfl_xor(v, o);
    return v;
}
__device__ __forceinline__ float wave_max(float v) {
#pragma unroll
    for (int o = 1; o < 64; o <<= 1) v = fmaxf(v, __shfl_xor(v, o));
    return v;
}
__device__ __forceinline__ float sigmoidf_(float x) { return 1.0f / (1.0f + expf(-x)); }
__device__ __forceinline__ float siluf_(float x) { return x / (1.0f + expf(-x)); }
__device__ __forceinline__ float softplusf_(float x) { return fmaxf(x, 0.f) + log1pf(expf(-fabsf(x))); }
__device__ __forceinline__ float logsigmoidf_(float x) { return fminf(x, 0.f) - log1pf(expf(-fabsf(x))); }
#define ROPE_INV(i) ((i) == 0 ? 1.0f : (i) == 1 ? 0.1939227432012558f : (i) == 2 ? 0.03760603070259094f : (i) == 3 ? 0.007292664609849453f : (i) == 4 ? 0.0014142135623842478f : (i) == 5 ? 0.00027424818836152554f : (i) == 6 ? 5.318296098266728e-05f : 1.0313386155758053e-05f)
__device__ __forceinline__ void rope_cs(int pos, float (&c)[8], float (&s)[8]) {
#pragma unroll
    for (int i = 0; i < 8; ++i) { const float ang = (float)pos * ROPE_INV(i); double rev = (double)ang * 0.15915494309189535; rev -= __builtin_rint(rev); const float fr = (float)rev;
        c[i] = __builtin_amdgcn_cosf(fr); s[i] = __builtin_amdgcn_sinf(fr); }
}

template <int MODE> __device__ __forceinline__ int colmap(int n) {
    if (MODE == 0) return n;
    if (n < 3328) return n; if (n < 5376) return n + 16; if (n < 5392) return n - 2048; if (n < 5400) return n; return -1;
}
template <int MODE> __device__ __forceinline__ void p0_transpose_item(const float* W, int K, int Norig, int Nrows, const float* gain, bf16* WT, LAS float* scr, int item, int lane) {
    const int nblk = Nrows / 32, kb = item / nblk, nb = item % nblk, k0 = 64 * kb, n0 = 32 * nb;
    const int oc = colmap<MODE>(n0 + (lane & 31));
#pragma unroll 8
    for (int i = 0; i < 32; ++i) { const int kk = 2 * i + (lane >> 5); float v = 0.f; if (oc >= 0) { v = W[(size_t)(k0 + kk) * Norig + oc]; if (gain) v *= gain[k0 + kk]; } scr[kk * 33 + (lane & 31)] = v; }
    LDS_WAIT(); asm volatile("" ::: "memory");
    const int c = lane & 7;
#pragma unroll
    for (int j = 0; j < 4; ++j) { const int n = (lane >> 3) + 8 * j; const LAS float* s = scr + (8 * c) * 33 + n;
        v4u o; o.x = pk2(s[0 * 33], s[1 * 33]); o.y = pk2(s[2 * 33], s[3 * 33]); o.z = pk2(s[4 * 33], s[5 * 33]); o.w = pk2(s[6 * 33], s[7 * 33]);
        *(GAS v4u*)(WT + (size_t)(n0 + n) * K + k0 + 8 * c) = o; }
    LDS_WAIT(); asm volatile("" ::: "memory");
}
__device__ __forceinline__ void x_row_to_bf16(int lane, const float* xrow, bf16* orow, float* ssqrow) {
    const GAS f32x4* xr = (const GAS f32x4*)xrow + lane;
    f32x4 v[8]; float s = 0.f;
#pragma unroll
    for (int j = 0; j < 8; ++j) { v[j] = xr[64 * j]; s += (v[j].x * v[j].x + v[j].y * v[j].y) + (v[j].z * v[j].z + v[j].w * v[j].w); }
    s = wave_sum(s);
    GAS unsigned long long* o8 = (GAS unsigned long long*)orow + lane;
#pragma unroll
    for (int j = 0; j < 8; ++j) o8[64 * j] = (unsigned long long)pk2(v[j].x, v[j].y) | ((unsigned long long)pk2(v[j].z, v[j].w) << 32);
    if (lane < 8) ssqrow[lane] = lane == 0 ? s : 0.f;
}
__device__ __forceinline__ void p0_prologue(Frame& F, const Args& a) {
    LAS float* scr = (LAS float*)(F.lds + RING_OFF + F.wave * 16384);
    const int gw = F.vcu * NWAVES + F.wave, NGW = F.G * NWAVES;
    constexpr int I_IN = (DM / 64) * (NINP / 32), I_OUT = (DM / 64) * (DM / 32), I_UP = (DM / 64) * (FF / 32), I_DN = (FF / 64) * (DM / 32);
    constexpr int PER_L = I_IN + I_OUT + I_UP + I_DN;
    unsigned char* ws = ARGWS();
    for (int it = gw; it < DEPTH * PER_L; it += NGW) {
        const int l = it / PER_L; int r = it % PER_L;
        if (r < I_IN) { p0_transpose_item<1>(ARGIN(10) + (size_t)l * DM * NIN, DM, NIN, NINP, ARGIN(9) + l * DM, (bf16*)(ws + WS_WIN + l * WIN_BYTES), scr, r, F.lane); continue; } r -= I_IN;
        if (r < I_OUT) { p0_transpose_item<0>(ARGIN(21) + (size_t)l * DM * DM, DM, DM, DM, nullptr, (bf16*)(ws + WS_WOUT + l * WOUT_BYTES), scr, r, F.lane); continue; } r -= I_OUT;
        if (r < I_UP) { p0_transpose_item<0>(ARGIN(23) + (size_t)l * DM * FF, DM, FF, FF, ARGIN(22) + l * DM, (bf16*)(ws + WS_WUP + l * WUP_BYTES), scr, r, F.lane); continue; } r -= I_UP;
        p0_transpose_item<0>(ARGIN(24) + (size_t)l * FF * DM, FF, DM, DM, nullptr, (bf16*)(ws + WS_WDN + l * WDN_BYTES), scr, r, F.lane);
    }
    bf16* XB = (bf16*)(ws + WS_XB); float* SSQA = (float*)(ws + WS_SSQA);
    for (int m = gw; m < MPAD; m += NGW) {
        if (m < MT) x_row_to_bf16(F.lane, m < MP ? ARGIN(0) + (size_t)m * DM : ARGIN(1) + (size_t)(m - MP) * DM, XB + (size_t)m * DM, SSQA + (size_t)m * 8);
        else { GAS v4u* o = (GAS v4u*)(XB + (size_t)m * DM) + F.lane;
#pragma unroll
            for (int j = 0; j < 4; ++j) o[64 * j] = (v4u){0u, 0u, 0u, 0u};
            if (F.lane < 8) SSQA[(size_t)m * 8 + F.lane] = 1.0f; }
    }
}

template <class EP> __device__ __forceinline__ void thin_gemm(Frame& F, const bf16* A, int lda, const bf16* Bt, int N, int K, const EP& epi) {
    const int fr = F.lane & 15, fq = F.lane >> 4;
    for (int item = F.vcu; item < N / 16; item += F.G) {
        const int n0 = item * 16;
        const GAS bf16x8* ap = (const GAS bf16x8*)(A + (size_t)(16 * F.wave + fr) * lda + 8 * fq);
        const GAS bf16x8* bp = (const GAS bf16x8*)(Bt + (size_t)(n0 + fr) * K + 8 * fq);
        f32x4 acc0 = (f32x4){0.f, 0.f, 0.f, 0.f}, acc1 = acc0;
        for (int k = 0; k < K / 8; k += 32) {
            bf16x8 a[8], b[8];
#pragma unroll
            for (int u = 0; u < 8; ++u) { a[u] = ap[k + 4 * u]; b[u] = bp[k + 4 * u]; }
#pragma unroll
            for (int u = 0; u < 8; u += 2) { acc0 = __builtin_amdgcn_mfma_f32_16x16x32_bf16(b[u], a[u], acc0, 0, 0, 0); acc1 = __builtin_amdgcn_mfma_f32_16x16x32_bf16(b[u + 1], a[u + 1], acc1, 0, 0, 0); }
        }
        epi(16 * F.wave + fr, n0 + 4 * fq, acc0 + acc1);
    }
}

__device__ __forceinline__ void conv_phase(Frame& F, const Args& a, int l) {
    const bf16* PROJ = (const bf16*)(ARGWS() + WS_PROJ); bf16* XC = (bf16*)(ARGWS() + WS_XC);
    const float* cw = ARGIN(12) + (size_t)l * 4 * XCW; const float* cb = ARGIN(13) + (size_t)l * XCW; const float* sconv = ARGIN(4) + (size_t)l * MS * 3 * XCW;
    float* pconv = ARGOUT() + O_PCONV + (size_t)l * NB * 3 * XCW; float* sconv_o = ARGOUT() + O_SCONV + (size_t)l * MS * 3 * XCW;
    for (int idx = F.vcu * NTHR + F.tid; idx < MT * (XCW / 8); idx += F.G * NTHR) {
        const int row = idx / (XCW / 8), c0 = (idx % (XCW / 8)) * 8;
        float r[4][8];
        if (row < MP) { const int t = row & (SEQL - 1);
#pragma unroll
            for (int j = 0; j < 4; ++j) { const int tt = t - 3 + j;
                if (tt >= 0) { const v4u w = *(const GAS v4u*)(PROJ + (size_t)(row - 3 + j) * NINP + C_XBC + c0); unpack8(w, r[j]); }
                else {
#pragma unroll
                    for (int i = 0; i < 8; ++i) r[j][i] = 0.f; } }
        } else { const int b = row - MP;
#pragma unroll
            for (int j = 0; j < 3; ++j) { const f32x4 u0 = *(const GAS f32x4*)(sconv + (size_t)(b * 3 + j) * XCW + c0), u1 = *(const GAS f32x4*)(sconv + (size_t)(b * 3 + j) * XCW + c0 + 4);
                r[j][0] = u0.x; r[j][1] = u0.y; r[j][2] = u0.z; r[j][3] = u0.w; r[j][4] = u1.x; r[j][5] = u1.y; r[j][6] = u1.z; r[j][7] = u1.w; }
            const v4u w = *(const GAS v4u*)(PROJ + (size_t)row * NINP + C_XBC + c0); unpack8(w, r[3]);
        }
        float y[8];
#pragma unroll
        for (int i = 0; i < 8; ++i) { float acc = cb[c0 + i];
#pragma unroll
            for (int j = 0; j < 4; ++j) acc += cw[j * XCW + c0 + i] * r[j][i];
            y[i] = siluf_(acc); }
        *(GAS v4u*)(XC + (size_t)row * XCW + c0) = pack8(y);
        if (row < MP) { const int t = row & (SEQL - 1), b = row >> 11;
            if (t >= SEQL - 3) { float* o = pconv + (size_t)(b * 3 + (t - (SEQL - 3))) * XCW + c0;
                *(GAS f32x4*)o = (f32x4){r[3][0], r[3][1], r[3][2], r[3][3]}; *(GAS f32x4*)(o + 4) = (f32x4){r[3][4], r[3][5], r[3][6], r[3][7]}; }
        } else { const int b = row - MP;
#pragma unroll
            for (int j = 0; j < 3; ++j) { float* o = sconv_o + (size_t)(b * 3 + j) * XCW + c0;
                *(GAS f32x4*)o = (f32x4){r[j + 1][0], r[j + 1][1], r[j + 1][2], r[j + 1][3]}; *(GAS f32x4*)(o + 4) = (f32x4){r[j + 1][4], r[j + 1][5], r[j + 1][6], r[j + 1][7]}; }
        }
    }
}

__device__ __forceinline__ void ssd_seq_item(Frame& F, const Args& a, int l, int b, int h, bool sample) {
    const bf16* PROJ = (const bf16*)(ARGWS() + WS_PROJ); const bf16* XC = (const bf16*)(ARGWS() + WS_XC); float* YG = (float*)(ARGWS() + WS_YG);
    const int row0 = sample ? MP + b : b * SEQL, L = sample ? 1 : SEQL, g = h >> 3, tid = F.tid;
    const float A = -expf(ARGIN(15)[l * 16 + h]), dtb = ARGIN(14)[l * 16 + h], Dh = ARGIN(16)[l * 16 + h];
    const int p = tid >> 3, nq = tid & 7;
    float S[16];
    if (sample) { const float* s0 = ARGIN(5) + ((((size_t)l * MS + b) * 16 + h) * 64 + p) * 128 + nq * 16;
#pragma unroll
        for (int i = 0; i < 4; ++i) { const f32x4 v = *(const GAS f32x4*)(s0 + 4 * i); S[4 * i] = v.x; S[4 * i + 1] = v.y; S[4 * i + 2] = v.z; S[4 * i + 3] = v.w; } }
    else {
#pragma unroll
        for (int i = 0; i < 16; ++i) S[i] = 0.f; }
    LAS float* xs = (LAS float*)(F.lds);
    LAS float* Bs = (LAS float*)(F.lds + 16384);
    LAS float* Cs = (LAS float*)(F.lds + 49152);
    LAS float* ys = (LAS float*)(F.lds + 81920);
    LAS float* dts = (LAS float*)(F.lds + 98304);
    LAS float* das = (LAS float*)(F.lds + 98304 + 256);
    for (int t0 = 0; t0 < L; t0 += 64) {
        const int nb = (L - t0) < 64 ? (L - t0) : 64;
        __syncthreads();
        { const int tt = tid >> 3, ch = tid & 7;
          if (tt < nb) { float f[8]; unpack8(*(const GAS v4u*)(XC + (size_t)(row0 + t0 + tt) * XCW + h * 64 + ch * 8), f);
#pragma unroll
              for (int i = 0; i < 8; ++i) xs[tt * 64 + ch * 8 + i] = f[i]; } }
#pragma unroll
        for (int rep = 0; rep < 2; ++rep) { const int task = tid + rep * NTHR, tt = task >> 4, ch = task & 15;
          if (tt < nb) { float f[8]; unpack8(*(const GAS v4u*)(XC + (size_t)(row0 + t0 + tt) * XCW + 1024 + g * 128 + ch * 8), f);
#pragma unroll
              for (int i = 0; i < 8; ++i) Bs[tt * 128 + ch * 8 + i] = f[i];
              unpack8(*(const GAS v4u*)(XC + (size_t)(row0 + t0 + tt) * XCW + 1280 + g * 128 + ch * 8), f);
#pragma unroll
              for (int i = 0; i < 8; ++i) Cs[tt * 128 + ch * 8 + i] = f[i]; } }
        if (tid < nb) { const float dt = softplusf_(bf2f(PROJ[(size_t)(row0 + t0 + tid) * NINP + C_DT + h]) + dtb); dts[tid] = dt; das[tid] = expf(dt * A); }
        __syncthreads();
        for (int tt = 0; tt < nb; ++tt) {
            const float dt = dts[tt], dA = das[tt], x = xs[tt * 64 + p], coef = dt * x;
            float y = 0.f;
#pragma unroll
            for (int i = 0; i < 16; ++i) { S[i] = dA * S[i] + coef * Bs[tt * 128 + nq * 16 + i]; y += S[i] * Cs[tt * 128 + nq * 16 + i]; }
            y += __shfl_xor(y, 1); y += __shfl_xor(y, 2); y += __shfl_xor(y, 4);
            if (nq == 0) ys[tt * 64 + p] = y + Dh * x;
        }
        __syncthreads();
        { const int tt = tid >> 3, ch = tid & 7;
          if (tt < nb) { float z[8]; unpack8(*(const GAS v4u*)(PROJ + (size_t)(row0 + t0 + tt) * NINP + C_Z + h * 64 + ch * 8), z);
              float o[8];
#pragma unroll
              for (int i = 0; i < 8; ++i) o[i] = ys[tt * 64 + ch * 8 + i] * siluf_(z[i]);
              float* dst = YG + (size_t)(row0 + t0 + tt) * 1024 + h * 64 + ch * 8;
              *(GAS f32x4*)dst = (f32x4){o[0], o[1], o[2], o[3]}; *(GAS f32x4*)(dst + 4) = (f32x4){o[4], o[5], o[6], o[7]}; } }
    }
    float* so = ARGOUT() + (sample ? O_SSSM + ((((size_t)l * MS + b) * 16 + h) * 64 + p) * 128 : O_PSSM + ((((size_t)l * NB + b) * 16 + h) * 64 + p) * 128) + nq * 16;
#pragma unroll
    for (int i = 0; i < 4; ++i) *(GAS f32x4*)(so + 4 * i) = (f32x4){S[4 * i], S[4 * i + 1], S[4 * i + 2], S[4 * i + 3]};
}

__device__ __forceinline__ void mlstm_seq_item(Frame& F, const Args& a, int l, int b, int h, int es, bool sample) {
    const bf16* PROJ = (const bf16*)(ARGWS() + WS_PROJ); float* HR = (float*)(ARGWS() + WS_HR);
    const int row0 = sample ? MP + b : b * SEQL, L = sample ? 1 : SEQL, tid = F.tid, w = F.wave, lane = F.lane;
    const int e0 = es * 32 + w * 4, d0 = 2 * lane, Bn = sample ? MS : NB;
    const float ib = ARGIN(18)[l * 4 + h], fb = ARGIN(19)[l * 4 + h];
    float C[2][4], n[2], m;
    if (sample) {
#pragma unroll
        for (int dd = 0; dd < 2; ++dd) { const f32x4 v = *(const GAS f32x4*)(ARGIN(6) + ((((size_t)l * MS + b) * 4 + h) * 128 + d0 + dd) * 128 + e0);
            C[dd][0] = v.x; C[dd][1] = v.y; C[dd][2] = v.z; C[dd][3] = v.w; n[dd] = ARGIN(7)[(((size_t)l * MS + b) * 4 + h) * 128 + d0 + dd]; }
        m = ARGIN(8)[((size_t)l * MS + b) * 4 + h];
    } else {
#pragma unroll
        for (int dd = 0; dd < 2; ++dd) { n[dd] = 0.f;
#pragma unroll
            for (int j = 0; j < 4; ++j) C[dd][j] = 0.f; }
        m = 0.f;
    }
    LAS float* qs = (LAS float*)(F.lds);
    LAS float* ks = (LAS float*)(F.lds + 32768);
    LAS float* vs = (LAS float*)(F.lds + 65536);
    LAS float* hs = (LAS float*)(F.lds + 73728);
    LAS float* igs = (LAS float*)(F.lds + 81920);
    LAS float* lfs = (LAS float*)(F.lds + 81920 + 256);
    for (int t0 = 0; t0 < L; t0 += 64) {
        const int nb = (L - t0) < 64 ? (L - t0) : 64;
        __syncthreads();
#pragma unroll
        for (int rep = 0; rep < 2; ++rep) { const int task = tid + rep * NTHR, tt = task >> 4, ch = task & 15;
          if (tt < nb) { float f[8]; unpack8(*(const GAS v4u*)(PROJ + (size_t)(row0 + t0 + tt) * NINP + C_MQ + h * 128 + ch * 8), f);
#pragma unroll
              for (int i = 0; i < 8; ++i) qs[tt * 128 + ch * 8 + i] = f[i];
              unpack8(*(const GAS v4u*)(PROJ + (size_t)(row0 + t0 + tt) * NINP + C_MK + h * 128 + ch * 8), f);
#pragma unroll
              for (int i = 0; i < 8; ++i) ks[tt * 128 + ch * 8 + i] = f[i] * 0.08838834764831845f; } }
        if (tid < 256) { const int tt = tid >> 2, ch = tid & 3;
          if (tt < nb) { float f[8]; unpack8(*(const GAS v4u*)(PROJ + (size_t)(row0 + t0 + tt) * NINP + C_MV + h * 128 + es * 32 + ch * 8), f);
#pragma unroll
              for (int i = 0; i < 8; ++i) vs[tt * 32 + ch * 8 + i] = f[i]; } }
        if (tid < nb) { igs[tid] = bf2f(PROJ[(size_t)(row0 + t0 + tid) * NINP + C_MI + h]) + ib; lfs[tid] = logsigmoidf_(bf2f(PROJ[(size_t)(row0 + t0 + tid) * NINP + C_MF + h]) + fb); }
        __syncthreads();
        for (int tt = 0; tt < nb; ++tt) {
            const float lf = lfs[tt], ig = igs[tt];
            const float m_new = fmaxf(lf + m, ig), fgt = expf(lf + m - m_new), igt = expf(ig - m_new); m = m_new;
            const float q0 = qs[tt * 128 + d0], q1 = qs[tt * 128 + d0 + 1], k0 = ks[tt * 128 + d0] * igt, k1 = ks[tt * 128 + d0 + 1] * igt;
            n[0] = fgt * n[0] + k0; n[1] = fgt * n[1] + k1;
            float red[5]; red[4] = q0 * n[0] + q1 * n[1];
#pragma unroll
            for (int j = 0; j < 4; ++j) { const float v = vs[tt * 32 + w * 4 + j]; C[0][j] = fgt * C[0][j] + k0 * v; C[1][j] = fgt * C[1][j] + k1 * v; red[j] = q0 * C[0][j] + q1 * C[1][j]; }
#pragma unroll
            for (int j = 0; j < 5; ++j) red[j] = wave_sum(red[j]);
            const float dn = fmaxf(fabsf(red[4]), expf(-m));
            if (lane < 4) hs[tt * 32 + w * 4 + lane] = (lane == 0 ? red[0] : lane == 1 ? red[1] : lane == 2 ? red[2] : red[3]) / dn;
        }
        __syncthreads();
        { const int tt = tid >> 3, e4 = (tid & 7) * 4;
          if (tt < nb) *(GAS f32x4*)(HR + (size_t)(row0 + t0 + tt) * 512 + h * 128 + es * 32 + e4) = (f32x4){hs[tt * 32 + e4], hs[tt * 32 + e4 + 1], hs[tt * 32 + e4 + 2], hs[tt * 32 + e4 + 3]}; }
    }
    float* co = ARGOUT() + (sample ? O_SC : O_PC) + (((size_t)l * Bn + b) * 4 + h) * 128 * 128;
#pragma unroll
    for (int dd = 0; dd < 2; ++dd) *(GAS f32x4*)(co + (size_t)(d0 + dd) * 128 + e0) = (f32x4){C[dd][0], C[dd][1], C[dd][2], C[dd][3]};
    if (es == 0 && w == 0) { float* no = ARGOUT() + (sample ? O_SN : O_PN) + (((size_t)l * Bn + b) * 4 + h) * 128; no[d0] = n[0]; no[d0 + 1] = n[1];
        if (lane == 0) ARGOUT()[(sample ? O_SM : O_PM) + ((size_t)l * Bn + b) * 4 + h] = m; }
}

__device__ __forceinline__ void attn_prompt_item(Frame& F, const Args& a, int l, int b, int blk, int kvh) {
    const bf16* PROJ = (const bf16*)(ARGWS() + WS_PROJ); bf16* MIXED = (bf16*)(ARGWS() + WS_MIXED);
    constexpr int KP = 68;
    LAS unsigned short* Ks = (LAS unsigned short*)(F.lds); LAS unsigned short* Vs = (LAS unsigned short*)(F.lds + 256 * KP * 2);
    const int tid = F.tid, w0 = blk * 128 - 128;
    float* pk = ARGOUT() + O_PK + (size_t)(l * NB + b) * 128 * 128; float* pv = ARGOUT() + O_PV + (size_t)(l * NB + b) * 128 * 128;
    __syncthreads();
#pragma unroll
    for (int rep = 0; rep < 4; ++rep) { const int task = tid + rep * NTHR, r = task >> 3, c = task & 7, pos = w0 + r; const bool keep = (blk == 15 && r >= 128);
        if (pos < 0) { *(LAS v4u*)(Ks + r * KP + c * 8) = (v4u){0u, 0u, 0u, 0u}; *(LAS v4u*)(Vs + r * KP + c * 8) = (v4u){0u, 0u, 0u, 0u}; continue; }
        const size_t grow = (size_t)(b * SEQL + pos) * NINP;
        { const v4u wv = *(const GAS v4u*)(PROJ + grow + C_V + kvh * 64 + c * 8); *(LAS v4u*)(Vs + r * KP + c * 8) = wv;
          if (keep) { float f[8]; unpack8(wv, f); float* o = pv + (size_t)((r - 128) * 2 + kvh) * 64 + c * 8; *(GAS f32x4*)o = (f32x4){f[0], f[1], f[2], f[3]}; *(GAS f32x4*)(o + 4) = (f32x4){f[4], f[5], f[6], f[7]}; } }
        if (c >= 2) { const v4u wk = *(const GAS v4u*)(PROJ + grow + C_K + kvh * 64 + c * 8); *(LAS v4u*)(Ks + r * KP + c * 8) = wk;
          if (keep) { float f[8]; unpack8(wk, f); float* o = pk + (size_t)((r - 128) * 2 + kvh) * 64 + c * 8; *(GAS f32x4*)o = (f32x4){f[0], f[1], f[2], f[3]}; *(GAS f32x4*)(o + 4) = (f32x4){f[4], f[5], f[6], f[7]}; } }
        else if (c == 0) { float x1[8], x2[8], cs[8], sn[8], o1[8], o2[8];
          unpack8(*(const GAS v4u*)(PROJ + grow + C_K + kvh * 64), x1); unpack8(*(const GAS v4u*)(PROJ + grow + C_K + kvh * 64 + 8), x2); rope_cs(pos, cs, sn);
#pragma unroll
          for (int i = 0; i < 8; ++i) { o1[i] = x1[i] * cs[i] - x2[i] * sn[i]; o2[i] = x2[i] * cs[i] + x1[i] * sn[i]; }
          *(LAS v4u*)(Ks + r * KP) = pack8(o1); *(LAS v4u*)(Ks + r * KP + 8) = pack8(o2);
          if (keep) { float* o = pk + (size_t)((r - 128) * 2 + kvh) * 64; *(GAS f32x4*)o = (f32x4){o1[0], o1[1], o1[2], o1[3]}; *(GAS f32x4*)(o + 4) = (f32x4){o1[4], o1[5], o1[6], o1[7]};
              *(GAS f32x4*)(o + 8) = (f32x4){o2[0], o2[1], o2[2], o2[3]}; *(GAS f32x4*)(o + 12) = (f32x4){o2[4], o2[5], o2[6], o2[7]}; } }
    }
    __syncthreads();
    const int i = tid >> 2, g = tid & 3, h = kvh * 4 + g, qpos = blk * 128 + i; const size_t row = (size_t)b * SEQL + qpos;
    float q[64];
#pragma unroll
    for (int c = 0; c < 8; ++c) { float f[8]; unpack8(*(const GAS v4u*)(PROJ + row * NINP + C_Q + h * 64 + c * 8), f);
#pragma unroll
        for (int e = 0; e < 8; ++e) q[c * 8 + e] = f[e]; }
    { float cs[8], sn[8]; rope_cs(qpos, cs, sn);
#pragma unroll
      for (int e = 0; e < 8; ++e) { const float x1 = q[e], x2 = q[8 + e]; q[e] = x1 * cs[e] - x2 * sn[e]; q[8 + e] = x2 * cs[e] + x1 * sn[e]; } }
#pragma unroll
    for (int e = 0; e < 64; ++e) q[e] *= 0.125f;
    float acc[64], mx = -INFINITY, sum = 0.f;
#pragma unroll
    for (int e = 0; e < 64; ++e) acc[e] = 0.f;
    for (int jj = 0; jj <= 128; ++jj) { const int r = i + jj;
        if (w0 + r < 0) continue;
        float s = 0.f;
#pragma unroll
        for (int c = 0; c < 8; ++c) { float f[8]; unpack8(*(const LAS v4u*)(Ks + r * KP + c * 8), f);
#pragma unroll
            for (int e = 0; e < 8; ++e) s += q[c * 8 + e] * f[e]; }
        const float mn = fmaxf(mx, s), sc = expf(mx - mn), p = expf(s - mn); mx = mn; sum = sum * sc + p;
#pragma unroll
        for (int c = 0; c < 8; ++c) { float f[8]; unpack8(*(const LAS v4u*)(Vs + r * KP + c * 8), f);
#pragma unroll
            for (int e = 0; e < 8; ++e) acc[c * 8 + e] = acc[c * 8 + e] * sc + p * f[e]; }
    }
    const float sink = ARGIN(11)[l * 8 + h], mf = fmaxf(mx, sink), sc = expf(mx - mf), den = sum * sc + expf(sink - mf), inv = sc / den;
#pragma unroll
    for (int c = 0; c < 8; ++c) { float o[8];
#pragma unroll
        for (int e = 0; e < 8; ++e) o[e] = acc[c * 8 + e] * inv;
        *(GAS v4u*)(MIXED + row * DM + h * 64 + c * 8) = pack8(o); }
}

__device__ __forceinline__ void attn_sample_item(Frame& F, const Args& a, int l, int b) {
    const bf16* PROJ = (const bf16*)(ARGWS() + WS_PROJ); bf16* MIXED = (bf16*)(ARGWS() + WS_MIXED);
    const int tid = F.tid, h = F.wave, lane = F.lane, kvh = h >> 2; const size_t prow = (size_t)(MP + b) * NINP;
    LAS float* qs = (LAS float*)(F.lds);
    LAS float* ps = (LAS float*)(F.lds + 2048);
    LAS float* knew = (LAS float*)(F.lds + 2048 + 4224);
    LAS float* vnew = knew + 128;
    const float* ck = ARGIN(2) + (size_t)(l * MS + b) * 128 * 128; const float* cv = ARGIN(3) + (size_t)(l * MS + b) * 128 * 128;
    __syncthreads();
    { float cs[8], sn[8]; rope_cs(8192, cs, sn);
      const int d = lane; float x = bf2f(PROJ[prow + C_Q + h * 64 + d]);
      if (d < 16) { const float xp = bf2f(PROJ[prow + C_Q + h * 64 + (d ^ 8)]); const float c = (d & 7) == 0 ? cs[0] : (d & 7) == 1 ? cs[1] : (d & 7) == 2 ? cs[2] : (d & 7) == 3 ? cs[3] : (d & 7) == 4 ? cs[4] : (d & 7) == 5 ? cs[5] : (d & 7) == 6 ? cs[6] : cs[7];
          const float s = (d & 7) == 0 ? sn[0] : (d & 7) == 1 ? sn[1] : (d & 7) == 2 ? sn[2] : (d & 7) == 3 ? sn[3] : (d & 7) == 4 ? sn[4] : (d & 7) == 5 ? sn[5] : (d & 7) == 6 ? sn[6] : sn[7];
          x = d < 8 ? x * c - xp * s : x * c + xp * s; }
      qs[h * 64 + d] = x * 0.125f;
      if (h < 2) { float y = bf2f(PROJ[prow + C_K + h * 64 + d]);
          if (d < 16) { const float yp = bf2f(PROJ[prow + C_K + h * 64 + (d ^ 8)]); const float c = (d & 7) == 0 ? cs[0] : (d & 7) == 1 ? cs[1] : (d & 7) == 2 ? cs[2] : (d & 7) == 3 ? cs[3] : (d & 7) == 4 ? cs[4] : (d & 7) == 5 ? cs[5] : (d & 7) == 6 ? cs[6] : cs[7];
              const float s = (d & 7) == 0 ? sn[0] : (d & 7) == 1 ? sn[1] : (d & 7) == 2 ? sn[2] : (d & 7) == 3 ? sn[3] : (d & 7) == 4 ? sn[4] : (d & 7) == 5 ? sn[5] : (d & 7) == 6 ? sn[6] : sn[7];
              y = d < 8 ? y * c - yp * s : y * c + yp * s; }
          knew[h * 64 + d] = y; vnew[h * 64 + d] = bf2f(PROJ[prow + C_V + h * 64 + d]); } }
    __syncthreads();
    float sa = 0.f, sb = 0.f, sn_ = 0.f;
    { const float* ka = ck + (size_t)(lane * 2 + kvh) * 64; const float* kb = ck + (size_t)((lane + 64) * 2 + kvh) * 64;
#pragma unroll
      for (int c = 0; c < 16; ++c) { const f32x4 x = *(const GAS f32x4*)(ka + 4 * c), y = *(const GAS f32x4*)(kb + 4 * c); const f32x4 qv = *(const LAS f32x4*)(qs + h * 64 + 4 * c), kn = *(const LAS f32x4*)(knew + kvh * 64 + 4 * c);
          sa += (qv.x * x.x + qv.y * x.y) + (qv.z * x.z + qv.w * x.w); sb += (qv.x * y.x + qv.y * y.y) + (qv.z * y.z + qv.w * y.w); sn_ += (qv.x * kn.x + qv.y * kn.y) + (qv.z * kn.z + qv.w * kn.w); } }
    const float sink = ARGIN(11)[l * 8 + h];
    const float mx = fmaxf(fmaxf(wave_max(fmaxf(sa, sb)), sn_), sink);
    const float ea = expf(sa - mx), eb = expf(sb - mx), en = expf(sn_ - mx);
    const float inv = 1.0f / (wave_sum(ea + eb) + en + expf(sink - mx));
    ps[h * 132 + lane] = ea * inv; ps[h * 132 + 64 + lane] = eb * inv; if (lane == 0) ps[h * 132 + 128] = en * inv;
    __syncthreads();
    { float o = ps[h * 132 + 128] * vnew[kvh * 64 + lane];
      for (int j = 0; j < 128; ++j) o += ps[h * 132 + j] * cv[(size_t)(j * 2 + kvh) * 64 + lane];
      ((unsigned short*)MIXED)[(size_t)(MP + b) * DM + h * 64 + lane] = (unsigned short)f2bf(o); }
    float* sk = ARGOUT() + O_SK + (size_t)(l * MS + b) * 128 * 128; float* sv = ARGOUT() + O_SV + (size_t)(l * MS + b) * 128 * 128;
    for (int idx = tid * 4; idx < 128 * 128; idx += NTHR * 4) { const int j = idx >> 7, rem = idx & 127;
        f32x4 kk, vv;
        if (j < 127) { kk = *(const GAS f32x4*)(ck + idx + 128); vv = *(const GAS f32x4*)(cv + idx + 128); }
        else { kk = *(const LAS f32x4*)(knew + rem); vv = *(const LAS f32x4*)(vnew + rem); }
        *(GAS f32x4*)(sk + idx) = kk; *(GAS f32x4*)(sv + idx) = vv; }
}

__device__ __forceinline__ void mixer_phase(Frame& F, const Args& a, int l) {
    constexpr int N_SSDP = NB * 16, N_MLP = NB * 4 * 4, N_ATP = NB * 16 * 2, N_SSDS = MS * 16, N_MLS = MS * 4 * 4, N_ATS = MS;
    constexpr int E0 = N_SSDP, E1 = E0 + N_MLP, E2 = E1 + N_ATP, E3 = E2 + N_SSDS, E4 = E3 + N_MLS, E5 = E4 + N_ATS;
    gu32* head = F.ctl + CW_QUEUE + 64 * l;
    volatile LAS unsigned* slot = F.MISC + 16;
    for (;;) {
        __syncthreads();
        if (F.tid == 0) slot[0] = __hip_atomic_fetch_add(head, 1u, RLX_AGENT);
        __syncthreads();
        const int it = (int)slot[0];
        if (it >= E5) break;
        if (it < E0) ssd_seq_item(F, a, l, it >> 4, it & 15, false);
        else if (it < E1) { const int r = it - E0; mlstm_seq_item(F, a, l, r >> 4, (r >> 2) & 3, r & 3, false); }
        else if (it < E2) { const int r = it - E1; attn_prompt_item(F, a, l, r >> 5, (r >> 1) & 15, r & 1); }
        else if (it < E3) { const int r = it - E2; ssd_seq_item(F, a, l, r >> 4, r & 15, true); }
        else if (it < E4) { const int r = it - E3; mlstm_seq_item(F, a, l, r >> 4, (r >> 2) & 3, r & 3, true); }
        else attn_sample_item(F, a, l, it - E4);
    }
}

__device__ __forceinline__ void finalize_phase(Frame& F, const Args& a, int l) {
    const bf16* PROJ = (const bf16*)(ARGWS() + WS_PROJ); bf16* MIXED = (bf16*)(ARGWS() + WS_MIXED); const float* YG = (const float*)(ARGWS() + WS_YG); const float* HR = (const float*)(ARGWS() + WS_HR);
    const float* wssm = ARGIN(17) + (size_t)l * 1024; const float* wml = ARGIN(20) + (size_t)l * 512;
    const int gw = F.vcu * NWAVES + F.wave, NGW = F.G * NWAVES, lane = F.lane;
    for (int row = gw; row < MT; row += NGW) {
#pragma unroll
        for (int g = 0; g < 2; ++g) { const float* src = YG + (size_t)row * 1024 + g * 512 + lane * 8; const f32x4 u0 = *(const GAS f32x4*)src, u1 = *(const GAS f32x4*)(src + 4);
            float ss = (u0.x * u0.x + u0.y * u0.y) + (u0.z * u0.z + u0.w * u0.w) + (u1.x * u1.x + u1.y * u1.y) + (u1.z * u1.z + u1.w * u1.w);
            ss = wave_sum(ss); const float rs = 1.0f / sqrtf(ss * (1.0f / 512.0f) + 1e-6f);
            const float* wp = wssm + g * 512 + lane * 8; const f32x4 w0 = *(const GAS f32x4*)wp, w1 = *(const GAS f32x4*)(wp + 4);
            float o[8] = {u0.x * rs * w0.x, u0.y * rs * w0.y, u0.z * rs * w0.z, u0.w * rs * w0.w, u1.x * rs * w1.x, u1.y * rs * w1.y, u1.z * rs * w1.z, u1.w * rs * w1.w};
            *(GAS v4u*)(MIXED + (size_t)row * DM + 512 + g * 512 + lane * 8) = pack8(o); }
#pragma unroll
        for (int hh = 0; hh < 4; ++hh) { const float* src = HR + (size_t)row * 512 + hh * 128 + lane * 2; const float v0 = src[0], v1 = src[1];
            const float ss = wave_sum(v0 * v0 + v1 * v1), rs = 1.0f / sqrtf(ss * (1.0f / 128.0f) + 1e-6f);
            const unsigned mo = *(const GAS unsigned*)(PROJ + (size_t)row * NINP + C_MO + hh * 128 + lane * 2);
            const float o0 = v0 * rs * wml[hh * 128 + lane * 2] * sigmoidf_(bflo(mo)), o1 = v1 * rs * wml[hh * 128 + lane * 2 + 1] * sigmoidf_(bfhi(mo));
            *(GAS unsigned*)(MIXED + (size_t)row * DM + 1536 + hh * 128 + lane * 2) = pk2(o0, o1); }
    }
}

__device__ __forceinline__ void final_norm_phase(Frame& F, const Args& a) {
    const float* SSQ = (const float*)(ARGWS() + WS_SSQA); const float* wf = ARGIN(25);
    const int gw = F.vcu * NWAVES + F.wave, NGW = F.G * NWAVES, lane = F.lane;
    for (int row = gw; row < MT; row += NGW) {
        const f32x4 p0 = *(const GAS f32x4*)(SSQ + (size_t)row * 8), p1 = *(const GAS f32x4*)(SSQ + (size_t)row * 8 + 4);
        const float ss = ((p0.x + p0.y) + (p0.z + p0.w)) + ((p1.x + p1.y) + (p1.z + p1.w)), rs = 1.0f / sqrtf(ss * (1.0f / 2048.0f) + 1e-6f);
        GAS f32x4* y = (GAS f32x4*)(ARGOUT() + O_Y + (size_t)row * DM) + lane; const GAS f32x4* wv = (const GAS f32x4*)wf + lane;
#pragma unroll
        for (int j = 0; j < 8; ++j) { const f32x4 v = y[64 * j], g = wv[64 * j]; y[64 * j] = (f32x4){v.x * rs * g.x, v.y * rs * g.y, v.z * rs * g.z, v.w * rs * g.w}; }
    }
}

#ifndef MK_N_LAUNCHES
#define MK_N_LAUNCHES 1
#endif
constexpr int N_PHASES = 16;
__global__ void __launch_bounds__(NTHR, 2) mk_fwd(Args args) {
    extern __shared__ __attribute__((aligned(16))) unsigned char lds[];
    Frame F;
    F.lds = (LAS unsigned char*)lds;
    F.MISC = (volatile LAS unsigned*)(F.lds + MISC_OFF);
    F.tid = threadIdx.x; F.lane = F.tid & 63; F.wave = __builtin_amdgcn_readfirstlane(F.tid >> 6);
    F.G = gridDim.x; { const int bx = blockIdx.x; F.vcu = (F.G % 8 == 0) ? (bx % 8) * (F.G / 8) + bx / 8 : bx; }
    unsigned char* ws = ARGWS();
    F.ctl = (gu32*)(ws + WS_CTL);
    for (int u = F.tid; u < (LDS_BYTES - LDSCTL_OFF) / 4; u += NTHR) ((LAS unsigned*)(F.lds + LDSCTL_OFF))[u] = 0u;
    __syncthreads();
    const int lo = args.ph_lo, hi = args.ph_hi;
    const bool use_bar = (hi - lo) > 1;
    XcdBarrier bar; bar.bar = (unsigned*)(F.ctl + CW_BAR); bar.x = 0; bar.st = nullptr;
    if (use_bar) bar = xcd_barrier_post((unsigned*)(F.ctl + CW_BAR), F.MISC + 8);
#define IN(k) (lo <= (k) && (k) < hi)
#define PHASE_BEGIN() do { int t_ = threadIdx.x, v_ = vcu0, g_ = G0; asm volatile("" : "+v"(t_)); asm volatile("" : "+s"(v_), "+s"(g_)); F.tid = t_; F.lane = t_ & 63; F.wave = __builtin_amdgcn_readfirstlane(t_ >> 6); F.vcu = v_; F.G = g_; } while (0)
#define SEAM(k) do { if (IN(k) && IN((k) + 1)) xcd_barrier(bar); } while (0)

    bf16* XB = (bf16*)(ws + WS_XB); float* XRES = (float*)(ws + WS_XRES); bf16* HBUF = (bf16*)(ws + WS_HBUF); bf16* PROJ = (bf16*)(ws + WS_PROJ); bf16* MIXED = (bf16*)(ws + WS_MIXED);
    float* SSQA = (float*)(ws + WS_SSQA); float* SSQB = (float*)(ws + WS_SSQB);

    const int vcu0 = F.vcu, G0 = F.G;
    if (IN(0)) { PHASE_BEGIN(); p0_prologue(F, args); }
    SEAM(0);
    for (int l = 0; l < DEPTH; ++l) {
        const int pb = 1 + 7 * l;
        const bf16* Wi = (const bf16*)(ws + WS_WIN + l * WIN_BYTES); const bf16* Wo = (const bf16*)(ws + WS_WOUT + l * WOUT_BYTES);
        const bf16* Wu = (const bf16*)(ws + WS_WUP + l * WUP_BYTES); const bf16* Wd = (const bf16*)(ws + WS_WDN + l * WDN_BYTES);
        if (IN(pb)) { PHASE_BEGIN();
            pg8::Gemm g{XB, Wi, MPAD, NINP, DM}; pg8::StaticOrder S; S.init(MPAD, NINP, F.G, (int)blockIdx.x);
            pg8::EpiScaleBf16<0> E{PROJ, NINP, SSQA};
            pg8::gemm_phase<pg8::EpiScaleBf16<0>, pg8::StaticOrder, true, true>(F.lds + RING_OFF, g, S, E, F.tid);
            if (blockIdx.x == 0) for (int i = F.tid; i < MS * 8; i += NTHR) SSQB[(size_t)MP * 8 + i] = 0.f;
        }
        SEAM(pb);
        if (IN(pb + 1)) { PHASE_BEGIN(); conv_phase(F, args, l); }
        SEAM(pb + 1);
        if (IN(pb + 2)) { PHASE_BEGIN(); mixer_phase(F, args, l); }
        SEAM(pb + 2);
        if (IN(pb + 3)) { PHASE_BEGIN(); finalize_phase(F, args, l); }
        SEAM(pb + 3);
        if (IN(pb + 4)) { PHASE_BEGIN();
            const float* basep = l == 0 ? ARGIN(0) : XRES; const float* bases = l == 0 ? ARGIN(1) : XRES + (size_t)MP * DM;
            pg8::Gemm g{MIXED, Wo, MP, DM, DM}; pg8::StaticOrder S; S.init(MP, DM, F.G, (int)blockIdx.x);
            pg8::EpiResid E{basep, XRES, XB, SSQB, DM};
            pg8::gemm_phase<pg8::EpiResid, pg8::StaticOrder, false, true>(F.lds + RING_OFF, g, S, E, F.tid);
            float* outs = XRES + (size_t)MP * DM; bf16* xbs = XB + (size_t)MP * DM; float* sq = SSQB + (size_t)MP * 8;
            thin_gemm(F, MIXED + (size_t)MP * DM, DM, Wo, DM, DM, [&](int row, int col, f32x4 acc) {
                const f32x4 bs = *(const GAS f32x4*)(bases + (size_t)row * DM + col); const f32x4 o = bs + acc;
                *(GAS f32x4*)(outs + (size_t)row * DM + col) = o;
                *(GAS unsigned long long*)(xbs + (size_t)row * DM + col) = (unsigned long long)pk2(o.x, o.y) | ((unsigned long long)pk2(o.z, o.w) << 32);
                float s = (o.x * o.x + o.y * o.y) + (o.z * o.z + o.w * o.w); s += __shfl_xor(s, 16); s += __shfl_xor(s, 32);
                if ((F.lane >> 4) == 0) atomicAdd(sq + (size_t)row * 8 + ((col >> 4) & 7), s); });
            if (blockIdx.x == 0) for (int i = F.tid; i < MS * 8; i += NTHR) SSQA[(size_t)MP * 8 + i] = 0.f;
        }
        SEAM(pb + 4);
        if (IN(pb + 5)) { PHASE_BEGIN();
            pg8::Gemm g{XB, Wu, MP, FF, DM}; pg8::StaticOrder S; S.init(MP, FF, F.G, (int)blockIdx.x);
            pg8::EpiScaleBf16<1> E{HBUF, FF, SSQB};
            pg8::gemm_phase<pg8::EpiScaleBf16<1>, pg8::StaticOrder, true, true>(F.lds + RING_OFF, g, S, E, F.tid);
            bf16* hs = HBUF + (size_t)MP * FF; const float* sq = SSQB + (size_t)MP * 8;
            thin_gemm(F, XB + (size_t)MP * DM, DM, Wu, FF, DM, [&](int row, int col, f32x4 acc) {
                const f32x4 p0 = *(const GAS f32x4*)(sq + (size_t)row * 8), p1 = *(const GAS f32x4*)(sq + (size_t)row * 8 + 4);
                const float ss = ((p0.x + p0.y) + (p0.z + p0.w)) + ((p1.x + p1.y) + (p1.z + p1.w)), rs = 1.0f / sqrtf(ss * (1.0f / 2048.0f) + 1e-6f);
                f32x4 v = acc * rs; v.x = fmaxf(v.x, 0.f); v.y = fmaxf(v.y, 0.f); v.z = fmaxf(v.z, 0.f); v.w = fmaxf(v.w, 0.f);
                *(GAS unsigned long long*)(hs + (size_t)row * FF + col) = (unsigned long long)pk2(v.x * v.x, v.y * v.y) | ((unsigned long long)pk2(v.z * v.z, v.w * v.w) << 32); });
        }
        SEAM(pb + 5);
        if (IN(pb + 6)) { PHASE_BEGIN();
            const bool lastl = (l == DEPTH - 1);
            float* outp = lastl ? ARGOUT() + O_Y : XRES; float* outs = lastl ? ARGOUT() + O_Y + (size_t)MP * DM : XRES + (size_t)MP * DM;
            pg8::Gemm g{HBUF, Wd, MP, DM, FF}; pg8::StaticOrder S; S.init(MP, DM, F.G, (int)blockIdx.x);
            pg8::EpiResid E{XRES, outp, lastl ? (bf16*)nullptr : XB, SSQA, DM};
            pg8::gemm_phase<pg8::EpiResid, pg8::StaticOrder, false, true>(F.lds + RING_OFF, g, S, E, F.tid);
            const float* bases = XRES + (size_t)MP * DM; bf16* xbs = XB + (size_t)MP * DM; float* sq = SSQA + (size_t)MP * 8;
            thin_gemm(F, HBUF + (size_t)MP * FF, FF, Wd, DM, FF, [&](int row, int col, f32x4 acc) {
                const f32x4 bs = *(const GAS f32x4*)(bases + (size_t)row * DM + col); const f32x4 o = bs + acc;
                *(GAS f32x4*)(outs + (size_t)row * DM + col) = o;
                if (!lastl) *(GAS unsigned long long*)(xbs + (size_t)row * DM + col) = (unsigned long long)pk2(o.x, o.y) | ((unsigned long long)pk2(o.z, o.w) << 32);
                float s = (o.x * o.x + o.y * o.y) + (o.z * o.z + o.w * o.w); s += __shfl_xor(s, 16); s += __shfl_xor(s, 32);
                if ((F.lane >> 4) == 0) atomicAdd(sq + (size_t)row * 8 + ((col >> 4) & 7), s); });
        }
        SEAM(pb + 6);
    }
    if (IN(15)) { PHASE_BEGIN(); final_norm_phase(F, args); }
#undef IN
#undef SEAM
}

extern "C" void kernel_launch(void* const* d_in, const int* in_sizes, int n_in, void* d_out, int out_size, void* d_ws, size_t ws_size, hipStream_t stream) {
    static int grid = 0;
    if (grid == 0) {
        if (n_in != 26 || (size_t)out_size != O_END || ws_size < WS_END) { fprintf(stderr, "kernel_launch: expected 26 inputs, %zu outputs, >= %zu bytes of workspace; got %d, %d, %zu\n", (size_t)O_END, (size_t)WS_END, n_in, out_size, ws_size); grid = -1; return; }
        int dev = 0, cus = 0, per_cu = 0;
        if (hipGetDevice(&dev) != hipSuccess || hipDeviceGetAttribute(&cus, hipDeviceAttributeMultiprocessorCount, dev) != hipSuccess) { grid = -1; return; }
        if (hipFuncSetAttribute((const void*)mk_fwd, hipFuncAttributeMaxDynamicSharedMemorySize, LDS_BYTES) != hipSuccess) { fprintf(stderr, "kernel_launch: hipFuncSetAttribute failed\n"); grid = -1; return; }
        if (hipOccupancyMaxActiveBlocksPerMultiprocessor(&per_cu, (const void*)mk_fwd, NTHR, LDS_BYTES) != hipSuccess || per_cu < 1) { fprintf(stderr, "kernel_launch: occupancy query says %d blocks per CU\n", per_cu); per_cu = 1; }
        (void)hipGetLastError();
        grid = cus;
        if (grid != 256) fprintf(stderr, "kernel_launch: %d CUs; the G2/G4 phases assume 256 workgroups\n", grid);
    }
    if (grid < 0) return;
    (void)hipMemsetAsync((char*)d_ws + WS_CTL, 0, CTL_ZERO_BYTES, stream);
    Args a{};
    for (int i = 0; i < 26; ++i) a.in[i] = (const float*)d_in[i];
    a.out = (float*)d_out; a.ws = (unsigned char*)d_ws;
#if MK_N_LAUNCHES == 1
    a.ph_lo = 0; a.ph_hi = N_PHASES;
    hipLaunchKernelGGL(mk_fwd, dim3(grid), dim3(NTHR), LDS_BYTES, stream, a);
#else
    for (int p = 0; p < N_PHASES; ++p) { a.ph_lo = p; a.ph_hi = p + 1; hipLaunchKernelGGL(mk_fwd, dim3(grid), dim3(NTHR), LDS_BYTES, stream, a); }
#endif
}
```

```cpp
#include <hip/hip_runtime.h>
#include <cstdio>
#include <cstdint>
namespace pg8 {
#define PG8_LAS __attribute__((address_space(3)))
typedef unsigned short bf16_t;
typedef short bf16x8 __attribute__((ext_vector_type(8)));
typedef float f32x4 __attribute__((ext_vector_type(4)));
typedef unsigned u32x4 __attribute__((ext_vector_type(4)));
constexpr int BM = 256, BK = 64, HALF = 128, HTB = HALF * BK * 2  , STAGE_BYTES = 8 * HTB, NXCD = 8, WGM = 8;

__host__ __device__ __forceinline__ int lds_byte(int r, int c) { const int st = (r >> 4) * 2 + (c >> 5), rr = r & 15, cc = c & 31, ob = rr * 64 + cc * 2; return st * 1024 + (ob ^ (((ob >> 9) & 1) << 5)); }
__host__ __device__ __forceinline__ void stage_rc(int b, int& R, int& C) { const int st = b / 1024, sb = b % 1024, swz = sb ^ (((sb >> 9) & 1) << 5); R = (st >> 1) * 16 + swz / 64; C = (st & 1) * 32 + (swz % 64) / 2; }
__host__ __device__ __forceinline__ int perm32(int rho) { const int n = rho >> 4, i = rho & 15; return 8 * (i >> 2) + 4 * n + (i & 3); }

struct Unit { int pm, pn; };
struct Gemm { const bf16_t* A; const bf16_t* Bt; int M, N, K; };

struct StaticOrder {
    int nM, nN, nwg, G, c;
    __host__ __device__ void init(int M, int N, int G_, int c_) { nM = M / BM; nN = N / BM; nwg = nM * nN; G = G_; c = c_; }
    __host__ __device__ bool next(int i, Unit& u) const {
        const long L = (long)i * G + c; if (L >= nwg) return false;
        int wgid = (int)L; { const int q = nwg / NXCD, r = nwg % NXCD, xcd = wgid % NXCD, off = wgid / NXCD; wgid = (xcd < r ? xcd * (q + 1) : r * (q + 1) + (xcd - r) * q) + off; }
        const int nig = WGM * nN, gid = wgid / nig, fm = gid * WGM, gsz = (nM - fm) < WGM ? (nM - fm) : WGM;
        u.pm = fm + ((wgid % nig) % gsz); u.pn = (wgid % nig) / gsz; return true;
    }
    __device__ __forceinline__ void a_ready(const Unit&) const {}
    __device__ __forceinline__ void done(const Unit&) const {}
};


__device__ __forceinline__ unsigned cvt_pk_bf16(float lo, float hi) { unsigned r; asm volatile("v_cvt_pk_bf16_f32 %0, %1, %2" : "=v"(r) : "v"(lo), "v"(hi)); return r; }

template <int ACT> struct EpiScaleBf16 {
    static constexpr bool PERM = true, AFTER_DRAIN = false;
    bf16_t* O; int ldc; const float* ssq;
    __device__ __forceinline__ void operator()(const f32x4 (&acc)[2][2][4][2], const Unit& u, int wr, int wc, int fr, int fq) const {
        const int row0 = u.pm * BM + wr * 64 + fr, col0 = u.pn * BM + wc * 32 + 8 * fq;
#pragma unroll
        for (int ai = 0; ai < 2; ++ai)
#pragma unroll
            for (int m = 0; m < 4; ++m) { const int row = row0 + ai * HALF + m * 16;
                const f32x4 p0 = *(const f32x4*)(ssq + (size_t)row * 8), p1 = *(const f32x4*)(ssq + (size_t)row * 8 + 4);
                const float ss = ((p0[0] + p0[1]) + (p0[2] + p0[3])) + ((p1[0] + p1[1]) + (p1[2] + p1[3]));
                const float rs = 1.0f / sqrtf(ss * (1.0f / 2048.0f) + 1e-6f);
                bf16_t* rowp = O + (size_t)row * ldc + col0;
#pragma unroll
                for (int bj = 0; bj < 2; ++bj) { f32x4 v0 = acc[ai][bj][m][0] * rs, v1 = acc[ai][bj][m][1] * rs;
                    if (ACT == 1) {
#pragma unroll
                        for (int e = 0; e < 4; ++e) { const float a = fmaxf(v0[e], 0.f), b = fmaxf(v1[e], 0.f); v0[e] = a * a; v1[e] = b * b; } }
                    u32x4 w; w.x = cvt_pk_bf16(v0[0], v0[1]); w.y = cvt_pk_bf16(v0[2], v0[3]); w.z = cvt_pk_bf16(v1[0], v1[1]); w.w = cvt_pk_bf16(v1[2], v1[3]);
                    *(u32x4*)(rowp + bj * HALF) = w; } }
    }
};

struct EpiResid {
    static constexpr bool PERM = false, AFTER_DRAIN = true;
    const float* base; float* out; bf16_t* xb; float* ssq; int ld;
    __device__ __forceinline__ void fused(f32x4 (&acc)[2][2][4][2], const Unit& u, int wr, int wc, int fr, int fq, PG8_LAS unsigned char* lds, int wid, int lane) const {
        typedef unsigned u32x2v __attribute__((ext_vector_type(2)));
        PG8_LAS float* P = (PG8_LAS float*)lds;
        const int col0 = u.pn * BM + wc * 32 + 4 * fq;
#pragma unroll
        for (int ai = 0; ai < 2; ++ai)
#pragma unroll
            for (int m = 0; m < 4; ++m) { const int r = ai * HALF + wr * 64 + m * 16 + fr; const size_t off = (size_t)(u.pm * BM + r) * ld + col0; float s = 0.f;
#pragma unroll
                for (int bj = 0; bj < 2; ++bj)
#pragma unroll
                    for (int n = 0; n < 2; ++n) { const f32x4 bs = *(const f32x4*)(base + off + bj * HALF + n * 16); const f32x4 o = bs + acc[ai][bj][m][n];
                        *(f32x4*)(out + off + bj * HALF + n * 16) = o;
                        if (xb) { u32x2v w; w.x = cvt_pk_bf16(o[0], o[1]); w.y = cvt_pk_bf16(o[2], o[3]); *(u32x2v*)(xb + off + bj * HALF + n * 16) = w; }
                        s += (o[0] * o[0] + o[1] * o[1]) + (o[2] * o[2] + o[3] * o[3]); }
                s += __shfl_xor(s, 16); s += __shfl_xor(s, 32);
                if (fq == 0) P[r * 4 + wc] = s;
                if (m & 1) asm volatile("" ::: "memory"); }
        asm volatile("s_waitcnt lgkmcnt(0)" ::: "memory"); __builtin_amdgcn_s_barrier(); asm volatile("" ::: "memory");
        const int t = wid * 64 + lane;
        if (t < 256) { const float s = (P[t * 4 + 0] + P[t * 4 + 1]) + (P[t * 4 + 2] + P[t * 4 + 3]); ssq[(size_t)(u.pm * BM + t) * 8 + u.pn] = s; }
        asm volatile("s_waitcnt lgkmcnt(0)" ::: "memory"); __builtin_amdgcn_s_barrier(); asm volatile("" ::: "memory");
    }
};
template <class Epi, class Sched, bool ALIGN_EPI = false, bool SP2 = false>
__device__ __forceinline__ void gemm_phase(PG8_LAS unsigned char* lds, const Gemm g, const Sched& S, const Epi& E, const int tid) {
    const int  wid = __builtin_amdgcn_readfirstlane(tid >> 6), lane = tid & 63, wr = wid >> 2, wc = wid & 3, fr = lane & 15, fq = lane >> 4;
    const int K = g.K, nt = K / BK;
    unsigned voffA[2], voffB[2];
#pragma unroll
    for (int i = 0; i < 2; ++i) { int R, C; stage_rc(tid * 16 + i * 8192, R, C); const int Rb = Epi::PERM ? ((R & ~31) + perm32(R & 31)) : R;
        voffA[i] = (unsigned)(R * K + C) * 2u; voffB[i] = (unsigned)(Rb * K + C) * 2u; }
    const size_t kstep = (size_t)(BK * 2);
    const size_t hstep = (size_t)HALF * K * 2;
    const size_t tstep = 2 * hstep;
    const unsigned ldsw = (unsigned)wid * 1024u;
    const int aoff = lds_byte(wr * 64 + fr, fq * 8), boff = lds_byte(wc * 32 + fr, fq * 8);
#define PG8_SA(b, h) (((b) * 2 + (h)) * HTB)
#define PG8_SB(b, h) ((4 + (b) * 2 + (h)) * HTB)
#define PG8_STAGE(bufoff, gbase, voff) do { _Pragma("unroll") for (int _i = 0; _i < 2; ++_i) \
        __builtin_amdgcn_global_load_lds((const unsigned*)((const char*)(gbase) + (voff)[_i]), (PG8_LAS unsigned*)(lds + (bufoff) + ldsw + _i * 8192), 16, 0, 0); } while (0)
#define PG8_LDA(dst, b, h) do { _Pragma("unroll") for (int m = 0; m < 4; ++m) _Pragma("unroll") for (int k = 0; k < 2; ++k) dst[m][k] = *(const PG8_LAS bf16x8*)(lds + PG8_SA(b, h) + aoff + m * 2048 + k * 1024); } while (0)
#define PG8_LDB(dst, b, h) do { _Pragma("unroll") for (int n = 0; n < 2; ++n) _Pragma("unroll") for (int k = 0; k < 2; ++k) dst[n][k] = *(const PG8_LAS bf16x8*)(lds + PG8_SB(b, h) + boff + n * 2048 + k * 1024); } while (0)
#define PG8_MMA(ai, bj, At, Bt) do { __builtin_amdgcn_s_setprio(1); _Pragma("unroll") for (int m = 0; m < 4; ++m) _Pragma("unroll") for (int n = 0; n < 2; ++n) _Pragma("unroll") for (int k = 0; k < 2; ++k) \
        acc[ai][bj][m][n] = __builtin_amdgcn_mfma_f32_16x16x32_bf16(Bt[n][k], At[m][k], acc[ai][bj][m][n], 0, 0, 0); __builtin_amdgcn_s_setprio(0); } while (0)
#define PG8_WAIT_V(n) asm volatile("s_waitcnt vmcnt(" #n ")" ::: "memory")
#define PG8_WAIT_L(n) asm volatile("s_waitcnt lgkmcnt(" #n ")" ::: "memory")
#define PG8_BAR __builtin_amdgcn_s_barrier()
#define PG8_SCHED __builtin_amdgcn_sched_barrier(0)
    Unit cur, nxt; int ui = 0;
    if (!S.next(0, cur)) return;
    f32x4 acc[2][2][4][2];
#pragma unroll
    for (int a = 0; a < 2; ++a)
#pragma unroll
        for (int b = 0; b < 2; ++b)
#pragma unroll
            for (int m = 0; m < 4; ++m)
#pragma unroll
                for (int n = 0; n < 2; ++n) acc[a][b][m][n] = (f32x4){0.f, 0.f, 0.f, 0.f};
    bf16x8 At[4][2], B0[2][2], B1[2][2];
    const char* cA = (const char*)g.A + (size_t)cur.pm * tstep; const char* cB = (const char*)g.Bt + (size_t)cur.pn * tstep;
    S.a_ready(cur);
    if constexpr (SP2) {
        PG8_STAGE(PG8_SB(0, 0), cB, voffB); PG8_STAGE(PG8_SB(0, 1), cB + hstep, voffB); PG8_STAGE(PG8_SA(0, 0), cA, voffA); PG8_STAGE(PG8_SA(0, 1), cA + hstep, voffA);
        if (wr == 1) PG8_BAR;
        PG8_WAIT_V(2); PG8_BAR;
        PG8_STAGE(PG8_SB(1, 0), cB + kstep, voffB); PG8_STAGE(PG8_SA(1, 0), cA + kstep, voffA); PG8_STAGE(PG8_SB(1, 1), cB + hstep + kstep, voffB);
        PG8_WAIT_V(6); PG8_BAR;
    } else {
        PG8_STAGE(PG8_SB(0, 0), cB, voffB); PG8_STAGE(PG8_SA(0, 0), cA, voffA); PG8_STAGE(PG8_SB(0, 1), cB + hstep, voffB); PG8_STAGE(PG8_SA(0, 1), cA + hstep, voffA);
        if (wr == 1) PG8_BAR;
        PG8_WAIT_V(4); PG8_BAR;
        PG8_STAGE(PG8_SB(1, 0), cB + kstep, voffB); PG8_STAGE(PG8_SA(1, 0), cA + kstep, voffA); PG8_STAGE(PG8_SB(1, 1), cB + hstep + kstep, voffB);
        PG8_WAIT_V(6); PG8_BAR;
    }
    for (;;) {
        const bool has_next = S.next(ui + 1, nxt);
        const char* nA = has_next ? (const char*)g.A + (size_t)nxt.pm * tstep : cA; const char* nB = has_next ? (const char*)g.Bt + (size_t)nxt.pn * tstep : cB;
        for (int t = 0; t < nt; t += 2) {
            const bool last = (t == nt - 2);
            const char* a1 = cA + (size_t)(t + 1) * kstep;
            const char* a2 = last ? nA : cA + (size_t)(t + 2) * kstep; const char* b2 = last ? nB : cB + (size_t)(t + 2) * kstep;
            const char* a3 = a2 + kstep; const char* b3 = b2 + kstep;
            if (last && has_next) S.a_ready(nxt);
            if constexpr (SP2) {
            PG8_LDB(B0, 0, 0); PG8_LDB(B1, 0, 1); PG8_SCHED; PG8_LDA(At, 0, 0); PG8_STAGE(PG8_SA(1, 1), a1 + hstep, voffA);
            PG8_WAIT_V(8); PG8_WAIT_L(0); PG8_BAR; PG8_MMA(0, 0, At, B0); PG8_MMA(0, 1, At, B1); PG8_BAR; PG8_SCHED;
            PG8_LDA(At, 0, 1); PG8_STAGE(PG8_SB(0, 0), b2, voffB); PG8_STAGE(PG8_SB(0, 1), b2 + hstep, voffB); PG8_STAGE(PG8_SA(0, 0), a2, voffA);
            PG8_WAIT_V(8); PG8_WAIT_L(0); PG8_BAR; PG8_MMA(1, 0, At, B0); PG8_MMA(1, 1, At, B1); PG8_BAR; PG8_SCHED;
            PG8_LDB(B0, 1, 0); PG8_LDB(B1, 1, 1); PG8_SCHED; PG8_LDA(At, 1, 0); PG8_STAGE(PG8_SA(0, 1), a2 + hstep, voffA);
            PG8_WAIT_V(8); PG8_WAIT_L(0); PG8_BAR; PG8_MMA(0, 0, At, B0); PG8_MMA(0, 1, At, B1); PG8_BAR; PG8_SCHED;
            PG8_LDA(At, 1, 1); PG8_STAGE(PG8_SB(1, 0), b3, voffB); PG8_STAGE(PG8_SB(1, 1), b3 + hstep, voffB); PG8_STAGE(PG8_SA(1, 0), a3, voffA);
            PG8_WAIT_V(8); PG8_WAIT_L(0); PG8_BAR; PG8_MMA(1, 0, At, B0); PG8_MMA(1, 1, At, B1); PG8_BAR; PG8_SCHED;
            } else {
            PG8_LDB(B0, 0, 0); PG8_SCHED; PG8_LDA(At, 0, 0); PG8_STAGE(PG8_SA(1, 1), a1 + hstep, voffA);
            PG8_WAIT_L(8); PG8_BAR; PG8_WAIT_L(0); PG8_MMA(0, 0, At, B0); PG8_BAR; PG8_SCHED;
            PG8_LDB(B1, 0, 1); PG8_STAGE(PG8_SB(0, 0), b2, voffB);
            PG8_BAR; PG8_WAIT_L(0); PG8_MMA(0, 1, At, B1); PG8_BAR;
            PG8_LDA(At, 0, 1); PG8_STAGE(PG8_SA(0, 0), a2, voffA);
            PG8_BAR; PG8_WAIT_L(0); PG8_MMA(1, 0, At, B0); PG8_BAR; PG8_SCHED;
            PG8_STAGE(PG8_SB(0, 1), b2 + hstep, voffB);
            PG8_WAIT_V(6); PG8_BAR; PG8_MMA(1, 1, At, B1); PG8_BAR;
            PG8_LDB(B0, 1, 0); PG8_SCHED; PG8_LDA(At, 1, 0); PG8_STAGE(PG8_SA(0, 1), a2 + hstep, voffA);
            PG8_WAIT_L(8); PG8_BAR; PG8_WAIT_L(0); PG8_MMA(0, 0, At, B0); PG8_BAR; PG8_SCHED;
            PG8_LDB(B1, 1, 1); PG8_STAGE(PG8_SB(1, 0), b3, voffB);
            PG8_BAR; PG8_WAIT_L(0); PG8_MMA(0, 1, At, B1); PG8_BAR;
            PG8_LDA(At, 1, 1); PG8_STAGE(PG8_SA(1, 0), a3, voffA);
            PG8_BAR; PG8_WAIT_L(0); PG8_MMA(1, 0, At, B0); PG8_BAR; PG8_SCHED;
            PG8_STAGE(PG8_SB(1, 1), b3 + hstep, voffB);
            PG8_WAIT_V(6); PG8_BAR; PG8_MMA(1, 1, At, B1); PG8_BAR;
            }
        }
        if constexpr (ALIGN_EPI) { if (wr == 0) PG8_BAR; }
        if constexpr (!Epi::AFTER_DRAIN) { E(acc, cur, wr, wc, fr, fq); S.done(cur); }
        if (!has_next) break;
#pragma unroll
        for (int a = 0; a < 2; ++a)
#pragma unroll
            for (int b = 0; b < 2; ++b)
#pragma unroll
                for (int m = 0; m < 4; ++m)
#pragma unroll
                    for (int n = 0; n < 2; ++n) acc[a][b][m][n] = (f32x4){0.f, 0.f, 0.f, 0.f};
        cur = nxt; cA = nA; cB = nB; ++ui;
        if constexpr (ALIGN_EPI) { if (wr == 1) PG8_BAR; }
    }
    PG8_WAIT_V(0);
    if constexpr (!ALIGN_EPI) { if (wr == 0) PG8_BAR; }
    PG8_BAR;
    if constexpr (Epi::AFTER_DRAIN) { E.fused(acc, cur, wr, wc, fr, fq, lds, wid, lane); S.done(cur); }
#undef PG8_SA
#undef PG8_SB
#undef PG8_STAGE
#undef PG8_LDA
#undef PG8_LDB
#undef PG8_MMA
#undef PG8_WAIT_V
#undef PG8_WAIT_L
#undef PG8_BAR
#undef PG8_SCHED
}
}

#ifndef PG8_SP2
#define PG8_SP2 true
#endif
#ifndef PG8_ALIGN
#define PG8_ALIGN true
#endif
#define GAS __attribute__((address_space(1)))
#define LAS __attribute__((address_space(3)))
typedef unsigned short bf16;
typedef unsigned v4u __attribute__((ext_vector_type(4)));
typedef float f32x4 __attribute__((ext_vector_type(4)));
typedef short bf16x8 __attribute__((ext_vector_type(8)));
typedef GAS unsigned gu32;
typedef GAS unsigned long long gu64;
#define RLX_AGENT __ATOMIC_RELAXED, __HIP_MEMORY_SCOPE_AGENT
#define LDS_WAIT() asm volatile("s_waitcnt lgkmcnt(0)" ::: "memory")
#define VM_WAIT() asm volatile("s_waitcnt vmcnt(0)" ::: "memory")
__device__ __forceinline__ unsigned long long rt() { return __builtin_amdgcn_s_memrealtime(); }
__device__ __forceinline__ unsigned f2bf(float f) { unsigned u = __builtin_bit_cast(unsigned, f); return (u + 0x7fffu + ((u >> 16) & 1u)) >> 16; }
__device__ __forceinline__ unsigned pk2(float lo, float hi) { return f2bf(lo) | (f2bf(hi) << 16); }

#define XB_TMO      128
#define XB_XCNT(j)  (256  + 64 * (j))
#define XB_XSUB(j)  (1280 + 64 * (j))
#define XB_XGEN(j)  (2304 + 64 * (j))
#define XB_TOP      3328
#define XB_TOPGEN   3392
#define XCD_BAR_WORDS 3456
#define XB_SPIN_CAP (1u << 18)

__device__ __forceinline__ unsigned xb_ld(unsigned* p)              { return __hip_atomic_load(p, __ATOMIC_RELAXED, __HIP_MEMORY_SCOPE_AGENT); }
__device__ __forceinline__ unsigned xb_add(unsigned* p, unsigned v) { return __hip_atomic_fetch_add(p, v, __ATOMIC_RELAXED, __HIP_MEMORY_SCOPE_AGENT); }
__device__ __forceinline__ unsigned xb_xcc_id() { return (unsigned)__builtin_amdgcn_s_getreg((3 << 11) | 20) & 0xFu; }
#define XB_SPIN(cond, bar) do { unsigned _sp = 0; while (cond) { __builtin_amdgcn_s_sleep(1); \
    if ((++_sp & 255u) == 0u) { if (xb_ld(&(bar)[XB_TMO])) break; if (_sp > XB_SPIN_CAP) { atomicAdd(&(bar)[XB_TMO], 1u); break; } } } } while (0)

struct XcdBarrier {
    unsigned* bar; unsigned x;
    volatile LAS unsigned* st;
};

__device__ __forceinline__ XcdBarrier xcd_barrier_post(unsigned* bar, volatile LAS unsigned* st) {
    XcdBarrier b; b.bar = bar; b.x = xb_xcc_id(); b.st = st;
    if (threadIdx.x == 0) (void)xb_add(&bar[XB_XCNT(b.x)], 1u);
    return b;
}
__device__ __forceinline__ void xcd_barrier_complete(unsigned* bar, unsigned x, unsigned& nloc, unsigned& nx) {
    const unsigned G = gridDim.x * gridDim.y * gridDim.z;
    unsigned sum, cnt, mine, sp = 0u;
    for (;;) {
        sum = 0u; cnt = 0u; mine = 0u;
#pragma unroll
        for (unsigned j = 0; j < 16; ++j) { const unsigned c = xb_ld(&bar[XB_XCNT(j)]); sum += c; cnt += (c > 0u) ? 1u : 0u; mine = (j == x) ? c : mine; }
        if (sum == G) break;
        __builtin_amdgcn_s_sleep(1);
        if ((++sp & 255u) == 0u) { if (xb_ld(&bar[XB_TMO])) break; if (sp > XB_SPIN_CAP) { atomicAdd(&bar[XB_TMO], 1u); break; } }
    }
    nloc = mine > 0u ? mine : 1u; nx = cnt > 0u ? cnt : 1u;
}

__device__ __forceinline__ void xcd_barrier(const XcdBarrier& b) {
    asm volatile("s_waitcnt vmcnt(0)" ::: "memory");
    __syncthreads();
    if (threadIdx.x == 0) {
        unsigned* bar = b.bar;
        __builtin_amdgcn_s_waitcnt(0);
        unsigned nloc = b.st[0], nx = b.st[1];
        if (nloc == 0u) { xcd_barrier_complete(bar, b.x, nloc, nx); b.st[0] = nloc; b.st[1] = nx; }
        const unsigned old = xb_add(&bar[XB_XSUB(b.x)], 1u);
        const unsigned gen = old / nloc;
        if (old + 1u == (gen + 1u) * nloc) {
            __builtin_amdgcn_fence(__ATOMIC_RELEASE, "agent");
            asm volatile("s_waitcnt vmcnt(0)" ::: "memory");
            const unsigned og = xb_add(&bar[XB_TOP], 1u);
            const unsigned tg = og / nx;
            if (og + 1u == (tg + 1u) * nx) xb_add(&bar[XB_TOPGEN], 1u);
            else XB_SPIN(xb_ld(&bar[XB_TOPGEN]) == tg, bar);
            __builtin_amdgcn_fence(__ATOMIC_ACQUIRE, "agent");
            xb_add(&bar[XB_XGEN(b.x)], 1u);
            asm volatile("s_waitcnt vmcnt(0)" ::: "memory");
        } else {
            XB_SPIN(xb_ld(&bar[XB_XGEN(b.x)]) == gen, bar);
            __builtin_amdgcn_fence(__ATOMIC_ACQUIRE, "agent");
            asm volatile("s_waitcnt vmcnt(0)" ::: "memory");
        }
    }
    __syncthreads();
}

constexpr int NWAVES = 8, NTHR = 512;
constexpr int DM = 2048, SEQL = 2048, NB = 4, MP = NB * SEQL  , MS = 128  , MT = MP + MS, MPAD = 8448;
constexpr int NIN = 5400, NINP = 5632, FF = 8192, DEPTH = 2;
constexpr int C_Q = 0, C_K = 512, C_V = 640, C_Z = 768, C_XBC = 1792, C_MQ = 3328, C_MK = 3840, C_MV = 4352, C_MO = 4864, C_DT = 5376, C_MI = 5392, C_MF = 5396;
constexpr int XCW = 1536;
constexpr size_t O_Y = 0, O_PK = 17039360, O_PV = 17170432, O_PCONV = 17301504, O_PSSM = 17338368, O_PC = 18386944, O_PN = 18911232, O_PM = 18915328,
                 O_SK = 18915360, O_SV = 23109664, O_SCONV = 27303968, O_SSSM = 28483616, O_SC = 62038048, O_SN = 78815264, O_SM = 78946336, O_END = 78947360;

constexpr size_t MiB = 1u << 20;
constexpr size_t WS_CTL = 0, CTL_ZERO_BYTES = 1 * MiB;
constexpr size_t WS_SSQA = 1 * MiB, WS_SSQB = 1 * MiB + 512 * 1024;
constexpr size_t WS_WIN = 2 * MiB, WIN_BYTES = 22 * MiB;
constexpr size_t WS_WOUT = 46 * MiB, WOUT_BYTES = 8 * MiB;
constexpr size_t WS_WUP = 62 * MiB, WUP_BYTES = 32 * MiB;
constexpr size_t WS_WDN = 126 * MiB, WDN_BYTES = 32 * MiB;
constexpr size_t WS_XB = 190 * MiB;
constexpr size_t WS_XRES = 223 * MiB;
constexpr size_t WS_HBUF = 289 * MiB;
constexpr size_t WS_PROJ = 289 * MiB;
constexpr size_t WS_MIXED = 380 * MiB;
constexpr size_t WS_XC = 421 * MiB;
constexpr size_t WS_YG = 446 * MiB;
constexpr size_t WS_HR = 479 * MiB;
constexpr size_t WS_END = 496 * MiB;
static_assert(WS_PROJ + (size_t)MPAD * NINP * 2 <= WS_MIXED && WS_MIXED + (size_t)MPAD * DM * 2 <= WS_XC && WS_HBUF + (size_t)MPAD * FF * 2 <= WS_XC, "ws map");
constexpr int CW_BAR = 4096;
constexpr int CW_QUEUE = 16384;

constexpr int RING_OFF = 0, RING_BYTES = 131072;
constexpr int LDSCTL_OFF = RING_BYTES, MISC_OFF = LDSCTL_OFF + 320;
constexpr int LDS_BYTES = 147456;

struct Args { const float* in[26]; float* out; unsigned char* ws; int ph_lo, ph_hi; };
typedef const __attribute__((address_space(4))) unsigned long long* karg_t;
__device__ __forceinline__ unsigned long long karg_u64(int idx) { int j = idx; asm volatile("" : "+s"(j)); return ((karg_t)__builtin_amdgcn_kernarg_segment_ptr())[j]; }
#define ARGIN(i) ((const float*)karg_u64(i))
#define ARGOUT() ((float*)karg_u64(26))
#define ARGWS() ((unsigned char*)karg_u64(27))

struct Frame {
    LAS unsigned char* lds;
    volatile LAS unsigned* MISC;
    gu32* ctl;
    int tid, lane, wave, vcu, G;
};

__device__ __forceinline__ float bf2f(unsigned short u) { return __builtin_bit_cast(float, (unsigned)u << 16); }
__device__ __forceinline__ float bflo(unsigned u) { return __builtin_bit_cast(float, u << 16); }
__device__ __forceinline__ float bfhi(unsigned u) { return __builtin_bit_cast(float, u & 0xffff0000u); }
__device__ __forceinline__ void unpack8(const v4u w, float (&f)[8]) { f[0] = bflo(w.x); f[1] = bfhi(w.x); f[2] = bflo(w.y); f[3] = bfhi(w.y); f[4] = bflo(w.z); f[5] = bfhi(w.z); f[6] = bflo(w.w); f[7] = bfhi(w.w); }
__device__ __forceinline__ v4u pack8(const float (&f)[8]) { v4u w; w.x = pk2(f[0], f[1]); w.y = pk2(f[2], f[3]); w.z = pk2(f[4], f[5]); w.w = pk2(f[6], f[7]); return w; }
__device__ __forceinline__ float wave_sum(float v) {
#pragma unroll
    for (int o = 1; o < 64; o <<= 1) v += __shfl_xor(v, o);
    return v;
}
__device__ __forceinline__ float wave_max(float v) {
#pragma unroll
    for (int o = 1; o < 64; o <<= 1) v = fmaxf(v, __shfl_xor(v, o));
    return v;
}
__device__ __forceinline__ float sigmoidf_(float x) { return 1.0f / (1.0f + expf(-x)); }
__device__ __forceinline__ float siluf_(float x) { return x / (1.0f + expf(-x)); }
__device__ __forceinline__ float softplusf_(float x) { return fmaxf(x, 0.f) + log1pf(expf(-fabsf(x))); }
__device__ __forceinline__ float logsigmoidf_(float x) { return fminf(x, 0.f) - log1pf(expf(-fabsf(x))); }
#define ROPE_INV(i) ((i) == 0 ? 1.0f : (i) == 1 ? 0.1939227432012558f : (i) == 2 ? 0.03760603070259094f : (i) == 3 ? 0.007292664609849453f : (i) == 4 ? 0.0014142135623842478f : (i) == 5 ? 0.00027424818836152554f : (i) == 6 ? 5.318296098266728e-05f : 1.0313386155758053e-05f)
__device__ __forceinline__ void rope_cs(int pos, float (&c)[8], float (&s)[8]) {
#pragma unroll
    for (int i = 0; i < 8; ++i) { const float ang = (float)pos * ROPE_INV(i); double rev = (double)ang * 0.15915494309189535; rev -= __builtin_rint(rev); const float fr = (float)rev;
        c[i] = __builtin_amdgcn_cosf(fr); s[i] = __builtin_amdgcn_sinf(fr); }
}

template <int MODE> __device__ __forceinline__ int colmap(int n) {
    if (MODE == 0) return n;
    if (n < 3328) return n; if (n < 5376) return n + 16; if (n < 5392) return n - 2048; if (n < 5400) return n; return -1;
}
template <int MODE> __device__ __forceinline__ void p0_transpose_item(const float* W, int K, int Norig, int Nrows, const float* gain, bf16* WT, LAS float* scr, int item, int lane) {
    const int nblk = Nrows / 32, kb = item / nblk, nb = item % nblk, k0 = 64 * kb, n0 = 32 * nb;
    const int oc = colmap<MODE>(n0 + (lane & 31));
#pragma unroll 8
    for (int i = 0; i < 32; ++i) { const int kk = 2 * i + (lane >> 5); float v = 0.f; if (oc >= 0) { v = W[(size_t)(k0 + kk) * Norig + oc]; if (gain) v *= gain[k0 + kk]; } scr[kk * 33 + (lane & 31)] = v; }
    LDS_WAIT(); asm volatile("" ::: "memory");
    const int c = lane & 7;
#pragma unroll
    for (int j = 0; j < 4; ++j) { const int n = (lane >> 3) + 8 * j; const LAS float* s = scr + (8 * c) * 33 + n;
        v4u o; o.x = pk2(s[0 * 33], s[1 * 33]); o.y = pk2(s[2 * 33], s[3 * 33]); o.z = pk2(s[4 * 33], s[5 * 33]); o.w = pk2(s[6 * 33], s[7 * 33]);
        *(GAS v4u*)(WT + (size_t)(n0 + n) * K + k0 + 8 * c) = o; }
    LDS_WAIT(); asm volatile("" ::: "memory");
}
__device__ __forceinline__ void x_row_to_bf16(int lane, const float* xrow, bf16* orow, float* ssqrow) {
    const GAS f32x4* xr = (const GAS f32x4*)xrow + lane;
    f32x4 v[8]; float s = 0.f;
#pragma unroll
    for (int j = 0; j < 8; ++j) { v[j] = xr[64 * j]; s += (v[j].x * v[j].x + v[j].y * v[j].y) + (v[j].z * v[j].z + v[j].w * v[j].w); }
    s = wave_sum(s);
    GAS unsigned long long* o8 = (GAS unsigned long long*)orow + lane;
#pragma unroll
    for (int j = 0; j < 8; ++j) o8[64 * j] = (unsigned long long)pk2(v[j].x, v[j].y) | ((unsigned long long)pk2(v[j].z, v[j].w) << 32);
    if (lane < 8) ssqrow[lane] = lane == 0 ? s : 0.f;
}
__device__ __forceinline__ void p0_prologue(Frame& F, const Args& a) {
    LAS float* scr = (LAS float*)(F.lds + RING_OFF + F.wave * 16384);
    const int gw = F.vcu * NWAVES + F.wave, NGW = F.G * NWAVES;
    constexpr int I_IN = (DM / 64) * (NINP / 32), I_OUT = (DM / 64) * (DM / 32), I_UP = (DM / 64) * (FF / 32), I_DN = (FF / 64) * (DM / 32);
    constexpr int PER_L = I_IN + I_OUT + I_UP + I_DN;
    unsigned char* ws = ARGWS();
    for (int it = gw; it < DEPTH * PER_L; it += NGW) {
        const int l = it / PER_L; int r = it % PER_L;
        if (r < I_IN) { p0_transpose_item<1>(ARGIN(10) + (size_t)l * DM * NIN, DM, NIN, NINP, ARGIN(9) + l * DM, (bf16*)(ws + WS_WIN + l * WIN_BYTES), scr, r, F.lane); continue; } r -= I_IN;
        if (r < I_OUT) { p0_transpose_item<0>(ARGIN(21) + (size_t)l * DM * DM, DM, DM, DM, nullptr, (bf16*)(ws + WS_WOUT + l * WOUT_BYTES), scr, r, F.lane); continue; } r -= I_OUT;
        if (r < I_UP) { p0_transpose_item<0>(ARGIN(23) + (size_t)l * DM * FF, DM, FF, FF, ARGIN(22) + l * DM, (bf16*)(ws + WS_WUP + l * WUP_BYTES), scr, r, F.lane); continue; } r -= I_UP;
        p0_transpose_item<0>(ARGIN(24) + (size_t)l * FF * DM, FF, DM, DM, nullptr, (bf16*)(ws + WS_WDN + l * WDN_BYTES), scr, r, F.lane);
    }
    bf16* XB = (bf16*)(ws + WS_XB); float* SSQA = (float*)(ws + WS_SSQA);
    for (int m = gw; m < MPAD; m += NGW) {
        if (m < MT) x_row_to_bf16(F.lane, m < MP ? ARGIN(0) + (size_t)m * DM : ARGIN(1) + (size_t)(m - MP) * DM, XB + (size_t)m * DM, SSQA + (size_t)m * 8);
        else { GAS v4u* o = (GAS v4u*)(XB + (size_t)m * DM) + F.lane;
#pragma unroll
            for (int j = 0; j < 4; ++j) o[64 * j] = (v4u){0u, 0u, 0u, 0u};
            if (F.lane < 8) SSQA[(size_t)m * 8 + F.lane] = 1.0f; }
    }
}

template <class EP> __device__ __forceinline__ void thin_gemm(Frame& F, const bf16* A, int lda, const bf16* Bt, int N, int K, const EP& epi) {
    const int fr = F.lane & 15, fq = F.lane >> 4;
    for (int item = F.vcu; item < N / 16; item += F.G) {
        const int n0 = item * 16;
        const GAS bf16x8* ap = (const GAS bf16x8*)(A + (size_t)(16 * F.wave + fr) * lda + 8 * fq);
        const GAS bf16x8* bp = (const GAS bf16x8*)(Bt + (size_t)(n0 + fr) * K + 8 * fq);
        f32x4 acc0 = (f32x4){0.f, 0.f, 0.f, 0.f}, acc1 = acc0;
        for (int k = 0; k < K / 8; k += 32) {
            bf16x8 a[8], b[8];
#pragma unroll
            for (int u = 0; u < 8; ++u) { a[u] = ap[k + 4 * u]; b[u] = bp[k + 4 * u]; }
#pragma unroll
            for (int u = 0; u < 8; u += 2) { acc0 = __builtin_amdgcn_mfma_f32_16x16x32_bf16(b[u], a[u], acc0, 0, 0, 0); acc1 = __builtin_amdgcn_mfma_f32_16x16x32_bf16(b[u + 1], a[u + 1], acc1, 0, 0, 0); }
        }
        epi(16 * F.wave + fr, n0 + 4 * fq, acc0 + acc1);
    }
}

#define MFMA16(yf, xf, acc) __builtin_amdgcn_mfma_f32_16x16x32_bf16(yf, xf, acc, 0, 0, 0)
constexpr int TP = 136, TPB = TP * 2;
__device__ __forceinline__ bf16x8 lds_frag(const LAS unsigned char* base, int row, int k0, int lane) { return *(const LAS bf16x8*)(base + (row + (lane & 15)) * TPB + (k0 + 8 * (lane >> 4)) * 2); }
__device__ __forceinline__ float wave_incl_scan_add(float v, int lane) {
#pragma unroll
    for (int o = 1; o < 64; o <<= 1) { const float u = __shfl_up(v, o); if (lane >= o) v += u; }
    return v;
}
__device__ __forceinline__ float wave_incl_scan_max(float v, int lane) {
#pragma unroll
    for (int o = 1; o < 64; o <<= 1) { const float u = __shfl_up(v, o); if (lane >= o) v = fmaxf(v, u); }
    return v;
}
constexpr size_t WS_DCT = 190 * MiB;
constexpr size_t WS_CPT = 206 * MiB;
constexpr size_t WS_DN = 214 * MiB, WS_NP = WS_DN + 131072, WS_SC = WS_NP + 131072, WS_MPV = WS_SC + 4096;
static_assert(WS_MPV + 4096 <= WS_XRES, "mlstm workspace inside the XB region");

__device__ __forceinline__ void mlstm_gates(Frame& F, const bf16* PROJ, int row0, int l, int h, LAS float* tab, float& bcum, float& a) {
    const int tid = F.tid, lane = F.lane;
    float v = 0.f, ig = 0.f;
    if (tid < 128) { ig = bf2f(PROJ[(size_t)(row0 + tid) * NINP + C_MI + h]) + ARGIN(18)[l * 4 + h];
        v = logsigmoidf_(bf2f(PROJ[(size_t)(row0 + tid) * NINP + C_MF + h]) + ARGIN(19)[l * 4 + h]);
        v = wave_incl_scan_add(v, lane);
        if (tid == 63) tab[0] = v; }
    __syncthreads();
    if (tid >= 64 && tid < 128) v += tab[0];
    bcum = v; a = ig - v;
}

__device__ __forceinline__ void mlstm_a_item(Frame& F, int l, int b, int h, int c) {
    const bf16* PROJ = (const bf16*)(ARGWS() + WS_PROJ);
    const int tid = F.tid, lane = F.lane, w = F.wave, row0 = b * SEQL + c * 128, item = (b * 4 + h) * 16 + c;
    LAS unsigned char* KT = F.lds; LAS unsigned char* VT = F.lds + 128 * TPB;
    LAS float* tab = (LAS float*)(F.lds + 2 * 128 * TPB); LAS float* wk = tab + 16;
    __syncthreads();
    float bcum, a; mlstm_gates(F, PROJ, row0, l, h, tab, bcum, a);
    if (tid < 128) { const float mx = wave_max(a); if (lane == 0) tab[1 + w] = mx; if (tid == 127) tab[3] = bcum; }
    __syncthreads();
    const float pmax = fmaxf(tab[1], tab[2]);
    if (tid < 128) wk[tid] = expf(a - pmax) * 0.08838834764831845f;
    __syncthreads();
#pragma unroll
    for (int rep = 0; rep < 4; ++rep) { const int task = tid + rep * NTHR, t = task & 127, ch = task >> 7;
        float f[8]; const float wt = wk[t];
        unpack8(*(const GAS v4u*)(PROJ + (size_t)(row0 + t) * NINP + C_MK + h * 128 + ch * 8), f);
#pragma unroll
        for (int i = 0; i < 8; ++i) *(LAS unsigned short*)(KT + (ch * 8 + i) * TPB + t * 2) = (unsigned short)f2bf(f[i] * wt);
        const v4u vv = *(const GAS v4u*)(PROJ + (size_t)(row0 + t) * NINP + C_MV + h * 128 + ch * 8);
        *(LAS unsigned short*)(VT + (ch * 8 + 0) * TPB + t * 2) = (unsigned short)(vv.x & 0xffffu); *(LAS unsigned short*)(VT + (ch * 8 + 1) * TPB + t * 2) = (unsigned short)(vv.x >> 16);
        *(LAS unsigned short*)(VT + (ch * 8 + 2) * TPB + t * 2) = (unsigned short)(vv.y & 0xffffu); *(LAS unsigned short*)(VT + (ch * 8 + 3) * TPB + t * 2) = (unsigned short)(vv.y >> 16);
        *(LAS unsigned short*)(VT + (ch * 8 + 4) * TPB + t * 2) = (unsigned short)(vv.z & 0xffffu); *(LAS unsigned short*)(VT + (ch * 8 + 5) * TPB + t * 2) = (unsigned short)(vv.z >> 16);
        *(LAS unsigned short*)(VT + (ch * 8 + 6) * TPB + t * 2) = (unsigned short)(vv.w & 0xffffu); *(LAS unsigned short*)(VT + (ch * 8 + 7) * TPB + t * 2) = (unsigned short)(vv.w >> 16); }
    __syncthreads();
    bf16x8 xf[4];
#pragma unroll
    for (int s = 0; s < 4; ++s) xf[s] = lds_frag(VT, 16 * w, 32 * s, lane);
    float* dct = (float*)(ARGWS() + WS_DCT) + (size_t)item * 16384;
#pragma unroll
    for (int t = 0; t < 8; ++t) { f32x4 acc = (f32x4){0.f, 0.f, 0.f, 0.f};
#pragma unroll
        for (int s = 0; s < 4; ++s) acc = MFMA16(lds_frag(KT, 16 * t, 32 * s, lane), xf[s], acc);
        *(GAS f32x4*)(dct + (size_t)(16 * w + (lane & 15)) * 128 + 16 * t + 4 * (lane >> 4)) = acc; }
    if (tid < 128) { float s = 0.f;
#pragma unroll
        for (int j = 0; j < 16; ++j) { float f[8]; unpack8(*(const LAS v4u*)(KT + tid * TPB + j * 16), f); s += ((f[0] + f[1]) + (f[2] + f[3])) + ((f[4] + f[5]) + (f[6] + f[7])); }
        ((float*)(ARGWS() + WS_DN))[(size_t)item * 128 + tid] = s; }
    if (tid == 0) { float* sc = (float*)(ARGWS() + WS_SC) + item * 2; sc[0] = tab[3]; sc[1] = pmax; }
}

__device__ __forceinline__ void mlstm_scan_phase(Frame& F, int l) {
    const int tid = F.tid;
    LAS float* coef = (LAS float*)(F.lds); LAS float* gend = coef + 16;
    for (int it = F.vcu; it < 128; it += F.G) {
        const int bh = it >> 3, b = bh >> 2, h = bh & 3, part = it & 7;
        __syncthreads();
        if (tid == 0) { const float* sc = (const float*)(ARGWS() + WS_SC) + bh * 32; float* mp = (float*)(ARGWS() + WS_MPV) + bh * 16; float m = 0.f;
            for (int c = 0; c < 16; ++c) { const float bl = sc[2 * c], pm = sc[2 * c + 1], M = fmaxf(m, pm); coef[c] = expf(pm - M); gend[c] = expf(m - M); if (part == 0) mp[c] = m; m = bl + M; }
            if (part == 0) ARGOUT()[O_PM + (size_t)(l * NB + b) * 4 + h] = m; }
        __syncthreads();
        const int elem = part * 512 + tid, e = elem >> 5, d4 = (elem & 31) * 4;
        const float* dct = (const float*)(ARGWS() + WS_DCT) + (size_t)bh * 16 * 16384 + (size_t)e * 128 + d4;
        bf16* cpt = (bf16*)(ARGWS() + WS_CPT) + (size_t)bh * 16 * 16384 + (size_t)e * 128 + d4;
        f32x4 dc[16];
#pragma unroll
        for (int c = 0; c < 16; ++c) dc[c] = *(const GAS f32x4*)(dct + (size_t)c * 16384);
        f32x4 C = (f32x4){0.f, 0.f, 0.f, 0.f};
#pragma unroll
        for (int c = 0; c < 16; ++c) { *(GAS unsigned long long*)(cpt + (size_t)c * 16384) = (unsigned long long)pk2(C.x, C.y) | ((unsigned long long)pk2(C.z, C.w) << 32);
            C = C * gend[c] + dc[c] * coef[c]; }
        float* pc = ARGOUT() + O_PC + ((size_t)(l * NB + b) * 4 + h) * 16384;
        pc[(size_t)(d4 + 0) * 128 + e] = C.x; pc[(size_t)(d4 + 1) * 128 + e] = C.y; pc[(size_t)(d4 + 2) * 128 + e] = C.z; pc[(size_t)(d4 + 3) * 128 + e] = C.w;
        if (part == 0 && tid < 128) { const float* dn = (const float*)(ARGWS() + WS_DN) + (size_t)bh * 16 * 128 + tid; float* np = (float*)(ARGWS() + WS_NP) + (size_t)bh * 16 * 128 + tid; float n = 0.f;
#pragma unroll
            for (int c = 0; c < 16; ++c) { np[c * 128] = n; n = n * gend[c] + dn[c * 128] * coef[c]; }
            ARGOUT()[O_PN + ((size_t)(l * NB + b) * 4 + h) * 128 + tid] = n; }
    }
}

__device__ __forceinline__ void mlstm_c_item(Frame& F, int l, int b, int h, int c) {
    const bf16* PROJ = (const bf16*)(ARGWS() + WS_PROJ); bf16* MIXED = (bf16*)(ARGWS() + WS_MIXED);
    const int tid = F.tid, lane = F.lane, w = F.wave, row0 = b * SEQL + c * 128, item = (b * 4 + h) * 16 + c, lc = lane & 15, lg = lane >> 4;
    LAS unsigned char* Kn = F.lds; LAS unsigned char* VT = F.lds + 128 * TPB; LAS unsigned char* CP = F.lds + 2 * 128 * TPB;
    LAS float* tab = (LAS float*)(F.lds + 3 * 128 * TPB); LAS float* Ak = tab + 16; LAS float* Mq = Ak + 128; LAS float* Emt = Mq + 128; LAS float* Np = Emt + 128;
    __syncthreads();
    float bcum, a; mlstm_gates(F, PROJ, row0, l, h, tab, bcum, a);
    const float mprev = ((const float*)(ARGWS() + WS_MPV))[item];
    float pm = -INFINITY;
    if (tid < 128) { pm = wave_incl_scan_max(a, lane); if (tid == 63) tab[1] = pm; }
    __syncthreads();
    if (tid < 128) { if (tid >= 64) pm = fmaxf(pm, tab[1]); const float M = fmaxf(mprev, pm); Ak[tid] = a; Mq[tid] = M; Emt[tid] = expf(-(bcum + M)); Np[tid] = ((const float*)(ARGWS() + WS_NP))[(size_t)item * 128 + tid]; }
#pragma unroll
    for (int rep = 0; rep < 4; ++rep) { const int task = tid + rep * NTHR;
        { const int ch = task & 15, t = task >> 4; *(LAS v4u*)(Kn + t * TPB + ch * 16) = *(const GAS v4u*)(PROJ + (size_t)(row0 + t) * NINP + C_MK + h * 128 + ch * 8);
          *(LAS v4u*)(CP + t * TPB + ch * 16) = *(const GAS v4u*)((const bf16*)(ARGWS() + WS_CPT) + (size_t)item * 16384 + (size_t)t * 128 + ch * 8); }
        { const int t = task & 127, ch = task >> 7; const v4u vv = *(const GAS v4u*)(PROJ + (size_t)(row0 + t) * NINP + C_MV + h * 128 + ch * 8);
          *(LAS unsigned short*)(VT + (ch * 8 + 0) * TPB + t * 2) = (unsigned short)(vv.x & 0xffffu); *(LAS unsigned short*)(VT + (ch * 8 + 1) * TPB + t * 2) = (unsigned short)(vv.x >> 16);
          *(LAS unsigned short*)(VT + (ch * 8 + 2) * TPB + t * 2) = (unsigned short)(vv.y & 0xffffu); *(LAS unsigned short*)(VT + (ch * 8 + 3) * TPB + t * 2) = (unsigned short)(vv.y >> 16);
          *(LAS unsigned short*)(VT + (ch * 8 + 4) * TPB + t * 2) = (unsigned short)(vv.z & 0xffffu); *(LAS unsigned short*)(VT + (ch * 8 + 5) * TPB + t * 2) = (unsigned short)(vv.z >> 16);
          *(LAS unsigned short*)(VT + (ch * 8 + 6) * TPB + t * 2) = (unsigned short)(vv.w & 0xffffu); *(LAS unsigned short*)(VT + (ch * 8 + 7) * TPB + t * 2) = (unsigned short)(vv.w >> 16); } }
    bf16x8 qf[4];
#pragma unroll
    for (int s = 0; s < 4; ++s) qf[s] = *(const GAS bf16x8*)(PROJ + (size_t)(row0 + 16 * w + lc) * NINP + C_MQ + h * 128 + 32 * s + 8 * lg);
    __syncthreads();
    float qn = 0.f;
#pragma unroll
    for (int s = 0; s < 4; ++s) { float f[8]; unpack8(__builtin_bit_cast(v4u, qf[s]), f);
#pragma unroll
        for (int i = 0; i < 8; ++i) qn += f[i] * Np[32 * s + 8 * lg + i]; }
    qn += __shfl_xor(qn, 16); qn += __shfl_xor(qn, 32);
    f32x4 sacc[8];
#pragma unroll
    for (int t = 0; t < 8; ++t) { sacc[t] = (f32x4){0.f, 0.f, 0.f, 0.f};
        if (t <= w) {
#pragma unroll
            for (int s = 0; s < 4; ++s) sacc[t] = MFMA16(lds_frag(Kn, 16 * t, 32 * s, lane), qf[s], sacc[t]); } }
    __syncthreads();
    LAS unsigned char* Pw = Kn + w * 16 * TPB;
    const int q = 16 * w + lc; const float Mrow = Mq[q], gq = expf(mprev - Mrow);
    float rsum = 0.f;
#pragma unroll
    for (int t = 0; t < 8; ++t) { if (t <= (w | 1)) { float p[4];
#pragma unroll
            for (int i = 0; i < 4; ++i) { const int k = 16 * t + 4 * lg + i; p[i] = (k <= q) ? expf(Ak[k] - Mrow) * 0.08838834764831845f * sacc[t][i] : 0.f; rsum += p[i]; }
            *(LAS unsigned long long*)(Pw + lc * TPB + (16 * t + 4 * lg) * 2) = (unsigned long long)pk2(p[0], p[1]) | ((unsigned long long)pk2(p[2], p[3]) << 32); } }
    rsum += __shfl_xor(rsum, 16); rsum += __shfl_xor(rsum, 32);
    asm volatile("s_waitcnt lgkmcnt(0)" ::: "memory");
    f32x4 acc[8];
#pragma unroll
    for (int t = 0; t < 8; ++t) { acc[t] = (f32x4){0.f, 0.f, 0.f, 0.f};
#pragma unroll
        for (int s = 0; s < 4; ++s) acc[t] = MFMA16(lds_frag(CP, 16 * t, 32 * s, lane), qf[s], acc[t]);
        acc[t] = acc[t] * gq; }
#pragma unroll
    for (int s = 0; s < 4; ++s) { if (s <= (w >> 1)) { const bf16x8 pf = lds_frag(Pw, 0, 32 * s, lane);
#pragma unroll
            for (int t = 0; t < 8; ++t) acc[t] = MFMA16(lds_frag(VT, 16 * t, 32 * s, lane), pf, acc[t]); } }
    const float den = rsum + gq * qn, dinv = 1.0f / fmaxf(fabsf(den), Emt[q]);
    float ss = 0.f;
#pragma unroll
    for (int t = 0; t < 8; ++t) { acc[t] = acc[t] * dinv; ss += (acc[t][0] * acc[t][0] + acc[t][1] * acc[t][1]) + (acc[t][2] * acc[t][2] + acc[t][3] * acc[t][3]); }
    ss += __shfl_xor(ss, 16); ss += __shfl_xor(ss, 32);
    const float rs = 1.0f / sqrtf(ss * (1.0f / 128.0f) + 1e-6f);
    const float* wml = ARGIN(20) + (size_t)l * 512 + h * 128;
#pragma unroll
    for (int t = 0; t < 8; ++t) { const int e0 = 16 * t + 4 * lg; const f32x4 g4 = *(const GAS f32x4*)(wml + e0);
        const unsigned long long mo = *(const GAS unsigned long long*)(PROJ + (size_t)(row0 + q) * NINP + C_MO + h * 128 + e0);
        const float o0 = acc[t][0] * rs * g4.x * sigmoidf_(bflo((unsigned)mo)), o1 = acc[t][1] * rs * g4.y * sigmoidf_(bfhi((unsigned)mo)),
                    o2 = acc[t][2] * rs * g4.z * sigmoidf_(bflo((unsigned)(mo >> 32))), o3 = acc[t][3] * rs * g4.w * sigmoidf_(bfhi((unsigned)(mo >> 32)));
        *(GAS unsigned long long*)(MIXED + (size_t)(row0 + q) * DM + 1536 + h * 128 + e0) = (unsigned long long)pk2(o0, o1) | ((unsigned long long)pk2(o2, o3) << 32); }
}

__device__ __forceinline__ void conv_phase(Frame& F, const Args& a, int l) {
    const bf16* PROJ = (const bf16*)(ARGWS() + WS_PROJ); bf16* XC = (bf16*)(ARGWS() + WS_XC);
    const float* cw = ARGIN(12) + (size_t)l * 4 * XCW; const float* cb = ARGIN(13) + (size_t)l * XCW; const float* sconv = ARGIN(4) + (size_t)l * MS * 3 * XCW;
    float* pconv = ARGOUT() + O_PCONV + (size_t)l * NB * 3 * XCW; float* sconv_o = ARGOUT() + O_SCONV + (size_t)l * MS * 3 * XCW;
    for (int idx = F.vcu * NTHR + F.tid; idx < MT * (XCW / 8); idx += F.G * NTHR) {
        const int row = idx / (XCW / 8), c0 = (idx % (XCW / 8)) * 8;
        float r[4][8];
        if (row < MP) { const int t = row & (SEQL - 1);
#pragma unroll
            for (int j = 0; j < 4; ++j) { const int tt = t - 3 + j;
                if (tt >= 0) { const v4u w = *(const GAS v4u*)(PROJ + (size_t)(row - 3 + j) * NINP + C_XBC + c0); unpack8(w, r[j]); }
                else {
#pragma unroll
                    for (int i = 0; i < 8; ++i) r[j][i] = 0.f; } }
        } else { const int b = row - MP;
#pragma unroll
            for (int j = 0; j < 3; ++j) { const f32x4 u0 = *(const GAS f32x4*)(sconv + (size_t)(b * 3 + j) * XCW + c0), u1 = *(const GAS f32x4*)(sconv + (size_t)(b * 3 + j) * XCW + c0 + 4);
                r[j][0] = u0.x; r[j][1] = u0.y; r[j][2] = u0.z; r[j][3] = u0.w; r[j][4] = u1.x; r[j][5] = u1.y; r[j][6] = u1.z; r[j][7] = u1.w; }
            const v4u w = *(const GAS v4u*)(PROJ + (size_t)row * NINP + C_XBC + c0); unpack8(w, r[3]);
        }
        float y[8];
#pragma unroll
        for (int i = 0; i < 8; ++i) { float acc = cb[c0 + i];
#pragma unroll
            for (int j = 0; j < 4; ++j) acc += cw[j * XCW + c0 + i] * r[j][i];
            y[i] = siluf_(acc); }
        *(GAS v4u*)(XC + (size_t)row * XCW + c0) = pack8(y);
        if (row < MP) { const int t = row & (SEQL - 1), b = row >> 11;
            if (t >= SEQL - 3) { float* o = pconv + (size_t)(b * 3 + (t - (SEQL - 3))) * XCW + c0;
                *(GAS f32x4*)o = (f32x4){r[3][0], r[3][1], r[3][2], r[3][3]}; *(GAS f32x4*)(o + 4) = (f32x4){r[3][4], r[3][5], r[3][6], r[3][7]}; }
        } else { const int b = row - MP;
#pragma unroll
            for (int j = 0; j < 3; ++j) { float* o = sconv_o + (size_t)(b * 3 + j) * XCW + c0;
                *(GAS f32x4*)o = (f32x4){r[j + 1][0], r[j + 1][1], r[j + 1][2], r[j + 1][3]}; *(GAS f32x4*)(o + 4) = (f32x4){r[j + 1][4], r[j + 1][5], r[j + 1][6], r[j + 1][7]}; }
        }
    }
}

__device__ __forceinline__ void ssd_seq_item(Frame& F, const Args& a, int l, int b, int h, bool sample) {
    const bf16* PROJ = (const bf16*)(ARGWS() + WS_PROJ); const bf16* XC = (const bf16*)(ARGWS() + WS_XC); float* YG = (float*)(ARGWS() + WS_YG);
    const int row0 = sample ? MP + b : b * SEQL, L = sample ? 1 : SEQL, g = h >> 3, tid = F.tid;
    const float A = -expf(ARGIN(15)[l * 16 + h]), dtb = ARGIN(14)[l * 16 + h], Dh = ARGIN(16)[l * 16 + h];
    const int p = tid >> 3, nq = tid & 7;
    float S[16];
    if (sample) { const float* s0 = ARGIN(5) + ((((size_t)l * MS + b) * 16 + h) * 64 + p) * 128 + nq * 16;
#pragma unroll
        for (int i = 0; i < 4; ++i) { const f32x4 v = *(const GAS f32x4*)(s0 + 4 * i); S[4 * i] = v.x; S[4 * i + 1] = v.y; S[4 * i + 2] = v.z; S[4 * i + 3] = v.w; } }
    else {
#pragma unroll
        for (int i = 0; i < 16; ++i) S[i] = 0.f; }
    LAS float* xs = (LAS float*)(F.lds);
    LAS float* Bs = (LAS float*)(F.lds + 16384);
    LAS float* Cs = (LAS float*)(F.lds + 49152);
    LAS float* ys = (LAS float*)(F.lds + 81920);
    LAS float* dts = (LAS float*)(F.lds + 98304);
    LAS float* das = (LAS float*)(F.lds + 98304 + 256);
    for (int t0 = 0; t0 < L; t0 += 64) {
        const int nb = (L - t0) < 64 ? (L - t0) : 64;
        __syncthreads();
        { const int tt = tid >> 3, ch = tid & 7;
          if (tt < nb) { float f[8]; unpack8(*(const GAS v4u*)(XC + (size_t)(row0 + t0 + tt) * XCW + h * 64 + ch * 8), f);
#pragma unroll
              for (int i = 0; i < 8; ++i) xs[tt * 64 + ch * 8 + i] = f[i]; } }
#pragma unroll
        for (int rep = 0; rep < 2; ++rep) { const int task = tid + rep * NTHR, tt = task >> 4, ch = task & 15;
          if (tt < nb) { float f[8]; unpack8(*(const GAS v4u*)(XC + (size_t)(row0 + t0 + tt) * XCW + 1024 + g * 128 + ch * 8), f);
#pragma unroll
              for (int i = 0; i < 8; ++i) Bs[tt * 128 + ch * 8 + i] = f[i];
              unpack8(*(const GAS v4u*)(XC + (size_t)(row0 + t0 + tt) * XCW + 1280 + g * 128 + ch * 8), f);
#pragma unroll
              for (int i = 0; i < 8; ++i) Cs[tt * 128 + ch * 8 + i] = f[i]; } }
        if (tid < nb) { const float dt = softplusf_(bf2f(PROJ[(size_t)(row0 + t0 + tid) * NINP + C_DT + h]) + dtb); dts[tid] = dt; das[tid] = expf(dt * A); }
        __syncthreads();
        for (int tt = 0; tt < nb; ++tt) {
            const float dt = dts[tt], dA = das[tt], x = xs[tt * 64 + p], coef = dt * x;
            float y = 0.f;
#pragma unroll
            for (int i = 0; i < 16; ++i) { S[i] = dA * S[i] + coef * Bs[tt * 128 + nq * 16 + i]; y += S[i] * Cs[tt * 128 + nq * 16 + i]; }
            y += __shfl_xor(y, 1); y += __shfl_xor(y, 2); y += __shfl_xor(y, 4);
            if (nq == 0) ys[tt * 64 + p] = y + Dh * x;
        }
        __syncthreads();
        { const int tt = tid >> 3, ch = tid & 7;
          if (tt < nb) { float z[8]; unpack8(*(const GAS v4u*)(PROJ + (size_t)(row0 + t0 + tt) * NINP + C_Z + h * 64 + ch * 8), z);
              float o[8];
#pragma unroll
              for (int i = 0; i < 8; ++i) o[i] = ys[tt * 64 + ch * 8 + i] * siluf_(z[i]);
              float* dst = YG + (size_t)(row0 + t0 + tt) * 1024 + h * 64 + ch * 8;
              *(GAS f32x4*)dst = (f32x4){o[0], o[1], o[2], o[3]}; *(GAS f32x4*)(dst + 4) = (f32x4){o[4], o[5], o[6], o[7]}; } }
    }
    float* so = ARGOUT() + (sample ? O_SSSM + ((((size_t)l * MS + b) * 16 + h) * 64 + p) * 128 : O_PSSM + ((((size_t)l * NB + b) * 16 + h) * 64 + p) * 128) + nq * 16;
#pragma unroll
    for (int i = 0; i < 4; ++i) *(GAS f32x4*)(so + 4 * i) = (f32x4){S[4 * i], S[4 * i + 1], S[4 * i + 2], S[4 * i + 3]};
}

__device__ __forceinline__ void mlstm_seq_item(Frame& F, const Args& a, int l, int b, int h, int es, bool sample) {
    const bf16* PROJ = (const bf16*)(ARGWS() + WS_PROJ); float* HR = (float*)(ARGWS() + WS_HR);
    const int row0 = sample ? MP + b : b * SEQL, L = sample ? 1 : SEQL, tid = F.tid, w = F.wave, lane = F.lane;
    const int e0 = es * 32 + w * 4, d0 = 2 * lane, Bn = sample ? MS : NB;
    const float ib = ARGIN(18)[l * 4 + h], fb = ARGIN(19)[l * 4 + h];
    float C[2][4], n[2], m;
    if (sample) {
#pragma unroll
        for (int dd = 0; dd < 2; ++dd) { const f32x4 v = *(const GAS f32x4*)(ARGIN(6) + ((((size_t)l * MS + b) * 4 + h) * 128 + d0 + dd) * 128 + e0);
            C[dd][0] = v.x; C[dd][1] = v.y; C[dd][2] = v.z; C[dd][3] = v.w; n[dd] = ARGIN(7)[(((size_t)l * MS + b) * 4 + h) * 128 + d0 + dd]; }
        m = ARGIN(8)[((size_t)l * MS + b) * 4 + h];
    } else {
#pragma unroll
        for (int dd = 0; dd < 2; ++dd) { n[dd] = 0.f;
#pragma unroll
            for (int j = 0; j < 4; ++j) C[dd][j] = 0.f; }
        m = 0.f;
    }
    LAS float* qs = (LAS float*)(F.lds);
    LAS float* ks = (LAS float*)(F.lds + 32768);
    LAS float* vs = (LAS float*)(F.lds + 65536);
    LAS float* hs = (LAS float*)(F.lds + 73728);
    LAS float* igs = (LAS float*)(F.lds + 81920);
    LAS float* lfs = (LAS float*)(F.lds + 81920 + 256);
    for (int t0 = 0; t0 < L; t0 += 64) {
        const int nb = (L - t0) < 64 ? (L - t0) : 64;
        __syncthreads();
#pragma unroll
        for (int rep = 0; rep < 2; ++rep) { const int task = tid + rep * NTHR, tt = task >> 4, ch = task & 15;
          if (tt < nb) { float f[8]; unpack8(*(const GAS v4u*)(PROJ + (size_t)(row0 + t0 + tt) * NINP + C_MQ + h * 128 + ch * 8), f);
#pragma unroll
              for (int i = 0; i < 8; ++i) qs[tt * 128 + ch * 8 + i] = f[i];
              unpack8(*(const GAS v4u*)(PROJ + (size_t)(row0 + t0 + tt) * NINP + C_MK + h * 128 + ch * 8), f);
#pragma unroll
              for (int i = 0; i < 8; ++i) ks[tt * 128 + ch * 8 + i] = f[i] * 0.08838834764831845f; } }
        if (tid < 256) { const int tt = tid >> 2, ch = tid & 3;
          if (tt < nb) { float f[8]; unpack8(*(const GAS v4u*)(PROJ + (size_t)(row0 + t0 + tt) * NINP + C_MV + h * 128 + es * 32 + ch * 8), f);
#pragma unroll
              for (int i = 0; i < 8; ++i) vs[tt * 32 + ch * 8 + i] = f[i]; } }
        if (tid < nb) { igs[tid] = bf2f(PROJ[(size_t)(row0 + t0 + tid) * NINP + C_MI + h]) + ib; lfs[tid] = logsigmoidf_(bf2f(PROJ[(size_t)(row0 + t0 + tid) * NINP + C_MF + h]) + fb); }
        __syncthreads();
        for (int tt = 0; tt < nb; ++tt) {
            const float lf = lfs[tt], ig = igs[tt];
            const float m_new = fmaxf(lf + m, ig), fgt = expf(lf + m - m_new), igt = expf(ig - m_new); m = m_new;
            const float q0 = qs[tt * 128 + d0], q1 = qs[tt * 128 + d0 + 1], k0 = ks[tt * 128 + d0] * igt, k1 = ks[tt * 128 + d0 + 1] * igt;
            n[0] = fgt * n[0] + k0; n[1] = fgt * n[1] + k1;
            float red[5]; red[4] = q0 * n[0] + q1 * n[1];
#pragma unroll
            for (int j = 0; j < 4; ++j) { const float v = vs[tt * 32 + w * 4 + j]; C[0][j] = fgt * C[0][j] + k0 * v; C[1][j] = fgt * C[1][j] + k1 * v; red[j] = q0 * C[0][j] + q1 * C[1][j]; }
#pragma unroll
            for (int j = 0; j < 5; ++j) red[j] = wave_sum(red[j]);
            const float dn = fmaxf(fabsf(red[4]), expf(-m));
            if (lane < 4) hs[tt * 32 + w * 4 + lane] = (lane == 0 ? red[0] : lane == 1 ? red[1] : lane == 2 ? red[2] : red[3]) / dn;
        }
        __syncthreads();
        { const int tt = tid >> 3, e4 = (tid & 7) * 4;
          if (tt < nb) *(GAS f32x4*)(HR + (size_t)(row0 + t0 + tt) * 512 + h * 128 + es * 32 + e4) = (f32x4){hs[tt * 32 + e4], hs[tt * 32 + e4 + 1], hs[tt * 32 + e4 + 2], hs[tt * 32 + e4 + 3]}; }
    }
    float* co = ARGOUT() + (sample ? O_SC : O_PC) + (((size_t)l * Bn + b) * 4 + h) * 128 * 128;
#pragma unroll
    for (int dd = 0; dd < 2; ++dd) *(GAS f32x4*)(co + (size_t)(d0 + dd) * 128 + e0) = (f32x4){C[dd][0], C[dd][1], C[dd][2], C[dd][3]};
    if (es == 0 && w == 0) { float* no = ARGOUT() + (sample ? O_SN : O_PN) + (((size_t)l * Bn + b) * 4 + h) * 128; no[d0] = n[0]; no[d0 + 1] = n[1];
        if (lane == 0) ARGOUT()[(sample ? O_SM : O_PM) + ((size_t)l * Bn + b) * 4 + h] = m; }
}

__device__ __forceinline__ void attn_prompt_item(Frame& F, const Args& a, int l, int b, int blk, int kvh) {
    const bf16* PROJ = (const bf16*)(ARGWS() + WS_PROJ); bf16* MIXED = (bf16*)(ARGWS() + WS_MIXED);
    constexpr int KP = 68;
    LAS unsigned short* Ks = (LAS unsigned short*)(F.lds); LAS unsigned short* Vs = (LAS unsigned short*)(F.lds + 256 * KP * 2);
    const int tid = F.tid, w0 = blk * 128 - 128;
    float* pk = ARGOUT() + O_PK + (size_t)(l * NB + b) * 128 * 128; float* pv = ARGOUT() + O_PV + (size_t)(l * NB + b) * 128 * 128;
    __syncthreads();
#pragma unroll
    for (int rep = 0; rep < 4; ++rep) { const int task = tid + rep * NTHR, r = task >> 3, c = task & 7, pos = w0 + r; const bool keep = (blk == 15 && r >= 128);
        if (pos < 0) { *(LAS v4u*)(Ks + r * KP + c * 8) = (v4u){0u, 0u, 0u, 0u}; *(LAS v4u*)(Vs + r * KP + c * 8) = (v4u){0u, 0u, 0u, 0u}; continue; }
        const size_t grow = (size_t)(b * SEQL + pos) * NINP;
        { const v4u wv = *(const GAS v4u*)(PROJ + grow + C_V + kvh * 64 + c * 8); *(LAS v4u*)(Vs + r * KP + c * 8) = wv;
          if (keep) { float f[8]; unpack8(wv, f); float* o = pv + (size_t)((r - 128) * 2 + kvh) * 64 + c * 8; *(GAS f32x4*)o = (f32x4){f[0], f[1], f[2], f[3]}; *(GAS f32x4*)(o + 4) = (f32x4){f[4], f[5], f[6], f[7]}; } }
        if (c >= 2) { const v4u wk = *(const GAS v4u*)(PROJ + grow + C_K + kvh * 64 + c * 8); *(LAS v4u*)(Ks + r * KP + c * 8) = wk;
          if (keep) { float f[8]; unpack8(wk, f); float* o = pk + (size_t)((r - 128) * 2 + kvh) * 64 + c * 8; *(GAS f32x4*)o = (f32x4){f[0], f[1], f[2], f[3]}; *(GAS f32x4*)(o + 4) = (f32x4){f[4], f[5], f[6], f[7]}; } }
        else if (c == 0) { float x1[8], x2[8], cs[8], sn[8], o1[8], o2[8];
          unpack8(*(const GAS v4u*)(PROJ + grow + C_K + kvh * 64), x1); unpack8(*(const GAS v4u*)(PROJ + grow + C_K + kvh * 64 + 8), x2); rope_cs(pos, cs, sn);
#pragma unroll
          for (int i = 0; i < 8; ++i) { o1[i] = x1[i] * cs[i] - x2[i] * sn[i]; o2[i] = x2[i] * cs[i] + x1[i] * sn[i]; }
          *(LAS v4u*)(Ks + r * KP) = pack8(o1); *(LAS v4u*)(Ks + r * KP + 8) = pack8(o2);
          if (keep) { float* o = pk + (size_t)((r - 128) * 2 + kvh) * 64; *(GAS f32x4*)o = (f32x4){o1[0], o1[1], o1[2], o1[3]}; *(GAS f32x4*)(o + 4) = (f32x4){o1[4], o1[5], o1[6], o1[7]};
              *(GAS f32x4*)(o + 8) = (f32x4){o2[0], o2[1], o2[2], o2[3]}; *(GAS f32x4*)(o + 12) = (f32x4){o2[4], o2[5], o2[6], o2[7]}; } }
    }
    __syncthreads();
    const int i = tid >> 2, g = tid & 3, h = kvh * 4 + g, qpos = blk * 128 + i; const size_t row = (size_t)b * SEQL + qpos;
    float q[64];
#pragma unroll
    for (int c = 0; c < 8; ++c) { float f[8]; unpack8(*(const GAS v4u*)(PROJ + row * NINP + C_Q + h * 64 + c * 8), f);
#pragma unroll
        for (int e = 0; e < 8; ++e) q[c * 8 + e] = f[e]; }
    { float cs[8], sn[8]; rope_cs(qpos, cs, sn);
#pragma unroll
      for (int e = 0; e < 8; ++e) { const float x1 = q[e], x2 = q[8 + e]; q[e] = x1 * cs[e] - x2 * sn[e]; q[8 + e] = x2 * cs[e] + x1 * sn[e]; } }
#pragma unroll
    for (int e = 0; e < 64; ++e) q[e] *= 0.125f;
    float acc[64], mx = -INFINITY, sum = 0.f;
#pragma unroll
    for (int e = 0; e < 64; ++e) acc[e] = 0.f;
    for (int jj = 0; jj <= 128; ++jj) { const int r = i + jj;
        if (w0 + r < 0) continue;
        float s = 0.f;
#pragma unroll
        for (int c = 0; c < 8; ++c) { float f[8]; unpack8(*(const LAS v4u*)(Ks + r * KP + c * 8), f);
#pragma unroll
            for (int e = 0; e < 8; ++e) s += q[c * 8 + e] * f[e]; }
        const float mn = fmaxf(mx, s), sc = expf(mx - mn), p = expf(s - mn); mx = mn; sum = sum * sc + p;
#pragma unroll
        for (int c = 0; c < 8; ++c) { float f[8]; unpack8(*(const LAS v4u*)(Vs + r * KP + c * 8), f);
#pragma unroll
            for (int e = 0; e < 8; ++e) acc[c * 8 + e] = acc[c * 8 + e] * sc + p * f[e]; }
    }
    const float sink = ARGIN(11)[l * 8 + h], mf = fmaxf(mx, sink), sc = expf(mx - mf), den = sum * sc + expf(sink - mf), inv = sc / den;
#pragma unroll
    for (int c = 0; c < 8; ++c) { float o[8];
#pragma unroll
        for (int e = 0; e < 8; ++e) o[e] = acc[c * 8 + e] * inv;
        *(GAS v4u*)(MIXED + row * DM + h * 64 + c * 8) = pack8(o); }
}

__device__ __forceinline__ void attn_sample_item(Frame& F, const Args& a, int l, int b) {
    const bf16* PROJ = (const bf16*)(ARGWS() + WS_PROJ); bf16* MIXED = (bf16*)(ARGWS() + WS_MIXED);
    const int tid = F.tid, h = F.wave, lane = F.lane, kvh = h >> 2; const size_t prow = (size_t)(MP + b) * NINP;
    LAS float* qs = (LAS float*)(F.lds);
    LAS float* ps = (LAS float*)(F.lds + 2048);
    LAS float* knew = (LAS float*)(F.lds + 2048 + 4224);
    LAS float* vnew = knew + 128;
    const float* ck = ARGIN(2) + (size_t)(l * MS + b) * 128 * 128; const float* cv = ARGIN(3) + (size_t)(l * MS + b) * 128 * 128;
    __syncthreads();
    { float cs[8], sn[8]; rope_cs(8192, cs, sn);
      const int d = lane; float x = bf2f(PROJ[prow + C_Q + h * 64 + d]);
      if (d < 16) { const float xp = bf2f(PROJ[prow + C_Q + h * 64 + (d ^ 8)]); const float c = (d & 7) == 0 ? cs[0] : (d & 7) == 1 ? cs[1] : (d & 7) == 2 ? cs[2] : (d & 7) == 3 ? cs[3] : (d & 7) == 4 ? cs[4] : (d & 7) == 5 ? cs[5] : (d & 7) == 6 ? cs[6] : cs[7];
          const float s = (d & 7) == 0 ? sn[0] : (d & 7) == 1 ? sn[1] : (d & 7) == 2 ? sn[2] : (d & 7) == 3 ? sn[3] : (d & 7) == 4 ? sn[4] : (d & 7) == 5 ? sn[5] : (d & 7) == 6 ? sn[6] : sn[7];
          x = d < 8 ? x * c - xp * s : x * c + xp * s; }
      qs[h * 64 + d] = x * 0.125f;
      if (h < 2) { float y = bf2f(PROJ[prow + C_K + h * 64 + d]);
          if (d < 16) { const float yp = bf2f(PROJ[prow + C_K + h * 64 + (d ^ 8)]); const float c = (d & 7) == 0 ? cs[0] : (d & 7) == 1 ? cs[1] : (d & 7) == 2 ? cs[2] : (d & 7) == 3 ? cs[3] : (d & 7) == 4 ? cs[4] : (d & 7) == 5 ? cs[5] : (d & 7) == 6 ? cs[6] : cs[7];
              const float s = (d & 7) == 0 ? sn[0] : (d & 7) == 1 ? sn[1] : (d & 7) == 2 ? sn[2] : (d & 7) == 3 ? sn[3] : (d & 7) == 4 ? sn[4] : (d & 7) == 5 ? sn[5] : (d & 7) == 6 ? sn[6] : sn[7];
              y = d < 8 ? y * c - yp * s : y * c + yp * s; }
          knew[h * 64 + d] = y; vnew[h * 64 + d] = bf2f(PROJ[prow + C_V + h * 64 + d]); } }
    __syncthreads();
    float sa = 0.f, sb = 0.f, sn_ = 0.f;
    { const float* ka = ck + (size_t)(lane * 2 + kvh) * 64; const float* kb = ck + (size_t)((lane + 64) * 2 + kvh) * 64;
#pragma unroll
      for (int c = 0; c < 16; ++c) { const f32x4 x = *(const GAS f32x4*)(ka + 4 * c), y = *(const GAS f32x4*)(kb + 4 * c); const f32x4 qv = *(const LAS f32x4*)(qs + h * 64 + 4 * c), kn = *(const LAS f32x4*)(knew + kvh * 64 + 4 * c);
          sa += (qv.x * x.x + qv.y * x.y) + (qv.z * x.z + qv.w * x.w); sb += (qv.x * y.x + qv.y * y.y) + (qv.z * y.z + qv.w * y.w); sn_ += (qv.x * kn.x + qv.y * kn.y) + (qv.z * kn.z + qv.w * kn.w); } }
    const float sink = ARGIN(11)[l * 8 + h];
    const float mx = fmaxf(fmaxf(wave_max(fmaxf(sa, sb)), sn_), sink);
    const float ea = expf(sa - mx), eb = expf(sb - mx), en = expf(sn_ - mx);
    const float inv = 1.0f / (wave_sum(ea + eb) + en + expf(sink - mx));
    ps[h * 132 + lane] = ea * inv; ps[h * 132 + 64 + lane] = eb * inv; if (lane == 0) ps[h * 132 + 128] = en * inv;
    __syncthreads();
    { float o = ps[h * 132 + 128] * vnew[kvh * 64 + lane];
      for (int j = 0; j < 128; ++j) o += ps[h * 132 + j] * cv[(size_t)(j * 2 + kvh) * 64 + lane];
      ((unsigned short*)MIXED)[(size_t)(MP + b) * DM + h * 64 + lane] = (unsigned short)f2bf(o); }
    float* sk = ARGOUT() + O_SK + (size_t)(l * MS + b) * 128 * 128; float* sv = ARGOUT() + O_SV + (size_t)(l * MS + b) * 128 * 128;
    for (int idx = tid * 4; idx < 128 * 128; idx += NTHR * 4) { const int j = idx >> 7, rem = idx & 127;
        f32x4 kk, vv;
        if (j < 127) { kk = *(const GAS f32x4*)(ck + idx + 128); vv = *(const GAS f32x4*)(cv + idx + 128); }
        else { kk = *(const LAS f32x4*)(knew + rem); vv = *(const LAS f32x4*)(vnew + rem); }
        *(GAS f32x4*)(sk + idx) = kk; *(GAS f32x4*)(sv + idx) = vv; }
}

__device__ __forceinline__ void mixer_phase(Frame& F, const Args& a, int l, int qslot) {
    constexpr int N_SSDP = NB * 16, N_MLP = NB * 4 * 16, N_ATP = NB * 16 * 2, N_SSDS = MS * 16, N_MLS = MS * 4 * 4, N_ATS = MS;
    constexpr int E0 = N_SSDP, E1 = E0 + N_MLP, E2 = E1 + N_ATP, E3 = E2 + N_SSDS, E4 = E3 + N_MLS, E5 = E4 + N_ATS;
    gu32* head = F.ctl + CW_QUEUE + 64 * qslot;
    volatile LAS unsigned* slot = F.MISC + 16;
    for (;;) {
        __syncthreads();
        if (F.tid == 0) slot[0] = __hip_atomic_fetch_add(head, 1u, RLX_AGENT);
        __syncthreads();
        const int it = (int)slot[0];
        if (it >= E5) break;
        { int t_ = threadIdx.x; asm volatile("" : "+v"(t_)); F.tid = t_; F.lane = t_ & 63; F.wave = __builtin_amdgcn_readfirstlane(t_ >> 6); }
        if (it < E0) ssd_seq_item(F, a, l, it >> 4, it & 15, false);
        else if (it < E1) { const int r = it - E0; mlstm_a_item(F, l, r >> 6, (r >> 4) & 3, r & 15); }
        else if (it < E2) { const int r = it - E1; attn_prompt_item(F, a, l, r >> 5, (r >> 1) & 15, r & 1); }
        else if (it < E3) { const int r = it - E2; ssd_seq_item(F, a, l, r >> 4, r & 15, true); }
        else if (it < E4) { const int r = it - E3; mlstm_seq_item(F, a, l, r >> 4, (r >> 2) & 3, r & 3, true); }
        else attn_sample_item(F, a, l, it - E4);
    }
}

__device__ __forceinline__ void finalize_phase(Frame& F, const Args& a, int l) {
    const bf16* PROJ = (const bf16*)(ARGWS() + WS_PROJ); bf16* MIXED = (bf16*)(ARGWS() + WS_MIXED); const float* YG = (const float*)(ARGWS() + WS_YG); const float* HR = (const float*)(ARGWS() + WS_HR);
    const float* wssm = ARGIN(17) + (size_t)l * 1024; const float* wml = ARGIN(20) + (size_t)l * 512;
    const int gw = F.vcu * NWAVES + F.wave, NGW = F.G * NWAVES, lane = F.lane;
    for (int row = gw; row < MT; row += NGW) {
#pragma unroll
        for (int g = 0; g < 2; ++g) { const float* src = YG + (size_t)row * 1024 + g * 512 + lane * 8; const f32x4 u0 = *(const GAS f32x4*)src, u1 = *(const GAS f32x4*)(src + 4);
            float ss = (u0.x * u0.x + u0.y * u0.y) + (u0.z * u0.z + u0.w * u0.w) + (u1.x * u1.x + u1.y * u1.y) + (u1.z * u1.z + u1.w * u1.w);
            ss = wave_sum(ss); const float rs = 1.0f / sqrtf(ss * (1.0f / 512.0f) + 1e-6f);
            const float* wp = wssm + g * 512 + lane * 8; const f32x4 w0 = *(const GAS f32x4*)wp, w1 = *(const GAS f32x4*)(wp + 4);
            float o[8] = {u0.x * rs * w0.x, u0.y * rs * w0.y, u0.z * rs * w0.z, u0.w * rs * w0.w, u1.x * rs * w1.x, u1.y * rs * w1.y, u1.z * rs * w1.z, u1.w * rs * w1.w};
            *(GAS v4u*)(MIXED + (size_t)row * DM + 512 + g * 512 + lane * 8) = pack8(o); }
#pragma unroll
        for (int hh = 0; hh < 4; ++hh) { if (row < MP) break; const float* src = HR + (size_t)row * 512 + hh * 128 + lane * 2; const float v0 = src[0], v1 = src[1];
            const float ss = wave_sum(v0 * v0 + v1 * v1), rs = 1.0f / sqrtf(ss * (1.0f / 128.0f) + 1e-6f);
            const unsigned mo = *(const GAS unsigned*)(PROJ + (size_t)row * NINP + C_MO + hh * 128 + lane * 2);
            const float o0 = v0 * rs * wml[hh * 128 + lane * 2] * sigmoidf_(bflo(mo)), o1 = v1 * rs * wml[hh * 128 + lane * 2 + 1] * sigmoidf_(bfhi(mo));
            *(GAS unsigned*)(MIXED + (size_t)row * DM + 1536 + hh * 128 + lane * 2) = pk2(o0, o1); }
    }
}

__device__ __forceinline__ void final_norm_phase(Frame& F, const Args& a) {
    const float* SSQ = (const float*)(ARGWS() + WS_SSQA); const float* wf = ARGIN(25);
    const int gw = F.vcu * NWAVES + F.wave, NGW = F.G * NWAVES, lane = F.lane;
    for (int row = gw; row < MT; row += NGW) {
        const f32x4 p0 = *(const GAS f32x4*)(SSQ + (size_t)row * 8), p1 = *(const GAS f32x4*)(SSQ + (size_t)row * 8 + 4);
        const float ss = ((p0.x + p0.y) + (p0.z + p0.w)) + ((p1.x + p1.y) + (p1.z + p1.w)), rs = 1.0f / sqrtf(ss * (1.0f / 2048.0f) + 1e-6f);
        GAS f32x4* y = (GAS f32x4*)(ARGOUT() + O_Y + (size_t)row * DM) + lane; const GAS f32x4* wv = (const GAS f32x4*)wf + lane;
#pragma unroll
        for (int j = 0; j < 8; ++j) { const f32x4 v = y[64 * j], g = wv[64 * j]; y[64 * j] = (f32x4){v.x * rs * g.x, v.y * rs * g.y, v.z * rs * g.z, v.w * rs * g.w}; }
    }
}

#ifndef MK_N_LAUNCHES
#define MK_N_LAUNCHES 1
#endif
constexpr int N_PHASES = 18;
__global__ void __launch_bounds__(NTHR, 2) mk_fwd(Args args) {
    extern __shared__ __attribute__((aligned(16))) unsigned char lds[];
    Frame F;
    F.lds = (LAS unsigned char*)lds;
    F.MISC = (volatile LAS unsigned*)(F.lds + MISC_OFF);
    F.tid = threadIdx.x; F.lane = F.tid & 63; F.wave = __builtin_amdgcn_readfirstlane(F.tid >> 6);
    F.G = gridDim.x; { const int bx = blockIdx.x; F.vcu = (F.G % 8 == 0) ? (bx % 8) * (F.G / 8) + bx / 8 : bx; }
    unsigned char* ws = ARGWS();
    F.ctl = (gu32*)(ws + WS_CTL);
    for (int u = F.tid; u < (LDS_BYTES - LDSCTL_OFF) / 4; u += NTHR) ((LAS unsigned*)(F.lds + LDSCTL_OFF))[u] = 0u;
    __syncthreads();
    const int lo = args.ph_lo, hi = args.ph_hi;
    const bool use_bar = (hi - lo) > 1;
    XcdBarrier bar; bar.bar = (unsigned*)(F.ctl + CW_BAR); bar.x = 0; bar.st = nullptr;
    if (use_bar) bar = xcd_barrier_post((unsigned*)(F.ctl + CW_BAR), F.MISC + 8);
#define IN(k) (lo <= (k) && (k) < hi)
#define PHASE_BEGIN() do { int t_ = threadIdx.x, v_ = vcu0, g_ = G0; asm volatile("" : "+v"(t_)); asm volatile("" : "+s"(v_), "+s"(g_)); F.tid = t_; F.lane = t_ & 63; F.wave = __builtin_amdgcn_readfirstlane(t_ >> 6); F.vcu = v_; F.G = g_; } while (0)
#define SEAM(k) do { if (IN(k) && IN((k) + 1)) xcd_barrier(bar); } while (0)

#define WSP(T, off) ((T*)(ARGWS() + (off)))
#define DECL_WS() bf16* XB = WSP(bf16, WS_XB); float* XRES = WSP(float, WS_XRES); bf16* HBUF = WSP(bf16, WS_HBUF); bf16* PROJ = WSP(bf16, WS_PROJ); bf16* MIXED = WSP(bf16, WS_MIXED); \
    float* SSQA = WSP(float, WS_SSQA); float* SSQB = WSP(float, WS_SSQB); \
    const bf16* Wi = WSP(const bf16, WS_WIN + l * WIN_BYTES); const bf16* Wo = WSP(const bf16, WS_WOUT + l * WOUT_BYTES); const bf16* Wu = WSP(const bf16, WS_WUP + l * WUP_BYTES); const bf16* Wd = WSP(const bf16, WS_WDN + l * WDN_BYTES); \
    (void)XB; (void)XRES; (void)HBUF; (void)PROJ; (void)MIXED; (void)SSQA; (void)SSQB; (void)Wi; (void)Wo; (void)Wu; (void)Wd

    const int vcu0 = F.vcu, G0 = F.G;
    if (IN(0)) { PHASE_BEGIN(); p0_prologue(F, args); }
    SEAM(0);
    for (int l = 0; l < DEPTH; ++l) {
        const int pb = 1 + 8 * l;
        if (IN(pb)) { PHASE_BEGIN(); DECL_WS();
            pg8::Gemm g{XB, Wi, MPAD, NINP, DM}; pg8::StaticOrder S; S.init(MPAD, NINP, F.G, (int)blockIdx.x);
            pg8::EpiScaleBf16<0> E{PROJ, NINP, SSQA};
            pg8::gemm_phase<pg8::EpiScaleBf16<0>, pg8::StaticOrder, true, true>(F.lds + RING_OFF, g, S, E, F.tid);
            if (blockIdx.x == 0) for (int i = F.tid; i < MS * 8; i += NTHR) SSQB[(size_t)MP * 8 + i] = 0.f;
        }
        SEAM(pb);
        if (IN(pb + 1)) { PHASE_BEGIN(); conv_phase(F, args, l); }
        SEAM(pb + 1);
        if (IN(pb + 2)) { PHASE_BEGIN(); mixer_phase(F, args, l, l); }
#if defined(MK_PROBE_DUP_MIXER)
        SEAM(pb + 2);
        if (IN(pb + 2)) { PHASE_BEGIN(); mixer_phase(F, args, l, l + 2); }
#endif
        SEAM(pb + 2);
        if (IN(pb + 3)) { PHASE_BEGIN(); mlstm_scan_phase(F, l); finalize_phase(F, args, l); }
        SEAM(pb + 3);
        if (IN(pb + 4)) { PHASE_BEGIN(); for (int it = F.vcu; it < NB * 4 * 16; it += F.G) mlstm_c_item(F, l, it >> 6, (it >> 4) & 3, it & 15); }
        SEAM(pb + 4);
        if (IN(pb + 5)) { PHASE_BEGIN(); DECL_WS();
            const float* basep = l == 0 ? ARGIN(0) : XRES; const float* bases = l == 0 ? ARGIN(1) : XRES + (size_t)MP * DM;
            pg8::Gemm g{MIXED, Wo, MP, DM, DM}; pg8::StaticOrder S; S.init(MP, DM, F.G, (int)blockIdx.x);
            pg8::EpiResid E{basep, XRES, XB, SSQB, DM};
            pg8::gemm_phase<pg8::EpiResid, pg8::StaticOrder, false, true>(F.lds + RING_OFF, g, S, E, F.tid);
            float* outs = XRES + (size_t)MP * DM; bf16* xbs = XB + (size_t)MP * DM; float* sq = SSQB + (size_t)MP * 8;
            thin_gemm(F, MIXED + (size_t)MP * DM, DM, Wo, DM, DM, [&](int row, int col, f32x4 acc) {
                const f32x4 bs = *(const GAS f32x4*)(bases + (size_t)row * DM + col); const f32x4 o = bs + acc;
                *(GAS f32x4*)(outs + (size_t)row * DM + col) = o;
                *(GAS unsigned long long*)(xbs + (size_t)row * DM + col) = (unsigned long long)pk2(o.x, o.y) | ((unsigned long long)pk2(o.z, o.w) << 32);
                float s = (o.x * o.x + o.y * o.y) + (o.z * o.z + o.w * o.w); s += __shfl_xor(s, 16); s += __shfl_xor(s, 32);
                if ((F.lane >> 4) == 0) atomicAdd(sq + (size_t)row * 8 + ((col >> 4) & 7), s); });
            if (blockIdx.x == 0) for (int i = F.tid; i < MS * 8; i += NTHR) SSQA[(size_t)MP * 8 + i] = 0.f;
        }
        SEAM(pb + 5);
        if (IN(pb + 6)) { PHASE_BEGIN(); DECL_WS();
            pg8::Gemm g{XB, Wu, MP, FF, DM}; pg8::StaticOrder S; S.init(MP, FF, F.G, (int)blockIdx.x);
            pg8::EpiScaleBf16<1> E{HBUF, FF, SSQB};
            pg8::gemm_phase<pg8::EpiScaleBf16<1>, pg8::StaticOrder, true, true>(F.lds + RING_OFF, g, S, E, F.tid);
            bf16* hs = HBUF + (size_t)MP * FF; const float* sq = SSQB + (size_t)MP * 8;
            thin_gemm(F, XB + (size_t)MP * DM, DM, Wu, FF, DM, [&](int row, int col, f32x4 acc) {
                const f32x4 p0 = *(const GAS f32x4*)(sq + (size_t)row * 8), p1 = *(const GAS f32x4*)(sq + (size_t)row * 8 + 4);
                const float ss = ((p0.x + p0.y) + (p0.z + p0.w)) + ((p1.x + p1.y) + (p1.z + p1.w)), rs = 1.0f / sqrtf(ss * (1.0f / 2048.0f) + 1e-6f);
                f32x4 v = acc * rs; v.x = fmaxf(v.x, 0.f); v.y = fmaxf(v.y, 0.f); v.z = fmaxf(v.z, 0.f); v.w = fmaxf(v.w, 0.f);
                *(GAS unsigned long long*)(hs + (size_t)row * FF + col) = (unsigned long long)pk2(v.x * v.x, v.y * v.y) | ((unsigned long long)pk2(v.z * v.z, v.w * v.w) << 32); });
        }
        SEAM(pb + 6);
        if (IN(pb + 7)) { PHASE_BEGIN(); DECL_WS();
            const bool lastl = (l == DEPTH - 1);
            float* outp = lastl ? ARGOUT() + O_Y : XRES; float* outs = lastl ? ARGOUT() + O_Y + (size_t)MP * DM : XRES + (size_t)MP * DM;
            pg8::Gemm g{HBUF, Wd, MP, DM, FF}; pg8::StaticOrder S; S.init(MP, DM, F.G, (int)blockIdx.x);
            pg8::EpiResid E{XRES, outp, lastl ? (bf16*)nullptr : XB, SSQA, DM};
            pg8::gemm_phase<pg8::EpiResid, pg8::StaticOrder, false, true>(F.lds + RING_OFF, g, S, E, F.tid);
            const float* bases = XRES + (size_t)MP * DM; bf16* xbs = XB + (size_t)MP * DM; float* sq = SSQA + (size_t)MP * 8;
            thin_gemm(F, HBUF + (size_t)MP * FF, FF, Wd, DM, FF, [&](int row, int col, f32x4 acc) {
                const f32x4 bs = *(const GAS f32x4*)(bases + (size_t)row * DM + col); const f32x4 o = bs + acc;
                *(GAS f32x4*)(outs + (size_t)row * DM + col) = o;
                if (!lastl) *(GAS unsigned long long*)(xbs + (size_t)row * DM + col) = (unsigned long long)pk2(o.x, o.y) | ((unsigned long long)pk2(o.z, o.w) << 32);
                float s = (o.x * o.x + o.y * o.y) + (o.z * o.z + o.w * o.w); s += __shfl_xor(s, 16); s += __shfl_xor(s, 32);
                if ((F.lane >> 4) == 0) atomicAdd(sq + (size_t)row * 8 + ((col >> 4) & 7), s); });
        }
        SEAM(pb + 7);
    }
    if (IN(17)) { PHASE_BEGIN(); final_norm_phase(F, args); }
#undef IN
#undef SEAM
}

extern "C" void kernel_launch(void* const* d_in, const int* in_sizes, int n_in, void* d_out, int out_size, void* d_ws, size_t ws_size, hipStream_t stream) {
    static int grid = 0;
    if (grid == 0) {
        if (n_in != 26 || (size_t)out_size != O_END || ws_size < WS_END) { fprintf(stderr, "kernel_launch: expected 26 inputs, %zu outputs, >= %zu bytes of workspace; got %d, %d, %zu\n", (size_t)O_END, (size_t)WS_END, n_in, out_size, ws_size); grid = -1; return; }
        int dev = 0, cus = 0, per_cu = 0;
        if (hipGetDevice(&dev) != hipSuccess || hipDeviceGetAttribute(&cus, hipDeviceAttributeMultiprocessorCount, dev) != hipSuccess) { grid = -1; return; }
        if (hipFuncSetAttribute((const void*)mk_fwd, hipFuncAttributeMaxDynamicSharedMemorySize, LDS_BYTES) != hipSuccess) { fprintf(stderr, "kernel_launch: hipFuncSetAttribute failed\n"); grid = -1; return; }
        if (hipOccupancyMaxActiveBlocksPerMultiprocessor(&per_cu, (const void*)mk_fwd, NTHR, LDS_BYTES) != hipSuccess || per_cu < 1) { fprintf(stderr, "kernel_launch: occupancy query says %d blocks per CU\n", per_cu); per_cu = 1; }
        (void)hipGetLastError();
        grid = cus;
        if (grid != 256) fprintf(stderr, "kernel_launch: %d CUs; the G2/G4 phases assume 256 workgroups\n", grid);
    }
    if (grid < 0) return;
    (void)hipMemsetAsync((char*)d_ws + WS_CTL, 0, CTL_ZERO_BYTES, stream);
    Args a{};
    for (int i = 0; i < 26; ++i) a.in[i] = (const float*)d_in[i];
    a.out = (float*)d_out; a.ws = (unsigned char*)d_ws;
#if MK_N_LAUNCHES == 1
    a.ph_lo = 0; a.ph_hi = N_PHASES;
    hipLaunchKernelGGL(mk_fwd, dim3(grid), dim3(NTHR), LDS_BYTES, stream, a);
#else
    for (int p = 0; p < N_PHASES; ++p) { a.ph_lo = p; a.ph_hi = p + 1; hipLaunchKernelGGL(mk_fwd, dim3(grid), dim3(NTHR), LDS_BYTES, stream, a); }
#endif
}
```

```cpp
#include <hip/hip_runtime.h>
#include <cstdio>
#include <cstdint>
namespace pg8 {
#define PG8_LAS __attribute__((address_space(3)))
typedef unsigned short bf16_t;
typedef short bf16x8 __attribute__((ext_vector_type(8)));
typedef float f32x4 __attribute__((ext_vector_type(4)));
typedef unsigned u32x4 __attribute__((ext_vector_type(4)));
constexpr int BM = 256, BK = 64, HALF = 128, HTB = HALF * BK * 2  , STAGE_BYTES = 8 * HTB, NXCD = 8, WGM = 8;

__host__ __device__ __forceinline__ int lds_byte(int r, int c) { const int st = (r >> 4) * 2 + (c >> 5), rr = r & 15, cc = c & 31, ob = rr * 64 + cc * 2; return st * 1024 + (ob ^ (((ob >> 9) & 1) << 5)); }
__host__ __device__ __forceinline__ void stage_rc(int b, int& R, int& C) { const int st = b / 1024, sb = b % 1024, swz = sb ^ (((sb >> 9) & 1) << 5); R = (st >> 1) * 16 + swz / 64; C = (st & 1) * 32 + (swz % 64) / 2; }
__host__ __device__ __forceinline__ int perm32(int rho) { const int n = rho >> 4, i = rho & 15; return 8 * (i >> 2) + 4 * n + (i & 3); }

struct Unit { int pm, pn; };
struct Gemm { const bf16_t* A; const bf16_t* Bt; int M, N, K; };

struct StaticOrder {
    int nM, nN, nwg, G, c;
    __host__ __device__ void init(int M, int N, int G_, int c_) { nM = M / BM; nN = N / BM; nwg = nM * nN; G = G_; c = c_; }
    __host__ __device__ bool next(int i, Unit& u) const {
        const long L = (long)i * G + c; if (L >= nwg) return false;
        int wgid = (int)L; { const int q = nwg / NXCD, r = nwg % NXCD, xcd = wgid % NXCD, off = wgid / NXCD; wgid = (xcd < r ? xcd * (q + 1) : r * (q + 1) + (xcd - r) * q) + off; }
        const int nig = WGM * nN, gid = wgid / nig, fm = gid * WGM, gsz = (nM - fm) < WGM ? (nM - fm) : WGM;
        u.pm = fm + ((wgid % nig) % gsz); u.pn = (wgid % nig) / gsz; return true;
    }
    __device__ __forceinline__ void a_ready(const Unit&) const {}
    __device__ __forceinline__ void done(const Unit&) const {}
};


__device__ __forceinline__ unsigned cvt_pk_bf16(float lo, float hi) { unsigned r; asm volatile("v_cvt_pk_bf16_f32 %0, %1, %2" : "=v"(r) : "v"(lo), "v"(hi)); return r; }

template <int ACT> struct EpiScaleBf16 {
    static constexpr bool PERM = true, AFTER_DRAIN = false;
    bf16_t* O; int ldc; const float* ssq;
    __device__ __forceinline__ void operator()(const f32x4 (&acc)[2][2][4][2], const Unit& u, int wr, int wc, int fr, int fq) const {
        const int row0 = u.pm * BM + wr * 64 + fr, col0 = u.pn * BM + wc * 32 + 8 * fq;
#pragma unroll
        for (int ai = 0; ai < 2; ++ai)
#pragma unroll
            for (int m = 0; m < 4; ++m) { const int row = row0 + ai * HALF + m * 16;
                const f32x4 p0 = *(const f32x4*)(ssq + (size_t)row * 8), p1 = *(const f32x4*)(ssq + (size_t)row * 8 + 4);
                const float ss = ((p0[0] + p0[1]) + (p0[2] + p0[3])) + ((p1[0] + p1[1]) + (p1[2] + p1[3]));
                const float rs = 1.0f / sqrtf(ss * (1.0f / 2048.0f) + 1e-6f);
                bf16_t* rowp = O + (size_t)row * ldc + col0;
#pragma unroll
                for (int bj = 0; bj < 2; ++bj) { f32x4 v0 = acc[ai][bj][m][0] * rs, v1 = acc[ai][bj][m][1] * rs;
                    if (ACT == 1) {
#pragma unroll
                        for (int e = 0; e < 4; ++e) { const float a = fmaxf(v0[e], 0.f), b = fmaxf(v1[e], 0.f); v0[e] = a * a; v1[e] = b * b; } }
                    u32x4 w; w.x = cvt_pk_bf16(v0[0], v0[1]); w.y = cvt_pk_bf16(v0[2], v0[3]); w.z = cvt_pk_bf16(v1[0], v1[1]); w.w = cvt_pk_bf16(v1[2], v1[3]);
                    *(u32x4*)(rowp + bj * HALF) = w; } }
    }
};

struct EpiResid {
    static constexpr bool PERM = false, AFTER_DRAIN = true;
    const float* base; float* out; bf16_t* xb; float* ssq; int ld;
    __device__ __forceinline__ void fused(f32x4 (&acc)[2][2][4][2], const Unit& u, int wr, int wc, int fr, int fq, PG8_LAS unsigned char* lds, int wid, int lane) const {
        typedef unsigned u32x2v __attribute__((ext_vector_type(2)));
        PG8_LAS float* P = (PG8_LAS float*)lds;
        const int col0 = u.pn * BM + wc * 32 + 4 * fq;
#pragma unroll
        for (int ai = 0; ai < 2; ++ai)
#pragma unroll
            for (int m = 0; m < 4; ++m) { const int r = ai * HALF + wr * 64 + m * 16 + fr; const size_t off = (size_t)(u.pm * BM + r) * ld + col0; float s = 0.f;
#pragma unroll
                for (int bj = 0; bj < 2; ++bj)
#pragma unroll
                    for (int n = 0; n < 2; ++n) { const f32x4 bs = *(const f32x4*)(base + off + bj * HALF + n * 16); const f32x4 o = bs + acc[ai][bj][m][n];
                        *(f32x4*)(out + off + bj * HALF + n * 16) = o;
                        if (xb) { u32x2v w; w.x = cvt_pk_bf16(o[0], o[1]); w.y = cvt_pk_bf16(o[2], o[3]); *(u32x2v*)(xb + off + bj * HALF + n * 16) = w; }
                        s += (o[0] * o[0] + o[1] * o[1]) + (o[2] * o[2] + o[3] * o[3]); }
                s += __shfl_xor(s, 16); s += __shfl_xor(s, 32);
                if (fq == 0) P[r * 4 + wc] = s;
                if (m & 1) asm volatile("" ::: "memory"); }
        asm volatile("s_waitcnt lgkmcnt(0)" ::: "memory"); __builtin_amdgcn_s_barrier(); asm volatile("" ::: "memory");
        const int t = wid * 64 + lane;
        if (t < 256) { const float s = (P[t * 4 + 0] + P[t * 4 + 1]) + (P[t * 4 + 2] + P[t * 4 + 3]); ssq[(size_t)(u.pm * BM + t) * 8 + u.pn] = s; }
        asm volatile("s_waitcnt lgkmcnt(0)" ::: "memory"); __builtin_amdgcn_s_barrier(); asm volatile("" ::: "memory");
    }
};
template <class Epi, class Sched, bool ALIGN_EPI = false, bool SP2 = false>
__device__ __forceinline__ void gemm_phase(PG8_LAS unsigned char* lds, const Gemm g, const Sched& S, const Epi& E, const int tid) {
    const int  wid = __builtin_amdgcn_readfirstlane(tid >> 6), lane = tid & 63, wr = wid >> 2, wc = wid & 3, fr = lane & 15, fq = lane >> 4;
    const int K = g.K, nt = K / BK;
    unsigned voffA[2], voffB[2];
#pragma unroll
    for (int i = 0; i < 2; ++i) { int R, C; stage_rc(tid * 16 + i * 8192, R, C); const int Rb = Epi::PERM ? ((R & ~31) + perm32(R & 31)) : R;
        voffA[i] = (unsigned)(R * K + C) * 2u; voffB[i] = (unsigned)(Rb * K + C) * 2u; }
    const size_t kstep = (size_t)(BK * 2);
    const size_t hstep = (size_t)HALF * K * 2;
    const size_t tstep = 2 * hstep;
    const unsigned ldsw = (unsigned)wid * 1024u;
    const int aoff = lds_byte(wr * 64 + fr, fq * 8), boff = lds_byte(wc * 32 + fr, fq * 8);
#define PG8_SA(b, h) (((b) * 2 + (h)) * HTB)
#define PG8_SB(b, h) ((4 + (b) * 2 + (h)) * HTB)
#define PG8_STAGE(bufoff, gbase, voff) do { _Pragma("unroll") for (int _i = 0; _i < 2; ++_i) \
        __builtin_amdgcn_global_load_lds((const unsigned*)((const char*)(gbase) + (voff)[_i]), (PG8_LAS unsigned*)(lds + (bufoff) + ldsw + _i * 8192), 16, 0, 0); } while (0)
#define PG8_LDA(dst, b, h) do { _Pragma("unroll") for (int m = 0; m < 4; ++m) _Pragma("unroll") for (int k = 0; k < 2; ++k) dst[m][k] = *(const PG8_LAS bf16x8*)(lds + PG8_SA(b, h) + aoff + m * 2048 + k * 1024); } while (0)
#define PG8_LDB(dst, b, h) do { _Pragma("unroll") for (int n = 0; n < 2; ++n) _Pragma("unroll") for (int k = 0; k < 2; ++k) dst[n][k] = *(const PG8_LAS bf16x8*)(lds + PG8_SB(b, h) + boff + n * 2048 + k * 1024); } while (0)
#define PG8_MMA(ai, bj, At, Bt) do { __builtin_amdgcn_s_setprio(1); _Pragma("unroll") for (int m = 0; m < 4; ++m) _Pragma("unroll") for (int n = 0; n < 2; ++n) _Pragma("unroll") for (int k = 0; k < 2; ++k) \
        acc[ai][bj][m][n] = __builtin_amdgcn_mfma_f32_16x16x32_bf16(Bt[n][k], At[m][k], acc[ai][bj][m][n], 0, 0, 0); __builtin_amdgcn_s_setprio(0); } while (0)
#define PG8_WAIT_V(n) asm volatile("s_waitcnt vmcnt(" #n ")" ::: "memory")
#define PG8_WAIT_L(n) asm volatile("s_waitcnt lgkmcnt(" #n ")" ::: "memory")
#define PG8_BAR __builtin_amdgcn_s_barrier()
#define PG8_SCHED __builtin_amdgcn_sched_barrier(0)
    Unit cur, nxt; int ui = 0;
    if (!S.next(0, cur)) return;
    f32x4 acc[2][2][4][2];
#pragma unroll
    for (int a = 0; a < 2; ++a)
#pragma unroll
        for (int b = 0; b < 2; ++b)
#pragma unroll
            for (int m = 0; m < 4; ++m)
#pragma unroll
                for (int n = 0; n < 2; ++n) acc[a][b][m][n] = (f32x4){0.f, 0.f, 0.f, 0.f};
    bf16x8 At[4][2], B0[2][2], B1[2][2];
    const char* cA = (const char*)g.A + (size_t)cur.pm * tstep; const char* cB = (const char*)g.Bt + (size_t)cur.pn * tstep;
    S.a_ready(cur);
    if constexpr (SP2) {
        PG8_STAGE(PG8_SB(0, 0), cB, voffB); PG8_STAGE(PG8_SB(0, 1), cB + hstep, voffB); PG8_STAGE(PG8_SA(0, 0), cA, voffA); PG8_STAGE(PG8_SA(0, 1), cA + hstep, voffA);
        if (wr == 1) PG8_BAR;
        PG8_WAIT_V(2); PG8_BAR;
        PG8_STAGE(PG8_SB(1, 0), cB + kstep, voffB); PG8_STAGE(PG8_SA(1, 0), cA + kstep, voffA); PG8_STAGE(PG8_SB(1, 1), cB + hstep + kstep, voffB);
        PG8_WAIT_V(6); PG8_BAR;
    } else {
        PG8_STAGE(PG8_SB(0, 0), cB, voffB); PG8_STAGE(PG8_SA(0, 0), cA, voffA); PG8_STAGE(PG8_SB(0, 1), cB + hstep, voffB); PG8_STAGE(PG8_SA(0, 1), cA + hstep, voffA);
        if (wr == 1) PG8_BAR;
        PG8_WAIT_V(4); PG8_BAR;
        PG8_STAGE(PG8_SB(1, 0), cB + kstep, voffB); PG8_STAGE(PG8_SA(1, 0), cA + kstep, voffA); PG8_STAGE(PG8_SB(1, 1), cB + hstep + kstep, voffB);
        PG8_WAIT_V(6); PG8_BAR;
    }
    for (;;) {
        const bool has_next = S.next(ui + 1, nxt);
        const char* nA = has_next ? (const char*)g.A + (size_t)nxt.pm * tstep : cA; const char* nB = has_next ? (const char*)g.Bt + (size_t)nxt.pn * tstep : cB;
        for (int t = 0; t < nt; t += 2) {
            const bool last = (t == nt - 2);
            const char* a1 = cA + (size_t)(t + 1) * kstep;
            const char* a2 = last ? nA : cA + (size_t)(t + 2) * kstep; const char* b2 = last ? nB : cB + (size_t)(t + 2) * kstep;
            const char* a3 = a2 + kstep; const char* b3 = b2 + kstep;
            if (last && has_next) S.a_ready(nxt);
            if constexpr (SP2) {
            PG8_LDB(B0, 0, 0); PG8_LDB(B1, 0, 1); PG8_SCHED; PG8_LDA(At, 0, 0); PG8_STAGE(PG8_SA(1, 1), a1 + hstep, voffA);
            PG8_WAIT_V(8); PG8_WAIT_L(0); PG8_BAR; PG8_MMA(0, 0, At, B0); PG8_MMA(0, 1, At, B1); PG8_BAR; PG8_SCHED;
            PG8_LDA(At, 0, 1); PG8_STAGE(PG8_SB(0, 0), b2, voffB); PG8_STAGE(PG8_SB(0, 1), b2 + hstep, voffB); PG8_STAGE(PG8_SA(0, 0), a2, voffA);
            PG8_WAIT_V(8); PG8_WAIT_L(0); PG8_BAR; PG8_MMA(1, 0, At, B0); PG8_MMA(1, 1, At, B1); PG8_BAR; PG8_SCHED;
            PG8_LDB(B0, 1, 0); PG8_LDB(B1, 1, 1); PG8_SCHED; PG8_LDA(At, 1, 0); PG8_STAGE(PG8_SA(0, 1), a2 + hstep, voffA);
            PG8_WAIT_V(8); PG8_WAIT_L(0); PG8_BAR; PG8_MMA(0, 0, At, B0); PG8_MMA(0, 1, At, B1); PG8_BAR; PG8_SCHED;
            PG8_LDA(At, 1, 1); PG8_STAGE(PG8_SB(1, 0), b3, voffB); PG8_STAGE(PG8_SB(1, 1), b3 + hstep, voffB); PG8_STAGE(PG8_SA(1, 0), a3, voffA);
            PG8_WAIT_V(8); PG8_WAIT_L(0); PG8_BAR; PG8_MMA(1, 0, At, B0); PG8_MMA(1, 1, At, B1); PG8_BAR; PG8_SCHED;
            } else {
            PG8_LDB(B0, 0, 0); PG8_SCHED; PG8_LDA(At, 0, 0); PG8_STAGE(PG8_SA(1, 1), a1 + hstep, voffA);
            PG8_WAIT_L(8); PG8_BAR; PG8_WAIT_L(0); PG8_MMA(0, 0, At, B0); PG8_BAR; PG8_SCHED;
            PG8_LDB(B1, 0, 1); PG8_STAGE(PG8_SB(0, 0), b2, voffB);
            PG8_BAR; PG8_WAIT_L(0); PG8_MMA(0, 1, At, B1); PG8_BAR;
            PG8_LDA(At, 0, 1); PG8_STAGE(PG8_SA(0, 0), a2, voffA);
            PG8_BAR; PG8_WAIT_L(0); PG8_MMA(1, 0, At, B0); PG8_BAR; PG8_SCHED;
            PG8_STAGE(PG8_SB(0, 1), b2 + hstep, voffB);
            PG8_WAIT_V(6); PG8_BAR; PG8_MMA(1, 1, At, B1); PG8_BAR;
            PG8_LDB(B0, 1, 0); PG8_SCHED; PG8_LDA(At, 1, 0); PG8_STAGE(PG8_SA(0, 1), a2 + hstep, voffA);
            PG8_WAIT_L(8); PG8_BAR; PG8_WAIT_L(0); PG8_MMA(0, 0, At, B0); PG8_BAR; PG8_SCHED;
            PG8_LDB(B1, 1, 1); PG8_STAGE(PG8_SB(1, 0), b3, voffB);
            PG8_BAR; PG8_WAIT_L(0); PG8_MMA(0, 1, At, B1); PG8_BAR;
            PG8_LDA(At, 1, 1); PG8_STAGE(PG8_SA(1, 0), a3, voffA);
            PG8_BAR; PG8_WAIT_L(0); PG8_MMA(1, 0, At, B0); PG8_BAR; PG8_SCHED;
            PG8_STAGE(PG8_SB(1, 1), b3 + hstep, voffB);
            PG8_WAIT_V(6); PG8_BAR; PG8_MMA(1, 1, At, B1); PG8_BAR;
            }
        }
        if constexpr (ALIGN_EPI) { if (wr == 0) PG8_BAR; }
        if constexpr (!Epi::AFTER_DRAIN) { E(acc, cur, wr, wc, fr, fq); S.done(cur); }
        if (!has_next) break;
#pragma unroll
        for (int a = 0; a < 2; ++a)
#pragma unroll
            for (int b = 0; b < 2; ++b)
#pragma unroll
                for (int m = 0; m < 4; ++m)
#pragma unroll
                    for (int n = 0; n < 2; ++n) acc[a][b][m][n] = (f32x4){0.f, 0.f, 0.f, 0.f};
        cur = nxt; cA = nA; cB = nB; ++ui;
        if constexpr (ALIGN_EPI) { if (wr == 1) PG8_BAR; }
    }
    PG8_WAIT_V(0);
    if constexpr (!ALIGN_EPI) { if (wr == 0) PG8_BAR; }
    PG8_BAR;
    if constexpr (Epi::AFTER_DRAIN) { E.fused(acc, cur, wr, wc, fr, fq, lds, wid, lane); S.done(cur); }
#undef PG8_SA
#undef PG8_SB
#undef PG8_STAGE
#undef PG8_LDA
#undef PG8_LDB
#undef PG8_MMA
#undef PG8_WAIT_V
#undef PG8_WAIT_L
#undef PG8_BAR
#undef PG8_SCHED
}
}

#ifndef PG8_SP2
#define PG8_SP2 true
#endif
#ifndef PG8_ALIGN
#define PG8_ALIGN true
#endif
#define GAS __attribute__((address_space(1)))
#define LAS __attribute__((address_space(3)))
typedef unsigned short bf16;
typedef unsigned v4u __attribute__((ext_vector_type(4)));
typedef float f32x4 __attribute__((ext_vector_type(4)));
typedef short bf16x8 __attribute__((ext_vector_type(8)));
typedef GAS unsigned gu32;
typedef GAS unsigned long long gu64;
#define RLX_AGENT __ATOMIC_RELAXED, __HIP_MEMORY_SCOPE_AGENT
#define LDS_WAIT() asm volatile("s_waitcnt lgkmcnt(0)" ::: "memory")
#define VM_WAIT() asm volatile("s_waitcnt vmcnt(0)" ::: "memory")
__device__ __forceinline__ unsigned long long rt() { return __builtin_amdgcn_s_memrealtime(); }
__device__ __forceinline__ unsigned f2bf(float f) { unsigned u = __builtin_bit_cast(unsigned, f); return (u + 0x7fffu + ((u >> 16) & 1u)) >> 16; }
__device__ __forceinline__ unsigned pk2(float lo, float hi) { return f2bf(lo) | (f2bf(hi) << 16); }

#define XB_TMO      128
#define XB_XCNT(j)  (256  + 64 * (j))
#define XB_XSUB(j)  (1280 + 64 * (j))
#define XB_XGEN(j)  (2304 + 64 * (j))
#define XB_TOP      3328
#define XB_TOPGEN   3392
#define XCD_BAR_WORDS 3456
#define XB_SPIN_CAP (1u << 18)

__device__ __forceinline__ unsigned xb_ld(unsigned* p)              { return __hip_atomic_load(p, __ATOMIC_RELAXED, __HIP_MEMORY_SCOPE_AGENT); }
__device__ __forceinline__ unsigned xb_add(unsigned* p, unsigned v) { return __hip_atomic_fetch_add(p, v, __ATOMIC_RELAXED, __HIP_MEMORY_SCOPE_AGENT); }
__device__ __forceinline__ unsigned xb_xcc_id() { return (unsigned)__builtin_amdgcn_s_getreg((3 << 11) | 20) & 0xFu; }
#define XB_SPIN(cond, bar) do { unsigned _sp = 0; while (cond) { __builtin_amdgcn_s_sleep(1); \
    if ((++_sp & 255u) == 0u) { if (xb_ld(&(bar)[XB_TMO])) break; if (_sp > XB_SPIN_CAP) { atomicAdd(&(bar)[XB_TMO], 1u); break; } } } } while (0)

struct XcdBarrier {
    unsigned* bar; unsigned x;
    volatile LAS unsigned* st;
};

__device__ __forceinline__ XcdBarrier xcd_barrier_post(unsigned* bar, volatile LAS unsigned* st) {
    XcdBarrier b; b.bar = bar; b.x = xb_xcc_id(); b.st = st;
    if (threadIdx.x == 0) (void)xb_add(&bar[XB_XCNT(b.x)], 1u);
    return b;
}
__device__ __forceinline__ void xcd_barrier_complete(unsigned* bar, unsigned x, unsigned& nloc, unsigned& nx) {
    const unsigned G = gridDim.x * gridDim.y * gridDim.z;
    unsigned sum, cnt, mine, sp = 0u;
    for (;;) {
        sum = 0u; cnt = 0u; mine = 0u;
#pragma unroll
        for (unsigned j = 0; j < 16; ++j) { const unsigned c = xb_ld(&bar[XB_XCNT(j)]); sum += c; cnt += (c > 0u) ? 1u : 0u; mine = (j == x) ? c : mine; }
        if (sum == G) break;
        __builtin_amdgcn_s_sleep(1);
        if ((++sp & 255u) == 0u) { if (xb_ld(&bar[XB_TMO])) break; if (sp > XB_SPIN_CAP) { atomicAdd(&bar[XB_TMO], 1u); break; } }
    }
    nloc = mine > 0u ? mine : 1u; nx = cnt > 0u ? cnt : 1u;
}

__device__ __forceinline__ void xcd_barrier(const XcdBarrier& b) {
    asm volatile("s_waitcnt vmcnt(0)" ::: "memory");
    __syncthreads();
    if (threadIdx.x == 0) {
        unsigned* bar = b.bar;
        __builtin_amdgcn_s_waitcnt(0);
        unsigned nloc = b.st[0], nx = b.st[1];
        if (nloc == 0u) { xcd_barrier_complete(bar, b.x, nloc, nx); b.st[0] = nloc; b.st[1] = nx; }
        const unsigned old = xb_add(&bar[XB_XSUB(b.x)], 1u);
        const unsigned gen = old / nloc;
        if (old + 1u == (gen + 1u) * nloc) {
            __builtin_amdgcn_fence(__ATOMIC_RELEASE, "agent");
            asm volatile("s_waitcnt vmcnt(0)" ::: "memory");
            const unsigned og = xb_add(&bar[XB_TOP], 1u);
            const unsigned tg = og / nx;
            if (og + 1u == (tg + 1u) * nx) xb_add(&bar[XB_TOPGEN], 1u);
            else XB_SPIN(xb_ld(&bar[XB_TOPGEN]) == tg, bar);
            __builtin_amdgcn_fence(__ATOMIC_ACQUIRE, "agent");
            xb_add(&bar[XB_XGEN(b.x)], 1u);
            asm volatile("s_waitcnt vmcnt(0)" ::: "memory");
        } else {
            XB_SPIN(xb_ld(&bar[XB_XGEN(b.x)]) == gen, bar);
            __builtin_amdgcn_fence(__ATOMIC_ACQUIRE, "agent");
            asm volatile("s_waitcnt vmcnt(0)" ::: "memory");
        }
    }
    __syncthreads();
}

constexpr int NWAVES = 8, NTHR = 512;
constexpr int DM = 2048, SEQL = 2048, NB = 4, MP = NB * SEQL  , MS = 128  , MT = MP + MS, MPAD = 8448;
constexpr int NIN = 5400, NINP = 5632, FF = 8192, DEPTH = 2;
constexpr int C_Q = 0, C_K = 512, C_V = 640, C_Z = 768, C_XBC = 1792, C_MQ = 3328, C_MK = 3840, C_MV = 4352, C_MO = 4864, C_DT = 5376, C_MI = 5392, C_MF = 5396;
constexpr int XCW = 1536;
constexpr size_t O_Y = 0, O_PK = 17039360, O_PV = 17170432, O_PCONV = 17301504, O_PSSM = 17338368, O_PC = 18386944, O_PN = 18911232, O_PM = 18915328,
                 O_SK = 18915360, O_SV = 23109664, O_SCONV = 27303968, O_SSSM = 28483616, O_SC = 62038048, O_SN = 78815264, O_SM = 78946336, O_END = 78947360;

constexpr size_t MiB = 1u << 20;
constexpr size_t WS_CTL = 0, CTL_ZERO_BYTES = 1 * MiB;
constexpr size_t WS_SSQA = 1 * MiB, WS_SSQB = 1 * MiB + 512 * 1024;
constexpr size_t WS_WIN = 2 * MiB, WIN_BYTES = 22 * MiB;
constexpr size_t WS_WOUT = 46 * MiB, WOUT_BYTES = 8 * MiB;
constexpr size_t WS_WUP = 62 * MiB, WUP_BYTES = 32 * MiB;
constexpr size_t WS_WDN = 126 * MiB, WDN_BYTES = 32 * MiB;
constexpr size_t WS_XB = 190 * MiB;
constexpr size_t WS_XRES = 223 * MiB;
constexpr size_t WS_HBUF = 289 * MiB;
constexpr size_t WS_PROJ = 289 * MiB;
constexpr size_t WS_MIXED = 380 * MiB;
constexpr size_t WS_XC = 421 * MiB;
constexpr size_t WS_YG = 446 * MiB;
constexpr size_t WS_HR = 479 * MiB;
constexpr size_t WS_END = 496 * MiB;
static_assert(WS_PROJ + (size_t)MPAD * NINP * 2 <= WS_MIXED && WS_MIXED + (size_t)MPAD * DM * 2 <= WS_XC && WS_HBUF + (size_t)MPAD * FF * 2 <= WS_XC, "ws map");
constexpr int CW_BAR = 4096;
constexpr int CW_QUEUE = 16384;

constexpr int RING_OFF = 0, RING_BYTES = 131072;
constexpr int LDSCTL_OFF = RING_BYTES, MISC_OFF = LDSCTL_OFF + 320;
constexpr int LDS_BYTES = 147456;

struct Args { const float* in[26]; float* out; unsigned char* ws; int ph_lo, ph_hi; };
typedef const __attribute__((address_space(4))) unsigned long long* karg_t;
__device__ __forceinline__ unsigned long long karg_u64(int idx) { int j = idx; asm volatile("" : "+s"(j)); return ((karg_t)__builtin_amdgcn_kernarg_segment_ptr())[j]; }
#define ARGIN(i) ((const float*)karg_u64(i))
#define ARGOUT() ((float*)karg_u64(26))
#define ARGWS() ((unsigned char*)karg_u64(27))

struct Frame {
    LAS unsigned char* lds;
    volatile LAS unsigned* MISC;
    gu32* ctl;
    int tid, lane, wave, vcu, G;
};

__device__ __forceinline__ float bf2f(unsigned short u) { return __builtin_bit_cast(float, (unsigned)u << 16); }
__device__ __forceinline__ float bflo(unsigned u) { return __builtin_bit_cast(float, u << 16); }
__device__ __forceinline__ float bfhi(unsigned u) { return __builtin_bit_cast(float, u & 0xffff0000u); }
__device__ __forceinline__ void unpack8(const v4u w, float (&f)[8]) { f[0] = bflo(w.x); f[1] = bfhi(w.x); f[2] = bflo(w.y); f[3] = bfhi(w.y); f[4] = bflo(w.z); f[5] = bfhi(w.z); f[6] = bflo(w.w); f[7] = bfhi(w.w); }
__device__ __forceinline__ v4u pack8(const float (&f)[8]) { v4u w; w.x = pk2(f[0], f[1]); w.y = pk2(f[2], f[3]); w.z = pk2(f[4], f[5]); w.w = pk2(f[6], f[7]); return w; }
__device__ __forceinline__ float wave_sum(float v) {
#pragma unroll
    for (int o = 1; o < 64; o <<= 1) v += __shfl_xor(v, o);
    return v;
}
__device__ __forceinline__ float wave_max(float v) {
#pragma unroll
    for (int o = 1; o < 64; o <<= 1) v = fmaxf(v, __shfl_xor(v, o));
    return v;
}
__device__ __forceinline__ float sigmoidf_(float x) { return 1.0f / (1.0f + expf(-x)); }
__device__ __forceinline__ float siluf_(float x) { return x / (1.0f + expf(-x)); }
__device__ __forceinline__ float softplusf_(float x) { return fmaxf(x, 0.f) + log1pf(expf(-fabsf(x))); }
__device__ __forceinline__ float logsigmoidf_(float x) { return fminf(x, 0.f) - log1pf(expf(-fabsf(x))); }
#define ROPE_INV(i) ((i) == 0 ? 1.0f : (i) == 1 ? 0.1939227432012558f : (i) == 2 ? 0.03760603070259094f : (i) == 3 ? 0.007292664609849453f : (i) == 4 ? 0.0014142135623842478f : (i) == 5 ? 0.00027424818836152554f : (i) == 6 ? 5.318296098266728e-05f : 1.0313386155758053e-05f)
__device__ __forceinline__ void rope_cs(int pos, float (&c)[8], float (&s)[8]) {
#pragma unroll
    for (int i = 0; i < 8; ++i) { const float ang = (float)pos * ROPE_INV(i); double rev = (double)ang * 0.15915494309189535; rev -= __builtin_rint(rev); const float fr = (float)rev;
        c[i] = __builtin_amdgcn_cosf(fr); s[i] = __builtin_amdgcn_sinf(fr); }
}

template <int MODE> __device__ __forceinline__ int colmap(int n) {
    if (MODE == 0) return n;
    if (n < 3328) return n; if (n < 5376) return n + 16; if (n < 5392) return n - 2048; if (n < 5400) return n; return -1;
}
template <int MODE> __device__ __forceinline__ void p0_transpose_item(const float* W, int K, int Norig, int Nrows, const float* gain, bf16* WT, LAS float* scr, int item, int lane) {
    const int nblk = Nrows / 32, kb = item / nblk, nb = item % nblk, k0 = 64 * kb, n0 = 32 * nb;
    const int oc = colmap<MODE>(n0 + (lane & 31));
#pragma unroll 8
    for (int i = 0; i < 32; ++i) { const int kk = 2 * i + (lane >> 5); float v = 0.f; if (oc >= 0) { v = W[(size_t)(k0 + kk) * Norig + oc]; if (gain) v *= gain[k0 + kk]; } scr[kk * 33 + (lane & 31)] = v; }
    LDS_WAIT(); asm volatile("" ::: "memory");
    const int c = lane & 7;
#pragma unroll
    for (int j = 0; j < 4; ++j) { const int n = (lane >> 3) + 8 * j; const LAS float* s = scr + (8 * c) * 33 + n;
        v4u o; o.x = pk2(s[0 * 33], s[1 * 33]); o.y = pk2(s[2 * 33], s[3 * 33]); o.z = pk2(s[4 * 33], s[5 * 33]); o.w = pk2(s[6 * 33], s[7 * 33]);
        *(GAS v4u*)(WT + (size_t)(n0 + n) * K + k0 + 8 * c) = o; }
    LDS_WAIT(); asm volatile("" ::: "memory");
}
__device__ __forceinline__ void x_row_to_bf16(int lane, const float* xrow, bf16* orow, float* ssqrow) {
    const GAS f32x4* xr = (const GAS f32x4*)xrow + lane;
    f32x4 v[8]; float s = 0.f;
#pragma unroll
    for (int j = 0; j < 8; ++j) { v[j] = xr[64 * j]; s += (v[j].x * v[j].x + v[j].y * v[j].y) + (v[j].z * v[j].z + v[j].w * v[j].w); }
    s = wave_sum(s);
    GAS unsigned long long* o8 = (GAS unsigned long long*)orow + lane;
#pragma unroll
    for (int j = 0; j < 8; ++j) o8[64 * j] = (unsigned long long)pk2(v[j].x, v[j].y) | ((unsigned long long)pk2(v[j].z, v[j].w) << 32);
    if (lane < 8) ssqrow[lane] = lane == 0 ? s : 0.f;
}
__device__ __forceinline__ void p0_prologue(Frame& F, const Args& a) {
    LAS float* scr = (LAS float*)(F.lds + RING_OFF + F.wave * 16384);
    const int gw = F.vcu * NWAVES + F.wave, NGW = F.G * NWAVES;
    constexpr int I_IN = (DM / 64) * (NINP / 32), I_OUT = (DM / 64) * (DM / 32), I_UP = (DM / 64) * (FF / 32), I_DN = (FF / 64) * (DM / 32);
    constexpr int PER_L = I_IN + I_OUT + I_UP + I_DN;
    unsigned char* ws = ARGWS();
    for (int it = gw; it < DEPTH * PER_L; it += NGW) {
        const int l = it / PER_L; int r = it % PER_L;
        if (r < I_IN) { p0_transpose_item<1>(ARGIN(10) + (size_t)l * DM * NIN, DM, NIN, NINP, ARGIN(9) + l * DM, (bf16*)(ws + WS_WIN + l * WIN_BYTES), scr, r, F.lane); continue; } r -= I_IN;
        if (r < I_OUT) { p0_transpose_item<0>(ARGIN(21) + (size_t)l * DM * DM, DM, DM, DM, nullptr, (bf16*)(ws + WS_WOUT + l * WOUT_BYTES), scr, r, F.lane); continue; } r -= I_OUT;
        if (r < I_UP) { p0_transpose_item<0>(ARGIN(23) + (size_t)l * DM * FF, DM, FF, FF, ARGIN(22) + l * DM, (bf16*)(ws + WS_WUP + l * WUP_BYTES), scr, r, F.lane); continue; } r -= I_UP;
        p0_transpose_item<0>(ARGIN(24) + (size_t)l * FF * DM, FF, DM, DM, nullptr, (bf16*)(ws + WS_WDN + l * WDN_BYTES), scr, r, F.lane);
    }
    bf16* XB = (bf16*)(ws + WS_XB); float* SSQA = (float*)(ws + WS_SSQA);
    for (int m = gw; m < MPAD; m += NGW) {
        if (m < MT) x_row_to_bf16(F.lane, m < MP ? ARGIN(0) + (size_t)m * DM : ARGIN(1) + (size_t)(m - MP) * DM, XB + (size_t)m * DM, SSQA + (size_t)m * 8);
        else { GAS v4u* o = (GAS v4u*)(XB + (size_t)m * DM) + F.lane;
#pragma unroll
            for (int j = 0; j < 4; ++j) o[64 * j] = (v4u){0u, 0u, 0u, 0u};
            if (F.lane < 8) SSQA[(size_t)m * 8 + F.lane] = 1.0f; }
    }
}

template <class EP> __device__ __forceinline__ void thin_gemm(Frame& F, const bf16* A, int lda, const bf16* Bt, int N, int K, const EP& epi) {
    const int fr = F.lane & 15, fq = F.lane >> 4;
    for (int item = F.vcu; item < N / 16; item += F.G) {
        const int n0 = item * 16;
        const GAS bf16x8* ap = (const GAS bf16x8*)(A + (size_t)(16 * F.wave + fr) * lda + 8 * fq);
        const GAS bf16x8* bp = (const GAS bf16x8*)(Bt + (size_t)(n0 + fr) * K + 8 * fq);
        f32x4 acc0 = (f32x4){0.f, 0.f, 0.f, 0.f}, acc1 = acc0;
        for (int k = 0; k < K / 8; k += 32) {
            bf16x8 a[8], b[8];
#pragma unroll
            for (int u = 0; u < 8; ++u) { a[u] = ap[k + 4 * u]; b[u] = bp[k + 4 * u]; }
#pragma unroll
            for (int u = 0; u < 8; u += 2) { acc0 = __builtin_amdgcn_mfma_f32_16x16x32_bf16(b[u], a[u], acc0, 0, 0, 0); acc1 = __builtin_amdgcn_mfma_f32_16x16x32_bf16(b[u + 1], a[u + 1], acc1, 0, 0, 0); }
        }
        epi(16 * F.wave + fr, n0 + 4 * fq, acc0 + acc1);
    }
}

#define MFMA16(yf, xf, acc) __builtin_amdgcn_mfma_f32_16x16x32_bf16(yf, xf, acc, 0, 0, 0)
constexpr int TP = 136, TPB = TP * 2;
__device__ __forceinline__ bf16x8 lds_frag(const LAS unsigned char* base, int row, int k0, int lane) { return *(const LAS bf16x8*)(base + (row + (lane & 15)) * TPB + (k0 + 8 * (lane >> 4)) * 2); }
__device__ __forceinline__ float wave_incl_scan_add(float v, int lane) {
#pragma unroll
    for (int o = 1; o < 64; o <<= 1) { const float u = __shfl_up(v, o); if (lane >= o) v += u; }
    return v;
}
__device__ __forceinline__ float wave_incl_scan_max(float v, int lane) {
#pragma unroll
    for (int o = 1; o < 64; o <<= 1) { const float u = __shfl_up(v, o); if (lane >= o) v = fmaxf(v, u); }
    return v;
}
constexpr size_t WS_DCT = 190 * MiB;
constexpr size_t WS_CPT = 206 * MiB;
constexpr size_t WS_DN = 214 * MiB, WS_NP = WS_DN + 131072, WS_SC = WS_NP + 131072, WS_MPV = WS_SC + 4096;
static_assert(WS_MPV + 4096 <= WS_XRES, "mlstm workspace inside the XB region");

__device__ __forceinline__ void mlstm_gates(Frame& F, const bf16* PROJ, int row0, int l, int h, LAS float* tab, float& bcum, float& a) {
    const int tid = F.tid, lane = F.lane;
    float v = 0.f, ig = 0.f;
    if (tid < 128) { ig = bf2f(PROJ[(size_t)(row0 + tid) * NINP + C_MI + h]) + ARGIN(18)[l * 4 + h];
        v = logsigmoidf_(bf2f(PROJ[(size_t)(row0 + tid) * NINP + C_MF + h]) + ARGIN(19)[l * 4 + h]);
        v = wave_incl_scan_add(v, lane);
        if (tid == 63) tab[0] = v; }
    __syncthreads();
    if (tid >= 64 && tid < 128) v += tab[0];
    bcum = v; a = ig - v;
}

__device__ __forceinline__ void mlstm_a_item(Frame& F, int l, int b, int h, int c) {
    const bf16* PROJ = (const bf16*)(ARGWS() + WS_PROJ);
    const int tid = F.tid, lane = F.lane, w = F.wave, row0 = b * SEQL + c * 128, item = (b * 4 + h) * 16 + c;
    LAS unsigned char* KT = F.lds; LAS unsigned char* VT = F.lds + 128 * TPB;
    LAS float* tab = (LAS float*)(F.lds + 2 * 128 * TPB); LAS float* wk = tab + 16;
    __syncthreads();
    float bcum, a; mlstm_gates(F, PROJ, row0, l, h, tab, bcum, a);
    if (tid < 128) { const float mx = wave_max(a); if (lane == 0) tab[1 + w] = mx; if (tid == 127) tab[3] = bcum; }
    __syncthreads();
    const float pmax = fmaxf(tab[1], tab[2]);
    if (tid < 128) wk[tid] = expf(a - pmax) * 0.08838834764831845f;
    __syncthreads();
#pragma unroll
    for (int rep = 0; rep < 4; ++rep) { const int task = tid + rep * NTHR, t = task & 127, ch = task >> 7;
        float f[8]; const float wt = wk[t];
        unpack8(*(const GAS v4u*)(PROJ + (size_t)(row0 + t) * NINP + C_MK + h * 128 + ch * 8), f);
#pragma unroll
        for (int i = 0; i < 8; ++i) *(LAS unsigned short*)(KT + (ch * 8 + i) * TPB + t * 2) = (unsigned short)f2bf(f[i] * wt);
        const v4u vv = *(const GAS v4u*)(PROJ + (size_t)(row0 + t) * NINP + C_MV + h * 128 + ch * 8);
        *(LAS unsigned short*)(VT + (ch * 8 + 0) * TPB + t * 2) = (unsigned short)(vv.x & 0xffffu); *(LAS unsigned short*)(VT + (ch * 8 + 1) * TPB + t * 2) = (unsigned short)(vv.x >> 16);
        *(LAS unsigned short*)(VT + (ch * 8 + 2) * TPB + t * 2) = (unsigned short)(vv.y & 0xffffu); *(LAS unsigned short*)(VT + (ch * 8 + 3) * TPB + t * 2) = (unsigned short)(vv.y >> 16);
        *(LAS unsigned short*)(VT + (ch * 8 + 4) * TPB + t * 2) = (unsigned short)(vv.z & 0xffffu); *(LAS unsigned short*)(VT + (ch * 8 + 5) * TPB + t * 2) = (unsigned short)(vv.z >> 16);
        *(LAS unsigned short*)(VT + (ch * 8 + 6) * TPB + t * 2) = (unsigned short)(vv.w & 0xffffu); *(LAS unsigned short*)(VT + (ch * 8 + 7) * TPB + t * 2) = (unsigned short)(vv.w >> 16); }
    __syncthreads();
    bf16x8 xf[4];
#pragma unroll
    for (int s = 0; s < 4; ++s) xf[s] = lds_frag(VT, 16 * w, 32 * s, lane);
    float* dct = (float*)(ARGWS() + WS_DCT) + (size_t)item * 16384;
#pragma unroll
    for (int t = 0; t < 8; ++t) { f32x4 acc = (f32x4){0.f, 0.f, 0.f, 0.f};
#pragma unroll
        for (int s = 0; s < 4; ++s) acc = MFMA16(lds_frag(KT, 16 * t, 32 * s, lane), xf[s], acc);
        *(GAS f32x4*)(dct + (size_t)(16 * w + (lane & 15)) * 128 + 16 * t + 4 * (lane >> 4)) = acc; }
    if (tid < 128) { float s = 0.f;
#pragma unroll
        for (int j = 0; j < 16; ++j) { float f[8]; unpack8(*(const LAS v4u*)(KT + tid * TPB + j * 16), f); s += ((f[0] + f[1]) + (f[2] + f[3])) + ((f[4] + f[5]) + (f[6] + f[7])); }
        ((float*)(ARGWS() + WS_DN))[(size_t)item * 128 + tid] = s; }
    if (tid == 0) { float* sc = (float*)(ARGWS() + WS_SC) + item * 2; sc[0] = tab[3]; sc[1] = pmax; }
}

__device__ __forceinline__ void mlstm_scan_phase(Frame& F, int l) {
    const int tid = F.tid;
    LAS float* coef = (LAS float*)(F.lds); LAS float* gend = coef + 16;
    for (int it = F.vcu; it < 128; it += F.G) {
        const int bh = it >> 3, b = bh >> 2, h = bh & 3, part = it & 7;
        __syncthreads();
        if (tid == 0) { const float* sc = (const float*)(ARGWS() + WS_SC) + bh * 32; float* mp = (float*)(ARGWS() + WS_MPV) + bh * 16; float m = 0.f;
            for (int c = 0; c < 16; ++c) { const float bl = sc[2 * c], pm = sc[2 * c + 1], M = fmaxf(m, pm); coef[c] = expf(pm - M); gend[c] = expf(m - M); if (part == 0) mp[c] = m; m = bl + M; }
            if (part == 0) ARGOUT()[O_PM + (size_t)(l * NB + b) * 4 + h] = m; }
        __syncthreads();
        const int elem = part * 512 + tid, e = elem >> 5, d4 = (elem & 31) * 4;
        const float* dct = (const float*)(ARGWS() + WS_DCT) + (size_t)bh * 16 * 16384 + (size_t)e * 128 + d4;
        bf16* cpt = (bf16*)(ARGWS() + WS_CPT) + (size_t)bh * 16 * 16384 + (size_t)e * 128 + d4;
        f32x4 dc[16];
#pragma unroll
        for (int c = 0; c < 16; ++c) dc[c] = *(const GAS f32x4*)(dct + (size_t)c * 16384);
        f32x4 C = (f32x4){0.f, 0.f, 0.f, 0.f};
#pragma unroll
        for (int c = 0; c < 16; ++c) { *(GAS unsigned long long*)(cpt + (size_t)c * 16384) = (unsigned long long)pk2(C.x, C.y) | ((unsigned long long)pk2(C.z, C.w) << 32);
            C = C * gend[c] + dc[c] * coef[c]; }
        float* pc = ARGOUT() + O_PC + ((size_t)(l * NB + b) * 4 + h) * 16384;
        pc[(size_t)(d4 + 0) * 128 + e] = C.x; pc[(size_t)(d4 + 1) * 128 + e] = C.y; pc[(size_t)(d4 + 2) * 128 + e] = C.z; pc[(size_t)(d4 + 3) * 128 + e] = C.w;
        if (part == 0 && tid < 128) { const float* dn = (const float*)(ARGWS() + WS_DN) + (size_t)bh * 16 * 128 + tid; float* np = (float*)(ARGWS() + WS_NP) + (size_t)bh * 16 * 128 + tid; float n = 0.f;
#pragma unroll
            for (int c = 0; c < 16; ++c) { np[c * 128] = n; n = n * gend[c] + dn[c * 128] * coef[c]; }
            ARGOUT()[O_PN + ((size_t)(l * NB + b) * 4 + h) * 128 + tid] = n; }
    }
}

__device__ __forceinline__ void mlstm_c_item(Frame& F, int l, int b, int h, int c) {
    const bf16* PROJ = (const bf16*)(ARGWS() + WS_PROJ); bf16* MIXED = (bf16*)(ARGWS() + WS_MIXED);
    const int tid = F.tid, lane = F.lane, w = F.wave, row0 = b * SEQL + c * 128, item = (b * 4 + h) * 16 + c, lc = lane & 15, lg = lane >> 4;
    LAS unsigned char* Kn = F.lds; LAS unsigned char* VT = F.lds + 128 * TPB; LAS unsigned char* CP = F.lds + 2 * 128 * TPB;
    LAS float* tab = (LAS float*)(F.lds + 3 * 128 * TPB); LAS float* Ak = tab + 16; LAS float* Mq = Ak + 128; LAS float* Emt = Mq + 128; LAS float* Np = Emt + 128;
    __syncthreads();
    float bcum, a; mlstm_gates(F, PROJ, row0, l, h, tab, bcum, a);
    const float mprev = ((const float*)(ARGWS() + WS_MPV))[item];
    float pm = -INFINITY;
    if (tid < 128) { pm = wave_incl_scan_max(a, lane); if (tid == 63) tab[1] = pm; }
    __syncthreads();
    if (tid < 128) { if (tid >= 64) pm = fmaxf(pm, tab[1]); const float M = fmaxf(mprev, pm); Ak[tid] = a; Mq[tid] = M; Emt[tid] = expf(-(bcum + M)); Np[tid] = ((const float*)(ARGWS() + WS_NP))[(size_t)item * 128 + tid]; }
#pragma unroll
    for (int rep = 0; rep < 4; ++rep) { const int task = tid + rep * NTHR;
        { const int ch = task & 15, t = task >> 4; *(LAS v4u*)(Kn + t * TPB + ch * 16) = *(const GAS v4u*)(PROJ + (size_t)(row0 + t) * NINP + C_MK + h * 128 + ch * 8);
          *(LAS v4u*)(CP + t * TPB + ch * 16) = *(const GAS v4u*)((const bf16*)(ARGWS() + WS_CPT) + (size_t)item * 16384 + (size_t)t * 128 + ch * 8); }
        { const int t = task & 127, ch = task >> 7; const v4u vv = *(const GAS v4u*)(PROJ + (size_t)(row0 + t) * NINP + C_MV + h * 128 + ch * 8);
          *(LAS unsigned short*)(VT + (ch * 8 + 0) * TPB + t * 2) = (unsigned short)(vv.x & 0xffffu); *(LAS unsigned short*)(VT + (ch * 8 + 1) * TPB + t * 2) = (unsigned short)(vv.x >> 16);
          *(LAS unsigned short*)(VT + (ch * 8 + 2) * TPB + t * 2) = (unsigned short)(vv.y & 0xffffu); *(LAS unsigned short*)(VT + (ch * 8 + 3) * TPB + t * 2) = (unsigned short)(vv.y >> 16);
          *(LAS unsigned short*)(VT + (ch * 8 + 4) * TPB + t * 2) = (unsigned short)(vv.z & 0xffffu); *(LAS unsigned short*)(VT + (ch * 8 + 5) * TPB + t * 2) = (unsigned short)(vv.z >> 16);
          *(LAS unsigned short*)(VT + (ch * 8 + 6) * TPB + t * 2) = (unsigned short)(vv.w & 0xffffu); *(LAS unsigned short*)(VT + (ch * 8 + 7) * TPB + t * 2) = (unsigned short)(vv.w >> 16); } }
    bf16x8 qf[4];
#pragma unroll
    for (int s = 0; s < 4; ++s) qf[s] = *(const GAS bf16x8*)(PROJ + (size_t)(row0 + 16 * w + lc) * NINP + C_MQ + h * 128 + 32 * s + 8 * lg);
    __syncthreads();
    float qn = 0.f;
#pragma unroll
    for (int s = 0; s < 4; ++s) { float f[8]; unpack8(__builtin_bit_cast(v4u, qf[s]), f);
#pragma unroll
        for (int i = 0; i < 8; ++i) qn += f[i] * Np[32 * s + 8 * lg + i]; }
    qn += __shfl_xor(qn, 16); qn += __shfl_xor(qn, 32);
    f32x4 sacc[8];
#pragma unroll
    for (int t = 0; t < 8; ++t) { sacc[t] = (f32x4){0.f, 0.f, 0.f, 0.f};
        if (t <= w) {
#pragma unroll
            for (int s = 0; s < 4; ++s) sacc[t] = MFMA16(lds_frag(Kn, 16 * t, 32 * s, lane), qf[s], sacc[t]); } }
    __syncthreads();
    LAS unsigned char* Pw = Kn + w * 16 * TPB;
    const int q = 16 * w + lc; const float Mrow = Mq[q], gq = expf(mprev - Mrow);
    float rsum = 0.f;
#pragma unroll
    for (int t = 0; t < 8; ++t) { if (t <= (w | 1)) { float p[4];
#pragma unroll
            for (int i = 0; i < 4; ++i) { const int k = 16 * t + 4 * lg + i; p[i] = (k <= q) ? expf(Ak[k] - Mrow) * 0.08838834764831845f * sacc[t][i] : 0.f; rsum += p[i]; }
            *(LAS unsigned long long*)(Pw + lc * TPB + (16 * t + 4 * lg) * 2) = (unsigned long long)pk2(p[0], p[1]) | ((unsigned long long)pk2(p[2], p[3]) << 32); } }
    rsum += __shfl_xor(rsum, 16); rsum += __shfl_xor(rsum, 32);
    asm volatile("s_waitcnt lgkmcnt(0)" ::: "memory");
    f32x4 acc[8];
#pragma unroll
    for (int t = 0; t < 8; ++t) { acc[t] = (f32x4){0.f, 0.f, 0.f, 0.f};
#pragma unroll
        for (int s = 0; s < 4; ++s) acc[t] = MFMA16(lds_frag(CP, 16 * t, 32 * s, lane), qf[s], acc[t]);
        acc[t] = acc[t] * gq; }
#pragma unroll
    for (int s = 0; s < 4; ++s) { if (s <= (w >> 1)) { const bf16x8 pf = lds_frag(Pw, 0, 32 * s, lane);
#pragma unroll
            for (int t = 0; t < 8; ++t) acc[t] = MFMA16(lds_frag(VT, 16 * t, 32 * s, lane), pf, acc[t]); } }
    const float den = rsum + gq * qn, dinv = 1.0f / fmaxf(fabsf(den), Emt[q]);
    float ss = 0.f;
#pragma unroll
    for (int t = 0; t < 8; ++t) { acc[t] = acc[t] * dinv; ss += (acc[t][0] * acc[t][0] + acc[t][1] * acc[t][1]) + (acc[t][2] * acc[t][2] + acc[t][3] * acc[t][3]); }
    ss += __shfl_xor(ss, 16); ss += __shfl_xor(ss, 32);
    const float rs = 1.0f / sqrtf(ss * (1.0f / 128.0f) + 1e-6f);
    const float* wml = ARGIN(20) + (size_t)l * 512 + h * 128;
#pragma unroll
    for (int t = 0; t < 8; ++t) { const int e0 = 16 * t + 4 * lg; const f32x4 g4 = *(const GAS f32x4*)(wml + e0);
        const unsigned long long mo = *(const GAS unsigned long long*)(PROJ + (size_t)(row0 + q) * NINP + C_MO + h * 128 + e0);
        const float o0 = acc[t][0] * rs * g4.x * sigmoidf_(bflo((unsigned)mo)), o1 = acc[t][1] * rs * g4.y * sigmoidf_(bfhi((unsigned)mo)),
                    o2 = acc[t][2] * rs * g4.z * sigmoidf_(bflo((unsigned)(mo >> 32))), o3 = acc[t][3] * rs * g4.w * sigmoidf_(bfhi((unsigned)(mo >> 32)));
        *(GAS unsigned long long*)(MIXED + (size_t)(row0 + q) * DM + 1536 + h * 128 + e0) = (unsigned long long)pk2(o0, o1) | ((unsigned long long)pk2(o2, o3) << 32); }
}

constexpr size_t WS_DS = 496 * MiB;
constexpr size_t WS_SP = 528 * MiB;
constexpr size_t WS_AL = 544 * MiB;
constexpr size_t WS_END2 = 545 * MiB;

__device__ __forceinline__ void conv8(const bf16* PROJ, const float* cw, const float* cb, size_t grow, int pos, int ch0, float (&y)[8]) {
    const f32x4 b0 = *(const GAS f32x4*)(cb + ch0), b1 = *(const GAS f32x4*)(cb + ch0 + 4);
    y[0] = b0.x; y[1] = b0.y; y[2] = b0.z; y[3] = b0.w; y[4] = b1.x; y[5] = b1.y; y[6] = b1.z; y[7] = b1.w;
#pragma unroll
    for (int j = 0; j < 4; ++j) { if (pos - 3 + j >= 0) { float r[8]; unpack8(*(const GAS v4u*)(PROJ + (grow - 3 + j) * NINP + C_XBC + ch0), r);
            const f32x4 w0 = *(const GAS f32x4*)(cw + j * XCW + ch0), w1 = *(const GAS f32x4*)(cw + j * XCW + ch0 + 4);
            y[0] += w0.x * r[0]; y[1] += w0.y * r[1]; y[2] += w0.z * r[2]; y[3] += w0.w * r[3]; y[4] += w1.x * r[4]; y[5] += w1.y * r[5]; y[6] += w1.z * r[6]; y[7] += w1.w * r[7]; } }
#pragma unroll
    for (int i = 0; i < 8; ++i) y[i] = siluf_(y[i]);
}

__device__ __forceinline__ void ssd_a_item(Frame& F, int l, int b, int g, int c, int half) {
    const bf16* PROJ = (const bf16*)(ARGWS() + WS_PROJ);
    const float* cw = ARGIN(12) + (size_t)l * 4 * XCW; const float* cb = ARGIN(13) + (size_t)l * XCW;
    const int tid = F.tid, lane = F.lane, w = F.wave, row0 = b * SEQL + c * 128, h0 = g * 8 + half * 4;
    LAS unsigned char* XT = F.lds; LAS unsigned char* BT = F.lds + 256 * TPB;
    LAS float* tab = (LAS float*)(F.lds + 384 * TPB); LAS float* wt = tab + 16;
    __syncthreads();
    { const int r = tid >> 7, t = tid & 127, h = h0 + r;
      const float dt = softplusf_(bf2f(PROJ[(size_t)(row0 + t) * NINP + C_DT + h]) + ARGIN(14)[l * 16 + h]), A = -expf(ARGIN(15)[l * 16 + h]);
      float v = wave_incl_scan_add(dt * A, lane);
      if (lane == 63 && (w & 1) == 0) tab[r] = v;
      __syncthreads();
      if (w & 1) v += tab[r];
      if (t == 127) tab[4 + r] = v;
      __syncthreads();
      const float al = tab[4 + r];
      wt[r * 128 + t] = expf(al - v) * dt;
      if (t == 127) ((float*)(ARGWS() + WS_AL))[((b * 16 + h) * 16) + c] = al; }
    __syncthreads();
#pragma unroll 2
    for (int rep = 0; rep < 12; ++rep) { const int task = tid + rep * NTHR, t = task & 127, cj = task >> 7;
        const int ch0 = cj < 32 ? h0 * 64 + cj * 8 : 1024 + g * 128 + (cj - 32) * 8;
        float y[8]; conv8(PROJ, cw, cb, (size_t)(row0 + t), c * 128 + t, ch0, y);
        if (cj < 32) { const float wv = wt[(cj >> 3) * 128 + t];
#pragma unroll
            for (int i = 0; i < 8; ++i) *(LAS unsigned short*)(XT + (cj * 8 + i) * TPB + t * 2) = (unsigned short)f2bf(y[i] * wv); }
        else {
#pragma unroll
            for (int i = 0; i < 8; ++i) *(LAS unsigned short*)(BT + ((cj - 32) * 8 + i) * TPB + t * 2) = (unsigned short)f2bf(y[i]); } }
    __syncthreads();
    const int r = w >> 1, h = h0 + r;
    float* ds = (float*)(ARGWS() + WS_DS) + (size_t)((b * 16 + h) * 16 + c) * 8192;
#pragma unroll
    for (int ps = 0; ps < 2; ++ps) { const int prow = 2 * (w & 1) + ps;
        bf16x8 xf[4];
#pragma unroll
        for (int s = 0; s < 4; ++s) xf[s] = lds_frag(XT, r * 64 + 16 * prow, 32 * s, lane);
#pragma unroll
        for (int t = 0; t < 8; ++t) { f32x4 acc = (f32x4){0.f, 0.f, 0.f, 0.f};
#pragma unroll
            for (int s = 0; s < 4; ++s) acc = MFMA16(lds_frag(BT, 16 * t, 32 * s, lane), xf[s], acc);
            *(GAS f32x4*)(ds + (size_t)(16 * prow + (lane & 15)) * 128 + 16 * t + 4 * (lane >> 4)) = acc; } }
}

__device__ __forceinline__ void ssd_scan_phase(Frame& F, int l) {
    for (int idx = F.vcu * NTHR + F.tid; idx < 64 * 2048; idx += F.G * NTHR) {
        const int bh = idx >> 11, e4 = (idx & 2047) * 4;
        const float* al = (const float*)(ARGWS() + WS_AL) + bh * 16;
        const float* ds = (const float*)(ARGWS() + WS_DS) + (size_t)bh * 16 * 8192 + e4;
        bf16* sp = (bf16*)(ARGWS() + WS_SP) + (size_t)bh * 16 * 8192 + e4;
        f32x4 d[16]; float dec[16];
#pragma unroll
        for (int c = 0; c < 16; ++c) { d[c] = *(const GAS f32x4*)(ds + (size_t)c * 8192); dec[c] = al[c]; }
        f32x4 S = (f32x4){0.f, 0.f, 0.f, 0.f};
#pragma unroll
        for (int c = 0; c < 16; ++c) { *(GAS unsigned long long*)(sp + (size_t)c * 8192) = (unsigned long long)pk2(S.x, S.y) | ((unsigned long long)pk2(S.z, S.w) << 32);
            S = S * expf(dec[c]) + d[c]; }
        *(GAS f32x4*)(ARGOUT() + O_PSSM + ((size_t)l * 64 + bh) * 8192 + e4) = S;
    }
}

__device__ __forceinline__ void ssd_c_item(Frame& F, int l, int b, int g, int c) {
    const bf16* PROJ = (const bf16*)(ARGWS() + WS_PROJ); bf16* MIXED = (bf16*)(ARGWS() + WS_MIXED); float* YG = (float*)(ARGWS() + WS_YG);
    const float* cw = ARGIN(12) + (size_t)l * 4 * XCW; const float* cb = ARGIN(13) + (size_t)l * XCW;
    const int tid = F.tid, lane = F.lane, w = F.wave, row0 = b * SEQL + c * 128, lc = lane & 15, lg = lane >> 4, q = 16 * w + lc;
    LAS unsigned char* Bn = F.lds; LAS unsigned char* XT = F.lds + 128 * TPB; LAS unsigned char* SP = F.lds + 256 * TPB;
    LAS float* tab = (LAS float*)(F.lds + 384 * TPB); LAS float* At = tab + 16; LAS float* Dt = At + 1024;
    __syncthreads();
    { float v[2], dtv[2];
#pragma unroll
      for (int rep = 0; rep < 2; ++rep) { const int r = (tid >> 7) + 4 * rep, t = tid & 127, h = g * 8 + r;
          dtv[rep] = softplusf_(bf2f(PROJ[(size_t)(row0 + t) * NINP + C_DT + h]) + ARGIN(14)[l * 16 + h]);
          v[rep] = wave_incl_scan_add(dtv[rep] * -expf(ARGIN(15)[l * 16 + h]), lane);
          if (lane == 63 && (w & 1) == 0) tab[r] = v[rep]; }
      __syncthreads();
#pragma unroll
      for (int rep = 0; rep < 2; ++rep) { const int r = (tid >> 7) + 4 * rep, t = tid & 127; if (w & 1) v[rep] += tab[r]; At[r * 128 + t] = v[rep]; Dt[r * 128 + t] = dtv[rep]; } }
    bf16x8 cf[4];
#pragma unroll
    for (int s = 0; s < 4; ++s) { float y[8]; conv8(PROJ, cw, cb, (size_t)(row0 + q), c * 128 + q, 1280 + g * 128 + 32 * s + 8 * lg, y); cf[s] = __builtin_bit_cast(bf16x8, pack8(y)); }
#pragma unroll
    for (int rep = 0; rep < 4; ++rep) { const int task = tid + rep * NTHR, ch = task & 15, t = task >> 4;
        float y[8]; conv8(PROJ, cw, cb, (size_t)(row0 + t), c * 128 + t, 1024 + g * 128 + ch * 8, y); *(LAS v4u*)(Bn + t * TPB + ch * 16) = pack8(y); }
    __syncthreads();
    f32x4 cbm[8];
#pragma unroll
    for (int t = 0; t < 8; ++t) { cbm[t] = (f32x4){0.f, 0.f, 0.f, 0.f};
        if (t <= w) {
#pragma unroll
            for (int s = 0; s < 4; ++s) cbm[t] = MFMA16(lds_frag(Bn, 16 * t, 32 * s, lane), cf[s], cbm[t]); } }
    LAS unsigned char* Pw = Bn + w * 16 * TPB;
    float ssq = 0.f;
    for (int hp = 0; hp < 4; ++hp) {
        __syncthreads();
#pragma unroll
        for (int rep = 0; rep < 4; ++rep) { const int task = tid + rep * NTHR;
            { const int t = task & 127, cj = task >> 7;
              float y[8]; conv8(PROJ, cw, cb, (size_t)(row0 + t), c * 128 + t, (g * 8 + 2 * hp) * 64 + cj * 8, y);
#pragma unroll
              for (int i = 0; i < 8; ++i) *(LAS unsigned short*)(XT + (cj * 8 + i) * TPB + t * 2) = (unsigned short)f2bf(y[i]); }
            { const int ch = task & 15, pr = task >> 4;
              const int h = g * 8 + 2 * hp + (pr >> 6);
              *(LAS v4u*)(SP + pr * TPB + ch * 16) = *(const GAS v4u*)((const bf16*)(ARGWS() + WS_SP) + (size_t)((b * 16 + h) * 16 + c) * 8192 + (size_t)(pr & 63) * 128 + ch * 8); } }
        __syncthreads();
#pragma unroll
        for (int rr = 0; rr < 2; ++rr) { const int r = 2 * hp + rr, h = g * 8 + r; const float Dh = ARGIN(16)[l * 16 + h], aq = At[r * 128 + q];
#pragma unroll
            for (int t = 0; t < 8; ++t) { if (t <= (w | 1)) { float p[4];
#pragma unroll
                    for (int i = 0; i < 4; ++i) { const int k = 16 * t + 4 * lg + i; p[i] = (k <= q) ? cbm[t][i] * expf(aq - At[r * 128 + k]) * Dt[r * 128 + k] : 0.f; if (k == q) p[i] += Dh; }
                    *(LAS unsigned long long*)(Pw + lc * TPB + (16 * t + 4 * lg) * 2) = (unsigned long long)pk2(p[0], p[1]) | ((unsigned long long)pk2(p[2], p[3]) << 32); } }
            asm volatile("s_waitcnt lgkmcnt(0)" ::: "memory");
            f32x4 acc[4]; const float eq = expf(aq);
#pragma unroll
            for (int pt = 0; pt < 4; ++pt) { acc[pt] = (f32x4){0.f, 0.f, 0.f, 0.f};
#pragma unroll
                for (int s = 0; s < 4; ++s) acc[pt] = MFMA16(lds_frag(SP, rr * 64 + 16 * pt, 32 * s, lane), cf[s], acc[pt]);
                acc[pt] = acc[pt] * eq; }
#pragma unroll
            for (int s = 0; s < 4; ++s) { if (s <= (w >> 1)) { const bf16x8 pf = lds_frag(Pw, 0, 32 * s, lane);
#pragma unroll
                    for (int pt = 0; pt < 4; ++pt) acc[pt] = MFMA16(lds_frag(XT, rr * 64 + 16 * pt, 32 * s, lane), pf, acc[pt]); } }
            asm volatile("s_waitcnt lgkmcnt(0)" ::: "memory");
#pragma unroll
            for (int pt = 0; pt < 4; ++pt) { const int p0 = 16 * pt + 4 * lg;
                const unsigned long long zz = *(const GAS unsigned long long*)(PROJ + (size_t)(row0 + q) * NINP + C_Z + h * 64 + p0);
                f32x4 y = acc[pt]; y.x *= siluf_(bflo((unsigned)zz)); y.y *= siluf_(bfhi((unsigned)zz)); y.z *= siluf_(bflo((unsigned)(zz >> 32))); y.w *= siluf_(bfhi((unsigned)(zz >> 32)));
                ssq += (y.x * y.x + y.y * y.y) + (y.z * y.z + y.w * y.w);
                *(GAS f32x4*)(YG + (size_t)(row0 + q) * 1024 + h * 64 + p0) = y; } }
    }
    ssq += __shfl_xor(ssq, 16); ssq += __shfl_xor(ssq, 32);
    const float rs = 1.0f / sqrtf(ssq * (1.0f / 512.0f) + 1e-6f);
    asm volatile("s_waitcnt vmcnt(0)" ::: "memory");
    const float* wn = ARGIN(17) + (size_t)l * 1024 + g * 512;
#pragma unroll 4
    for (int j = 0; j < 32; ++j) { const int col = 16 * j + 4 * lg;
        const f32x4 y = *(const GAS f32x4*)(YG + (size_t)(row0 + q) * 1024 + g * 512 + col), g4 = *(const GAS f32x4*)(wn + col);
        *(GAS unsigned long long*)(MIXED + (size_t)(row0 + q) * DM + 512 + g * 512 + col) = (unsigned long long)pk2(y.x * rs * g4.x, y.y * rs * g4.y) | ((unsigned long long)pk2(y.z * rs * g4.z, y.w * rs * g4.w) << 32); }
}

__device__ __forceinline__ void conv_phase(Frame& F, const Args& a, int l) {
    const bf16* PROJ = (const bf16*)(ARGWS() + WS_PROJ); bf16* XC = (bf16*)(ARGWS() + WS_XC);
    const float* cw = ARGIN(12) + (size_t)l * 4 * XCW; const float* cb = ARGIN(13) + (size_t)l * XCW; const float* sconv = ARGIN(4) + (size_t)l * MS * 3 * XCW;
    float* pconv = ARGOUT() + O_PCONV + (size_t)l * NB * 3 * XCW; float* sconv_o = ARGOUT() + O_SCONV + (size_t)l * MS * 3 * XCW;
    for (int idx = F.vcu * NTHR + F.tid; idx < (MS + NB * 3) * (XCW / 8); idx += F.G * NTHR) {
        const int rr_ = idx / (XCW / 8), c0 = (idx % (XCW / 8)) * 8;
        const int row = rr_ < MS ? MP + rr_ : ((rr_ - MS) / 3) * SEQL + (SEQL - 3) + (rr_ - MS) % 3;
        float r[4][8];
        if (row < MP) { const int t = row & (SEQL - 1);
#pragma unroll
            for (int j = 0; j < 4; ++j) { const int tt = t - 3 + j;
                if (tt >= 0) { const v4u w = *(const GAS v4u*)(PROJ + (size_t)(row - 3 + j) * NINP + C_XBC + c0); unpack8(w, r[j]); }
                else {
#pragma unroll
                    for (int i = 0; i < 8; ++i) r[j][i] = 0.f; } }
        } else { const int b = row - MP;
#pragma unroll
            for (int j = 0; j < 3; ++j) { const f32x4 u0 = *(const GAS f32x4*)(sconv + (size_t)(b * 3 + j) * XCW + c0), u1 = *(const GAS f32x4*)(sconv + (size_t)(b * 3 + j) * XCW + c0 + 4);
                r[j][0] = u0.x; r[j][1] = u0.y; r[j][2] = u0.z; r[j][3] = u0.w; r[j][4] = u1.x; r[j][5] = u1.y; r[j][6] = u1.z; r[j][7] = u1.w; }
            const v4u w = *(const GAS v4u*)(PROJ + (size_t)row * NINP + C_XBC + c0); unpack8(w, r[3]);
        }
        float y[8];
#pragma unroll
        for (int i = 0; i < 8; ++i) { float acc = cb[c0 + i];
#pragma unroll
            for (int j = 0; j < 4; ++j) acc += cw[j * XCW + c0 + i] * r[j][i];
            y[i] = siluf_(acc); }
        *(GAS v4u*)(XC + (size_t)row * XCW + c0) = pack8(y);
        if (row < MP) { const int t = row & (SEQL - 1), b = row >> 11;
            if (t >= SEQL - 3) { float* o = pconv + (size_t)(b * 3 + (t - (SEQL - 3))) * XCW + c0;
                *(GAS f32x4*)o = (f32x4){r[3][0], r[3][1], r[3][2], r[3][3]}; *(GAS f32x4*)(o + 4) = (f32x4){r[3][4], r[3][5], r[3][6], r[3][7]}; }
        } else { const int b = row - MP;
#pragma unroll
            for (int j = 0; j < 3; ++j) { float* o = sconv_o + (size_t)(b * 3 + j) * XCW + c0;
                *(GAS f32x4*)o = (f32x4){r[j + 1][0], r[j + 1][1], r[j + 1][2], r[j + 1][3]}; *(GAS f32x4*)(o + 4) = (f32x4){r[j + 1][4], r[j + 1][5], r[j + 1][6], r[j + 1][7]}; }
        }
    }
}

__device__ __forceinline__ void ssd_seq_item(Frame& F, const Args& a, int l, int b, int h, bool sample) {
    const bf16* PROJ = (const bf16*)(ARGWS() + WS_PROJ); const bf16* XC = (const bf16*)(ARGWS() + WS_XC); float* YG = (float*)(ARGWS() + WS_YG);
    const int row0 = sample ? MP + b : b * SEQL, L = sample ? 1 : SEQL, g = h >> 3, tid = F.tid;
    const float A = -expf(ARGIN(15)[l * 16 + h]), dtb = ARGIN(14)[l * 16 + h], Dh = ARGIN(16)[l * 16 + h];
    const int p = tid >> 3, nq = tid & 7;
    float S[16];
    if (sample) { const float* s0 = ARGIN(5) + ((((size_t)l * MS + b) * 16 + h) * 64 + p) * 128 + nq * 16;
#pragma unroll
        for (int i = 0; i < 4; ++i) { const f32x4 v = *(const GAS f32x4*)(s0 + 4 * i); S[4 * i] = v.x; S[4 * i + 1] = v.y; S[4 * i + 2] = v.z; S[4 * i + 3] = v.w; } }
    else {
#pragma unroll
        for (int i = 0; i < 16; ++i) S[i] = 0.f; }
    LAS float* xs = (LAS float*)(F.lds);
    LAS float* Bs = (LAS float*)(F.lds + 16384);
    LAS float* Cs = (LAS float*)(F.lds + 49152);
    LAS float* ys = (LAS float*)(F.lds + 81920);
    LAS float* dts = (LAS float*)(F.lds + 98304);
    LAS float* das = (LAS float*)(F.lds + 98304 + 256);
    for (int t0 = 0; t0 < L; t0 += 64) {
        const int nb = (L - t0) < 64 ? (L - t0) : 64;
        __syncthreads();
        { const int tt = tid >> 3, ch = tid & 7;
          if (tt < nb) { float f[8]; unpack8(*(const GAS v4u*)(XC + (size_t)(row0 + t0 + tt) * XCW + h * 64 + ch * 8), f);
#pragma unroll
              for (int i = 0; i < 8; ++i) xs[tt * 64 + ch * 8 + i] = f[i]; } }
#pragma unroll
        for (int rep = 0; rep < 2; ++rep) { const int task = tid + rep * NTHR, tt = task >> 4, ch = task & 15;
          if (tt < nb) { float f[8]; unpack8(*(const GAS v4u*)(XC + (size_t)(row0 + t0 + tt) * XCW + 1024 + g * 128 + ch * 8), f);
#pragma unroll
              for (int i = 0; i < 8; ++i) Bs[tt * 128 + ch * 8 + i] = f[i];
              unpack8(*(const GAS v4u*)(XC + (size_t)(row0 + t0 + tt) * XCW + 1280 + g * 128 + ch * 8), f);
#pragma unroll
              for (int i = 0; i < 8; ++i) Cs[tt * 128 + ch * 8 + i] = f[i]; } }
        if (tid < nb) { const float dt = softplusf_(bf2f(PROJ[(size_t)(row0 + t0 + tid) * NINP + C_DT + h]) + dtb); dts[tid] = dt; das[tid] = expf(dt * A); }
        __syncthreads();
        for (int tt = 0; tt < nb; ++tt) {
            const float dt = dts[tt], dA = das[tt], x = xs[tt * 64 + p], coef = dt * x;
            float y = 0.f;
#pragma unroll
            for (int i = 0; i < 16; ++i) { S[i] = dA * S[i] + coef * Bs[tt * 128 + nq * 16 + i]; y += S[i] * Cs[tt * 128 + nq * 16 + i]; }
            y += __shfl_xor(y, 1); y += __shfl_xor(y, 2); y += __shfl_xor(y, 4);
            if (nq == 0) ys[tt * 64 + p] = y + Dh * x;
        }
        __syncthreads();
        { const int tt = tid >> 3, ch = tid & 7;
          if (tt < nb) { float z[8]; unpack8(*(const GAS v4u*)(PROJ + (size_t)(row0 + t0 + tt) * NINP + C_Z + h * 64 + ch * 8), z);
              float o[8];
#pragma unroll
              for (int i = 0; i < 8; ++i) o[i] = ys[tt * 64 + ch * 8 + i] * siluf_(z[i]);
              float* dst = YG + (size_t)(row0 + t0 + tt) * 1024 + h * 64 + ch * 8;
              *(GAS f32x4*)dst = (f32x4){o[0], o[1], o[2], o[3]}; *(GAS f32x4*)(dst + 4) = (f32x4){o[4], o[5], o[6], o[7]}; } }
    }
    float* so = ARGOUT() + (sample ? O_SSSM + ((((size_t)l * MS + b) * 16 + h) * 64 + p) * 128 : O_PSSM + ((((size_t)l * NB + b) * 16 + h) * 64 + p) * 128) + nq * 16;
#pragma unroll
    for (int i = 0; i < 4; ++i) *(GAS f32x4*)(so + 4 * i) = (f32x4){S[4 * i], S[4 * i + 1], S[4 * i + 2], S[4 * i + 3]};
}

__device__ __forceinline__ void mlstm_seq_item(Frame& F, const Args& a, int l, int b, int h, int es, bool sample) {
    const bf16* PROJ = (const bf16*)(ARGWS() + WS_PROJ); float* HR = (float*)(ARGWS() + WS_HR);
    const int row0 = sample ? MP + b : b * SEQL, L = sample ? 1 : SEQL, tid = F.tid, w = F.wave, lane = F.lane;
    const int e0 = es * 32 + w * 4, d0 = 2 * lane, Bn = sample ? MS : NB;
    const float ib = ARGIN(18)[l * 4 + h], fb = ARGIN(19)[l * 4 + h];
    float C[2][4], n[2], m;
    if (sample) {
#pragma unroll
        for (int dd = 0; dd < 2; ++dd) { const f32x4 v = *(const GAS f32x4*)(ARGIN(6) + ((((size_t)l * MS + b) * 4 + h) * 128 + d0 + dd) * 128 + e0);
            C[dd][0] = v.x; C[dd][1] = v.y; C[dd][2] = v.z; C[dd][3] = v.w; n[dd] = ARGIN(7)[(((size_t)l * MS + b) * 4 + h) * 128 + d0 + dd]; }
        m = ARGIN(8)[((size_t)l * MS + b) * 4 + h];
    } else {
#pragma unroll
        for (int dd = 0; dd < 2; ++dd) { n[dd] = 0.f;
#pragma unroll
            for (int j = 0; j < 4; ++j) C[dd][j] = 0.f; }
        m = 0.f;
    }
    LAS float* qs = (LAS float*)(F.lds);
    LAS float* ks = (LAS float*)(F.lds + 32768);
    LAS float* vs = (LAS float*)(F.lds + 65536);
    LAS float* hs = (LAS float*)(F.lds + 73728);
    LAS float* igs = (LAS float*)(F.lds + 81920);
    LAS float* lfs = (LAS float*)(F.lds + 81920 + 256);
    for (int t0 = 0; t0 < L; t0 += 64) {
        const int nb = (L - t0) < 64 ? (L - t0) : 64;
        __syncthreads();
#pragma unroll
        for (int rep = 0; rep < 2; ++rep) { const int task = tid + rep * NTHR, tt = task >> 4, ch = task & 15;
          if (tt < nb) { float f[8]; unpack8(*(const GAS v4u*)(PROJ + (size_t)(row0 + t0 + tt) * NINP + C_MQ + h * 128 + ch * 8), f);
#pragma unroll
              for (int i = 0; i < 8; ++i) qs[tt * 128 + ch * 8 + i] = f[i];
              unpack8(*(const GAS v4u*)(PROJ + (size_t)(row0 + t0 + tt) * NINP + C_MK + h * 128 + ch * 8), f);
#pragma unroll
              for (int i = 0; i < 8; ++i) ks[tt * 128 + ch * 8 + i] = f[i] * 0.08838834764831845f; } }
        if (tid < 256) { const int tt = tid >> 2, ch = tid & 3;
          if (tt < nb) { float f[8]; unpack8(*(const GAS v4u*)(PROJ + (size_t)(row0 + t0 + tt) * NINP + C_MV + h * 128 + es * 32 + ch * 8), f);
#pragma unroll
              for (int i = 0; i < 8; ++i) vs[tt * 32 + ch * 8 + i] = f[i]; } }
        if (tid < nb) { igs[tid] = bf2f(PROJ[(size_t)(row0 + t0 + tid) * NINP + C_MI + h]) + ib; lfs[tid] = logsigmoidf_(bf2f(PROJ[(size_t)(row0 + t0 + tid) * NINP + C_MF + h]) + fb); }
        __syncthreads();
        for (int tt = 0; tt < nb; ++tt) {
            const float lf = lfs[tt], ig = igs[tt];
            const float m_new = fmaxf(lf + m, ig), fgt = expf(lf + m - m_new), igt = expf(ig - m_new); m = m_new;
            const float q0 = qs[tt * 128 + d0], q1 = qs[tt * 128 + d0 + 1], k0 = ks[tt * 128 + d0] * igt, k1 = ks[tt * 128 + d0 + 1] * igt;
            n[0] = fgt * n[0] + k0; n[1] = fgt * n[1] + k1;
            float red[5]; red[4] = q0 * n[0] + q1 * n[1];
#pragma unroll
            for (int j = 0; j < 4; ++j) { const float v = vs[tt * 32 + w * 4 + j]; C[0][j] = fgt * C[0][j] + k0 * v; C[1][j] = fgt * C[1][j] + k1 * v; red[j] = q0 * C[0][j] + q1 * C[1][j]; }
#pragma unroll
            for (int j = 0; j < 5; ++j) red[j] = wave_sum(red[j]);
            const float dn = fmaxf(fabsf(red[4]), expf(-m));
            if (lane < 4) hs[tt * 32 + w * 4 + lane] = (lane == 0 ? red[0] : lane == 1 ? red[1] : lane == 2 ? red[2] : red[3]) / dn;
        }
        __syncthreads();
        { const int tt = tid >> 3, e4 = (tid & 7) * 4;
          if (tt < nb) *(GAS f32x4*)(HR + (size_t)(row0 + t0 + tt) * 512 + h * 128 + es * 32 + e4) = (f32x4){hs[tt * 32 + e4], hs[tt * 32 + e4 + 1], hs[tt * 32 + e4 + 2], hs[tt * 32 + e4 + 3]}; }
    }
    float* co = ARGOUT() + (sample ? O_SC : O_PC) + (((size_t)l * Bn + b) * 4 + h) * 128 * 128;
#pragma unroll
    for (int dd = 0; dd < 2; ++dd) *(GAS f32x4*)(co + (size_t)(d0 + dd) * 128 + e0) = (f32x4){C[dd][0], C[dd][1], C[dd][2], C[dd][3]};
    if (es == 0 && w == 0) { float* no = ARGOUT() + (sample ? O_SN : O_PN) + (((size_t)l * Bn + b) * 4 + h) * 128; no[d0] = n[0]; no[d0 + 1] = n[1];
        if (lane == 0) ARGOUT()[(sample ? O_SM : O_PM) + ((size_t)l * Bn + b) * 4 + h] = m; }
}

__device__ __forceinline__ void attn_prompt_item(Frame& F, const Args& a, int l, int b, int blk, int kvh) {
    const bf16* PROJ = (const bf16*)(ARGWS() + WS_PROJ); bf16* MIXED = (bf16*)(ARGWS() + WS_MIXED);
    constexpr int KP = 68;
    LAS unsigned short* Ks = (LAS unsigned short*)(F.lds); LAS unsigned short* Vs = (LAS unsigned short*)(F.lds + 256 * KP * 2);
    const int tid = F.tid, w0 = blk * 128 - 128;
    float* pk = ARGOUT() + O_PK + (size_t)(l * NB + b) * 128 * 128; float* pv = ARGOUT() + O_PV + (size_t)(l * NB + b) * 128 * 128;
    __syncthreads();
#pragma unroll
    for (int rep = 0; rep < 4; ++rep) { const int task = tid + rep * NTHR, r = task >> 3, c = task & 7, pos = w0 + r; const bool keep = (blk == 15 && r >= 128);
        if (pos < 0) { *(LAS v4u*)(Ks + r * KP + c * 8) = (v4u){0u, 0u, 0u, 0u}; *(LAS v4u*)(Vs + r * KP + c * 8) = (v4u){0u, 0u, 0u, 0u}; continue; }
        const size_t grow = (size_t)(b * SEQL + pos) * NINP;
        { const v4u wv = *(const GAS v4u*)(PROJ + grow + C_V + kvh * 64 + c * 8); *(LAS v4u*)(Vs + r * KP + c * 8) = wv;
          if (keep) { float f[8]; unpack8(wv, f); float* o = pv + (size_t)((r - 128) * 2 + kvh) * 64 + c * 8; *(GAS f32x4*)o = (f32x4){f[0], f[1], f[2], f[3]}; *(GAS f32x4*)(o + 4) = (f32x4){f[4], f[5], f[6], f[7]}; } }
        if (c >= 2) { const v4u wk = *(const GAS v4u*)(PROJ + grow + C_K + kvh * 64 + c * 8); *(LAS v4u*)(Ks + r * KP + c * 8) = wk;
          if (keep) { float f[8]; unpack8(wk, f); float* o = pk + (size_t)((r - 128) * 2 + kvh) * 64 + c * 8; *(GAS f32x4*)o = (f32x4){f[0], f[1], f[2], f[3]}; *(GAS f32x4*)(o + 4) = (f32x4){f[4], f[5], f[6], f[7]}; } }
        else if (c == 0) { float x1[8], x2[8], cs[8], sn[8], o1[8], o2[8];
          unpack8(*(const GAS v4u*)(PROJ + grow + C_K + kvh * 64), x1); unpack8(*(const GAS v4u*)(PROJ + grow + C_K + kvh * 64 + 8), x2); rope_cs(pos, cs, sn);
#pragma unroll
          for (int i = 0; i < 8; ++i) { o1[i] = x1[i] * cs[i] - x2[i] * sn[i]; o2[i] = x2[i] * cs[i] + x1[i] * sn[i]; }
          *(LAS v4u*)(Ks + r * KP) = pack8(o1); *(LAS v4u*)(Ks + r * KP + 8) = pack8(o2);
          if (keep) { float* o = pk + (size_t)((r - 128) * 2 + kvh) * 64; *(GAS f32x4*)o = (f32x4){o1[0], o1[1], o1[2], o1[3]}; *(GAS f32x4*)(o + 4) = (f32x4){o1[4], o1[5], o1[6], o1[7]};
              *(GAS f32x4*)(o + 8) = (f32x4){o2[0], o2[1], o2[2], o2[3]}; *(GAS f32x4*)(o + 12) = (f32x4){o2[4], o2[5], o2[6], o2[7]}; } }
    }
    __syncthreads();
    const int i = tid >> 2, g = tid & 3, h = kvh * 4 + g, qpos = blk * 128 + i; const size_t row = (size_t)b * SEQL + qpos;
    float q[64];
#pragma unroll
    for (int c = 0; c < 8; ++c) { float f[8]; unpack8(*(const GAS v4u*)(PROJ + row * NINP + C_Q + h * 64 + c * 8), f);
#pragma unroll
        for (int e = 0; e < 8; ++e) q[c * 8 + e] = f[e]; }
    { float cs[8], sn[8]; rope_cs(qpos, cs, sn);
#pragma unroll
      for (int e = 0; e < 8; ++e) { const float x1 = q[e], x2 = q[8 + e]; q[e] = x1 * cs[e] - x2 * sn[e]; q[8 + e] = x2 * cs[e] + x1 * sn[e]; } }
#pragma unroll
    for (int e = 0; e < 64; ++e) q[e] *= 0.125f;
    float acc[64], mx = -INFINITY, sum = 0.f;
#pragma unroll
    for (int e = 0; e < 64; ++e) acc[e] = 0.f;
    for (int jj = 0; jj <= 128; ++jj) { const int r = i + jj;
        if (w0 + r < 0) continue;
        float s = 0.f;
#pragma unroll
        for (int c = 0; c < 8; ++c) { float f[8]; unpack8(*(const LAS v4u*)(Ks + r * KP + c * 8), f);
#pragma unroll
            for (int e = 0; e < 8; ++e) s += q[c * 8 + e] * f[e]; }
        const float mn = fmaxf(mx, s), sc = expf(mx - mn), p = expf(s - mn); mx = mn; sum = sum * sc + p;
#pragma unroll
        for (int c = 0; c < 8; ++c) { float f[8]; unpack8(*(const LAS v4u*)(Vs + r * KP + c * 8), f);
#pragma unroll
            for (int e = 0; e < 8; ++e) acc[c * 8 + e] = acc[c * 8 + e] * sc + p * f[e]; }
    }
    const float sink = ARGIN(11)[l * 8 + h], mf = fmaxf(mx, sink), sc = expf(mx - mf), den = sum * sc + expf(sink - mf), inv = sc / den;
#pragma unroll
    for (int c = 0; c < 8; ++c) { float o[8];
#pragma unroll
        for (int e = 0; e < 8; ++e) o[e] = acc[c * 8 + e] * inv;
        *(GAS v4u*)(MIXED + row * DM + h * 64 + c * 8) = pack8(o); }
}

__device__ __forceinline__ void attn_sample_item(Frame& F, const Args& a, int l, int b) {
    const bf16* PROJ = (const bf16*)(ARGWS() + WS_PROJ); bf16* MIXED = (bf16*)(ARGWS() + WS_MIXED);
    const int tid = F.tid, h = F.wave, lane = F.lane, kvh = h >> 2; const size_t prow = (size_t)(MP + b) * NINP;
    LAS float* qs = (LAS float*)(F.lds);
    LAS float* ps = (LAS float*)(F.lds + 2048);
    LAS float* knew = (LAS float*)(F.lds + 2048 + 4224);
    LAS float* vnew = knew + 128;
    const float* ck = ARGIN(2) + (size_t)(l * MS + b) * 128 * 128; const float* cv = ARGIN(3) + (size_t)(l * MS + b) * 128 * 128;
    __syncthreads();
    { float cs[8], sn[8]; rope_cs(8192, cs, sn);
      const int d = lane; float x = bf2f(PROJ[prow + C_Q + h * 64 + d]);
      if (d < 16) { const float xp = bf2f(PROJ[prow + C_Q + h * 64 + (d ^ 8)]); const float c = (d & 7) == 0 ? cs[0] : (d & 7) == 1 ? cs[1] : (d & 7) == 2 ? cs[2] : (d & 7) == 3 ? cs[3] : (d & 7) == 4 ? cs[4] : (d & 7) == 5 ? cs[5] : (d & 7) == 6 ? cs[6] : cs[7];
          const float s = (d & 7) == 0 ? sn[0] : (d & 7) == 1 ? sn[1] : (d & 7) == 2 ? sn[2] : (d & 7) == 3 ? sn[3] : (d & 7) == 4 ? sn[4] : (d & 7) == 5 ? sn[5] : (d & 7) == 6 ? sn[6] : sn[7];
          x = d < 8 ? x * c - xp * s : x * c + xp * s; }
      qs[h * 64 + d] = x * 0.125f;
      if (h < 2) { float y = bf2f(PROJ[prow + C_K + h * 64 + d]);
          if (d < 16) { const float yp = bf2f(PROJ[prow + C_K + h * 64 + (d ^ 8)]); const float c = (d & 7) == 0 ? cs[0] : (d & 7) == 1 ? cs[1] : (d & 7) == 2 ? cs[2] : (d & 7) == 3 ? cs[3] : (d & 7) == 4 ? cs[4] : (d & 7) == 5 ? cs[5] : (d & 7) == 6 ? cs[6] : cs[7];
              const float s = (d & 7) == 0 ? sn[0] : (d & 7) == 1 ? sn[1] : (d & 7) == 2 ? sn[2] : (d & 7) == 3 ? sn[3] : (d & 7) == 4 ? sn[4] : (d & 7) == 5 ? sn[5] : (d & 7) == 6 ? sn[6] : sn[7];
              y = d < 8 ? y * c - yp * s : y * c + yp * s; }
          knew[h * 64 + d] = y; vnew[h * 64 + d] = bf2f(PROJ[prow + C_V + h * 64 + d]); } }
    __syncthreads();
    float sa = 0.f, sb = 0.f, sn_ = 0.f;
    { const float* ka = ck + (size_t)(lane * 2 + kvh) * 64; const float* kb = ck + (size_t)((lane + 64) * 2 + kvh) * 64;
#pragma unroll
      for (int c = 0; c < 16; ++c) { const f32x4 x = *(const GAS f32x4*)(ka + 4 * c), y = *(const GAS f32x4*)(kb + 4 * c); const f32x4 qv = *(const LAS f32x4*)(qs + h * 64 + 4 * c), kn = *(const LAS f32x4*)(knew + kvh * 64 + 4 * c);
          sa += (qv.x * x.x + qv.y * x.y) + (qv.z * x.z + qv.w * x.w); sb += (qv.x * y.x + qv.y * y.y) + (qv.z * y.z + qv.w * y.w); sn_ += (qv.x * kn.x + qv.y * kn.y) + (qv.z * kn.z + qv.w * kn.w); } }
    const float sink = ARGIN(11)[l * 8 + h];
    const float mx = fmaxf(fmaxf(wave_max(fmaxf(sa, sb)), sn_), sink);
    const float ea = expf(sa - mx), eb = expf(sb - mx), en = expf(sn_ - mx);
    const float inv = 1.0f / (wave_sum(ea + eb) + en + expf(sink - mx));
    ps[h * 132 + lane] = ea * inv; ps[h * 132 + 64 + lane] = eb * inv; if (lane == 0) ps[h * 132 + 128] = en * inv;
    __syncthreads();
    { float o = ps[h * 132 + 128] * vnew[kvh * 64 + lane];
      for (int j = 0; j < 128; ++j) o += ps[h * 132 + j] * cv[(size_t)(j * 2 + kvh) * 64 + lane];
      ((unsigned short*)MIXED)[(size_t)(MP + b) * DM + h * 64 + lane] = (unsigned short)f2bf(o); }
    float* sk = ARGOUT() + O_SK + (size_t)(l * MS + b) * 128 * 128; float* sv = ARGOUT() + O_SV + (size_t)(l * MS + b) * 128 * 128;
    for (int idx = tid * 4; idx < 128 * 128; idx += NTHR * 4) { const int j = idx >> 7, rem = idx & 127;
        f32x4 kk, vv;
        if (j < 127) { kk = *(const GAS f32x4*)(ck + idx + 128); vv = *(const GAS f32x4*)(cv + idx + 128); }
        else { kk = *(const LAS f32x4*)(knew + rem); vv = *(const LAS f32x4*)(vnew + rem); }
        *(GAS f32x4*)(sk + idx) = kk; *(GAS f32x4*)(sv + idx) = vv; }
}

__device__ __forceinline__ bool queue_next(Frame& F, gu32* head, int& it) {
    volatile LAS unsigned* slot = F.MISC + 16;
    __syncthreads();
    if (F.tid == 0) slot[0] = __hip_atomic_fetch_add(head, 1u, RLX_AGENT);
    __syncthreads();
    it = (int)slot[0];
    { int t_ = threadIdx.x; asm volatile("" : "+v"(t_)); F.tid = t_; F.lane = t_ & 63; F.wave = __builtin_amdgcn_readfirstlane(t_ >> 6); }
    return true;
}
__device__ __forceinline__ void mixer_phase(Frame& F, const Args& a, int l, int qslot) {
    constexpr int N_ATP = NB * 16 * 2, N_SSDA = NB * 2 * 16 * 2, N_MLA = NB * 4 * 16, N_SSDS = MS * 16, N_MLS = MS * 4 * 4, N_ATS = MS;
    constexpr int E0 = N_ATP, E1 = E0 + N_SSDA, E2 = E1 + N_MLA, E3 = E2 + N_SSDS, E4 = E3 + N_MLS, E5 = E4 + N_ATS;
    gu32* head = F.ctl + CW_QUEUE + 64 * qslot;
    for (;;) {
        int it; queue_next(F, head, it);
        if (it >= E5) break;
        if (it < E0) attn_prompt_item(F, a, l, it >> 5, (it >> 1) & 15, it & 1);
        else if (it < E1) { const int r = it - E0; ssd_a_item(F, l, r >> 6, (r >> 5) & 1, (r >> 1) & 15, r & 1); }
        else if (it < E2) { const int r = it - E1; mlstm_a_item(F, l, r >> 6, (r >> 4) & 3, r & 15); }
        else if (it < E3) { const int r = it - E2; ssd_seq_item(F, a, l, r >> 4, r & 15, true); }
        else if (it < E4) { const int r = it - E3; mlstm_seq_item(F, a, l, r >> 4, (r >> 2) & 3, r & 3, true); }
        else attn_sample_item(F, a, l, it - E4);
    }
}
__device__ __forceinline__ void mixer_c_phase(Frame& F, int l, int qslot) {
    constexpr int N_SSDC = NB * 2 * 16, N_MLC = NB * 4 * 16;
    gu32* head = F.ctl + CW_QUEUE + 64 * qslot;
    for (;;) {
        int it; queue_next(F, head, it);
        if (it >= N_SSDC + N_MLC) break;
        if (it < N_SSDC) ssd_c_item(F, l, it >> 5, (it >> 4) & 1, it & 15);
        else { const int r = it - N_SSDC; mlstm_c_item(F, l, r >> 6, (r >> 4) & 3, r & 15); }
    }
}

__device__ __forceinline__ void finalize_phase(Frame& F, const Args& a, int l) {
    const bf16* PROJ = (const bf16*)(ARGWS() + WS_PROJ); bf16* MIXED = (bf16*)(ARGWS() + WS_MIXED); const float* YG = (const float*)(ARGWS() + WS_YG); const float* HR = (const float*)(ARGWS() + WS_HR);
    const float* wssm = ARGIN(17) + (size_t)l * 1024; const float* wml = ARGIN(20) + (size_t)l * 512;
    const int gw = F.vcu * NWAVES + F.wave, NGW = F.G * NWAVES, lane = F.lane;
    for (int row = MP + gw; row < MT; row += NGW) {
#pragma unroll
        for (int g = 0; g < 2; ++g) { const float* src = YG + (size_t)row * 1024 + g * 512 + lane * 8; const f32x4 u0 = *(const GAS f32x4*)src, u1 = *(const GAS f32x4*)(src + 4);
            float ss = (u0.x * u0.x + u0.y * u0.y) + (u0.z * u0.z + u0.w * u0.w) + (u1.x * u1.x + u1.y * u1.y) + (u1.z * u1.z + u1.w * u1.w);
            ss = wave_sum(ss); const float rs = 1.0f / sqrtf(ss * (1.0f / 512.0f) + 1e-6f);
            const float* wp = wssm + g * 512 + lane * 8; const f32x4 w0 = *(const GAS f32x4*)wp, w1 = *(const GAS f32x4*)(wp + 4);
            float o[8] = {u0.x * rs * w0.x, u0.y * rs * w0.y, u0.z * rs * w0.z, u0.w * rs * w0.w, u1.x * rs * w1.x, u1.y * rs * w1.y, u1.z * rs * w1.z, u1.w * rs * w1.w};
            *(GAS v4u*)(MIXED + (size_t)row * DM + 512 + g * 512 + lane * 8) = pack8(o); }
#pragma unroll
        for (int hh = 0; hh < 4; ++hh) { const float* src = HR + (size_t)row * 512 + hh * 128 + lane * 2; const float v0 = src[0], v1 = src[1];
            const float ss = wave_sum(v0 * v0 + v1 * v1), rs = 1.0f / sqrtf(ss * (1.0f / 128.0f) + 1e-6f);
            const unsigned mo = *(const GAS unsigned*)(PROJ + (size_t)row * NINP + C_MO + hh * 128 + lane * 2);
            const float o0 = v0 * rs * wml[hh * 128 + lane * 2] * sigmoidf_(bflo(mo)), o1 = v1 * rs * wml[hh * 128 + lane * 2 + 1] * sigmoidf_(bfhi(mo));
            *(GAS unsigned*)(MIXED + (size_t)row * DM + 1536 + hh * 128 + lane * 2) = pk2(o0, o1); }
    }
}

__device__ __forceinline__ void final_norm_phase(Frame& F, const Args& a) {
    const float* SSQ = (const float*)(ARGWS() + WS_SSQA); const float* wf = ARGIN(25);
    const int gw = F.vcu * NWAVES + F.wave, NGW = F.G * NWAVES, lane = F.lane;
    for (int row = gw; row < MT; row += NGW) {
        const f32x4 p0 = *(const GAS f32x4*)(SSQ + (size_t)row * 8), p1 = *(const GAS f32x4*)(SSQ + (size_t)row * 8 + 4);
        const float ss = ((p0.x + p0.y) + (p0.z + p0.w)) + ((p1.x + p1.y) + (p1.z + p1.w)), rs = 1.0f / sqrtf(ss * (1.0f / 2048.0f) + 1e-6f);
        GAS f32x4* y = (GAS f32x4*)(ARGOUT() + O_Y + (size_t)row * DM) + lane; const GAS f32x4* wv = (const GAS f32x4*)wf + lane;
#pragma unroll
        for (int j = 0; j < 8; ++j) { const f32x4 v = y[64 * j], g = wv[64 * j]; y[64 * j] = (f32x4){v.x * rs * g.x, v.y * rs * g.y, v.z * rs * g.z, v.w * rs * g.w}; }
    }
}

#ifndef MK_N_LAUNCHES
#define MK_N_LAUNCHES 1
#endif
constexpr int N_PHASES = 18;
__global__ void __launch_bounds__(NTHR, 2) mk_fwd(Args args) {
    extern __shared__ __attribute__((aligned(16))) unsigned char lds[];
    Frame F;
    F.lds = (LAS unsigned char*)lds;
    F.MISC = (volatile LAS unsigned*)(F.lds + MISC_OFF);
    F.tid = threadIdx.x; F.lane = F.tid & 63; F.wave = __builtin_amdgcn_readfirstlane(F.tid >> 6);
    F.G = gridDim.x; { const int bx = blockIdx.x; F.vcu = (F.G % 8 == 0) ? (bx % 8) * (F.G / 8) + bx / 8 : bx; }
    unsigned char* ws = ARGWS();
    F.ctl = (gu32*)(ws + WS_CTL);
    for (int u = F.tid; u < (LDS_BYTES - LDSCTL_OFF) / 4; u += NTHR) ((LAS unsigned*)(F.lds + LDSCTL_OFF))[u] = 0u;
    __syncthreads();
    const int lo = args.ph_lo, hi = args.ph_hi;
    const bool use_bar = (hi - lo) > 1;
    XcdBarrier bar; bar.bar = (unsigned*)(F.ctl + CW_BAR); bar.x = 0; bar.st = nullptr;
    if (use_bar) bar = xcd_barrier_post((unsigned*)(F.ctl + CW_BAR), F.MISC + 8);
#define IN(k) (lo <= (k) && (k) < hi)
#define PHASE_BEGIN() do { int t_ = threadIdx.x, v_ = vcu0, g_ = G0; asm volatile("" : "+v"(t_)); asm volatile("" : "+s"(v_), "+s"(g_)); F.tid = t_; F.lane = t_ & 63; F.wave = __builtin_amdgcn_readfirstlane(t_ >> 6); F.vcu = v_; F.G = g_; } while (0)
#define SEAM(k) do { if (IN(k) && IN((k) + 1)) xcd_barrier(bar); } while (0)

#define WSP(T, off) ((T*)(ARGWS() + (off)))
#define DECL_WS() bf16* XB = WSP(bf16, WS_XB); float* XRES = WSP(float, WS_XRES); bf16* HBUF = WSP(bf16, WS_HBUF); bf16* PROJ = WSP(bf16, WS_PROJ); bf16* MIXED = WSP(bf16, WS_MIXED); \
    float* SSQA = WSP(float, WS_SSQA); float* SSQB = WSP(float, WS_SSQB); \
    const bf16* Wi = WSP(const bf16, WS_WIN + l * WIN_BYTES); const bf16* Wo = WSP(const bf16, WS_WOUT + l * WOUT_BYTES); const bf16* Wu = WSP(const bf16, WS_WUP + l * WUP_BYTES); const bf16* Wd = WSP(const bf16, WS_WDN + l * WDN_BYTES); \
    (void)XB; (void)XRES; (void)HBUF; (void)PROJ; (void)MIXED; (void)SSQA; (void)SSQB; (void)Wi; (void)Wo; (void)Wu; (void)Wd

    const int vcu0 = F.vcu, G0 = F.G;
    if (IN(0)) { PHASE_BEGIN(); p0_prologue(F, args); }
    SEAM(0);
    for (int l = 0; l < DEPTH; ++l) {
        const int pb = 1 + 8 * l;
        if (IN(pb)) { PHASE_BEGIN(); DECL_WS();
            pg8::Gemm g{XB, Wi, MPAD, NINP, DM}; pg8::StaticOrder S; S.init(MPAD, NINP, F.G, (int)blockIdx.x);
            pg8::EpiScaleBf16<0> E{PROJ, NINP, SSQA};
            pg8::gemm_phase<pg8::EpiScaleBf16<0>, pg8::StaticOrder, true, true>(F.lds + RING_OFF, g, S, E, F.tid);
            if (blockIdx.x == 0) for (int i = F.tid; i < MS * 8; i += NTHR) SSQB[(size_t)MP * 8 + i] = 0.f;
        }
        SEAM(pb);
        if (IN(pb + 1)) { PHASE_BEGIN(); conv_phase(F, args, l); }
        SEAM(pb + 1);
        if (IN(pb + 2)) { PHASE_BEGIN(); mixer_phase(F, args, l, l); }

        SEAM(pb + 2);
        if (IN(pb + 3)) { PHASE_BEGIN(); mlstm_scan_phase(F, l); ssd_scan_phase(F, l); finalize_phase(F, args, l); }
        SEAM(pb + 3);
        if (IN(pb + 4)) { PHASE_BEGIN(); mixer_c_phase(F, l, 2 + l); }
        SEAM(pb + 4);
        if (IN(pb + 5)) { PHASE_BEGIN(); DECL_WS();
            const float* basep = l == 0 ? ARGIN(0) : XRES; const float* bases = l == 0 ? ARGIN(1) : XRES + (size_t)MP * DM;
            pg8::Gemm g{MIXED, Wo, MP, DM, DM}; pg8::StaticOrder S; S.init(MP, DM, F.G, (int)blockIdx.x);
            pg8::EpiResid E{basep, XRES, XB, SSQB, DM};
            pg8::gemm_phase<pg8::EpiResid, pg8::StaticOrder, false, true>(F.lds + RING_OFF, g, S, E, F.tid);
            float* outs = XRES + (size_t)MP * DM; bf16* xbs = XB + (size_t)MP * DM; float* sq = SSQB + (size_t)MP * 8;
            thin_gemm(F, MIXED + (size_t)MP * DM, DM, Wo, DM, DM, [&](int row, int col, f32x4 acc) {
                const f32x4 bs = *(const GAS f32x4*)(bases + (size_t)row * DM + col); const f32x4 o = bs + acc;
                *(GAS f32x4*)(outs + (size_t)row * DM + col) = o;
                *(GAS unsigned long long*)(xbs + (size_t)row * DM + col) = (unsigned long long)pk2(o.x, o.y) | ((unsigned long long)pk2(o.z, o.w) << 32);
                float s = (o.x * o.x + o.y * o.y) + (o.z * o.z + o.w * o.w); s += __shfl_xor(s, 16); s += __shfl_xor(s, 32);
                if ((F.lane >> 4) == 0) atomicAdd(sq + (size_t)row * 8 + ((col >> 4) & 7), s); });
            if (blockIdx.x == 0) for (int i = F.tid; i < MS * 8; i += NTHR) SSQA[(size_t)MP * 8 + i] = 0.f;
        }
        SEAM(pb + 5);
        if (IN(pb + 6)) { PHASE_BEGIN(); DECL_WS();
            pg8::Gemm g{XB, Wu, MP, FF, DM}; pg8::StaticOrder S; S.init(MP, FF, F.G, (int)blockIdx.x);
            pg8::EpiScaleBf16<1> E{HBUF, FF, SSQB};
            pg8::gemm_phase<pg8::EpiScaleBf16<1>, pg8::StaticOrder, true, true>(F.lds + RING_OFF, g, S, E, F.tid);
            bf16* hs = HBUF + (size_t)MP * FF; const float* sq = SSQB + (size_t)MP * 8;
            thin_gemm(F, XB + (size_t)MP * DM, DM, Wu, FF, DM, [&](int row, int col, f32x4 acc) {
                const f32x4 p0 = *(const GAS f32x4*)(sq + (size_t)row * 8), p1 = *(const GAS f32x4*)(sq + (size_t)row * 8 + 4);
                const float ss = ((p0.x + p0.y) + (p0.z + p0.w)) + ((p1.x + p1.y) + (p1.z + p1.w)), rs = 1.0f / sqrtf(ss * (1.0f / 2048.0f) + 1e-6f);
                f32x4 v = acc * rs; v.x = fmaxf(v.x, 0.f); v.y = fmaxf(v.y, 0.f); v.z = fmaxf(v.z, 0.f); v.w = fmaxf(v.w, 0.f);
                *(GAS unsigned long long*)(hs + (size_t)row * FF + col) = (unsigned long long)pk2(v.x * v.x, v.y * v.y) | ((unsigned long long)pk2(v.z * v.z, v.w * v.w) << 32); });
        }
        SEAM(pb + 6);
        if (IN(pb + 7)) { PHASE_BEGIN(); DECL_WS();
            const bool lastl = (l == DEPTH - 1);
            float* outp = lastl ? ARGOUT() + O_Y : XRES; float* outs = lastl ? ARGOUT() + O_Y + (size_t)MP * DM : XRES + (size_t)MP * DM;
            pg8::Gemm g{HBUF, Wd, MP, DM, FF}; pg8::StaticOrder S; S.init(MP, DM, F.G, (int)blockIdx.x);
            pg8::EpiResid E{XRES, outp, lastl ? (bf16*)nullptr : XB, SSQA, DM};
            pg8::gemm_phase<pg8::EpiResid, pg8::StaticOrder, false, true>(F.lds + RING_OFF, g, S, E, F.tid);
            const float* bases = XRES + (size_t)MP * DM; bf16* xbs = XB + (size_t)MP * DM; float* sq = SSQA + (size_t)MP * 8;
            thin_gemm(F, HBUF + (size_t)MP * FF, FF, Wd, DM, FF, [&](int row, int col, f32x4 acc) {
                const f32x4 bs = *(const GAS f32x4*)(bases + (size_t)row * DM + col); const f32x4 o = bs + acc;
                *(GAS f32x4*)(outs + (size_t)row * DM + col) = o;
                if (!lastl) *(GAS unsigned long long*)(xbs + (size_t)row * DM + col) = (unsigned long long)pk2(o.x, o.y) | ((unsigned long long)pk2(o.z, o.w) << 32);
                float s = (o.x * o.x + o.y * o.y) + (o.z * o.z + o.w * o.w); s += __shfl_xor(s, 16); s += __shfl_xor(s, 32);
                if ((F.lane >> 4) == 0) atomicAdd(sq + (size_t)row * 8 + ((col >> 4) & 7), s); });
        }
        SEAM(pb + 7);
    }
    if (IN(17)) { PHASE_BEGIN(); final_norm_phase(F, args); }
#undef IN
#undef SEAM
}

extern "C" void kernel_launch(void* const* d_in, const int* in_sizes, int n_in, void* d_out, int out_size, void* d_ws, size_t ws_size, hipStream_t stream) {
    static int grid = 0;
    if (grid == 0) {
        if (n_in != 26 || (size_t)out_size != O_END || ws_size < WS_END2) { fprintf(stderr, "kernel_launch: expected 26 inputs, %zu outputs, >= %zu bytes of workspace; got %d, %d, %zu\n", (size_t)O_END, (size_t)WS_END2, n_in, out_size, ws_size); grid = -1; return; }
        int dev = 0, cus = 0, per_cu = 0;
        if (hipGetDevice(&dev) != hipSuccess || hipDeviceGetAttribute(&cus, hipDeviceAttributeMultiprocessorCount, dev) != hipSuccess) { grid = -1; return; }
        if (hipFuncSetAttribute((const void*)mk_fwd, hipFuncAttributeMaxDynamicSharedMemorySize, LDS_BYTES) != hipSuccess) { fprintf(stderr, "kernel_launch: hipFuncSetAttribute failed\n"); grid = -1; return; }
        if (hipOccupancyMaxActiveBlocksPerMultiprocessor(&per_cu, (const void*)mk_fwd, NTHR, LDS_BYTES) != hipSuccess || per_cu < 1) { fprintf(stderr, "kernel_launch: occupancy query says %d blocks per CU\n", per_cu); per_cu = 1; }
        (void)hipGetLastError();
        grid = cus;
        if (grid != 256) fprintf(stderr, "kernel_launch: %d CUs; the G2/G4 phases assume 256 workgroups\n", grid);
    }
    if (grid < 0) return;
    (void)hipMemsetAsync((char*)d_ws + WS_CTL, 0, CTL_ZERO_BYTES, stream);
    Args a{};
    for (int i = 0; i < 26; ++i) a.in[i] = (const float*)d_in[i];
    a.out = (float*)d_out; a.ws = (unsigned char*)d_ws;
#if MK_N_LAUNCHES == 1
    a.ph_lo = 0; a.ph_hi = N_PHASES;
    hipLaunchKernelGGL(mk_fwd, dim3(grid), dim3(NTHR), LDS_BYTES, stream, a);
#else
    for (int p = 0; p < N_PHASES; ++p) { a.ph_lo = p; a.ph_hi = p + 1; hipLaunchKernelGGL(mk_fwd, dim3(grid), dim3(NTHR), LDS_BYTES, stream, a); }
#endif
}
```

```cpp
#include <hip/hip_runtime.h>
#include <cstdio>
#include <cstdint>
namespace pg8 {
#define PG8_LAS __attribute__((address_space(3)))
typedef unsigned short bf16_t;
typedef short bf16x8 __attribute__((ext_vector_type(8)));
typedef float f32x4 __attribute__((ext_vector_type(4)));
typedef unsigned u32x4 __attribute__((ext_vector_type(4)));
constexpr int BM = 256, BK = 64, HALF = 128, HTB = HALF * BK * 2  , STAGE_BYTES = 8 * HTB, NXCD = 8, WGM = 8;

__host__ __device__ __forceinline__ int lds_byte(int r, int c) { const int st = (r >> 4) * 2 + (c >> 5), rr = r & 15, cc = c & 31, ob = rr * 64 + cc * 2; return st * 1024 + (ob ^ (((ob >> 9) & 1) << 5)); }
__host__ __device__ __forceinline__ void stage_rc(int b, int& R, int& C) { const int st = b / 1024, sb = b % 1024, swz = sb ^ (((sb >> 9) & 1) << 5); R = (st >> 1) * 16 + swz / 64; C = (st & 1) * 32 + (swz % 64) / 2; }
__host__ __device__ __forceinline__ int perm32(int rho) { const int n = rho >> 4, i = rho & 15; return 8 * (i >> 2) + 4 * n + (i & 3); }

struct Unit { int pm, pn; };
struct Gemm { const bf16_t* A; const bf16_t* Bt; int M, N, K; };

struct StaticOrder {
    int nM, nN, nwg, G, c;
    __host__ __device__ void init(int M, int N, int G_, int c_) { nM = M / BM; nN = N / BM; nwg = nM * nN; G = G_; c = c_; }
    __host__ __device__ bool next(int i, Unit& u) const {
        const long L = (long)i * G + c; if (L >= nwg) return false;
        int wgid = (int)L; { const int q = nwg / NXCD, r = nwg % NXCD, xcd = wgid % NXCD, off = wgid / NXCD; wgid = (xcd < r ? xcd * (q + 1) : r * (q + 1) + (xcd - r) * q) + off; }
        const int nig = WGM * nN, gid = wgid / nig, fm = gid * WGM, gsz = (nM - fm) < WGM ? (nM - fm) : WGM;
        u.pm = fm + ((wgid % nig) % gsz); u.pn = (wgid % nig) / gsz; return true;
    }
    __device__ __forceinline__ void a_ready(const Unit&) const {}
    __device__ __forceinline__ void done(const Unit&) const {}
};


__device__ __forceinline__ unsigned cvt_pk_bf16(float lo, float hi) { unsigned r; asm volatile("v_cvt_pk_bf16_f32 %0, %1, %2" : "=v"(r) : "v"(lo), "v"(hi)); return r; }

template <int ACT> struct EpiScaleBf16 {
    static constexpr bool PERM = true, AFTER_DRAIN = false;
    bf16_t* O; int ldc; const float* ssq;
    __device__ __forceinline__ void operator()(const f32x4 (&acc)[2][2][4][2], const Unit& u, int wr, int wc, int fr, int fq) const {
        const int row0 = u.pm * BM + wr * 64 + fr, col0 = u.pn * BM + wc * 32 + 8 * fq;
#pragma unroll
        for (int ai = 0; ai < 2; ++ai)
#pragma unroll
            for (int m = 0; m < 4; ++m) { const int row = row0 + ai * HALF + m * 16;
                const f32x4 p0 = *(const f32x4*)(ssq + (size_t)row * 8), p1 = *(const f32x4*)(ssq + (size_t)row * 8 + 4);
                const float ss = ((p0[0] + p0[1]) + (p0[2] + p0[3])) + ((p1[0] + p1[1]) + (p1[2] + p1[3]));
                const float rs = 1.0f / sqrtf(ss * (1.0f / 2048.0f) + 1e-6f);
                bf16_t* rowp = O + (size_t)row * ldc + col0;
#pragma unroll
                for (int bj = 0; bj < 2; ++bj) { f32x4 v0 = acc[ai][bj][m][0] * rs, v1 = acc[ai][bj][m][1] * rs;
                    if (ACT == 1) {
#pragma unroll
                        for (int e = 0; e < 4; ++e) { const float a = fmaxf(v0[e], 0.f), b = fmaxf(v1[e], 0.f); v0[e] = a * a; v1[e] = b * b; } }
                    u32x4 w; w.x = cvt_pk_bf16(v0[0], v0[1]); w.y = cvt_pk_bf16(v0[2], v0[3]); w.z = cvt_pk_bf16(v1[0], v1[1]); w.w = cvt_pk_bf16(v1[2], v1[3]);
                    *(u32x4*)(rowp + bj * HALF) = w; } }
    }
};

struct EpiResid {
    static constexpr bool PERM = false, AFTER_DRAIN = true;
    const float* base; float* out; bf16_t* xb; float* ssq; int ld;
    __device__ __forceinline__ void fused(f32x4 (&acc)[2][2][4][2], const Unit& u, int wr, int wc, int fr, int fq, PG8_LAS unsigned char* lds, int wid, int lane) const {
        typedef unsigned u32x2v __attribute__((ext_vector_type(2)));
        PG8_LAS float* P = (PG8_LAS float*)lds;
        const int col0 = u.pn * BM + wc * 32 + 4 * fq;
#pragma unroll
        for (int ai = 0; ai < 2; ++ai)
#pragma unroll
            for (int m = 0; m < 4; ++m) { const int r = ai * HALF + wr * 64 + m * 16 + fr; const size_t off = (size_t)(u.pm * BM + r) * ld + col0; float s = 0.f;
#pragma unroll
                for (int bj = 0; bj < 2; ++bj)
#pragma unroll
                    for (int n = 0; n < 2; ++n) { const f32x4 bs = *(const f32x4*)(base + off + bj * HALF + n * 16); const f32x4 o = bs + acc[ai][bj][m][n];
                        *(f32x4*)(out + off + bj * HALF + n * 16) = o;
                        if (xb) { u32x2v w; w.x = cvt_pk_bf16(o[0], o[1]); w.y = cvt_pk_bf16(o[2], o[3]); *(u32x2v*)(xb + off + bj * HALF + n * 16) = w; }
                        s += (o[0] * o[0] + o[1] * o[1]) + (o[2] * o[2] + o[3] * o[3]); }
                s += __shfl_xor(s, 16); s += __shfl_xor(s, 32);
                if (fq == 0) P[r * 4 + wc] = s;
                if (m & 1) asm volatile("" ::: "memory"); }
        asm volatile("s_waitcnt lgkmcnt(0)" ::: "memory"); __builtin_amdgcn_s_barrier(); asm volatile("" ::: "memory");
        const int t = wid * 64 + lane;
        if (t < 256) { const float s = (P[t * 4 + 0] + P[t * 4 + 1]) + (P[t * 4 + 2] + P[t * 4 + 3]); ssq[(size_t)(u.pm * BM + t) * 8 + u.pn] = s; }
        asm volatile("s_waitcnt lgkmcnt(0)" ::: "memory"); __builtin_amdgcn_s_barrier(); asm volatile("" ::: "memory");
    }
};
template <class Epi, class Sched, bool ALIGN_EPI = false, bool SP2 = false>
__device__ __forceinline__ void gemm_phase(PG8_LAS unsigned char* lds, const Gemm g, const Sched& S, const Epi& E, const int tid) {
    const int  wid = __builtin_amdgcn_readfirstlane(tid >> 6), lane = tid & 63, wr = wid >> 2, wc = wid & 3, fr = lane & 15, fq = lane >> 4;
    const int K = g.K, nt = K / BK;
    unsigned voffA[2], voffB[2];
#pragma unroll
    for (int i = 0; i < 2; ++i) { int R, C; stage_rc(tid * 16 + i * 8192, R, C); const int Rb = Epi::PERM ? ((R & ~31) + perm32(R & 31)) : R;
        voffA[i] = (unsigned)(R * K + C) * 2u; voffB[i] = (unsigned)(Rb * K + C) * 2u; }
    const size_t kstep = (size_t)(BK * 2);
    const size_t hstep = (size_t)HALF * K * 2;
    const size_t tstep = 2 * hstep;
    const unsigned ldsw = (unsigned)wid * 1024u;
    const int aoff = lds_byte(wr * 64 + fr, fq * 8), boff = lds_byte(wc * 32 + fr, fq * 8);
#define PG8_SA(b, h) (((b) * 2 + (h)) * HTB)
#define PG8_SB(b, h) ((4 + (b) * 2 + (h)) * HTB)
#define PG8_STAGE(bufoff, gbase, voff) do { _Pragma("unroll") for (int _i = 0; _i < 2; ++_i) \
        __builtin_amdgcn_global_load_lds((const unsigned*)((const char*)(gbase) + (voff)[_i]), (PG8_LAS unsigned*)(lds + (bufoff) + ldsw + _i * 8192), 16, 0, 0); } while (0)
#define PG8_LDA(dst, b, h) do { _Pragma("unroll") for (int m = 0; m < 4; ++m) _Pragma("unroll") for (int k = 0; k < 2; ++k) dst[m][k] = *(const PG8_LAS bf16x8*)(lds + PG8_SA(b, h) + aoff + m * 2048 + k * 1024); } while (0)
#define PG8_LDB(dst, b, h) do { _Pragma("unroll") for (int n = 0; n < 2; ++n) _Pragma("unroll") for (int k = 0; k < 2; ++k) dst[n][k] = *(const PG8_LAS bf16x8*)(lds + PG8_SB(b, h) + boff + n * 2048 + k * 1024); } while (0)
#define PG8_MMA(ai, bj, At, Bt) do { __builtin_amdgcn_s_setprio(1); _Pragma("unroll") for (int m = 0; m < 4; ++m) _Pragma("unroll") for (int n = 0; n < 2; ++n) _Pragma("unroll") for (int k = 0; k < 2; ++k) \
        acc[ai][bj][m][n] = __builtin_amdgcn_mfma_f32_16x16x32_bf16(Bt[n][k], At[m][k], acc[ai][bj][m][n], 0, 0, 0); __builtin_amdgcn_s_setprio(0); } while (0)
#define PG8_WAIT_V(n) asm volatile("s_waitcnt vmcnt(" #n ")" ::: "memory")
#define PG8_WAIT_L(n) asm volatile("s_waitcnt lgkmcnt(" #n ")" ::: "memory")
#define PG8_BAR __builtin_amdgcn_s_barrier()
#define PG8_SCHED __builtin_amdgcn_sched_barrier(0)
    Unit cur, nxt; int ui = 0;
    if (!S.next(0, cur)) return;
    f32x4 acc[2][2][4][2];
#pragma unroll
    for (int a = 0; a < 2; ++a)
#pragma unroll
        for (int b = 0; b < 2; ++b)
#pragma unroll
            for (int m = 0; m < 4; ++m)
#pragma unroll
                for (int n = 0; n < 2; ++n) acc[a][b][m][n] = (f32x4){0.f, 0.f, 0.f, 0.f};
    bf16x8 At[4][2], B0[2][2], B1[2][2];
    const char* cA = (const char*)g.A + (size_t)cur.pm * tstep; const char* cB = (const char*)g.Bt + (size_t)cur.pn * tstep;
    S.a_ready(cur);
    if constexpr (SP2) {
        PG8_STAGE(PG8_SB(0, 0), cB, voffB); PG8_STAGE(PG8_SB(0, 1), cB + hstep, voffB); PG8_STAGE(PG8_SA(0, 0), cA, voffA); PG8_STAGE(PG8_SA(0, 1), cA + hstep, voffA);
        if (wr == 1) PG8_BAR;
        PG8_WAIT_V(2); PG8_BAR;
        PG8_STAGE(PG8_SB(1, 0), cB + kstep, voffB); PG8_STAGE(PG8_SA(1, 0), cA + kstep, voffA); PG8_STAGE(PG8_SB(1, 1), cB + hstep + kstep, voffB);
        PG8_WAIT_V(6); PG8_BAR;
    } else {
        PG8_STAGE(PG8_SB(0, 0), cB, voffB); PG8_STAGE(PG8_SA(0, 0), cA, voffA); PG8_STAGE(PG8_SB(0, 1), cB + hstep, voffB); PG8_STAGE(PG8_SA(0, 1), cA + hstep, voffA);
        if (wr == 1) PG8_BAR;
        PG8_WAIT_V(4); PG8_BAR;
        PG8_STAGE(PG8_SB(1, 0), cB + kstep, voffB); PG8_STAGE(PG8_SA(1, 0), cA + kstep, voffA); PG8_STAGE(PG8_SB(1, 1), cB + hstep + kstep, voffB);
        PG8_WAIT_V(6); PG8_BAR;
    }
    for (;;) {
        const bool has_next = S.next(ui + 1, nxt);
        const char* nA = has_next ? (const char*)g.A + (size_t)nxt.pm * tstep : cA; const char* nB = has_next ? (const char*)g.Bt + (size_t)nxt.pn * tstep : cB;
        for (int t = 0; t < nt; t += 2) {
            const bool last = (t == nt - 2);
            const char* a1 = cA + (size_t)(t + 1) * kstep;
            const char* a2 = last ? nA : cA + (size_t)(t + 2) * kstep; const char* b2 = last ? nB : cB + (size_t)(t + 2) * kstep;
            const char* a3 = a2 + kstep; const char* b3 = b2 + kstep;
            if (last && has_next) S.a_ready(nxt);
            if constexpr (SP2) {
            PG8_LDB(B0, 0, 0); PG8_LDB(B1, 0, 1); PG8_SCHED; PG8_LDA(At, 0, 0); PG8_STAGE(PG8_SA(1, 1), a1 + hstep, voffA);
            PG8_WAIT_V(8); PG8_WAIT_L(0); PG8_BAR; PG8_MMA(0, 0, At, B0); PG8_MMA(0, 1, At, B1); PG8_BAR; PG8_SCHED;
            PG8_LDA(At, 0, 1); PG8_STAGE(PG8_SB(0, 0), b2, voffB); PG8_STAGE(PG8_SB(0, 1), b2 + hstep, voffB); PG8_STAGE(PG8_SA(0, 0), a2, voffA);
            PG8_WAIT_V(8); PG8_WAIT_L(0); PG8_BAR; PG8_MMA(1, 0, At, B0); PG8_MMA(1, 1, At, B1); PG8_BAR; PG8_SCHED;
            PG8_LDB(B0, 1, 0); PG8_LDB(B1, 1, 1); PG8_SCHED; PG8_LDA(At, 1, 0); PG8_STAGE(PG8_SA(0, 1), a2 + hstep, voffA);
            PG8_WAIT_V(8); PG8_WAIT_L(0); PG8_BAR; PG8_MMA(0, 0, At, B0); PG8_MMA(0, 1, At, B1); PG8_BAR; PG8_SCHED;
            PG8_LDA(At, 1, 1); PG8_STAGE(PG8_SB(1, 0), b3, voffB); PG8_STAGE(PG8_SB(1, 1), b3 + hstep, voffB); PG8_STAGE(PG8_SA(1, 0), a3, voffA);
            PG8_WAIT_V(8); PG8_WAIT_L(0); PG8_BAR; PG8_MMA(1, 0, At, B0); PG8_MMA(1, 1, At, B1); PG8_BAR; PG8_SCHED;
            } else {
            PG8_LDB(B0, 0, 0); PG8_SCHED; PG8_LDA(At, 0, 0); PG8_STAGE(PG8_SA(1, 1), a1 + hstep, voffA);
            PG8_WAIT_L(8); PG8_BAR; PG8_WAIT_L(0); PG8_MMA(0, 0, At, B0); PG8_BAR; PG8_SCHED;
            PG8_LDB(B1, 0, 1); PG8_STAGE(PG8_SB(0, 0), b2, voffB);
            PG8_BAR; PG8_WAIT_L(0); PG8_MMA(0, 1, At, B1); PG8_BAR;
            PG8_LDA(At, 0, 1); PG8_STAGE(PG8_SA(0, 0), a2, voffA);
            PG8_BAR; PG8_WAIT_L(0); PG8_MMA(1, 0, At, B0); PG8_BAR; PG8_SCHED;
            PG8_STAGE(PG8_SB(0, 1), b2 + hstep, voffB);
            PG8_WAIT_V(6); PG8_BAR; PG8_MMA(1, 1, At, B1); PG8_BAR;
            PG8_LDB(B0, 1, 0); PG8_SCHED; PG8_LDA(At, 1, 0); PG8_STAGE(PG8_SA(0, 1), a2 + hstep, voffA);
            PG8_WAIT_L(8); PG8_BAR; PG8_WAIT_L(0); PG8_MMA(0, 0, At, B0); PG8_BAR; PG8_SCHED;
            PG8_LDB(B1, 1, 1); PG8_STAGE(PG8_SB(1, 0), b3, voffB);
            PG8_BAR; PG8_WAIT_L(0); PG8_MMA(0, 1, At, B1); PG8_BAR;
            PG8_LDA(At, 1, 1); PG8_STAGE(PG8_SA(1, 0), a3, voffA);
            PG8_BAR; PG8_WAIT_L(0); PG8_MMA(1, 0, At, B0); PG8_BAR; PG8_SCHED;
            PG8_STAGE(PG8_SB(1, 1), b3 + hstep, voffB);
            PG8_WAIT_V(6); PG8_BAR; PG8_MMA(1, 1, At, B1); PG8_BAR;
            }
        }
        if constexpr (ALIGN_EPI) { if (wr == 0) PG8_BAR; }
        if constexpr (!Epi::AFTER_DRAIN) { E(acc, cur, wr, wc, fr, fq); S.done(cur); }
        if (!has_next) break;
#pragma unroll
        for (int a = 0; a < 2; ++a)
#pragma unroll
            for (int b = 0; b < 2; ++b)
#pragma unroll
                for (int m = 0; m < 4; ++m)
#pragma unroll
                    for (int n = 0; n < 2; ++n) acc[a][b][m][n] = (f32x4){0.f, 0.f, 0.f, 0.f};
        cur = nxt; cA = nA; cB = nB; ++ui;
        if constexpr (ALIGN_EPI) { if (wr == 1) PG8_BAR; }
    }
    PG8_WAIT_V(0);
    if constexpr (!ALIGN_EPI) { if (wr == 0) PG8_BAR; }
    PG8_BAR;
    if constexpr (Epi::AFTER_DRAIN) { E.fused(acc, cur, wr, wc, fr, fq, lds, wid, lane); S.done(cur); }
#undef PG8_SA
#undef PG8_SB
#undef PG8_STAGE
#undef PG8_LDA
#undef PG8_LDB
#undef PG8_MMA
#undef PG8_WAIT_V
#undef PG8_WAIT_L
#undef PG8_BAR
#undef PG8_SCHED
}
}

#ifndef PG8_SP2
#define PG8_SP2 true
#endif
#ifndef PG8_ALIGN
#define PG8_ALIGN true
#endif
#define GAS __attribute__((address_space(1)))
#define LAS __attribute__((address_space(3)))
typedef unsigned short bf16;
typedef unsigned v4u __attribute__((ext_vector_type(4)));
typedef float f32x4 __attribute__((ext_vector_type(4)));
typedef short bf16x8 __attribute__((ext_vector_type(8)));
typedef GAS unsigned gu32;
typedef GAS unsigned long long gu64;
#define RLX_AGENT __ATOMIC_RELAXED, __HIP_MEMORY_SCOPE_AGENT
#define LDS_WAIT() asm volatile("s_waitcnt lgkmcnt(0)" ::: "memory")
#define VM_WAIT() asm volatile("s_waitcnt vmcnt(0)" ::: "memory")
__device__ __forceinline__ unsigned long long rt() { return __builtin_amdgcn_s_memrealtime(); }
__device__ __forceinline__ unsigned f2bf(float f) { unsigned u = __builtin_bit_cast(unsigned, f); return (u + 0x7fffu + ((u >> 16) & 1u)) >> 16; }
__device__ __forceinline__ unsigned pk2(float lo, float hi) { return f2bf(lo) | (f2bf(hi) << 16); }

#define XB_TMO      128
#define XB_XCNT(j)  (256  + 64 * (j))
#define XB_XSUB(j)  (1280 + 64 * (j))
#define XB_XGEN(j)  (2304 + 64 * (j))
#define XB_TOP      3328
#define XB_TOPGEN   3392
#define XCD_BAR_WORDS 3456
#define XB_SPIN_CAP (1u << 18)

__device__ __forceinline__ unsigned xb_ld(unsigned* p)              { return __hip_atomic_load(p, __ATOMIC_RELAXED, __HIP_MEMORY_SCOPE_AGENT); }
__device__ __forceinline__ unsigned xb_add(unsigned* p, unsigned v) { return __hip_atomic_fetch_add(p, v, __ATOMIC_RELAXED, __HIP_MEMORY_SCOPE_AGENT); }
__device__ __forceinline__ unsigned xb_xcc_id() { return (unsigned)__builtin_amdgcn_s_getreg((3 << 11) | 20) & 0xFu; }
#define XB_SPIN(cond, bar) do { unsigned _sp = 0; while (cond) { __builtin_amdgcn_s_sleep(1); \
    if ((++_sp & 255u) == 0u) { if (xb_ld(&(bar)[XB_TMO])) break; if (_sp > XB_SPIN_CAP) { atomicAdd(&(bar)[XB_TMO], 1u); break; } } } } while (0)

struct XcdBarrier {
    unsigned* bar; unsigned x;
    volatile LAS unsigned* st;
};

__device__ __forceinline__ XcdBarrier xcd_barrier_post(unsigned* bar, volatile LAS unsigned* st) {
    XcdBarrier b; b.bar = bar; b.x = xb_xcc_id(); b.st = st;
    if (threadIdx.x == 0) (void)xb_add(&bar[XB_XCNT(b.x)], 1u);
    return b;
}
__device__ __forceinline__ void xcd_barrier_complete(unsigned* bar, unsigned x, unsigned& nloc, unsigned& nx) {
    const unsigned G = gridDim.x * gridDim.y * gridDim.z;
    unsigned sum, cnt, mine, sp = 0u;
    for (;;) {
        sum = 0u; cnt = 0u; mine = 0u;
#pragma unroll
        for (unsigned j = 0; j < 16; ++j) { const unsigned c = xb_ld(&bar[XB_XCNT(j)]); sum += c; cnt += (c > 0u) ? 1u : 0u; mine = (j == x) ? c : mine; }
        if (sum == G) break;
        __builtin_amdgcn_s_sleep(1);
        if ((++sp & 255u) == 0u) { if (xb_ld(&bar[XB_TMO])) break; if (sp > XB_SPIN_CAP) { atomicAdd(&bar[XB_TMO], 1u); break; } }
    }
    nloc = mine > 0u ? mine : 1u; nx = cnt > 0u ? cnt : 1u;
}

__device__ __forceinline__ void xcd_barrier(const XcdBarrier& b) {
    asm volatile("s_waitcnt vmcnt(0)" ::: "memory");
    __syncthreads();
    if (threadIdx.x == 0) {
        unsigned* bar = b.bar;
        __builtin_amdgcn_s_waitcnt(0);
        unsigned nloc = b.st[0], nx = b.st[1];
        if (nloc == 0u) { xcd_barrier_complete(bar, b.x, nloc, nx); b.st[0] = nloc; b.st[1] = nx; }
        const unsigned old = xb_add(&bar[XB_XSUB(b.x)], 1u);
        const unsigned gen = old / nloc;
        if (old + 1u == (gen + 1u) * nloc) {
            __builtin_amdgcn_fence(__ATOMIC_RELEASE, "agent");
            asm volatile("s_waitcnt vmcnt(0)" ::: "memory");
            const unsigned og = xb_add(&bar[XB_TOP], 1u);
            const unsigned tg = og / nx;
            if (og + 1u == (tg + 1u) * nx) xb_add(&bar[XB_TOPGEN], 1u);
            else XB_SPIN(xb_ld(&bar[XB_TOPGEN]) == tg, bar);
            __builtin_amdgcn_fence(__ATOMIC_ACQUIRE, "agent");
            xb_add(&bar[XB_XGEN(b.x)], 1u);
            asm volatile("s_waitcnt vmcnt(0)" ::: "memory");
        } else {
            XB_SPIN(xb_ld(&bar[XB_XGEN(b.x)]) == gen, bar);
            __builtin_amdgcn_fence(__ATOMIC_ACQUIRE, "agent");
            asm volatile("s_waitcnt vmcnt(0)" ::: "memory");
        }
    }
    __syncthreads();
}

constexpr int NWAVES = 8, NTHR = 512;
constexpr int DM = 2048, SEQL = 2048, NB = 4, MP = NB * SEQL  , MS = 128  , MT = MP + MS, MPAD = 8448;
constexpr int NIN = 5400, NINP = 5632, FF = 8192, DEPTH = 2;
constexpr int C_Q = 0, C_K = 512, C_V = 640, C_Z = 768, C_XBC = 1792, C_MQ = 3328, C_MK = 3840, C_MV = 4352, C_MO = 4864, C_DT = 5376, C_MI = 5392, C_MF = 5396;
constexpr int XCW = 1536;
constexpr size_t O_Y = 0, O_PK = 17039360, O_PV = 17170432, O_PCONV = 17301504, O_PSSM = 17338368, O_PC = 18386944, O_PN = 18911232, O_PM = 18915328,
                 O_SK = 18915360, O_SV = 23109664, O_SCONV = 27303968, O_SSSM = 28483616, O_SC = 62038048, O_SN = 78815264, O_SM = 78946336, O_END = 78947360;

constexpr size_t MiB = 1u << 20;
constexpr size_t WS_CTL = 0, CTL_ZERO_BYTES = 1 * MiB;
constexpr size_t WS_SSQA = 1 * MiB, WS_SSQB = 1 * MiB + 512 * 1024;
constexpr size_t WS_WIN = 2 * MiB, WIN_BYTES = 22 * MiB;
constexpr size_t WS_WOUT = 46 * MiB, WOUT_BYTES = 8 * MiB;
constexpr size_t WS_WUP = 62 * MiB, WUP_BYTES = 32 * MiB;
constexpr size_t WS_WDN = 126 * MiB, WDN_BYTES = 32 * MiB;
constexpr size_t WS_XB = 190 * MiB;
constexpr size_t WS_XRES = 223 * MiB;
constexpr size_t WS_HBUF = 289 * MiB;
constexpr size_t WS_PROJ = 289 * MiB;
constexpr size_t WS_MIXED = 380 * MiB;
constexpr size_t WS_XC = 421 * MiB;
constexpr size_t WS_YG = 446 * MiB;
constexpr size_t WS_HR = 479 * MiB;
constexpr size_t WS_END = 496 * MiB;
static_assert(WS_PROJ + (size_t)MPAD * NINP * 2 <= WS_MIXED && WS_MIXED + (size_t)MPAD * DM * 2 <= WS_XC && WS_HBUF + (size_t)MPAD * FF * 2 <= WS_XC, "ws map");
constexpr int CW_BAR = 4096;
constexpr int CW_QUEUE = 16384;

constexpr int RING_OFF = 0, RING_BYTES = 131072;
constexpr int LDSCTL_OFF = RING_BYTES, MISC_OFF = LDSCTL_OFF + 320;
constexpr int LDS_BYTES = 147456;

struct Args { const float* in[26]; float* out; unsigned char* ws; int ph_lo, ph_hi; };
typedef const __attribute__((address_space(4))) unsigned long long* karg_t;
__device__ __forceinline__ unsigned long long karg_u64(int idx) { int j = idx; asm volatile("" : "+s"(j)); return ((karg_t)__builtin_amdgcn_kernarg_segment_ptr())[j]; }
#define ARGIN(i) ((const float*)karg_u64(i))
#define ARGOUT() ((float*)karg_u64(26))
#define ARGWS() ((unsigned char*)karg_u64(27))

struct Frame {
    LAS unsigned char* lds;
    volatile LAS unsigned* MISC;
    gu32* ctl;
    int tid, lane, wave, vcu, G;
};

__device__ __forceinline__ float bf2f(unsigned short u) { return __builtin_bit_cast(float, (unsigned)u << 16); }
__device__ __forceinline__ float bflo(unsigned u) { return __builtin_bit_cast(float, u << 16); }
__device__ __forceinline__ float bfhi(unsigned u) { return __builtin_bit_cast(float, u & 0xffff0000u); }
__device__ __forceinline__ void unpack8(const v4u w, float (&f)[8]) { f[0] = bflo(w.x); f[1] = bfhi(w.x); f[2] = bflo(w.y); f[3] = bfhi(w.y); f[4] = bflo(w.z); f[5] = bfhi(w.z); f[6] = bflo(w.w); f[7] = bfhi(w.w); }
__device__ __forceinline__ v4u pack8(const float (&f)[8]) { v4u w; w.x = pk2(f[0], f[1]); w.y = pk2(f[2], f[3]); w.z = pk2(f[4], f[5]); w.w = pk2(f[6], f[7]); return w; }
__device__ __forceinline__ float wave_sum(float v) {
#pragma unroll
    for (int o = 1; o < 64; o <<= 1) v += __shfl_xor(v, o);
    return v;
}
__device__ __forceinline__ float wave_max(float v) {
#pragma unroll
    for (int o = 1; o < 64; o <<= 1) v = fmaxf(v, __shfl_xor(v, o));
    return v;
}
__device__ __forceinline__ float sigmoidf_(float x) { return 1.0f / (1.0f + expf(-x)); }
__device__ __forceinline__ float siluf_(float x) { return x / (1.0f + expf(-x)); }
__device__ __forceinline__ float softplusf_(float x) { return fmaxf(x, 0.f) + log1pf(expf(-fabsf(x))); }
__device__ __forceinline__ float logsigmoidf_(float x) { return fminf(x, 0.f) - log1pf(expf(-fabsf(x))); }
#define ROPE_INV(i) ((i) == 0 ? 1.0f : (i) == 1 ? 0.1939227432012558f : (i) == 2 ? 0.03760603070259094f : (i) == 3 ? 0.007292664609849453f : (i) == 4 ? 0.0014142135623842478f : (i) == 5 ? 0.00027424818836152554f : (i) == 6 ? 5.318296098266728e-05f : 1.0313386155758053e-05f)
__device__ __forceinline__ void rope_cs(int pos, float (&c)[8], float (&s)[8]) {
#pragma unroll
    for (int i = 0; i < 8; ++i) { const float ang = (float)pos * ROPE_INV(i); double rev = (double)ang * 0.15915494309189535; rev -= __builtin_rint(rev); const float fr = (float)rev;
        c[i] = __builtin_amdgcn_cosf(fr); s[i] = __builtin_amdgcn_sinf(fr); }
}

template <int MODE> __device__ __forceinline__ int colmap(int n) {
    if (MODE == 0) return n;
    if (n < 3328) return n; if (n < 5376) return n + 16; if (n < 5392) return n - 2048; if (n < 5400) return n; return -1;
}
template <int MODE> __device__ __forceinline__ void p0_transpose_item(const float* W, int K, int Norig, int Nrows, const float* gain, bf16* WT, LAS float* scr, int item, int lane) {
    const int nblk = Nrows / 32, kb = item / nblk, nb = item % nblk, k0 = 64 * kb, n0 = 32 * nb;
    const int oc = colmap<MODE>(n0 + (lane & 31));
#pragma unroll 8
    for (int i = 0; i < 32; ++i) { const int kk = 2 * i + (lane >> 5); float v = 0.f; if (oc >= 0) { v = W[(size_t)(k0 + kk) * Norig + oc]; if (gain) v *= gain[k0 + kk]; } scr[kk * 33 + (lane & 31)] = v; }
    LDS_WAIT(); asm volatile("" ::: "memory");
    const int c = lane & 7;
#pragma unroll
    for (int j = 0; j < 4; ++j) { const int n = (lane >> 3) + 8 * j; const LAS float* s = scr + (8 * c) * 33 + n;
        v4u o; o.x = pk2(s[0 * 33], s[1 * 33]); o.y = pk2(s[2 * 33], s[3 * 33]); o.z = pk2(s[4 * 33], s[5 * 33]); o.w = pk2(s[6 * 33], s[7 * 33]);
        *(GAS v4u*)(WT + (size_t)(n0 + n) * K + k0 + 8 * c) = o; }
    LDS_WAIT(); asm volatile("" ::: "memory");
}
__device__ __forceinline__ void x_row_to_bf16(int lane, const float* xrow, bf16* orow, float* ssqrow) {
    const GAS f32x4* xr = (const GAS f32x4*)xrow + lane;
    f32x4 v[8]; float s = 0.f;
#pragma unroll
    for (int j = 0; j < 8; ++j) { v[j] = xr[64 * j]; s += (v[j].x * v[j].x + v[j].y * v[j].y) + (v[j].z * v[j].z + v[j].w * v[j].w); }
    s = wave_sum(s);
    GAS unsigned long long* o8 = (GAS unsigned long long*)orow + lane;
#pragma unroll
    for (int j = 0; j < 8; ++j) o8[64 * j] = (unsigned long long)pk2(v[j].x, v[j].y) | ((unsigned long long)pk2(v[j].z, v[j].w) << 32);
    if (lane < 8) ssqrow[lane] = lane == 0 ? s : 0.f;
}
__device__ __forceinline__ void p0_prologue(Frame& F, const Args& a) {
    LAS float* scr = (LAS float*)(F.lds + RING_OFF + F.wave * 16384);
    const int gw = F.vcu * NWAVES + F.wave, NGW = F.G * NWAVES;
    constexpr int I_IN = (DM / 64) * (NINP / 32), I_OUT = (DM / 64) * (DM / 32), I_UP = (DM / 64) * (FF / 32), I_DN = (FF / 64) * (DM / 32);
    constexpr int PER_L = I_IN + I_OUT + I_UP + I_DN;
    unsigned char* ws = ARGWS();
    for (int it = gw; it < DEPTH * PER_L; it += NGW) {
        const int l = it / PER_L; int r = it % PER_L;
        if (r < I_IN) { p0_transpose_item<1>(ARGIN(10) + (size_t)l * DM * NIN, DM, NIN, NINP, ARGIN(9) + l * DM, (bf16*)(ws + WS_WIN + l * WIN_BYTES), scr, r, F.lane); continue; } r -= I_IN;
        if (r < I_OUT) { p0_transpose_item<0>(ARGIN(21) + (size_t)l * DM * DM, DM, DM, DM, nullptr, (bf16*)(ws + WS_WOUT + l * WOUT_BYTES), scr, r, F.lane); continue; } r -= I_OUT;
        if (r < I_UP) { p0_transpose_item<0>(ARGIN(23) + (size_t)l * DM * FF, DM, FF, FF, ARGIN(22) + l * DM, (bf16*)(ws + WS_WUP + l * WUP_BYTES), scr, r, F.lane); continue; } r -= I_UP;
        p0_transpose_item<0>(ARGIN(24) + (size_t)l * FF * DM, FF, DM, DM, nullptr, (bf16*)(ws + WS_WDN + l * WDN_BYTES), scr, r, F.lane);
    }
    bf16* XB = (bf16*)(ws + WS_XB); float* SSQA = (float*)(ws + WS_SSQA);
    for (int m = gw; m < MPAD; m += NGW) {
        if (m < MT) x_row_to_bf16(F.lane, m < MP ? ARGIN(0) + (size_t)m * DM : ARGIN(1) + (size_t)(m - MP) * DM, XB + (size_t)m * DM, SSQA + (size_t)m * 8);
        else { GAS v4u* o = (GAS v4u*)(XB + (size_t)m * DM) + F.lane;
#pragma unroll
            for (int j = 0; j < 4; ++j) o[64 * j] = (v4u){0u, 0u, 0u, 0u};
            if (F.lane < 8) SSQA[(size_t)m * 8 + F.lane] = 1.0f; }
    }
}

template <class EP> __device__ __forceinline__ void thin_gemm(Frame& F, const bf16* A, int lda, const bf16* Bt, int N, int K, const EP& epi) {
    const int fr = F.lane & 15, fq = F.lane >> 4;
    for (int item = F.vcu; item < N / 16; item += F.G) {
        const int n0 = item * 16;
        const GAS bf16x8* ap = (const GAS bf16x8*)(A + (size_t)(16 * F.wave + fr) * lda + 8 * fq);
        const GAS bf16x8* bp = (const GAS bf16x8*)(Bt + (size_t)(n0 + fr) * K + 8 * fq);
        f32x4 acc0 = (f32x4){0.f, 0.f, 0.f, 0.f}, acc1 = acc0;
        for (int k = 0; k < K / 8; k += 32) {
            bf16x8 a[8], b[8];
#pragma unroll
            for (int u = 0; u < 8; ++u) { a[u] = ap[k + 4 * u]; b[u] = bp[k + 4 * u]; }
#pragma unroll
            for (int u = 0; u < 8; u += 2) { acc0 = __builtin_amdgcn_mfma_f32_16x16x32_bf16(b[u], a[u], acc0, 0, 0, 0); acc1 = __builtin_amdgcn_mfma_f32_16x16x32_bf16(b[u + 1], a[u + 1], acc1, 0, 0, 0); }
        }
        epi(16 * F.wave + fr, n0 + 4 * fq, acc0 + acc1);
    }
}

#define MFMA16(yf, xf, acc) __builtin_amdgcn_mfma_f32_16x16x32_bf16(yf, xf, acc, 0, 0, 0)
constexpr int TP = 136, TPB = TP * 2;
__device__ __forceinline__ bf16x8 lds_frag(const LAS unsigned char* base, int row, int k0, int lane) { return *(const LAS bf16x8*)(base + (row + (lane & 15)) * TPB + (k0 + 8 * (lane >> 4)) * 2); }
__device__ __forceinline__ float wave_incl_scan_add(float v, int lane) {
#pragma unroll
    for (int o = 1; o < 64; o <<= 1) { const float u = __shfl_up(v, o); if (lane >= o) v += u; }
    return v;
}
__device__ __forceinline__ float wave_incl_scan_max(float v, int lane) {
#pragma unroll
    for (int o = 1; o < 64; o <<= 1) { const float u = __shfl_up(v, o); if (lane >= o) v = fmaxf(v, u); }
    return v;
}
constexpr size_t WS_DCT = 190 * MiB;
constexpr size_t WS_CPT = 206 * MiB;
constexpr size_t WS_DN = 214 * MiB, WS_NP = WS_DN + 131072, WS_SC = WS_NP + 131072, WS_MPV = WS_SC + 4096;
static_assert(WS_MPV + 4096 <= WS_XRES, "mlstm workspace inside the XB region");

__device__ __forceinline__ void mlstm_gates(Frame& F, const bf16* PROJ, int row0, int l, int h, LAS float* tab, float& bcum, float& a) {
    const int tid = F.tid, lane = F.lane;
    float v = 0.f, ig = 0.f;
    if (tid < 128) { ig = bf2f(PROJ[(size_t)(row0 + tid) * NINP + C_MI + h]) + ARGIN(18)[l * 4 + h];
        v = logsigmoidf_(bf2f(PROJ[(size_t)(row0 + tid) * NINP + C_MF + h]) + ARGIN(19)[l * 4 + h]);
        v = wave_incl_scan_add(v, lane);
        if (tid == 63) tab[0] = v; }
    __syncthreads();
    if (tid >= 64 && tid < 128) v += tab[0];
    bcum = v; a = ig - v;
}

__device__ __forceinline__ void mlstm_a_item(Frame& F, int l, int b, int h, int c) {
    const bf16* PROJ = (const bf16*)(ARGWS() + WS_PROJ);
    const int tid = F.tid, lane = F.lane, w = F.wave, row0 = b * SEQL + c * 128, item = (b * 4 + h) * 16 + c;
    LAS unsigned char* KT = F.lds; LAS unsigned char* VT = F.lds + 128 * TPB;
    LAS float* tab = (LAS float*)(F.lds + 2 * 128 * TPB); LAS float* wk = tab + 16;
    __syncthreads();
    float bcum, a; mlstm_gates(F, PROJ, row0, l, h, tab, bcum, a);
    if (tid < 128) { const float mx = wave_max(a); if (lane == 0) tab[1 + w] = mx; if (tid == 127) tab[3] = bcum; }
    __syncthreads();
    const float pmax = fmaxf(tab[1], tab[2]);
    if (tid < 128) wk[tid] = expf(a - pmax) * 0.08838834764831845f;
    __syncthreads();
#pragma unroll
    for (int rep = 0; rep < 4; ++rep) { const int task = tid + rep * NTHR, t = task & 127, ch = task >> 7;
        float f[8]; const float wt = wk[t];
        unpack8(*(const GAS v4u*)(PROJ + (size_t)(row0 + t) * NINP + C_MK + h * 128 + ch * 8), f);
#pragma unroll
        for (int i = 0; i < 8; ++i) *(LAS unsigned short*)(KT + (ch * 8 + i) * TPB + t * 2) = (unsigned short)f2bf(f[i] * wt);
        const v4u vv = *(const GAS v4u*)(PROJ + (size_t)(row0 + t) * NINP + C_MV + h * 128 + ch * 8);
        *(LAS unsigned short*)(VT + (ch * 8 + 0) * TPB + t * 2) = (unsigned short)(vv.x & 0xffffu); *(LAS unsigned short*)(VT + (ch * 8 + 1) * TPB + t * 2) = (unsigned short)(vv.x >> 16);
        *(LAS unsigned short*)(VT + (ch * 8 + 2) * TPB + t * 2) = (unsigned short)(vv.y & 0xffffu); *(LAS unsigned short*)(VT + (ch * 8 + 3) * TPB + t * 2) = (unsigned short)(vv.y >> 16);
        *(LAS unsigned short*)(VT + (ch * 8 + 4) * TPB + t * 2) = (unsigned short)(vv.z & 0xffffu); *(LAS unsigned short*)(VT + (ch * 8 + 5) * TPB + t * 2) = (unsigned short)(vv.z >> 16);
        *(LAS unsigned short*)(VT + (ch * 8 + 6) * TPB + t * 2) = (unsigned short)(vv.w & 0xffffu); *(LAS unsigned short*)(VT + (ch * 8 + 7) * TPB + t * 2) = (unsigned short)(vv.w >> 16); }
    __syncthreads();
    bf16x8 xf[4];
#pragma unroll
    for (int s = 0; s < 4; ++s) xf[s] = lds_frag(VT, 16 * w, 32 * s, lane);
    float* dct = (float*)(ARGWS() + WS_DCT) + (size_t)item * 16384;
#pragma unroll
    for (int t = 0; t < 8; ++t) { f32x4 acc = (f32x4){0.f, 0.f, 0.f, 0.f};
#pragma unroll
        for (int s = 0; s < 4; ++s) acc = MFMA16(lds_frag(KT, 16 * t, 32 * s, lane), xf[s], acc);
        *(GAS f32x4*)(dct + (size_t)(16 * w + (lane & 15)) * 128 + 16 * t + 4 * (lane >> 4)) = acc; }
    if (tid < 128) { float s = 0.f;
#pragma unroll
        for (int j = 0; j < 16; ++j) { float f[8]; unpack8(*(const LAS v4u*)(KT + tid * TPB + j * 16), f); s += ((f[0] + f[1]) + (f[2] + f[3])) + ((f[4] + f[5]) + (f[6] + f[7])); }
        ((float*)(ARGWS() + WS_DN))[(size_t)item * 128 + tid] = s; }
    if (tid == 0) { float* sc = (float*)(ARGWS() + WS_SC) + item * 2; sc[0] = tab[3]; sc[1] = pmax; }
}

__device__ __forceinline__ void mlstm_scan_phase(Frame& F, int l) {
    const int tid = F.tid;
    LAS float* coef = (LAS float*)(F.lds); LAS float* gend = coef + 16;
    for (int it = F.vcu; it < 128; it += F.G) {
        const int bh = it >> 3, b = bh >> 2, h = bh & 3, part = it & 7;
        __syncthreads();
        if (tid == 0) { const float* sc = (const float*)(ARGWS() + WS_SC) + bh * 32; float* mp = (float*)(ARGWS() + WS_MPV) + bh * 16; float m = 0.f;
            for (int c = 0; c < 16; ++c) { const float bl = sc[2 * c], pm = sc[2 * c + 1], M = fmaxf(m, pm); coef[c] = expf(pm - M); gend[c] = expf(m - M); if (part == 0) mp[c] = m; m = bl + M; }
            if (part == 0) ARGOUT()[O_PM + (size_t)(l * NB + b) * 4 + h] = m; }
        __syncthreads();
        const int elem = part * 512 + tid, e = elem >> 5, d4 = (elem & 31) * 4;
        const float* dct = (const float*)(ARGWS() + WS_DCT) + (size_t)bh * 16 * 16384 + (size_t)e * 128 + d4;
        bf16* cpt = (bf16*)(ARGWS() + WS_CPT) + (size_t)bh * 16 * 16384 + (size_t)e * 128 + d4;
        f32x4 dc[16];
#pragma unroll
        for (int c = 0; c < 16; ++c) dc[c] = *(const GAS f32x4*)(dct + (size_t)c * 16384);
        f32x4 C = (f32x4){0.f, 0.f, 0.f, 0.f};
#pragma unroll
        for (int c = 0; c < 16; ++c) { *(GAS unsigned long long*)(cpt + (size_t)c * 16384) = (unsigned long long)pk2(C.x, C.y) | ((unsigned long long)pk2(C.z, C.w) << 32);
            C = C * gend[c] + dc[c] * coef[c]; }
        float* pc = ARGOUT() + O_PC + ((size_t)(l * NB + b) * 4 + h) * 16384;
        pc[(size_t)(d4 + 0) * 128 + e] = C.x; pc[(size_t)(d4 + 1) * 128 + e] = C.y; pc[(size_t)(d4 + 2) * 128 + e] = C.z; pc[(size_t)(d4 + 3) * 128 + e] = C.w;
        if (part == 0 && tid < 128) { const float* dn = (const float*)(ARGWS() + WS_DN) + (size_t)bh * 16 * 128 + tid; float* np = (float*)(ARGWS() + WS_NP) + (size_t)bh * 16 * 128 + tid; float n = 0.f;
#pragma unroll
            for (int c = 0; c < 16; ++c) { np[c * 128] = n; n = n * gend[c] + dn[c * 128] * coef[c]; }
            ARGOUT()[O_PN + ((size_t)(l * NB + b) * 4 + h) * 128 + tid] = n; }
    }
}

__device__ __forceinline__ void mlstm_c_item(Frame& F, int l, int b, int h, int c) {
    const bf16* PROJ = (const bf16*)(ARGWS() + WS_PROJ); bf16* MIXED = (bf16*)(ARGWS() + WS_MIXED);
    const int tid = F.tid, lane = F.lane, w = F.wave, row0 = b * SEQL + c * 128, item = (b * 4 + h) * 16 + c, lc = lane & 15, lg = lane >> 4;
    LAS unsigned char* Kn = F.lds; LAS unsigned char* VT = F.lds + 128 * TPB; LAS unsigned char* CP = F.lds + 2 * 128 * TPB;
    LAS float* tab = (LAS float*)(F.lds + 3 * 128 * TPB); LAS float* Ak = tab + 16; LAS float* Mq = Ak + 128; LAS float* Emt = Mq + 128; LAS float* Np = Emt + 128;
    __syncthreads();
    float bcum, a; mlstm_gates(F, PROJ, row0, l, h, tab, bcum, a);
    const float mprev = ((const float*)(ARGWS() + WS_MPV))[item];
    float pm = -INFINITY;
    if (tid < 128) { pm = wave_incl_scan_max(a, lane); if (tid == 63) tab[1] = pm; }
    __syncthreads();
    if (tid < 128) { if (tid >= 64) pm = fmaxf(pm, tab[1]); const float M = fmaxf(mprev, pm); Ak[tid] = a; Mq[tid] = M; Emt[tid] = expf(-(bcum + M)); Np[tid] = ((const float*)(ARGWS() + WS_NP))[(size_t)item * 128 + tid]; }
#pragma unroll
    for (int rep = 0; rep < 4; ++rep) { const int task = tid + rep * NTHR;
        { const int ch = task & 15, t = task >> 4; *(LAS v4u*)(Kn + t * TPB + ch * 16) = *(const GAS v4u*)(PROJ + (size_t)(row0 + t) * NINP + C_MK + h * 128 + ch * 8);
          *(LAS v4u*)(CP + t * TPB + ch * 16) = *(const GAS v4u*)((const bf16*)(ARGWS() + WS_CPT) + (size_t)item * 16384 + (size_t)t * 128 + ch * 8); }
        { const int t = task & 127, ch = task >> 7; const v4u vv = *(const GAS v4u*)(PROJ + (size_t)(row0 + t) * NINP + C_MV + h * 128 + ch * 8);
          *(LAS unsigned short*)(VT + (ch * 8 + 0) * TPB + t * 2) = (unsigned short)(vv.x & 0xffffu); *(LAS unsigned short*)(VT + (ch * 8 + 1) * TPB + t * 2) = (unsigned short)(vv.x >> 16);
          *(LAS unsigned short*)(VT + (ch * 8 + 2) * TPB + t * 2) = (unsigned short)(vv.y & 0xffffu); *(LAS unsigned short*)(VT + (ch * 8 + 3) * TPB + t * 2) = (unsigned short)(vv.y >> 16);
          *(LAS unsigned short*)(VT + (ch * 8 + 4) * TPB + t * 2) = (unsigned short)(vv.z & 0xffffu); *(LAS unsigned short*)(VT + (ch * 8 + 5) * TPB + t * 2) = (unsigned short)(vv.z >> 16);
          *(LAS unsigned short*)(VT + (ch * 8 + 6) * TPB + t * 2) = (unsigned short)(vv.w & 0xffffu); *(LAS unsigned short*)(VT + (ch * 8 + 7) * TPB + t * 2) = (unsigned short)(vv.w >> 16); } }
    bf16x8 qf[4];
#pragma unroll
    for (int s = 0; s < 4; ++s) qf[s] = *(const GAS bf16x8*)(PROJ + (size_t)(row0 + 16 * w + lc) * NINP + C_MQ + h * 128 + 32 * s + 8 * lg);
    __syncthreads();
    float qn = 0.f;
#pragma unroll
    for (int s = 0; s < 4; ++s) { float f[8]; unpack8(__builtin_bit_cast(v4u, qf[s]), f);
#pragma unroll
        for (int i = 0; i < 8; ++i) qn += f[i] * Np[32 * s + 8 * lg + i]; }
    qn += __shfl_xor(qn, 16); qn += __shfl_xor(qn, 32);
    f32x4 sacc[8];
#pragma unroll
    for (int t = 0; t < 8; ++t) { sacc[t] = (f32x4){0.f, 0.f, 0.f, 0.f};
        if (t <= w) {
#pragma unroll
            for (int s = 0; s < 4; ++s) sacc[t] = MFMA16(lds_frag(Kn, 16 * t, 32 * s, lane), qf[s], sacc[t]); } }
    __syncthreads();
    LAS unsigned char* Pw = Kn + w * 16 * TPB;
    const int q = 16 * w + lc; const float Mrow = Mq[q], gq = expf(mprev - Mrow);
    float rsum = 0.f;
#pragma unroll
    for (int t = 0; t < 8; ++t) { if (t <= (w | 1)) { float p[4];
#pragma unroll
            for (int i = 0; i < 4; ++i) { const int k = 16 * t + 4 * lg + i; p[i] = (k <= q) ? expf(Ak[k] - Mrow) * 0.08838834764831845f * sacc[t][i] : 0.f; rsum += p[i]; }
            *(LAS unsigned long long*)(Pw + lc * TPB + (16 * t + 4 * lg) * 2) = (unsigned long long)pk2(p[0], p[1]) | ((unsigned long long)pk2(p[2], p[3]) << 32); } }
    rsum += __shfl_xor(rsum, 16); rsum += __shfl_xor(rsum, 32);
    asm volatile("s_waitcnt lgkmcnt(0)" ::: "memory");
    f32x4 acc[8];
#pragma unroll
    for (int t = 0; t < 8; ++t) { acc[t] = (f32x4){0.f, 0.f, 0.f, 0.f};
#pragma unroll
        for (int s = 0; s < 4; ++s) acc[t] = MFMA16(lds_frag(CP, 16 * t, 32 * s, lane), qf[s], acc[t]);
        acc[t] = acc[t] * gq; }
#pragma unroll
    for (int s = 0; s < 4; ++s) { if (s <= (w >> 1)) { const bf16x8 pf = lds_frag(Pw, 0, 32 * s, lane);
#pragma unroll
            for (int t = 0; t < 8; ++t) acc[t] = MFMA16(lds_frag(VT, 16 * t, 32 * s, lane), pf, acc[t]); } }
    const float den = rsum + gq * qn, dinv = 1.0f / fmaxf(fabsf(den), Emt[q]);
    float ss = 0.f;
#pragma unroll
    for (int t = 0; t < 8; ++t) { acc[t] = acc[t] * dinv; ss += (acc[t][0] * acc[t][0] + acc[t][1] * acc[t][1]) + (acc[t][2] * acc[t][2] + acc[t][3] * acc[t][3]); }
    ss += __shfl_xor(ss, 16); ss += __shfl_xor(ss, 32);
    const float rs = 1.0f / sqrtf(ss * (1.0f / 128.0f) + 1e-6f);
    const float* wml = ARGIN(20) + (size_t)l * 512 + h * 128;
#pragma unroll
    for (int t = 0; t < 8; ++t) { const int e0 = 16 * t + 4 * lg; const f32x4 g4 = *(const GAS f32x4*)(wml + e0);
        const unsigned long long mo = *(const GAS unsigned long long*)(PROJ + (size_t)(row0 + q) * NINP + C_MO + h * 128 + e0);
        const float o0 = acc[t][0] * rs * g4.x * sigmoidf_(bflo((unsigned)mo)), o1 = acc[t][1] * rs * g4.y * sigmoidf_(bfhi((unsigned)mo)),
                    o2 = acc[t][2] * rs * g4.z * sigmoidf_(bflo((unsigned)(mo >> 32))), o3 = acc[t][3] * rs * g4.w * sigmoidf_(bfhi((unsigned)(mo >> 32)));
        *(GAS unsigned long long*)(MIXED + (size_t)(row0 + q) * DM + 1536 + h * 128 + e0) = (unsigned long long)pk2(o0, o1) | ((unsigned long long)pk2(o2, o3) << 32); }
}

constexpr size_t WS_DS = 496 * MiB;
constexpr size_t WS_SP = 528 * MiB;
constexpr size_t WS_AL = 544 * MiB;
constexpr size_t WS_END2 = 545 * MiB;

__device__ __forceinline__ void conv8(const bf16* PROJ, const float* cw, const float* cb, size_t grow, int pos, int ch0, float (&y)[8]) {
    const f32x4 b0 = *(const GAS f32x4*)(cb + ch0), b1 = *(const GAS f32x4*)(cb + ch0 + 4);
    y[0] = b0.x; y[1] = b0.y; y[2] = b0.z; y[3] = b0.w; y[4] = b1.x; y[5] = b1.y; y[6] = b1.z; y[7] = b1.w;
#pragma unroll
    for (int j = 0; j < 4; ++j) { if (pos - 3 + j >= 0) { float r[8]; unpack8(*(const GAS v4u*)(PROJ + (grow - 3 + j) * NINP + C_XBC + ch0), r);
            const f32x4 w0 = *(const GAS f32x4*)(cw + j * XCW + ch0), w1 = *(const GAS f32x4*)(cw + j * XCW + ch0 + 4);
            y[0] += w0.x * r[0]; y[1] += w0.y * r[1]; y[2] += w0.z * r[2]; y[3] += w0.w * r[3]; y[4] += w1.x * r[4]; y[5] += w1.y * r[5]; y[6] += w1.z * r[6]; y[7] += w1.w * r[7]; } }
#pragma unroll
    for (int i = 0; i < 8; ++i) y[i] = siluf_(y[i]);
}

__device__ __forceinline__ void ssd_a_item(Frame& F, int l, int b, int g, int c, int half) {
    const bf16* PROJ = (const bf16*)(ARGWS() + WS_PROJ);
    const float* cw = ARGIN(12) + (size_t)l * 4 * XCW; const float* cb = ARGIN(13) + (size_t)l * XCW;
    const int tid = F.tid, lane = F.lane, w = F.wave, row0 = b * SEQL + c * 128, h0 = g * 8 + half * 4;
    LAS unsigned char* XT = F.lds; LAS unsigned char* BT = F.lds + 256 * TPB;
    LAS float* tab = (LAS float*)(F.lds + 384 * TPB); LAS float* wt = tab + 16;
    __syncthreads();
    { const int r = tid >> 7, t = tid & 127, h = h0 + r;
      const float dt = softplusf_(bf2f(PROJ[(size_t)(row0 + t) * NINP + C_DT + h]) + ARGIN(14)[l * 16 + h]), A = -expf(ARGIN(15)[l * 16 + h]);
      float v = wave_incl_scan_add(dt * A, lane);
      if (lane == 63 && (w & 1) == 0) tab[r] = v;
      __syncthreads();
      if (w & 1) v += tab[r];
      if (t == 127) tab[4 + r] = v;
      __syncthreads();
      const float al = tab[4 + r];
      wt[r * 128 + t] = expf(al - v) * dt;
      if (t == 127) ((float*)(ARGWS() + WS_AL))[((b * 16 + h) * 16) + c] = al; }
    __syncthreads();
#pragma unroll 2
    for (int rep = 0; rep < 12; ++rep) { const int task = tid + rep * NTHR, t = task & 127, cj = task >> 7;
        const int ch0 = cj < 32 ? h0 * 64 + cj * 8 : 1024 + g * 128 + (cj - 32) * 8;
        float y[8]; conv8(PROJ, cw, cb, (size_t)(row0 + t), c * 128 + t, ch0, y);
        if (cj < 32) { const float wv = wt[(cj >> 3) * 128 + t];
#pragma unroll
            for (int i = 0; i < 8; ++i) *(LAS unsigned short*)(XT + (cj * 8 + i) * TPB + t * 2) = (unsigned short)f2bf(y[i] * wv); }
        else {
#pragma unroll
            for (int i = 0; i < 8; ++i) *(LAS unsigned short*)(BT + ((cj - 32) * 8 + i) * TPB + t * 2) = (unsigned short)f2bf(y[i]); } }
    __syncthreads();
    const int r = w >> 1, h = h0 + r;
    float* ds = (float*)(ARGWS() + WS_DS) + (size_t)((b * 16 + h) * 16 + c) * 8192;
#pragma unroll
    for (int ps = 0; ps < 2; ++ps) { const int prow = 2 * (w & 1) + ps;
        bf16x8 xf[4];
#pragma unroll
        for (int s = 0; s < 4; ++s) xf[s] = lds_frag(XT, r * 64 + 16 * prow, 32 * s, lane);
#pragma unroll
        for (int t = 0; t < 8; ++t) { f32x4 acc = (f32x4){0.f, 0.f, 0.f, 0.f};
#pragma unroll
            for (int s = 0; s < 4; ++s) acc = MFMA16(lds_frag(BT, 16 * t, 32 * s, lane), xf[s], acc);
            *(GAS f32x4*)(ds + (size_t)(16 * prow + (lane & 15)) * 128 + 16 * t + 4 * (lane >> 4)) = acc; } }
}

__device__ __forceinline__ void ssd_scan_phase(Frame& F, int l) {
    for (int idx = F.vcu * NTHR + F.tid; idx < 64 * 2048; idx += F.G * NTHR) {
        const int bh = idx >> 11, e4 = (idx & 2047) * 4;
        const float* al = (const float*)(ARGWS() + WS_AL) + bh * 16;
        const float* ds = (const float*)(ARGWS() + WS_DS) + (size_t)bh * 16 * 8192 + e4;
        bf16* sp = (bf16*)(ARGWS() + WS_SP) + (size_t)bh * 16 * 8192 + e4;
        f32x4 d[16]; float dec[16];
#pragma unroll
        for (int c = 0; c < 16; ++c) { d[c] = *(const GAS f32x4*)(ds + (size_t)c * 8192); dec[c] = al[c]; }
        f32x4 S = (f32x4){0.f, 0.f, 0.f, 0.f};
#pragma unroll
        for (int c = 0; c < 16; ++c) { *(GAS unsigned long long*)(sp + (size_t)c * 8192) = (unsigned long long)pk2(S.x, S.y) | ((unsigned long long)pk2(S.z, S.w) << 32);
            S = S * expf(dec[c]) + d[c]; }
        *(GAS f32x4*)(ARGOUT() + O_PSSM + ((size_t)l * 64 + bh) * 8192 + e4) = S;
    }
}

__device__ __forceinline__ void ssd_c_item(Frame& F, int l, int b, int g, int c) {
    const bf16* PROJ = (const bf16*)(ARGWS() + WS_PROJ); bf16* MIXED = (bf16*)(ARGWS() + WS_MIXED); float* YG = (float*)(ARGWS() + WS_YG);
    const float* cw = ARGIN(12) + (size_t)l * 4 * XCW; const float* cb = ARGIN(13) + (size_t)l * XCW;
    const int tid = F.tid, lane = F.lane, w = F.wave, row0 = b * SEQL + c * 128, lc = lane & 15, lg = lane >> 4, q = 16 * w + lc;
    LAS unsigned char* Bn = F.lds; LAS unsigned char* XT = F.lds + 128 * TPB; LAS unsigned char* SP = F.lds + 256 * TPB;
    LAS float* tab = (LAS float*)(F.lds + 384 * TPB); LAS float* At = tab + 16; LAS float* Dt = At + 1024;
    __syncthreads();
    { float v[2], dtv[2];
#pragma unroll
      for (int rep = 0; rep < 2; ++rep) { const int r = (tid >> 7) + 4 * rep, t = tid & 127, h = g * 8 + r;
          dtv[rep] = softplusf_(bf2f(PROJ[(size_t)(row0 + t) * NINP + C_DT + h]) + ARGIN(14)[l * 16 + h]);
          v[rep] = wave_incl_scan_add(dtv[rep] * -expf(ARGIN(15)[l * 16 + h]), lane);
          if (lane == 63 && (w & 1) == 0) tab[r] = v[rep]; }
      __syncthreads();
#pragma unroll
      for (int rep = 0; rep < 2; ++rep) { const int r = (tid >> 7) + 4 * rep, t = tid & 127; if (w & 1) v[rep] += tab[r]; At[r * 128 + t] = v[rep]; Dt[r * 128 + t] = dtv[rep]; } }
    bf16x8 cf[4];
#pragma unroll
    for (int s = 0; s < 4; ++s) { float y[8]; conv8(PROJ, cw, cb, (size_t)(row0 + q), c * 128 + q, 1280 + g * 128 + 32 * s + 8 * lg, y); cf[s] = __builtin_bit_cast(bf16x8, pack8(y)); }
#pragma unroll
    for (int rep = 0; rep < 4; ++rep) { const int task = tid + rep * NTHR, ch = task & 15, t = task >> 4;
        float y[8]; conv8(PROJ, cw, cb, (size_t)(row0 + t), c * 128 + t, 1024 + g * 128 + ch * 8, y); *(LAS v4u*)(Bn + t * TPB + ch * 16) = pack8(y); }
    __syncthreads();
    f32x4 cbm[8];
#pragma unroll
    for (int t = 0; t < 8; ++t) { cbm[t] = (f32x4){0.f, 0.f, 0.f, 0.f};
        if (t <= w) {
#pragma unroll
            for (int s = 0; s < 4; ++s) cbm[t] = MFMA16(lds_frag(Bn, 16 * t, 32 * s, lane), cf[s], cbm[t]); } }
    LAS unsigned char* Pw = Bn + w * 16 * TPB;
    float ssq = 0.f;
    for (int hp = 0; hp < 4; ++hp) {
        __syncthreads();
#pragma unroll
        for (int rep = 0; rep < 4; ++rep) { const int task = tid + rep * NTHR;
            { const int t = task & 127, cj = task >> 7;
              float y[8]; conv8(PROJ, cw, cb, (size_t)(row0 + t), c * 128 + t, (g * 8 + 2 * hp) * 64 + cj * 8, y);
#pragma unroll
              for (int i = 0; i < 8; ++i) *(LAS unsigned short*)(XT + (cj * 8 + i) * TPB + t * 2) = (unsigned short)f2bf(y[i]); }
            { const int ch = task & 15, pr = task >> 4;
              const int h = g * 8 + 2 * hp + (pr >> 6);
              *(LAS v4u*)(SP + pr * TPB + ch * 16) = *(const GAS v4u*)((const bf16*)(ARGWS() + WS_SP) + (size_t)((b * 16 + h) * 16 + c) * 8192 + (size_t)(pr & 63) * 128 + ch * 8); } }
        __syncthreads();
#pragma unroll
        for (int rr = 0; rr < 2; ++rr) { const int r = 2 * hp + rr, h = g * 8 + r; const float Dh = ARGIN(16)[l * 16 + h], aq = At[r * 128 + q];
#pragma unroll
            for (int t = 0; t < 8; ++t) { if (t <= (w | 1)) { float p[4];
#pragma unroll
                    for (int i = 0; i < 4; ++i) { const int k = 16 * t + 4 * lg + i; p[i] = (k <= q) ? cbm[t][i] * expf(aq - At[r * 128 + k]) * Dt[r * 128 + k] : 0.f; if (k == q) p[i] += Dh; }
                    *(LAS unsigned long long*)(Pw + lc * TPB + (16 * t + 4 * lg) * 2) = (unsigned long long)pk2(p[0], p[1]) | ((unsigned long long)pk2(p[2], p[3]) << 32); } }
            asm volatile("s_waitcnt lgkmcnt(0)" ::: "memory");
            f32x4 acc[4]; const float eq = expf(aq);
#pragma unroll
            for (int pt = 0; pt < 4; ++pt) { acc[pt] = (f32x4){0.f, 0.f, 0.f, 0.f};
#pragma unroll
                for (int s = 0; s < 4; ++s) acc[pt] = MFMA16(lds_frag(SP, rr * 64 + 16 * pt, 32 * s, lane), cf[s], acc[pt]);
                acc[pt] = acc[pt] * eq; }
#pragma unroll
            for (int s = 0; s < 4; ++s) { if (s <= (w >> 1)) { const bf16x8 pf = lds_frag(Pw, 0, 32 * s, lane);
#pragma unroll
                    for (int pt = 0; pt < 4; ++pt) acc[pt] = MFMA16(lds_frag(XT, rr * 64 + 16 * pt, 32 * s, lane), pf, acc[pt]); } }
            asm volatile("s_waitcnt lgkmcnt(0)" ::: "memory");
#pragma unroll
            for (int pt = 0; pt < 4; ++pt) { const int p0 = 16 * pt + 4 * lg;
                const unsigned long long zz = *(const GAS unsigned long long*)(PROJ + (size_t)(row0 + q) * NINP + C_Z + h * 64 + p0);
                f32x4 y = acc[pt]; y.x *= siluf_(bflo((unsigned)zz)); y.y *= siluf_(bfhi((unsigned)zz)); y.z *= siluf_(bflo((unsigned)(zz >> 32))); y.w *= siluf_(bfhi((unsigned)(zz >> 32)));
                ssq += (y.x * y.x + y.y * y.y) + (y.z * y.z + y.w * y.w);
                *(GAS f32x4*)(YG + (size_t)(row0 + q) * 1024 + h * 64 + p0) = y; } }
    }
    if (c == 15 && tid < 288) {
        const int j = tid / 96, kk = tid % 96, ch0 = kk < 64 ? g * 512 + kk * 8 : (kk < 80 ? 1024 + g * 128 + (kk - 64) * 8 : 1280 + g * 128 + (kk - 80) * 8);
        float r[8]; unpack8(*(const GAS v4u*)(PROJ + (size_t)(row0 + 125 + j) * NINP + C_XBC + ch0), r);
        float* o = ARGOUT() + O_PCONV + (size_t)((l * NB + b) * 3 + j) * XCW + ch0;
        *(GAS f32x4*)o = (f32x4){r[0], r[1], r[2], r[3]}; *(GAS f32x4*)(o + 4) = (f32x4){r[4], r[5], r[6], r[7]}; }
    ssq += __shfl_xor(ssq, 16); ssq += __shfl_xor(ssq, 32);
    const float rs = 1.0f / sqrtf(ssq * (1.0f / 512.0f) + 1e-6f);
    asm volatile("s_waitcnt vmcnt(0)" ::: "memory");
    const float* wn = ARGIN(17) + (size_t)l * 1024 + g * 512;
#pragma unroll 4
    for (int j = 0; j < 32; ++j) { const int col = 16 * j + 4 * lg;
        const f32x4 y = *(const GAS f32x4*)(YG + (size_t)(row0 + q) * 1024 + g * 512 + col), g4 = *(const GAS f32x4*)(wn + col);
        *(GAS unsigned long long*)(MIXED + (size_t)(row0 + q) * DM + 512 + g * 512 + col) = (unsigned long long)pk2(y.x * rs * g4.x, y.y * rs * g4.y) | ((unsigned long long)pk2(y.z * rs * g4.z, y.w * rs * g4.w) << 32); }
}

constexpr int AKP = 72 * 2, AVP = 280 * 2, APP = 168 * 2;
__device__ __forceinline__ void attn_mfma_item(Frame& F, int l, int b, int blk, int kvh) {
    const bf16* PROJ = (const bf16*)(ARGWS() + WS_PROJ); bf16* MIXED = (bf16*)(ARGWS() + WS_MIXED);
    const int tid = F.tid, lane = F.lane, w = F.wave, lc = lane & 15, lg = lane >> 4, w0 = blk * 128 - 128;
    LAS unsigned char* Ks = F.lds; LAS unsigned char* Vt = F.lds + 256 * AKP; LAS unsigned char* Pw = F.lds + 256 * AKP + 64 * AVP + w * 16 * APP;
    float* pk = ARGOUT() + O_PK + (size_t)(l * NB + b) * 128 * 128; float* pv = ARGOUT() + O_PV + (size_t)(l * NB + b) * 128 * 128;
    __syncthreads();
    if (tid < 64 * 3) { const int d = tid / 3, j = tid % 3; *(LAS v4u*)(Vt + d * AVP + 512 + j * 16) = (v4u){0u, 0u, 0u, 0u}; }
#pragma unroll
    for (int rep = 0; rep < 4; ++rep) { const int task = tid + rep * NTHR;
        { const int r = task >> 3, c = task & 7, pos = w0 + r; const bool keep = (blk == 15 && r >= 128);
          if (pos < 0) { *(LAS v4u*)(Ks + r * AKP + c * 16) = (v4u){0u, 0u, 0u, 0u}; }
          else { const size_t grow = (size_t)(b * SEQL + pos) * NINP;
            if (c >= 2) { const v4u wk = *(const GAS v4u*)(PROJ + grow + C_K + kvh * 64 + c * 8); *(LAS v4u*)(Ks + r * AKP + c * 16) = wk;
              if (keep) { float f[8]; unpack8(wk, f); float* o = pk + (size_t)((r - 128) * 2 + kvh) * 64 + c * 8; *(GAS f32x4*)o = (f32x4){f[0], f[1], f[2], f[3]}; *(GAS f32x4*)(o + 4) = (f32x4){f[4], f[5], f[6], f[7]}; } }
            else if (c == 0) { float x1[8], x2[8], cs[8], sn[8], o1[8], o2[8];
              unpack8(*(const GAS v4u*)(PROJ + grow + C_K + kvh * 64), x1); unpack8(*(const GAS v4u*)(PROJ + grow + C_K + kvh * 64 + 8), x2); rope_cs(pos, cs, sn);
#pragma unroll
              for (int i = 0; i < 8; ++i) { o1[i] = x1[i] * cs[i] - x2[i] * sn[i]; o2[i] = x2[i] * cs[i] + x1[i] * sn[i]; }
              *(LAS v4u*)(Ks + r * AKP) = pack8(o1); *(LAS v4u*)(Ks + r * AKP + 16) = pack8(o2);
              if (keep) { float* o = pk + (size_t)((r - 128) * 2 + kvh) * 64; *(GAS f32x4*)o = (f32x4){o1[0], o1[1], o1[2], o1[3]}; *(GAS f32x4*)(o + 4) = (f32x4){o1[4], o1[5], o1[6], o1[7]};
                  *(GAS f32x4*)(o + 8) = (f32x4){o2[0], o2[1], o2[2], o2[3]}; *(GAS f32x4*)(o + 12) = (f32x4){o2[4], o2[5], o2[6], o2[7]}; } } } }
        { const int r = task & 255, c = task >> 8, pos = w0 + r; const bool keep = (blk == 15 && r >= 128);
          v4u wv = (v4u){0u, 0u, 0u, 0u};
          if (pos >= 0) wv = *(const GAS v4u*)(PROJ + (size_t)(b * SEQL + pos) * NINP + C_V + kvh * 64 + c * 8);
          *(LAS unsigned short*)(Vt + (c * 8 + 0) * AVP + r * 2) = (unsigned short)(wv.x & 0xffffu); *(LAS unsigned short*)(Vt + (c * 8 + 1) * AVP + r * 2) = (unsigned short)(wv.x >> 16);
          *(LAS unsigned short*)(Vt + (c * 8 + 2) * AVP + r * 2) = (unsigned short)(wv.y & 0xffffu); *(LAS unsigned short*)(Vt + (c * 8 + 3) * AVP + r * 2) = (unsigned short)(wv.y >> 16);
          *(LAS unsigned short*)(Vt + (c * 8 + 4) * AVP + r * 2) = (unsigned short)(wv.z & 0xffffu); *(LAS unsigned short*)(Vt + (c * 8 + 5) * AVP + r * 2) = (unsigned short)(wv.z >> 16);
          *(LAS unsigned short*)(Vt + (c * 8 + 6) * AVP + r * 2) = (unsigned short)(wv.w & 0xffffu); *(LAS unsigned short*)(Vt + (c * 8 + 7) * AVP + r * 2) = (unsigned short)(wv.w >> 16);
          if (keep) { float f[8]; unpack8(wv, f); float* o = pv + (size_t)((r - 128) * 2 + kvh) * 64 + c * 8; *(GAS f32x4*)o = (f32x4){f[0], f[1], f[2], f[3]}; *(GAS f32x4*)(o + 4) = (f32x4){f[4], f[5], f[6], f[7]}; } } }
    const int qpos = blk * 128 + 16 * w + lc; const size_t qrow = (size_t)b * SEQL + qpos;
    float cs[8], sn[8]; rope_cs(qpos, cs, sn);
    __syncthreads();
    for (int g = 0; g < 4; ++g) { const int h = kvh * 4 + g;
        v4u q0 = *(const GAS v4u*)(PROJ + qrow * NINP + C_Q + h * 64 + 8 * lg); const v4u q1 = *(const GAS v4u*)(PROJ + qrow * NINP + C_Q + h * 64 + 32 + 8 * lg);
        { v4u pp; pp.x = __shfl_xor(q0.x, 16); pp.y = __shfl_xor(q0.y, 16); pp.z = __shfl_xor(q0.z, 16); pp.w = __shfl_xor(q0.w, 16);
          float own[8], oth[8], o[8]; unpack8(q0, own); unpack8(pp, oth);
#pragma unroll
          for (int i = 0; i < 8; ++i) o[i] = lg == 0 ? own[i] * cs[i] - oth[i] * sn[i] : own[i] * cs[i] + oth[i] * sn[i];
          if (lg < 2) q0 = pack8(o); }
        const bf16x8 qf0 = __builtin_bit_cast(bf16x8, q0), qf1 = __builtin_bit_cast(bf16x8, q1);
        f32x4 sc[9]; float mx = -INFINITY;
#pragma unroll
        for (int tt = 0; tt < 9; ++tt) { const LAS unsigned char* kb = Ks + (16 * (w + tt) + lc) * AKP + 16 * lg;
            f32x4 a = (f32x4){0.f, 0.f, 0.f, 0.f};
            a = MFMA16(*(const LAS bf16x8*)kb, qf0, a); a = MFMA16(*(const LAS bf16x8*)(kb + 64), qf1, a);
#pragma unroll
            for (int i = 0; i < 4; ++i) { const int kk = 16 * tt + 4 * lg + i; const bool ok = (kk >= lc) && (kk <= 128 + lc) && (w0 + 16 * w + kk >= 0);
                a[i] = ok ? a[i] * 0.125f : -INFINITY; mx = fmaxf(mx, a[i]); }
            sc[tt] = a; }
        mx = fmaxf(mx, __shfl_xor(mx, 16)); mx = fmaxf(mx, __shfl_xor(mx, 32));
        const float sink = ARGIN(11)[l * 8 + h]; mx = fmaxf(mx, sink);
        float rsum = 0.f;
#pragma unroll
        for (int tt = 0; tt < 10; ++tt) { float p[4] = {0.f, 0.f, 0.f, 0.f};
            if (tt < 9) {
#pragma unroll
                for (int i = 0; i < 4; ++i) { p[i] = expf(sc[tt < 9 ? tt : 0][i] - mx); rsum += p[i]; } }
            *(LAS unsigned long long*)(Pw + lc * APP + (16 * tt + 4 * lg) * 2) = (unsigned long long)pk2(p[0], p[1]) | ((unsigned long long)pk2(p[2], p[3]) << 32); }
        rsum += __shfl_xor(rsum, 16); rsum += __shfl_xor(rsum, 32);
        const float inv = 1.0f / (rsum + expf(sink - mx));
        asm volatile("s_waitcnt lgkmcnt(0)" ::: "memory");
        f32x4 acc[4];
#pragma unroll
        for (int dt = 0; dt < 4; ++dt) acc[dt] = (f32x4){0.f, 0.f, 0.f, 0.f};
#pragma unroll
        for (int s = 0; s < 5; ++s) { const bf16x8 pf = *(const LAS bf16x8*)(Pw + lc * APP + (32 * s + 8 * lg) * 2);
#pragma unroll
            for (int dt = 0; dt < 4; ++dt) acc[dt] = MFMA16(*(const LAS bf16x8*)(Vt + (16 * dt + lc) * AVP + (16 * w + 32 * s + 8 * lg) * 2), pf, acc[dt]); }
        asm volatile("s_waitcnt lgkmcnt(0)" ::: "memory");
#pragma unroll
        for (int dt = 0; dt < 4; ++dt) *(GAS unsigned long long*)(MIXED + qrow * DM + h * 64 + 16 * dt + 4 * lg) =
            (unsigned long long)pk2(acc[dt][0] * inv, acc[dt][1] * inv) | ((unsigned long long)pk2(acc[dt][2] * inv, acc[dt][3] * inv) << 32);
    }
}

__device__ __forceinline__ void conv8_sample(const bf16* PROJ, const float* cw, const float* cb, const float* sconv, float* sconv_o, int b, int ch0, float (&y)[8]) {
    float r[4][8];
#pragma unroll
    for (int j = 0; j < 3; ++j) { const f32x4 u0 = *(const GAS f32x4*)(sconv + (size_t)(b * 3 + j) * XCW + ch0), u1 = *(const GAS f32x4*)(sconv + (size_t)(b * 3 + j) * XCW + ch0 + 4);
        r[j][0] = u0.x; r[j][1] = u0.y; r[j][2] = u0.z; r[j][3] = u0.w; r[j][4] = u1.x; r[j][5] = u1.y; r[j][6] = u1.z; r[j][7] = u1.w; }
    unpack8(*(const GAS v4u*)(PROJ + (size_t)(MP + b) * NINP + C_XBC + ch0), r[3]);
#pragma unroll
    for (int i = 0; i < 8; ++i) { float acc = cb[ch0 + i];
#pragma unroll
        for (int j = 0; j < 4; ++j) acc += cw[j * XCW + ch0 + i] * r[j][i];
        y[i] = siluf_(acc); }
#pragma unroll
    for (int j = 0; j < 3; ++j) { float* o = sconv_o + (size_t)(b * 3 + j) * XCW + ch0;
        *(GAS f32x4*)o = (f32x4){r[j + 1][0], r[j + 1][1], r[j + 1][2], r[j + 1][3]}; *(GAS f32x4*)(o + 4) = (f32x4){r[j + 1][4], r[j + 1][5], r[j + 1][6], r[j + 1][7]}; }
}
__device__ __forceinline__ void ssd_sample_item(Frame& F, int l, int b, int g) {
    const bf16* PROJ = (const bf16*)(ARGWS() + WS_PROJ); bf16* MIXED = (bf16*)(ARGWS() + WS_MIXED);
    const float* cw = ARGIN(12) + (size_t)l * 4 * XCW; const float* cb = ARGIN(13) + (size_t)l * XCW; const float* sconv = ARGIN(4) + (size_t)l * MS * 3 * XCW; float* sconv_o = ARGOUT() + O_SCONV + (size_t)l * MS * 3 * XCW;
    const int tid = F.tid, lane = F.lane, w = F.wave, p = tid >> 3, nq = tid & 7;
    LAS float* xs = (LAS float*)(F.lds);
    LAS float* Bs = xs + 512;
    LAS float* Cs = Bs + 128;
    LAS float* ys = Cs + 128;
    LAS float* red = ys + 512;
    __syncthreads();
    if (tid < 96) { const int ch0 = tid < 64 ? g * 512 + tid * 8 : (tid < 80 ? 1024 + g * 128 + (tid - 64) * 8 : 1280 + g * 128 + (tid - 80) * 8);
        float y[8]; conv8_sample(PROJ, cw, cb, sconv, sconv_o, b, ch0, y);
        LAS float* dst = tid < 64 ? xs + tid * 8 : (tid < 80 ? Bs + (tid - 64) * 8 : Cs + (tid - 80) * 8);
#pragma unroll
        for (int i = 0; i < 8; ++i) dst[i] = y[i]; }
    __syncthreads();
    float Bv[16], Cv[16];
#pragma unroll
    for (int i = 0; i < 16; ++i) { Bv[i] = Bs[nq * 16 + i]; Cv[i] = Cs[nq * 16 + i]; }
    float ssq = 0.f;
#pragma unroll 2
    for (int r = 0; r < 8; ++r) { const int h = g * 8 + r;
        const float dt = softplusf_(bf2f(PROJ[(size_t)(MP + b) * NINP + C_DT + h]) + ARGIN(14)[l * 16 + h]), dA = expf(dt * -expf(ARGIN(15)[l * 16 + h])), x = xs[r * 64 + p], coef = dt * x;
        const float* s0 = ARGIN(5) + ((((size_t)l * MS + b) * 16 + h) * 64 + p) * 128 + nq * 16; float* so = ARGOUT() + O_SSSM + ((((size_t)l * MS + b) * 16 + h) * 64 + p) * 128 + nq * 16;
        float y = 0.f;
#pragma unroll
        for (int i = 0; i < 4; ++i) { f32x4 v = *(const GAS f32x4*)(s0 + 4 * i);
            v.x = dA * v.x + coef * Bv[4 * i]; v.y = dA * v.y + coef * Bv[4 * i + 1]; v.z = dA * v.z + coef * Bv[4 * i + 2]; v.w = dA * v.w + coef * Bv[4 * i + 3];
            y += (v.x * Cv[4 * i] + v.y * Cv[4 * i + 1]) + (v.z * Cv[4 * i + 2] + v.w * Cv[4 * i + 3]);
            *(GAS f32x4*)(so + 4 * i) = v; }
        y += __shfl_xor(y, 1); y += __shfl_xor(y, 2); y += __shfl_xor(y, 4);
        if (nq == 0) { const float z = bf2f(PROJ[(size_t)(MP + b) * NINP + C_Z + h * 64 + p]); const float yo = (y + ARGIN(16)[l * 16 + h] * x) * siluf_(z); ys[r * 64 + p] = yo; ssq += yo * yo; } }
    ssq = wave_sum(ssq); if (lane == 0) red[w] = ssq;
    __syncthreads();
    const float tot = ((red[0] + red[1]) + (red[2] + red[3])) + ((red[4] + red[5]) + (red[6] + red[7])), rs = 1.0f / sqrtf(tot * (1.0f / 512.0f) + 1e-6f);
    ((unsigned short*)MIXED)[(size_t)(MP + b) * DM + 512 + g * 512 + tid] = (unsigned short)f2bf(ys[tid] * rs * ARGIN(17)[(size_t)l * 1024 + g * 512 + tid]);
}
__device__ __forceinline__ void mlstm_sample_item(Frame& F, int l, int b, int h) {
    const bf16* PROJ = (const bf16*)(ARGWS() + WS_PROJ); bf16* MIXED = (bf16*)(ARGWS() + WS_MIXED);
    const int tid = F.tid, lane = F.lane, w = F.wave, dg = tid >> 5, e4 = (tid & 31) * 4; const size_t prow = (size_t)(MP + b) * NINP, sidx = ((size_t)l * MS + b) * 4 + h;
    LAS float* qs = (LAS float*)(F.lds);
    LAS float* ks = qs + 128;
    LAS float* part = ks + 128;
    LAS float* red = part + 1024;
    const float m0 = ARGIN(8)[sidx];
    const float ig = bf2f(PROJ[prow + C_MI + h]) + ARGIN(18)[l * 4 + h], lf = logsigmoidf_(bf2f(PROJ[prow + C_MF + h]) + ARGIN(19)[l * 4 + h]);
    const float mn = fmaxf(lf + m0, ig), fgt = expf(lf + m0 - mn), igt = expf(ig - mn);
    __syncthreads();
    float dpart = 0.f;
    if (tid < 128) { const float q = bf2f(PROJ[prow + C_MQ + h * 128 + tid]), k = bf2f(PROJ[prow + C_MK + h * 128 + tid]) * 0.08838834764831845f * igt;
        qs[tid] = q; ks[tid] = k;
        const float nn = fgt * ARGIN(7)[sidx * 128 + tid] + k; ARGOUT()[O_SN + sidx * 128 + tid] = nn; dpart = q * nn; }
    dpart = wave_sum(dpart); if (lane == 0) red[w] = dpart;
    __syncthreads();
    const float den = red[0] + red[1];
    f32x4 vv; { const unsigned long long u = *(const GAS unsigned long long*)(PROJ + prow + C_MV + h * 128 + e4); vv = (f32x4){bflo((unsigned)u), bfhi((unsigned)u), bflo((unsigned)(u >> 32)), bfhi((unsigned)(u >> 32))}; }
    const float* c0 = ARGIN(6) + sidx * 16384; float* co = ARGOUT() + O_SC + sidx * 16384;
    f32x4 cr[8];
#pragma unroll
    for (int j = 0; j < 8; ++j) cr[j] = *(const GAS f32x4*)(c0 + (size_t)(dg + 16 * j) * 128 + e4);
    f32x4 num = (f32x4){0.f, 0.f, 0.f, 0.f};
#pragma unroll
    for (int j = 0; j < 8; ++j) { const int d = dg + 16 * j; const f32x4 cn = cr[j] * fgt + vv * ks[d]; *(GAS f32x4*)(co + (size_t)d * 128 + e4) = cn; num = num + cn * qs[d]; }
    num.x += __shfl_xor(num.x, 32); num.y += __shfl_xor(num.y, 32); num.z += __shfl_xor(num.z, 32); num.w += __shfl_xor(num.w, 32);
    if (lane < 32) *(LAS f32x4*)(part + w * 128 + e4) = num;
    __syncthreads();
    float hv = 0.f;
    if (tid < 128) { float s = 0.f;
#pragma unroll
        for (int j = 0; j < 8; ++j) s += part[j * 128 + tid];
        hv = s / fmaxf(fabsf(den), expf(-mn)); }
    const float s2 = wave_sum(hv * hv); if (lane == 0) red[8 + w] = s2;
    __syncthreads();
    if (tid < 128) { const float rs = 1.0f / sqrtf((red[8] + red[9]) * (1.0f / 128.0f) + 1e-6f);
        ((unsigned short*)MIXED)[(size_t)(MP + b) * DM + 1536 + h * 128 + tid] = (unsigned short)f2bf(hv * rs * ARGIN(20)[(size_t)l * 512 + h * 128 + tid] * sigmoidf_(bf2f(PROJ[prow + C_MO + h * 128 + tid]))); }
    if (tid == 0) ARGOUT()[O_SM + sidx] = mn;
}

__device__ __forceinline__ void conv_phase(Frame& F, const Args& a, int l) {
    const bf16* PROJ = (const bf16*)(ARGWS() + WS_PROJ); bf16* XC = (bf16*)(ARGWS() + WS_XC);
    const float* cw = ARGIN(12) + (size_t)l * 4 * XCW; const float* cb = ARGIN(13) + (size_t)l * XCW; const float* sconv = ARGIN(4) + (size_t)l * MS * 3 * XCW;
    float* pconv = ARGOUT() + O_PCONV + (size_t)l * NB * 3 * XCW; float* sconv_o = ARGOUT() + O_SCONV + (size_t)l * MS * 3 * XCW;
    for (int idx = F.vcu * NTHR + F.tid; idx < (MS + NB * 3) * (XCW / 8); idx += F.G * NTHR) {
        const int rr_ = idx / (XCW / 8), c0 = (idx % (XCW / 8)) * 8;
        const int row = rr_ < MS ? MP + rr_ : ((rr_ - MS) / 3) * SEQL + (SEQL - 3) + (rr_ - MS) % 3;
        float r[4][8];
        if (row < MP) { const int t = row & (SEQL - 1);
#pragma unroll
            for (int j = 0; j < 4; ++j) { const int tt = t - 3 + j;
                if (tt >= 0) { const v4u w = *(const GAS v4u*)(PROJ + (size_t)(row - 3 + j) * NINP + C_XBC + c0); unpack8(w, r[j]); }
                else {
#pragma unroll
                    for (int i = 0; i < 8; ++i) r[j][i] = 0.f; } }
        } else { const int b = row - MP;
#pragma unroll
            for (int j = 0; j < 3; ++j) { const f32x4 u0 = *(const GAS f32x4*)(sconv + (size_t)(b * 3 + j) * XCW + c0), u1 = *(const GAS f32x4*)(sconv + (size_t)(b * 3 + j) * XCW + c0 + 4);
                r[j][0] = u0.x; r[j][1] = u0.y; r[j][2] = u0.z; r[j][3] = u0.w; r[j][4] = u1.x; r[j][5] = u1.y; r[j][6] = u1.z; r[j][7] = u1.w; }
            const v4u w = *(const GAS v4u*)(PROJ + (size_t)row * NINP + C_XBC + c0); unpack8(w, r[3]);
        }
        float y[8];
#pragma unroll
        for (int i = 0; i < 8; ++i) { float acc = cb[c0 + i];
#pragma unroll
            for (int j = 0; j < 4; ++j) acc += cw[j * XCW + c0 + i] * r[j][i];
            y[i] = siluf_(acc); }
        *(GAS v4u*)(XC + (size_t)row * XCW + c0) = pack8(y);
        if (row < MP) { const int t = row & (SEQL - 1), b = row >> 11;
            if (t >= SEQL - 3) { float* o = pconv + (size_t)(b * 3 + (t - (SEQL - 3))) * XCW + c0;
                *(GAS f32x4*)o = (f32x4){r[3][0], r[3][1], r[3][2], r[3][3]}; *(GAS f32x4*)(o + 4) = (f32x4){r[3][4], r[3][5], r[3][6], r[3][7]}; }
        } else { const int b = row - MP;
#pragma unroll
            for (int j = 0; j < 3; ++j) { float* o = sconv_o + (size_t)(b * 3 + j) * XCW + c0;
                *(GAS f32x4*)o = (f32x4){r[j + 1][0], r[j + 1][1], r[j + 1][2], r[j + 1][3]}; *(GAS f32x4*)(o + 4) = (f32x4){r[j + 1][4], r[j + 1][5], r[j + 1][6], r[j + 1][7]}; }
        }
    }
}

__device__ __forceinline__ void ssd_seq_item(Frame& F, const Args& a, int l, int b, int h, bool sample) {
    const bf16* PROJ = (const bf16*)(ARGWS() + WS_PROJ); const bf16* XC = (const bf16*)(ARGWS() + WS_XC); float* YG = (float*)(ARGWS() + WS_YG);
    const int row0 = sample ? MP + b : b * SEQL, L = sample ? 1 : SEQL, g = h >> 3, tid = F.tid;
    const float A = -expf(ARGIN(15)[l * 16 + h]), dtb = ARGIN(14)[l * 16 + h], Dh = ARGIN(16)[l * 16 + h];
    const int p = tid >> 3, nq = tid & 7;
    float S[16];
    if (sample) { const float* s0 = ARGIN(5) + ((((size_t)l * MS + b) * 16 + h) * 64 + p) * 128 + nq * 16;
#pragma unroll
        for (int i = 0; i < 4; ++i) { const f32x4 v = *(const GAS f32x4*)(s0 + 4 * i); S[4 * i] = v.x; S[4 * i + 1] = v.y; S[4 * i + 2] = v.z; S[4 * i + 3] = v.w; } }
    else {
#pragma unroll
        for (int i = 0; i < 16; ++i) S[i] = 0.f; }
    LAS float* xs = (LAS float*)(F.lds);
    LAS float* Bs = (LAS float*)(F.lds + 16384);
    LAS float* Cs = (LAS float*)(F.lds + 49152);
    LAS float* ys = (LAS float*)(F.lds + 81920);
    LAS float* dts = (LAS float*)(F.lds + 98304);
    LAS float* das = (LAS float*)(F.lds + 98304 + 256);
    for (int t0 = 0; t0 < L; t0 += 64) {
        const int nb = (L - t0) < 64 ? (L - t0) : 64;
        __syncthreads();
        { const int tt = tid >> 3, ch = tid & 7;
          if (tt < nb) { float f[8]; unpack8(*(const GAS v4u*)(XC + (size_t)(row0 + t0 + tt) * XCW + h * 64 + ch * 8), f);
#pragma unroll
              for (int i = 0; i < 8; ++i) xs[tt * 64 + ch * 8 + i] = f[i]; } }
#pragma unroll
        for (int rep = 0; rep < 2; ++rep) { const int task = tid + rep * NTHR, tt = task >> 4, ch = task & 15;
          if (tt < nb) { float f[8]; unpack8(*(const GAS v4u*)(XC + (size_t)(row0 + t0 + tt) * XCW + 1024 + g * 128 + ch * 8), f);
#pragma unroll
              for (int i = 0; i < 8; ++i) Bs[tt * 128 + ch * 8 + i] = f[i];
              unpack8(*(const GAS v4u*)(XC + (size_t)(row0 + t0 + tt) * XCW + 1280 + g * 128 + ch * 8), f);
#pragma unroll
              for (int i = 0; i < 8; ++i) Cs[tt * 128 + ch * 8 + i] = f[i]; } }
        if (tid < nb) { const float dt = softplusf_(bf2f(PROJ[(size_t)(row0 + t0 + tid) * NINP + C_DT + h]) + dtb); dts[tid] = dt; das[tid] = expf(dt * A); }
        __syncthreads();
        for (int tt = 0; tt < nb; ++tt) {
            const float dt = dts[tt], dA = das[tt], x = xs[tt * 64 + p], coef = dt * x;
            float y = 0.f;
#pragma unroll
            for (int i = 0; i < 16; ++i) { S[i] = dA * S[i] + coef * Bs[tt * 128 + nq * 16 + i]; y += S[i] * Cs[tt * 128 + nq * 16 + i]; }
            y += __shfl_xor(y, 1); y += __shfl_xor(y, 2); y += __shfl_xor(y, 4);
            if (nq == 0) ys[tt * 64 + p] = y + Dh * x;
        }
        __syncthreads();
        { const int tt = tid >> 3, ch = tid & 7;
          if (tt < nb) { float z[8]; unpack8(*(const GAS v4u*)(PROJ + (size_t)(row0 + t0 + tt) * NINP + C_Z + h * 64 + ch * 8), z);
              float o[8];
#pragma unroll
              for (int i = 0; i < 8; ++i) o[i] = ys[tt * 64 + ch * 8 + i] * siluf_(z[i]);
              float* dst = YG + (size_t)(row0 + t0 + tt) * 1024 + h * 64 + ch * 8;
              *(GAS f32x4*)dst = (f32x4){o[0], o[1], o[2], o[3]}; *(GAS f32x4*)(dst + 4) = (f32x4){o[4], o[5], o[6], o[7]}; } }
    }
    float* so = ARGOUT() + (sample ? O_SSSM + ((((size_t)l * MS + b) * 16 + h) * 64 + p) * 128 : O_PSSM + ((((size_t)l * NB + b) * 16 + h) * 64 + p) * 128) + nq * 16;
#pragma unroll
    for (int i = 0; i < 4; ++i) *(GAS f32x4*)(so + 4 * i) = (f32x4){S[4 * i], S[4 * i + 1], S[4 * i + 2], S[4 * i + 3]};
}

__device__ __forceinline__ void mlstm_seq_item(Frame& F, const Args& a, int l, int b, int h, int es, bool sample) {
    const bf16* PROJ = (const bf16*)(ARGWS() + WS_PROJ); float* HR = (float*)(ARGWS() + WS_HR);
    const int row0 = sample ? MP + b : b * SEQL, L = sample ? 1 : SEQL, tid = F.tid, w = F.wave, lane = F.lane;
    const int e0 = es * 32 + w * 4, d0 = 2 * lane, Bn = sample ? MS : NB;
    const float ib = ARGIN(18)[l * 4 + h], fb = ARGIN(19)[l * 4 + h];
    float C[2][4], n[2], m;
    if (sample) {
#pragma unroll
        for (int dd = 0; dd < 2; ++dd) { const f32x4 v = *(const GAS f32x4*)(ARGIN(6) + ((((size_t)l * MS + b) * 4 + h) * 128 + d0 + dd) * 128 + e0);
            C[dd][0] = v.x; C[dd][1] = v.y; C[dd][2] = v.z; C[dd][3] = v.w; n[dd] = ARGIN(7)[(((size_t)l * MS + b) * 4 + h) * 128 + d0 + dd]; }
        m = ARGIN(8)[((size_t)l * MS + b) * 4 + h];
    } else {
#pragma unroll
        for (int dd = 0; dd < 2; ++dd) { n[dd] = 0.f;
#pragma unroll
            for (int j = 0; j < 4; ++j) C[dd][j] = 0.f; }
        m = 0.f;
    }
    LAS float* qs = (LAS float*)(F.lds);
    LAS float* ks = (LAS float*)(F.lds + 32768);
    LAS float* vs = (LAS float*)(F.lds + 65536);
    LAS float* hs = (LAS float*)(F.lds + 73728);
    LAS float* igs = (LAS float*)(F.lds + 81920);
    LAS float* lfs = (LAS float*)(F.lds + 81920 + 256);
    for (int t0 = 0; t0 < L; t0 += 64) {
        const int nb = (L - t0) < 64 ? (L - t0) : 64;
        __syncthreads();
#pragma unroll
        for (int rep = 0; rep < 2; ++rep) { const int task = tid + rep * NTHR, tt = task >> 4, ch = task & 15;
          if (tt < nb) { float f[8]; unpack8(*(const GAS v4u*)(PROJ + (size_t)(row0 + t0 + tt) * NINP + C_MQ + h * 128 + ch * 8), f);
#pragma unroll
              for (int i = 0; i < 8; ++i) qs[tt * 128 + ch * 8 + i] = f[i];
              unpack8(*(const GAS v4u*)(PROJ + (size_t)(row0 + t0 + tt) * NINP + C_MK + h * 128 + ch * 8), f);
#pragma unroll
              for (int i = 0; i < 8; ++i) ks[tt * 128 + ch * 8 + i] = f[i] * 0.08838834764831845f; } }
        if (tid < 256) { const int tt = tid >> 2, ch = tid & 3;
          if (tt < nb) { float f[8]; unpack8(*(const GAS v4u*)(PROJ + (size_t)(row0 + t0 + tt) * NINP + C_MV + h * 128 + es * 32 + ch * 8), f);
#pragma unroll
              for (int i = 0; i < 8; ++i) vs[tt * 32 + ch * 8 + i] = f[i]; } }
        if (tid < nb) { igs[tid] = bf2f(PROJ[(size_t)(row0 + t0 + tid) * NINP + C_MI + h]) + ib; lfs[tid] = logsigmoidf_(bf2f(PROJ[(size_t)(row0 + t0 + tid) * NINP + C_MF + h]) + fb); }
        __syncthreads();
        for (int tt = 0; tt < nb; ++tt) {
            const float lf = lfs[tt], ig = igs[tt];
            const float m_new = fmaxf(lf + m, ig), fgt = expf(lf + m - m_new), igt = expf(ig - m_new); m = m_new;
            const float q0 = qs[tt * 128 + d0], q1 = qs[tt * 128 + d0 + 1], k0 = ks[tt * 128 + d0] * igt, k1 = ks[tt * 128 + d0 + 1] * igt;
            n[0] = fgt * n[0] + k0; n[1] = fgt * n[1] + k1;
            float red[5]; red[4] = q0 * n[0] + q1 * n[1];
#pragma unroll
            for (int j = 0; j < 4; ++j) { const float v = vs[tt * 32 + w * 4 + j]; C[0][j] = fgt * C[0][j] + k0 * v; C[1][j] = fgt * C[1][j] + k1 * v; red[j] = q0 * C[0][j] + q1 * C[1][j]; }
#pragma unroll
            for (int j = 0; j < 5; ++j) red[j] = wave_sum(red[j]);
            const float dn = fmaxf(fabsf(red[4]), expf(-m));
            if (lane < 4) hs[tt * 32 + w * 4 + lane] = (lane == 0 ? red[0] : lane == 1 ? red[1] : lane == 2 ? red[2] : red[3]) / dn;
        }
        __syncthreads();
        { const int tt = tid >> 3, e4 = (tid & 7) * 4;
          if (tt < nb) *(GAS f32x4*)(HR + (size_t)(row0 + t0 + tt) * 512 + h * 128 + es * 32 + e4) = (f32x4){hs[tt * 32 + e4], hs[tt * 32 + e4 + 1], hs[tt * 32 + e4 + 2], hs[tt * 32 + e4 + 3]}; }
    }
    float* co = ARGOUT() + (sample ? O_SC : O_PC) + (((size_t)l * Bn + b) * 4 + h) * 128 * 128;
#pragma unroll
    for (int dd = 0; dd < 2; ++dd) *(GAS f32x4*)(co + (size_t)(d0 + dd) * 128 + e0) = (f32x4){C[dd][0], C[dd][1], C[dd][2], C[dd][3]};
    if (es == 0 && w == 0) { float* no = ARGOUT() + (sample ? O_SN : O_PN) + (((size_t)l * Bn + b) * 4 + h) * 128; no[d0] = n[0]; no[d0 + 1] = n[1];
        if (lane == 0) ARGOUT()[(sample ? O_SM : O_PM) + ((size_t)l * Bn + b) * 4 + h] = m; }
}

__device__ __forceinline__ void attn_prompt_item(Frame& F, const Args& a, int l, int b, int blk, int kvh) {
    const bf16* PROJ = (const bf16*)(ARGWS() + WS_PROJ); bf16* MIXED = (bf16*)(ARGWS() + WS_MIXED);
    constexpr int KP = 68;
    LAS unsigned short* Ks = (LAS unsigned short*)(F.lds); LAS unsigned short* Vs = (LAS unsigned short*)(F.lds + 256 * KP * 2);
    const int tid = F.tid, w0 = blk * 128 - 128;
    float* pk = ARGOUT() + O_PK + (size_t)(l * NB + b) * 128 * 128; float* pv = ARGOUT() + O_PV + (size_t)(l * NB + b) * 128 * 128;
    __syncthreads();
#pragma unroll
    for (int rep = 0; rep < 4; ++rep) { const int task = tid + rep * NTHR, r = task >> 3, c = task & 7, pos = w0 + r; const bool keep = (blk == 15 && r >= 128);
        if (pos < 0) { *(LAS v4u*)(Ks + r * KP + c * 8) = (v4u){0u, 0u, 0u, 0u}; *(LAS v4u*)(Vs + r * KP + c * 8) = (v4u){0u, 0u, 0u, 0u}; continue; }
        const size_t grow = (size_t)(b * SEQL + pos) * NINP;
        { const v4u wv = *(const GAS v4u*)(PROJ + grow + C_V + kvh * 64 + c * 8); *(LAS v4u*)(Vs + r * KP + c * 8) = wv;
          if (keep) { float f[8]; unpack8(wv, f); float* o = pv + (size_t)((r - 128) * 2 + kvh) * 64 + c * 8; *(GAS f32x4*)o = (f32x4){f[0], f[1], f[2], f[3]}; *(GAS f32x4*)(o + 4) = (f32x4){f[4], f[5], f[6], f[7]}; } }
        if (c >= 2) { const v4u wk = *(const GAS v4u*)(PROJ + grow + C_K + kvh * 64 + c * 8); *(LAS v4u*)(Ks + r * KP + c * 8) = wk;
          if (keep) { float f[8]; unpack8(wk, f); float* o = pk + (size_t)((r - 128) * 2 + kvh) * 64 + c * 8; *(GAS f32x4*)o = (f32x4){f[0], f[1], f[2], f[3]}; *(GAS f32x4*)(o + 4) = (f32x4){f[4], f[5], f[6], f[7]}; } }
        else if (c == 0) { float x1[8], x2[8], cs[8], sn[8], o1[8], o2[8];
          unpack8(*(const GAS v4u*)(PROJ + grow + C_K + kvh * 64), x1); unpack8(*(const GAS v4u*)(PROJ + grow + C_K + kvh * 64 + 8), x2); rope_cs(pos, cs, sn);
#pragma unroll
          for (int i = 0; i < 8; ++i) { o1[i] = x1[i] * cs[i] - x2[i] * sn[i]; o2[i] = x2[i] * cs[i] + x1[i] * sn[i]; }
          *(LAS v4u*)(Ks + r * KP) = pack8(o1); *(LAS v4u*)(Ks + r * KP + 8) = pack8(o2);
          if (keep) { float* o = pk + (size_t)((r - 128) * 2 + kvh) * 64; *(GAS f32x4*)o = (f32x4){o1[0], o1[1], o1[2], o1[3]}; *(GAS f32x4*)(o + 4) = (f32x4){o1[4], o1[5], o1[6], o1[7]};
              *(GAS f32x4*)(o + 8) = (f32x4){o2[0], o2[1], o2[2], o2[3]}; *(GAS f32x4*)(o + 12) = (f32x4){o2[4], o2[5], o2[6], o2[7]}; } }
    }
    __syncthreads();
    const int i = tid >> 2, g = tid & 3, h = kvh * 4 + g, qpos = blk * 128 + i; const size_t row = (size_t)b * SEQL + qpos;
    float q[64];
#pragma unroll
    for (int c = 0; c < 8; ++c) { float f[8]; unpack8(*(const GAS v4u*)(PROJ + row * NINP + C_Q + h * 64 + c * 8), f);
#pragma unroll
        for (int e = 0; e < 8; ++e) q[c * 8 + e] = f[e]; }
    { float cs[8], sn[8]; rope_cs(qpos, cs, sn);
#pragma unroll
      for (int e = 0; e < 8; ++e) { const float x1 = q[e], x2 = q[8 + e]; q[e] = x1 * cs[e] - x2 * sn[e]; q[8 + e] = x2 * cs[e] + x1 * sn[e]; } }
#pragma unroll
    for (int e = 0; e < 64; ++e) q[e] *= 0.125f;
    float acc[64], mx = -INFINITY, sum = 0.f;
#pragma unroll
    for (int e = 0; e < 64; ++e) acc[e] = 0.f;
    for (int jj = 0; jj <= 128; ++jj) { const int r = i + jj;
        if (w0 + r < 0) continue;
        float s = 0.f;
#pragma unroll
        for (int c = 0; c < 8; ++c) { float f[8]; unpack8(*(const LAS v4u*)(Ks + r * KP + c * 8), f);
#pragma unroll
            for (int e = 0; e < 8; ++e) s += q[c * 8 + e] * f[e]; }
        const float mn = fmaxf(mx, s), sc = expf(mx - mn), p = expf(s - mn); mx = mn; sum = sum * sc + p;
#pragma unroll
        for (int c = 0; c < 8; ++c) { float f[8]; unpack8(*(const LAS v4u*)(Vs + r * KP + c * 8), f);
#pragma unroll
            for (int e = 0; e < 8; ++e) acc[c * 8 + e] = acc[c * 8 + e] * sc + p * f[e]; }
    }
    const float sink = ARGIN(11)[l * 8 + h], mf = fmaxf(mx, sink), sc = expf(mx - mf), den = sum * sc + expf(sink - mf), inv = sc / den;
#pragma unroll
    for (int c = 0; c < 8; ++c) { float o[8];
#pragma unroll
        for (int e = 0; e < 8; ++e) o[e] = acc[c * 8 + e] * inv;
        *(GAS v4u*)(MIXED + row * DM + h * 64 + c * 8) = pack8(o); }
}

__device__ __forceinline__ void attn_sample_item(Frame& F, const Args& a, int l, int b) {
    const bf16* PROJ = (const bf16*)(ARGWS() + WS_PROJ); bf16* MIXED = (bf16*)(ARGWS() + WS_MIXED);
    const int tid = F.tid, h = F.wave, lane = F.lane, kvh = h >> 2; const size_t prow = (size_t)(MP + b) * NINP;
    LAS float* qs = (LAS float*)(F.lds);
    LAS float* ps = (LAS float*)(F.lds + 2048);
    LAS float* knew = (LAS float*)(F.lds + 2048 + 4224);
    LAS float* vnew = knew + 128;
    const float* ck = ARGIN(2) + (size_t)(l * MS + b) * 128 * 128; const float* cv = ARGIN(3) + (size_t)(l * MS + b) * 128 * 128;
    __syncthreads();
    { float cs[8], sn[8]; rope_cs(8192, cs, sn);
      const int d = lane; float x = bf2f(PROJ[prow + C_Q + h * 64 + d]);
      if (d < 16) { const float xp = bf2f(PROJ[prow + C_Q + h * 64 + (d ^ 8)]); const float c = (d & 7) == 0 ? cs[0] : (d & 7) == 1 ? cs[1] : (d & 7) == 2 ? cs[2] : (d & 7) == 3 ? cs[3] : (d & 7) == 4 ? cs[4] : (d & 7) == 5 ? cs[5] : (d & 7) == 6 ? cs[6] : cs[7];
          const float s = (d & 7) == 0 ? sn[0] : (d & 7) == 1 ? sn[1] : (d & 7) == 2 ? sn[2] : (d & 7) == 3 ? sn[3] : (d & 7) == 4 ? sn[4] : (d & 7) == 5 ? sn[5] : (d & 7) == 6 ? sn[6] : sn[7];
          x = d < 8 ? x * c - xp * s : x * c + xp * s; }
      qs[h * 64 + d] = x * 0.125f;
      if (h < 2) { float y = bf2f(PROJ[prow + C_K + h * 64 + d]);
          if (d < 16) { const float yp = bf2f(PROJ[prow + C_K + h * 64 + (d ^ 8)]); const float c = (d & 7) == 0 ? cs[0] : (d & 7) == 1 ? cs[1] : (d & 7) == 2 ? cs[2] : (d & 7) == 3 ? cs[3] : (d & 7) == 4 ? cs[4] : (d & 7) == 5 ? cs[5] : (d & 7) == 6 ? cs[6] : cs[7];
              const float s = (d & 7) == 0 ? sn[0] : (d & 7) == 1 ? sn[1] : (d & 7) == 2 ? sn[2] : (d & 7) == 3 ? sn[3] : (d & 7) == 4 ? sn[4] : (d & 7) == 5 ? sn[5] : (d & 7) == 6 ? sn[6] : sn[7];
              y = d < 8 ? y * c - yp * s : y * c + yp * s; }
          knew[h * 64 + d] = y; vnew[h * 64 + d] = bf2f(PROJ[prow + C_V + h * 64 + d]); } }
    __syncthreads();
    float sa = 0.f, sb = 0.f, sn_ = 0.f;
    { const float* ka = ck + (size_t)(lane * 2 + kvh) * 64; const float* kb = ck + (size_t)((lane + 64) * 2 + kvh) * 64;
#pragma unroll
      for (int c = 0; c < 16; ++c) { const f32x4 x = *(const GAS f32x4*)(ka + 4 * c), y = *(const GAS f32x4*)(kb + 4 * c); const f32x4 qv = *(const LAS f32x4*)(qs + h * 64 + 4 * c), kn = *(const LAS f32x4*)(knew + kvh * 64 + 4 * c);
          sa += (qv.x * x.x + qv.y * x.y) + (qv.z * x.z + qv.w * x.w); sb += (qv.x * y.x + qv.y * y.y) + (qv.z * y.z + qv.w * y.w); sn_ += (qv.x * kn.x + qv.y * kn.y) + (qv.z * kn.z + qv.w * kn.w); } }
    const float sink = ARGIN(11)[l * 8 + h];
    const float mx = fmaxf(fmaxf(wave_max(fmaxf(sa, sb)), sn_), sink);
    const float ea = expf(sa - mx), eb = expf(sb - mx), en = expf(sn_ - mx);
    const float inv = 1.0f / (wave_sum(ea + eb) + en + expf(sink - mx));
    ps[h * 132 + lane] = ea * inv; ps[h * 132 + 64 + lane] = eb * inv; if (lane == 0) ps[h * 132 + 128] = en * inv;
    __syncthreads();
    { float o = ps[h * 132 + 128] * vnew[kvh * 64 + lane];
      for (int j = 0; j < 128; ++j) o += ps[h * 132 + j] * cv[(size_t)(j * 2 + kvh) * 64 + lane];
      ((unsigned short*)MIXED)[(size_t)(MP + b) * DM + h * 64 + lane] = (unsigned short)f2bf(o); }
    float* sk = ARGOUT() + O_SK + (size_t)(l * MS + b) * 128 * 128; float* sv = ARGOUT() + O_SV + (size_t)(l * MS + b) * 128 * 128;
    for (int idx = tid * 4; idx < 128 * 128; idx += NTHR * 4) { const int j = idx >> 7, rem = idx & 127;
        f32x4 kk, vv;
        if (j < 127) { kk = *(const GAS f32x4*)(ck + idx + 128); vv = *(const GAS f32x4*)(cv + idx + 128); }
        else { kk = *(const LAS f32x4*)(knew + rem); vv = *(const LAS f32x4*)(vnew + rem); }
        *(GAS f32x4*)(sk + idx) = kk; *(GAS f32x4*)(sv + idx) = vv; }
}

__device__ __forceinline__ bool queue_next(Frame& F, gu32* head, int& it) {
    volatile LAS unsigned* slot = F.MISC + 16;
    __syncthreads();
    if (F.tid == 0) slot[0] = __hip_atomic_fetch_add(head, 1u, RLX_AGENT);
    __syncthreads();
    it = (int)slot[0];
    { int t_ = threadIdx.x; asm volatile("" : "+v"(t_)); F.tid = t_; F.lane = t_ & 63; F.wave = __builtin_amdgcn_readfirstlane(t_ >> 6); }
    return true;
}
__device__ __forceinline__ void mixer_phase(Frame& F, const Args& a, int l, int qslot) {
    constexpr int N_ATP = NB * 16 * 2, N_SSDA = NB * 2 * 16 * 2, N_MLA = NB * 4 * 16, N_SSDS = MS * 2, N_MLS = MS * 4, N_ATS = MS;
    constexpr int E0 = N_ATP, E1 = E0 + N_SSDA, E2 = E1 + N_MLA, E3 = E2 + N_SSDS, E4 = E3 + N_MLS, E5 = E4 + N_ATS;
    gu32* head = F.ctl + CW_QUEUE + 64 * qslot;
    for (;;) {
        int it; queue_next(F, head, it);
        if (it >= E5) break;
        if (it < E0) attn_mfma_item(F, l, it >> 5, (it >> 1) & 15, it & 1);
        else if (it < E1) { const int r = it - E0; ssd_a_item(F, l, r >> 6, (r >> 5) & 1, (r >> 1) & 15, r & 1); }
        else if (it < E2) { const int r = it - E1; mlstm_a_item(F, l, r >> 6, (r >> 4) & 3, r & 15); }
        else if (it < E3) { const int r = it - E2; ssd_sample_item(F, l, r >> 1, r & 1); }
        else if (it < E4) { const int r = it - E3; mlstm_sample_item(F, l, r >> 2, r & 3); }
        else attn_sample_item(F, a, l, it - E4);
    }
}
__device__ __forceinline__ void mixer_c_phase(Frame& F, int l, int qslot) {
    constexpr int N_SSDC = NB * 2 * 16, N_MLC = NB * 4 * 16;
    gu32* head = F.ctl + CW_QUEUE + 64 * qslot;
    for (;;) {
        int it; queue_next(F, head, it);
        if (it >= N_SSDC + N_MLC) break;
        if (it < N_SSDC) ssd_c_item(F, l, it >> 5, (it >> 4) & 1, it & 15);
        else { const int r = it - N_SSDC; mlstm_c_item(F, l, r >> 6, (r >> 4) & 3, r & 15); }
    }
}

__device__ __forceinline__ void finalize_phase(Frame& F, const Args& a, int l) {
    const bf16* PROJ = (const bf16*)(ARGWS() + WS_PROJ); bf16* MIXED = (bf16*)(ARGWS() + WS_MIXED); const float* YG = (const float*)(ARGWS() + WS_YG); const float* HR = (const float*)(ARGWS() + WS_HR);
    const float* wssm = ARGIN(17) + (size_t)l * 1024; const float* wml = ARGIN(20) + (size_t)l * 512;
    const int gw = F.vcu * NWAVES + F.wave, NGW = F.G * NWAVES, lane = F.lane;
    for (int row = MP + gw; row < MT; row += NGW) {
#pragma unroll
        for (int g = 0; g < 2; ++g) { const float* src = YG + (size_t)row * 1024 + g * 512 + lane * 8; const f32x4 u0 = *(const GAS f32x4*)src, u1 = *(const GAS f32x4*)(src + 4);
            float ss = (u0.x * u0.x + u0.y * u0.y) + (u0.z * u0.z + u0.w * u0.w) + (u1.x * u1.x + u1.y * u1.y) + (u1.z * u1.z + u1.w * u1.w);
            ss = wave_sum(ss); const float rs = 1.0f / sqrtf(ss * (1.0f / 512.0f) + 1e-6f);
            const float* wp = wssm + g * 512 + lane * 8; const f32x4 w0 = *(const GAS f32x4*)wp, w1 = *(const GAS f32x4*)(wp + 4);
            float o[8] = {u0.x * rs * w0.x, u0.y * rs * w0.y, u0.z * rs * w0.z, u0.w * rs * w0.w, u1.x * rs * w1.x, u1.y * rs * w1.y, u1.z * rs * w1.z, u1.w * rs * w1.w};
            *(GAS v4u*)(MIXED + (size_t)row * DM + 512 + g * 512 + lane * 8) = pack8(o); }
#pragma unroll
        for (int hh = 0; hh < 4; ++hh) { const float* src = HR + (size_t)row * 512 + hh * 128 + lane * 2; const float v0 = src[0], v1 = src[1];
            const float ss = wave_sum(v0 * v0 + v1 * v1), rs = 1.0f / sqrtf(ss * (1.0f / 128.0f) + 1e-6f);
            const unsigned mo = *(const GAS unsigned*)(PROJ + (size_t)row * NINP + C_MO + hh * 128 + lane * 2);
            const float o0 = v0 * rs * wml[hh * 128 + lane * 2] * sigmoidf_(bflo(mo)), o1 = v1 * rs * wml[hh * 128 + lane * 2 + 1] * sigmoidf_(bfhi(mo));
            *(GAS unsigned*)(MIXED + (size_t)row * DM + 1536 + hh * 128 + lane * 2) = pk2(o0, o1); }
    }
}

__device__ __forceinline__ void final_norm_phase(Frame& F, const Args& a) {
    const float* SSQ = (const float*)(ARGWS() + WS_SSQA); const float* wf = ARGIN(25);
    const int gw = F.vcu * NWAVES + F.wave, NGW = F.G * NWAVES, lane = F.lane;
    for (int row = gw; row < MT; row += NGW) {
        const f32x4 p0 = *(const GAS f32x4*)(SSQ + (size_t)row * 8), p1 = *(const GAS f32x4*)(SSQ + (size_t)row * 8 + 4);
        const float ss = ((p0.x + p0.y) + (p0.z + p0.w)) + ((p1.x + p1.y) + (p1.z + p1.w)), rs = 1.0f / sqrtf(ss * (1.0f / 2048.0f) + 1e-6f);
        GAS f32x4* y = (GAS f32x4*)(ARGOUT() + O_Y + (size_t)row * DM) + lane; const GAS f32x4* wv = (const GAS f32x4*)wf + lane;
#pragma unroll
        for (int j = 0; j < 8; ++j) { const f32x4 v = y[64 * j], g = wv[64 * j]; y[64 * j] = (f32x4){v.x * rs * g.x, v.y * rs * g.y, v.z * rs * g.z, v.w * rs * g.w}; }
    }
}

#ifndef MK_N_LAUNCHES
#define MK_N_LAUNCHES 1
#endif
constexpr int N_PHASES = 16;
#ifndef MK_REP_G1
#define MK_REP_G1 1
#endif
#ifndef MK_REP_G3
#define MK_REP_G3 1
#endif
#ifndef MK_REP_M1
#define MK_REP_M1 1
#endif
#ifndef MK_REP_M3
#define MK_REP_M3 1
#endif
__global__ void __launch_bounds__(NTHR, 2) mk_fwd(Args args) {
    extern __shared__ __attribute__((aligned(16))) unsigned char lds[];
    Frame F;
    F.lds = (LAS unsigned char*)lds;
    F.MISC = (volatile LAS unsigned*)(F.lds + MISC_OFF);
    F.tid = threadIdx.x; F.lane = F.tid & 63; F.wave = __builtin_amdgcn_readfirstlane(F.tid >> 6);
    F.G = gridDim.x; { const int bx = blockIdx.x; F.vcu = (F.G % 8 == 0) ? (bx % 8) * (F.G / 8) + bx / 8 : bx; }
    unsigned char* ws = ARGWS();
    F.ctl = (gu32*)(ws + WS_CTL);
    for (int u = F.tid; u < (LDS_BYTES - LDSCTL_OFF) / 4; u += NTHR) ((LAS unsigned*)(F.lds + LDSCTL_OFF))[u] = 0u;
    __syncthreads();
    const int lo = args.ph_lo, hi = args.ph_hi;
    const bool use_bar = (hi - lo) > 1;
    XcdBarrier bar; bar.bar = (unsigned*)(F.ctl + CW_BAR); bar.x = 0; bar.st = nullptr;
    if (use_bar) bar = xcd_barrier_post((unsigned*)(F.ctl + CW_BAR), F.MISC + 8);
#define IN(k) (lo <= (k) && (k) < hi)
#define PHASE_BEGIN() do { int t_ = threadIdx.x, v_ = vcu0, g_ = G0; asm volatile("" : "+v"(t_)); asm volatile("" : "+s"(v_), "+s"(g_)); F.tid = t_; F.lane = t_ & 63; F.wave = __builtin_amdgcn_readfirstlane(t_ >> 6); F.vcu = v_; F.G = g_; } while (0)
#define SEAM(k) do { if (IN(k) && IN((k) + 1)) xcd_barrier(bar); } while (0)

#define WSP(T, off) ((T*)(ARGWS() + (off)))
#define DECL_WS() bf16* XB = WSP(bf16, WS_XB); float* XRES = WSP(float, WS_XRES); bf16* HBUF = WSP(bf16, WS_HBUF); bf16* PROJ = WSP(bf16, WS_PROJ); bf16* MIXED = WSP(bf16, WS_MIXED); \
    float* SSQA = WSP(float, WS_SSQA); float* SSQB = WSP(float, WS_SSQB); \
    const bf16* Wi = WSP(const bf16, WS_WIN + l * WIN_BYTES); const bf16* Wo = WSP(const bf16, WS_WOUT + l * WOUT_BYTES); const bf16* Wu = WSP(const bf16, WS_WUP + l * WUP_BYTES); const bf16* Wd = WSP(const bf16, WS_WDN + l * WDN_BYTES); \
    (void)XB; (void)XRES; (void)HBUF; (void)PROJ; (void)MIXED; (void)SSQA; (void)SSQB; (void)Wi; (void)Wo; (void)Wu; (void)Wd

    const int vcu0 = F.vcu, G0 = F.G;
    if (IN(0)) { PHASE_BEGIN(); p0_prologue(F, args); }
    SEAM(0);
    for (int l = 0; l < DEPTH; ++l) {
        const int pb = 1 + 7 * l;
        for (int rep_ = 0; rep_ < MK_REP_G1; ++rep_) if (IN(pb)) { if (rep_) xcd_barrier(bar); PHASE_BEGIN(); DECL_WS();
            pg8::Gemm g{XB, Wi, MPAD, NINP, DM}; pg8::StaticOrder S; S.init(MPAD, NINP, F.G, (int)blockIdx.x);
            pg8::EpiScaleBf16<0> E{PROJ, NINP, SSQA};
            pg8::gemm_phase<pg8::EpiScaleBf16<0>, pg8::StaticOrder, true, true>(F.lds + RING_OFF, g, S, E, F.tid);
            if (blockIdx.x == 0) for (int i = F.tid; i < MS * 8; i += NTHR) SSQB[(size_t)MP * 8 + i] = 0.f;
        }
        SEAM(pb);
        for (int rep_ = 0; rep_ < MK_REP_M1; ++rep_) if (IN(pb + 1)) { if (rep_) xcd_barrier(bar); PHASE_BEGIN(); mixer_phase(F, args, l, l + 4 * rep_); }

        SEAM(pb + 1);
        if (IN(pb + 2)) { PHASE_BEGIN(); mlstm_scan_phase(F, l); ssd_scan_phase(F, l); }
        SEAM(pb + 2);
        for (int rep_ = 0; rep_ < MK_REP_M3; ++rep_) if (IN(pb + 3)) { if (rep_) xcd_barrier(bar); PHASE_BEGIN(); mixer_c_phase(F, l, 2 + l + 4 * rep_); }
        SEAM(pb + 3);
        if (IN(pb + 4)) { PHASE_BEGIN(); DECL_WS();
            const float* basep = l == 0 ? ARGIN(0) : XRES; const float* bases = l == 0 ? ARGIN(1) : XRES + (size_t)MP * DM;
            pg8::Gemm g{MIXED, Wo, MP, DM, DM}; pg8::StaticOrder S; S.init(MP, DM, F.G, (int)blockIdx.x);
            pg8::EpiResid E{basep, XRES, XB, SSQB, DM};
            pg8::gemm_phase<pg8::EpiResid, pg8::StaticOrder, false, true>(F.lds + RING_OFF, g, S, E, F.tid);
            float* outs = XRES + (size_t)MP * DM; bf16* xbs = XB + (size_t)MP * DM; float* sq = SSQB + (size_t)MP * 8;
            thin_gemm(F, MIXED + (size_t)MP * DM, DM, Wo, DM, DM, [&](int row, int col, f32x4 acc) {
                const f32x4 bs = *(const GAS f32x4*)(bases + (size_t)row * DM + col); const f32x4 o = bs + acc;
                *(GAS f32x4*)(outs + (size_t)row * DM + col) = o;
                *(GAS unsigned long long*)(xbs + (size_t)row * DM + col) = (unsigned long long)pk2(o.x, o.y) | ((unsigned long long)pk2(o.z, o.w) << 32);
                float s = (o.x * o.x + o.y * o.y) + (o.z * o.z + o.w * o.w); s += __shfl_xor(s, 16); s += __shfl_xor(s, 32);
                if ((F.lane >> 4) == 0) atomicAdd(sq + (size_t)row * 8 + ((col >> 4) & 7), s); });
            if (blockIdx.x == 0) for (int i = F.tid; i < MS * 8; i += NTHR) SSQA[(size_t)MP * 8 + i] = 0.f;
        }
        SEAM(pb + 4);
        for (int rep_ = 0; rep_ < MK_REP_G3; ++rep_) if (IN(pb + 5)) { if (rep_) xcd_barrier(bar); PHASE_BEGIN(); DECL_WS();
            pg8::Gemm g{XB, Wu, MP, FF, DM}; pg8::StaticOrder S; S.init(MP, FF, F.G, (int)blockIdx.x);
            pg8::EpiScaleBf16<1> E{HBUF, FF, SSQB};
            pg8::gemm_phase<pg8::EpiScaleBf16<1>, pg8::StaticOrder, true, true>(F.lds + RING_OFF, g, S, E, F.tid);
            bf16* hs = HBUF + (size_t)MP * FF; const float* sq = SSQB + (size_t)MP * 8;
            thin_gemm(F, XB + (size_t)MP * DM, DM, Wu, FF, DM, [&](int row, int col, f32x4 acc) {
                const f32x4 p0 = *(const GAS f32x4*)(sq + (size_t)row * 8), p1 = *(const GAS f32x4*)(sq + (size_t)row * 8 + 4);
                const float ss = ((p0.x + p0.y) + (p0.z + p0.w)) + ((p1.x + p1.y) + (p1.z + p1.w)), rs = 1.0f / sqrtf(ss * (1.0f / 2048.0f) + 1e-6f);
                f32x4 v = acc * rs; v.x = fmaxf(v.x, 0.f); v.y = fmaxf(v.y, 0.f); v.z = fmaxf(v.z, 0.f); v.w = fmaxf(v.w, 0.f);
                *(GAS unsigned long long*)(hs + (size_t)row * FF + col) = (unsigned long long)pk2(v.x * v.x, v.y * v.y) | ((unsigned long long)pk2(v.z * v.z, v.w * v.w) << 32); });
        }
        SEAM(pb + 5);
        if (IN(pb + 6)) { PHASE_BEGIN(); DECL_WS();
            const bool lastl = (l == DEPTH - 1);
            float* outp = lastl ? ARGOUT() + O_Y : XRES; float* outs = lastl ? ARGOUT() + O_Y + (size_t)MP * DM : XRES + (size_t)MP * DM;
            pg8::Gemm g{HBUF, Wd, MP, DM, FF}; pg8::StaticOrder S; S.init(MP, DM, F.G, (int)blockIdx.x);
            pg8::EpiResid E{XRES, outp, lastl ? (bf16*)nullptr : XB, SSQA, DM};
            pg8::gemm_phase<pg8::EpiResid, pg8::StaticOrder, false, true>(F.lds + RING_OFF, g, S, E, F.tid);
            const float* bases = XRES + (size_t)MP * DM; bf16* xbs = XB + (size_t)MP * DM; float* sq = SSQA + (size_t)MP * 8;
            thin_gemm(F, HBUF + (size_t)MP * FF, FF, Wd, DM, FF, [&](int row, int col, f32x4 acc) {
                const f32x4 bs = *(const GAS f32x4*)(bases + (size_t)row * DM + col); const f32x4 o = bs + acc;
                *(GAS f32x4*)(outs + (size_t)row * DM + col) = o;
                if (!lastl) *(GAS unsigned long long*)(xbs + (size_t)row * DM + col) = (unsigned long long)pk2(o.x, o.y) | ((unsigned long long)pk2(o.z, o.w) << 32);
                float s = (o.x * o.x + o.y * o.y) + (o.z * o.z + o.w * o.w); s += __shfl_xor(s, 16); s += __shfl_xor(s, 32);
                if ((F.lane >> 4) == 0) atomicAdd(sq + (size_t)row * 8 + ((col >> 4) & 7), s); });
        }
        SEAM(pb + 6);
    }
    if (IN(15)) { PHASE_BEGIN(); final_norm_phase(F, args); }
#undef IN
#undef SEAM
}

extern "C" void kernel_launch(void* const* d_in, const int* in_sizes, int n_in, void* d_out, int out_size, void* d_ws, size_t ws_size, hipStream_t stream) {
    static int grid = 0;
    if (grid == 0) {
        if (n_in != 26 || (size_t)out_size != O_END || ws_size < WS_END2) { fprintf(stderr, "kernel_launch: expected 26 inputs, %zu outputs, >= %zu bytes of workspace; got %d, %d, %zu\n", (size_t)O_END, (size_t)WS_END2, n_in, out_size, ws_size); grid = -1; return; }
        int dev = 0, cus = 0, per_cu = 0;
        if (hipGetDevice(&dev) != hipSuccess || hipDeviceGetAttribute(&cus, hipDeviceAttributeMultiprocessorCount, dev) != hipSuccess) { grid = -1; return; }
        if (hipFuncSetAttribute((const void*)mk_fwd, hipFuncAttributeMaxDynamicSharedMemorySize, LDS_BYTES) != hipSuccess) { fprintf(stderr, "kernel_launch: hipFuncSetAttribute failed\n"); grid = -1; return; }
        if (hipOccupancyMaxActiveBlocksPerMultiprocessor(&per_cu, (const void*)mk_fwd, NTHR, LDS_BYTES) != hipSuccess || per_cu < 1) { fprintf(stderr, "kernel_launch: occupancy query says %d blocks per CU\n", per_cu); per_cu = 1; }
        (void)hipGetLastError();
        grid = cus;
        if (grid != 256) fprintf(stderr, "kernel_launch: %d CUs; the G2/G4 phases assume 256 workgroups\n", grid);
    }
    if (grid < 0) return;
    (void)hipMemsetAsync((char*)d_ws + WS_CTL, 0, CTL_ZERO_BYTES, stream);
    Args a{};
    for (int i = 0; i < 26; ++i) a.in[i] = (const float*)d_in[i];
    a.out = (float*)d_out; a.ws = (unsigned char*)d_ws;
#if MK_N_LAUNCHES == 1
    a.ph_lo = 0; a.ph_hi = N_PHASES;
    hipLaunchKernelGGL(mk_fwd, dim3(grid), dim3(NTHR), LDS_BYTES, stream, a);
#else
    for (int p = 0; p < N_PHASES; ++p) { a.ph_lo = p; a.ph_hi = p + 1; hipLaunchKernelGGL(mk_fwd, dim3(grid), dim3(NTHR), LDS_BYTES, stream, a); }
#endif
}
```

```cpp
#include <hip/hip_runtime.h>
#include <cstdio>
#include <cstdint>
namespace pg8 {
#define PG8_LAS __attribute__((address_space(3)))
typedef unsigned short bf16_t;
typedef short bf16x8 __attribute__((ext_vector_type(8)));
typedef float f32x4 __attribute__((ext_vector_type(4)));
typedef unsigned u32x4 __attribute__((ext_vector_type(4)));
constexpr int BM = 256, BK = 64, HALF = 128, HTB = HALF * BK * 2  , STAGE_BYTES = 8 * HTB, NXCD = 8, WGM = 8;

__host__ __device__ __forceinline__ int lds_byte(int r, int c) { const int st = (r >> 4) * 2 + (c >> 5), rr = r & 15, cc = c & 31, ob = rr * 64 + cc * 2; return st * 1024 + (ob ^ (((ob >> 9) & 1) << 5)); }
__host__ __device__ __forceinline__ void stage_rc(int b, int& R, int& C) { const int st = b / 1024, sb = b % 1024, swz = sb ^ (((sb >> 9) & 1) << 5); R = (st >> 1) * 16 + swz / 64; C = (st & 1) * 32 + (swz % 64) / 2; }
__host__ __device__ __forceinline__ int perm32(int rho) { const int n = rho >> 4, i = rho & 15; return 8 * (i >> 2) + 4 * n + (i & 3); }

struct Unit { int pm, pn; };
struct Gemm { const bf16_t* A; const bf16_t* Bt; int M, N, K; };

struct StaticOrder {
    int nM, nN, nwg, G, c;
    __host__ __device__ void init(int M, int N, int G_, int c_) { nM = M / BM; nN = N / BM; nwg = nM * nN; G = G_; c = c_; }
    __host__ __device__ bool next(int i, Unit& u) const {
        const long L = (long)i * G + c; if (L >= nwg) return false;
        int wgid = (int)L; { const int q = nwg / NXCD, r = nwg % NXCD, xcd = wgid % NXCD, off = wgid / NXCD; wgid = (xcd < r ? xcd * (q + 1) : r * (q + 1) + (xcd - r) * q) + off; }
        const int nig = WGM * nN, gid = wgid / nig, fm = gid * WGM, gsz = (nM - fm) < WGM ? (nM - fm) : WGM;
        u.pm = fm + ((wgid % nig) % gsz); u.pn = (wgid % nig) / gsz; return true;
    }
    __device__ __forceinline__ void a_ready(const Unit&) const {}
    __device__ __forceinline__ void done(const Unit&) const {}
};


__device__ __forceinline__ unsigned cvt_pk_bf16(float lo, float hi) { unsigned r; asm volatile("v_cvt_pk_bf16_f32 %0, %1, %2" : "=v"(r) : "v"(lo), "v"(hi)); return r; }

template <int ACT> struct EpiScaleBf16 {
    static constexpr bool PERM = true, AFTER_DRAIN = false;
    bf16_t* O; int ldc; const float* ssq;
    __device__ __forceinline__ void operator()(const f32x4 (&acc)[2][2][4][2], const Unit& u, int wr, int wc, int fr, int fq) const {
        const int row0 = u.pm * BM + wr * 64 + fr, col0 = u.pn * BM + wc * 32 + 8 * fq;
#pragma unroll
        for (int ai = 0; ai < 2; ++ai)
#pragma unroll
            for (int m = 0; m < 4; ++m) { const int row = row0 + ai * HALF + m * 16;
                const f32x4 p0 = *(const f32x4*)(ssq + (size_t)row * 8), p1 = *(const f32x4*)(ssq + (size_t)row * 8 + 4);
                const float ss = ((p0[0] + p0[1]) + (p0[2] + p0[3])) + ((p1[0] + p1[1]) + (p1[2] + p1[3]));
                const float rs = 1.0f / sqrtf(ss * (1.0f / 2048.0f) + 1e-6f);
                bf16_t* rowp = O + (size_t)row * ldc + col0;
#pragma unroll
                for (int bj = 0; bj < 2; ++bj) { f32x4 v0 = acc[ai][bj][m][0] * rs, v1 = acc[ai][bj][m][1] * rs;
                    if (ACT == 1) {
#pragma unroll
                        for (int e = 0; e < 4; ++e) { const float a = fmaxf(v0[e], 0.f), b = fmaxf(v1[e], 0.f); v0[e] = a * a; v1[e] = b * b; } }
                    u32x4 w; w.x = cvt_pk_bf16(v0[0], v0[1]); w.y = cvt_pk_bf16(v0[2], v0[3]); w.z = cvt_pk_bf16(v1[0], v1[1]); w.w = cvt_pk_bf16(v1[2], v1[3]);
                    *(u32x4*)(rowp + bj * HALF) = w; } }
    }
};

struct EpiResid {
    static constexpr bool PERM = false, AFTER_DRAIN = true;
    const float* base; float* out; bf16_t* xb; float* ssq; int ld;
    __device__ __forceinline__ void fused(f32x4 (&acc)[2][2][4][2], const Unit& u, int wr, int wc, int fr, int fq, PG8_LAS unsigned char* lds, int wid, int lane) const {
        typedef unsigned u32x2v __attribute__((ext_vector_type(2)));
        PG8_LAS float* P = (PG8_LAS float*)lds;
        const int col0 = u.pn * BM + wc * 32 + 4 * fq;
#pragma unroll
        for (int ai = 0; ai < 2; ++ai)
#pragma unroll
            for (int m = 0; m < 4; ++m) { const int r = ai * HALF + wr * 64 + m * 16 + fr; const size_t off = (size_t)(u.pm * BM + r) * ld + col0; float s = 0.f;
#pragma unroll
                for (int bj = 0; bj < 2; ++bj)
#pragma unroll
                    for (int n = 0; n < 2; ++n) { const f32x4 bs = *(const f32x4*)(base + off + bj * HALF + n * 16); const f32x4 o = bs + acc[ai][bj][m][n];
                        *(f32x4*)(out + off + bj * HALF + n * 16) = o;
                        if (xb) { u32x2v w; w.x = cvt_pk_bf16(o[0], o[1]); w.y = cvt_pk_bf16(o[2], o[3]); *(u32x2v*)(xb + off + bj * HALF + n * 16) = w; }
                        s += (o[0] * o[0] + o[1] * o[1]) + (o[2] * o[2] + o[3] * o[3]); }
                s += __shfl_xor(s, 16); s += __shfl_xor(s, 32);
                if (fq == 0) P[r * 4 + wc] = s;
                if (m & 1) asm volatile("" ::: "memory"); }
        asm volatile("s_waitcnt lgkmcnt(0)" ::: "memory"); __builtin_amdgcn_s_barrier(); asm volatile("" ::: "memory");
        const int t = wid * 64 + lane;
        if (t < 256) { const float s = (P[t * 4 + 0] + P[t * 4 + 1]) + (P[t * 4 + 2] + P[t * 4 + 3]); ssq[(size_t)(u.pm * BM + t) * 8 + u.pn] = s; }
        asm volatile("s_waitcnt lgkmcnt(0)" ::: "memory"); __builtin_amdgcn_s_barrier(); asm volatile("" ::: "memory");
    }
};
template <class Epi, class Sched, bool ALIGN_EPI = false, bool SP2 = false>
__device__ __forceinline__ void gemm_phase(PG8_LAS unsigned char* lds, const Gemm g, const Sched& S, const Epi& E, const int tid) {
    const int  wid = __builtin_amdgcn_readfirstlane(tid >> 6), lane = tid & 63, wr = wid >> 2, wc = wid & 3, fr = lane & 15, fq = lane >> 4;
    const int K = g.K, nt = K / BK;
    unsigned voffA[2], voffB[2];
#pragma unroll
    for (int i = 0; i < 2; ++i) { int R, C; stage_rc(tid * 16 + i * 8192, R, C); const int Rb = Epi::PERM ? ((R & ~31) + perm32(R & 31)) : R;
        voffA[i] = (unsigned)(R * K + C) * 2u; voffB[i] = (unsigned)(Rb * K + C) * 2u; }
    const size_t kstep = (size_t)(BK * 2);
    const size_t hstep = (size_t)HALF * K * 2;
    const size_t tstep = 2 * hstep;
    const unsigned ldsw = (unsigned)wid * 1024u;
    const int aoff = lds_byte(wr * 64 + fr, fq * 8), boff = lds_byte(wc * 32 + fr, fq * 8);
#define PG8_SA(b, h) (((b) * 2 + (h)) * HTB)
#define PG8_SB(b, h) ((4 + (b) * 2 + (h)) * HTB)
#define PG8_STAGE(bufoff, gbase, voff) do { _Pragma("unroll") for (int _i = 0; _i < 2; ++_i) \
        __builtin_amdgcn_global_load_lds((const unsigned*)((const char*)(gbase) + (voff)[_i]), (PG8_LAS unsigned*)(lds + (bufoff) + ldsw + _i * 8192), 16, 0, 0); } while (0)
#define PG8_LDA(dst, b, h) do { _Pragma("unroll") for (int m = 0; m < 4; ++m) _Pragma("unroll") for (int k = 0; k < 2; ++k) dst[m][k] = *(const PG8_LAS bf16x8*)(lds + PG8_SA(b, h) + aoff + m * 2048 + k * 1024); } while (0)
#define PG8_LDB(dst, b, h) do { _Pragma("unroll") for (int n = 0; n < 2; ++n) _Pragma("unroll") for (int k = 0; k < 2; ++k) dst[n][k] = *(const PG8_LAS bf16x8*)(lds + PG8_SB(b, h) + boff + n * 2048 + k * 1024); } while (0)
#define PG8_MMA(ai, bj, At, Bt) do { __builtin_amdgcn_s_setprio(1); _Pragma("unroll") for (int m = 0; m < 4; ++m) _Pragma("unroll") for (int n = 0; n < 2; ++n) _Pragma("unroll") for (int k = 0; k < 2; ++k) \
        acc[ai][bj][m][n] = __builtin_amdgcn_mfma_f32_16x16x32_bf16(Bt[n][k], At[m][k], acc[ai][bj][m][n], 0, 0, 0); __builtin_amdgcn_s_setprio(0); } while (0)
#define PG8_WAIT_V(n) asm volatile("s_waitcnt vmcnt(" #n ")" ::: "memory")
#define PG8_WAIT_L(n) asm volatile("s_waitcnt lgkmcnt(" #n ")" ::: "memory")
#define PG8_BAR __builtin_amdgcn_s_barrier()
#define PG8_SCHED __builtin_amdgcn_sched_barrier(0)
    Unit cur, nxt; int ui = 0;
    if (!S.next(0, cur)) return;
    f32x4 acc[2][2][4][2];
#pragma unroll
    for (int a = 0; a < 2; ++a)
#pragma unroll
        for (int b = 0; b < 2; ++b)
#pragma unroll
            for (int m = 0; m < 4; ++m)
#pragma unroll
                for (int n = 0; n < 2; ++n) acc[a][b][m][n] = (f32x4){0.f, 0.f, 0.f, 0.f};
    bf16x8 At[4][2], B0[2][2], B1[2][2];
    const char* cA = (const char*)g.A + (size_t)cur.pm * tstep; const char* cB = (const char*)g.Bt + (size_t)cur.pn * tstep;
    S.a_ready(cur);
    if constexpr (SP2) {
        PG8_STAGE(PG8_SB(0, 0), cB, voffB); PG8_STAGE(PG8_SB(0, 1), cB + hstep, voffB); PG8_STAGE(PG8_SA(0, 0), cA, voffA); PG8_STAGE(PG8_SA(0, 1), cA + hstep, voffA);
        if (wr == 1) PG8_BAR;
        PG8_WAIT_V(2); PG8_BAR;
        PG8_STAGE(PG8_SB(1, 0), cB + kstep, voffB); PG8_STAGE(PG8_SA(1, 0), cA + kstep, voffA); PG8_STAGE(PG8_SB(1, 1), cB + hstep + kstep, voffB);
        PG8_WAIT_V(6); PG8_BAR;
    } else {
        PG8_STAGE(PG8_SB(0, 0), cB, voffB); PG8_STAGE(PG8_SA(0, 0), cA, voffA); PG8_STAGE(PG8_SB(0, 1), cB + hstep, voffB); PG8_STAGE(PG8_SA(0, 1), cA + hstep, voffA);
        if (wr == 1) PG8_BAR;
        PG8_WAIT_V(4); PG8_BAR;
        PG8_STAGE(PG8_SB(1, 0), cB + kstep, voffB); PG8_STAGE(PG8_SA(1, 0), cA + kstep, voffA); PG8_STAGE(PG8_SB(1, 1), cB + hstep + kstep, voffB);
        PG8_WAIT_V(6); PG8_BAR;
    }
    for (;;) {
        const bool has_next = S.next(ui + 1, nxt);
        const char* nA = has_next ? (const char*)g.A + (size_t)nxt.pm * tstep : cA; const char* nB = has_next ? (const char*)g.Bt + (size_t)nxt.pn * tstep : cB;
        for (int t = 0; t < nt; t += 2) {
            const bool last = (t == nt - 2);
            const char* a1 = cA + (size_t)(t + 1) * kstep;
            const char* a2 = last ? nA : cA + (size_t)(t + 2) * kstep; const char* b2 = last ? nB : cB + (size_t)(t + 2) * kstep;
            const char* a3 = a2 + kstep; const char* b3 = b2 + kstep;
            if (last && has_next) S.a_ready(nxt);
            if constexpr (SP2) {
            PG8_LDB(B0, 0, 0); PG8_LDB(B1, 0, 1); PG8_SCHED; PG8_LDA(At, 0, 0); PG8_STAGE(PG8_SA(1, 1), a1 + hstep, voffA);
            PG8_WAIT_V(8); PG8_WAIT_L(0); PG8_BAR; PG8_MMA(0, 0, At, B0); PG8_MMA(0, 1, At, B1); PG8_BAR; PG8_SCHED;
            PG8_LDA(At, 0, 1); PG8_STAGE(PG8_SB(0, 0), b2, voffB); PG8_STAGE(PG8_SB(0, 1), b2 + hstep, voffB); PG8_STAGE(PG8_SA(0, 0), a2, voffA);
            PG8_WAIT_V(8); PG8_WAIT_L(0); PG8_BAR; PG8_MMA(1, 0, At, B0); PG8_MMA(1, 1, At, B1); PG8_BAR; PG8_SCHED;
            PG8_LDB(B0, 1, 0); PG8_LDB(B1, 1, 1); PG8_SCHED; PG8_LDA(At, 1, 0); PG8_STAGE(PG8_SA(0, 1), a2 + hstep, voffA);
            PG8_WAIT_V(8); PG8_WAIT_L(0); PG8_BAR; PG8_MMA(0, 0, At, B0); PG8_MMA(0, 1, At, B1); PG8_BAR; PG8_SCHED;
            PG8_LDA(At, 1, 1); PG8_STAGE(PG8_SB(1, 0), b3, voffB); PG8_STAGE(PG8_SB(1, 1), b3 + hstep, voffB); PG8_STAGE(PG8_SA(1, 0), a3, voffA);
            PG8_WAIT_V(8); PG8_WAIT_L(0); PG8_BAR; PG8_MMA(1, 0, At, B0); PG8_MMA(1, 1, At, B1); PG8_BAR; PG8_SCHED;
            } else {
            PG8_LDB(B0, 0, 0); PG8_SCHED; PG8_LDA(At, 0, 0); PG8_STAGE(PG8_SA(1, 1), a1 + hstep, voffA);
            PG8_WAIT_L(8); PG8_BAR; PG8_WAIT_L(0); PG8_MMA(0, 0, At, B0); PG8_BAR; PG8_SCHED;
            PG8_LDB(B1, 0, 1); PG8_STAGE(PG8_SB(0, 0), b2, voffB);
            PG8_BAR; PG8_WAIT_L(0); PG8_MMA(0, 1, At, B1); PG8_BAR;
            PG8_LDA(At, 0, 1); PG8_STAGE(PG8_SA(0, 0), a2, voffA);
            PG8_BAR; PG8_WAIT_L(0); PG8_MMA(1, 0, At, B0); PG8_BAR; PG8_SCHED;
            PG8_STAGE(PG8_SB(0, 1), b2 + hstep, voffB);
            PG8_WAIT_V(6); PG8_BAR; PG8_MMA(1, 1, At, B1); PG8_BAR;
            PG8_LDB(B0, 1, 0); PG8_SCHED; PG8_LDA(At, 1, 0); PG8_STAGE(PG8_SA(0, 1), a2 + hstep, voffA);
            PG8_WAIT_L(8); PG8_BAR; PG8_WAIT_L(0); PG8_MMA(0, 0, At, B0); PG8_BAR; PG8_SCHED;
            PG8_LDB(B1, 1, 1); PG8_STAGE(PG8_SB(1, 0), b3, voffB);
            PG8_BAR; PG8_WAIT_L(0); PG8_MMA(0, 1, At, B1); PG8_BAR;
            PG8_LDA(At, 1, 1); PG8_STAGE(PG8_SA(1, 0), a3, voffA);
            PG8_BAR; PG8_WAIT_L(0); PG8_MMA(1, 0, At, B0); PG8_BAR; PG8_SCHED;
            PG8_STAGE(PG8_SB(1, 1), b3 + hstep, voffB);
            PG8_WAIT_V(6); PG8_BAR; PG8_MMA(1, 1, At, B1); PG8_BAR;
            }
        }
        if constexpr (ALIGN_EPI) { if (wr == 0) PG8_BAR; }
        if constexpr (!Epi::AFTER_DRAIN) { E(acc, cur, wr, wc, fr, fq); S.done(cur); }
        if (!has_next) break;
#pragma unroll
        for (int a = 0; a < 2; ++a)
#pragma unroll
            for (int b = 0; b < 2; ++b)
#pragma unroll
                for (int m = 0; m < 4; ++m)
#pragma unroll
                    for (int n = 0; n < 2; ++n) acc[a][b][m][n] = (f32x4){0.f, 0.f, 0.f, 0.f};
        cur = nxt; cA = nA; cB = nB; ++ui;
        if constexpr (ALIGN_EPI) { if (wr == 1) PG8_BAR; }
    }
    PG8_WAIT_V(0);
    if constexpr (!ALIGN_EPI) { if (wr == 0) PG8_BAR; }
    PG8_BAR;
    if constexpr (Epi::AFTER_DRAIN) { E.fused(acc, cur, wr, wc, fr, fq, lds, wid, lane); S.done(cur); }
#undef PG8_SA
#undef PG8_SB
#undef PG8_STAGE
#undef PG8_LDA
#undef PG8_LDB
#undef PG8_MMA
#undef PG8_WAIT_V
#undef PG8_WAIT_L
#undef PG8_BAR
#undef PG8_SCHED
}
}

#ifndef PG8_SP2
#define PG8_SP2 true
#endif
#ifndef PG8_ALIGN
#define PG8_ALIGN true
#endif
#define GAS __attribute__((address_space(1)))
#define LAS __attribute__((address_space(3)))
typedef unsigned short bf16;
typedef unsigned v4u __attribute__((ext_vector_type(4)));
typedef float f32x4 __attribute__((ext_vector_type(4)));
typedef short bf16x8 __attribute__((ext_vector_type(8)));
typedef GAS unsigned gu32;
typedef GAS unsigned long long gu64;
#define RLX_AGENT __ATOMIC_RELAXED, __HIP_MEMORY_SCOPE_AGENT
#define LDS_WAIT() asm volatile("s_waitcnt lgkmcnt(0)" ::: "memory")
#define VM_WAIT() asm volatile("s_waitcnt vmcnt(0)" ::: "memory")
__device__ __forceinline__ unsigned long long rt() { return __builtin_amdgcn_s_memrealtime(); }
__device__ __forceinline__ unsigned f2bf(float f) { unsigned u = __builtin_bit_cast(unsigned, f); return (u + 0x7fffu + ((u >> 16) & 1u)) >> 16; }
__device__ __forceinline__ unsigned pk2(float lo, float hi) { return f2bf(lo) | (f2bf(hi) << 16); }

#define XB_TMO      128
#define XB_XCNT(j)  (256  + 64 * (j))
#define XB_XSUB(j)  (1280 + 64 * (j))
#define XB_XGEN(j)  (2304 + 64 * (j))
#define XB_TOP      3328
#define XB_TOPGEN   3392
#define XCD_BAR_WORDS 3456
#define XB_SPIN_CAP (1u << 18)

__device__ __forceinline__ unsigned xb_ld(unsigned* p)              { return __hip_atomic_load(p, __ATOMIC_RELAXED, __HIP_MEMORY_SCOPE_AGENT); }
__device__ __forceinline__ unsigned xb_add(unsigned* p, unsigned v) { return __hip_atomic_fetch_add(p, v, __ATOMIC_RELAXED, __HIP_MEMORY_SCOPE_AGENT); }
__device__ __forceinline__ unsigned xb_xcc_id() { return (unsigned)__builtin_amdgcn_s_getreg((3 << 11) | 20) & 0xFu; }
#define XB_SPIN(cond, bar) do { unsigned _sp = 0; while (cond) { __builtin_amdgcn_s_sleep(1); \
    if ((++_sp & 255u) == 0u) { if (xb_ld(&(bar)[XB_TMO])) break; if (_sp > XB_SPIN_CAP) { atomicAdd(&(bar)[XB_TMO], 1u); break; } } } } while (0)

struct XcdBarrier {
    unsigned* bar; unsigned x;
    volatile LAS unsigned* st;
};

__device__ __forceinline__ XcdBarrier xcd_barrier_post(unsigned* bar, volatile LAS unsigned* st) {
    XcdBarrier b; b.bar = bar; b.x = xb_xcc_id(); b.st = st;
    if (threadIdx.x == 0) (void)xb_add(&bar[XB_XCNT(b.x)], 1u);
    return b;
}
__device__ __forceinline__ void xcd_barrier_complete(unsigned* bar, unsigned x, unsigned& nloc, unsigned& nx) {
    const unsigned G = gridDim.x * gridDim.y * gridDim.z;
    unsigned sum, cnt, mine, sp = 0u;
    for (;;) {
        sum = 0u; cnt = 0u; mine = 0u;
#pragma unroll
        for (unsigned j = 0; j < 16; ++j) { const unsigned c = xb_ld(&bar[XB_XCNT(j)]); sum += c; cnt += (c > 0u) ? 1u : 0u; mine = (j == x) ? c : mine; }
        if (sum == G) break;
        __builtin_amdgcn_s_sleep(1);
        if ((++sp & 255u) == 0u) { if (xb_ld(&bar[XB_TMO])) break; if (sp > XB_SPIN_CAP) { atomicAdd(&bar[XB_TMO], 1u); break; } }
    }
    nloc = mine > 0u ? mine : 1u; nx = cnt > 0u ? cnt : 1u;
}

__device__ __forceinline__ void xcd_barrier(const XcdBarrier& b) {
    asm volatile("s_waitcnt vmcnt(0)" ::: "memory");
    __syncthreads();
    if (threadIdx.x == 0) {
        unsigned* bar = b.bar;
        __builtin_amdgcn_s_waitcnt(0);
        unsigned nloc = b.st[0], nx = b.st[1];
        if (nloc == 0u) { xcd_barrier_complete(bar, b.x, nloc, nx); b.st[0] = nloc; b.st[1] = nx; }
        const unsigned old = xb_add(&bar[XB_XSUB(b.x)], 1u);
        const unsigned gen = old / nloc;
        if (old + 1u == (gen + 1u) * nloc) {
            __builtin_amdgcn_fence(__ATOMIC_RELEASE, "agent");
            asm volatile("s_waitcnt vmcnt(0)" ::: "memory");
            const unsigned og = xb_add(&bar[XB_TOP], 1u);
            const unsigned tg = og / nx;
            if (og + 1u == (tg + 1u) * nx) xb_add(&bar[XB_TOPGEN], 1u);
            else XB_SPIN(xb_ld(&bar[XB_TOPGEN]) == tg, bar);
            __builtin_amdgcn_fence(__ATOMIC_ACQUIRE, "agent");
            xb_add(&bar[XB_XGEN(b.x)], 1u);
            asm volatile("s_waitcnt vmcnt(0)" ::: "memory");
        } else {
            XB_SPIN(xb_ld(&bar[XB_XGEN(b.x)]) == gen, bar);
            __builtin_amdgcn_fence(__ATOMIC_ACQUIRE, "agent");
            asm volatile("s_waitcnt vmcnt(0)" ::: "memory");
        }
    }
    __syncthreads();
}

constexpr int NWAVES = 8, NTHR = 512;
constexpr int DM = 2048, SEQL = 2048, NB = 4, MP = NB * SEQL  , MS = 128  , MT = MP + MS, MPAD = 8448;
constexpr int NIN = 5400, NINP = 5632, FF = 8192, DEPTH = 2;
constexpr int C_Q = 0, C_K = 512, C_V = 640, C_Z = 768, C_XBC = 1792, C_MQ = 3328, C_MK = 3840, C_MV = 4352, C_MO = 4864, C_DT = 5376, C_MI = 5392, C_MF = 5396;
constexpr int XCW = 1536;
constexpr size_t O_Y = 0, O_PK = 17039360, O_PV = 17170432, O_PCONV = 17301504, O_PSSM = 17338368, O_PC = 18386944, O_PN = 18911232, O_PM = 18915328,
                 O_SK = 18915360, O_SV = 23109664, O_SCONV = 27303968, O_SSSM = 28483616, O_SC = 62038048, O_SN = 78815264, O_SM = 78946336, O_END = 78947360;

constexpr size_t MiB = 1u << 20;
constexpr size_t WS_CTL = 0, CTL_ZERO_BYTES = 1 * MiB;
constexpr size_t WS_SSQA = 1 * MiB, WS_SSQB = 1 * MiB + 512 * 1024;
constexpr size_t WS_WIN = 2 * MiB, WIN_BYTES = 22 * MiB;
constexpr size_t WS_WOUT = 46 * MiB, WOUT_BYTES = 8 * MiB;
constexpr size_t WS_WUP = 62 * MiB, WUP_BYTES = 32 * MiB;
constexpr size_t WS_WDN = 126 * MiB, WDN_BYTES = 32 * MiB;
constexpr size_t WS_XB = 190 * MiB;
constexpr size_t WS_XRES = 223 * MiB;
constexpr size_t WS_HBUF = 289 * MiB;
constexpr size_t WS_PROJ = 289 * MiB;
constexpr size_t WS_MIXED = 380 * MiB;
constexpr size_t WS_XC = 421 * MiB;
constexpr size_t WS_YG = 446 * MiB;
constexpr size_t WS_HR = 479 * MiB;
constexpr size_t WS_END = 496 * MiB;
static_assert(WS_PROJ + (size_t)MPAD * NINP * 2 <= WS_MIXED && WS_MIXED + (size_t)MPAD * DM * 2 <= WS_XC && WS_HBUF + (size_t)MPAD * FF * 2 <= WS_XC, "ws map");
constexpr int CW_BAR = 4096;
constexpr int CW_QUEUE = 16384;

constexpr int RING_OFF = 0, RING_BYTES = 131072;
constexpr int LDSCTL_OFF = RING_BYTES, MISC_OFF = LDSCTL_OFF + 320;
constexpr int LDS_BYTES = 147456;

struct Args { const float* in[26]; float* out; unsigned char* ws; int ph_lo, ph_hi; };
typedef const __attribute__((address_space(4))) unsigned long long* karg_t;
__device__ __forceinline__ unsigned long long karg_u64(int idx) { int j = idx; asm volatile("" : "+s"(j)); return ((karg_t)__builtin_amdgcn_kernarg_segment_ptr())[j]; }
#define ARGIN(i) ((const float*)karg_u64(i))
#define ARGOUT() ((float*)karg_u64(26))
#define ARGWS() ((unsigned char*)karg_u64(27))

struct Frame {
    LAS unsigned char* lds;
    volatile LAS unsigned* MISC;
    gu32* ctl;
    int tid, lane, wave, vcu, G;
};

__device__ __forceinline__ float bf2f(unsigned short u) { return __builtin_bit_cast(float, (unsigned)u << 16); }
__device__ __forceinline__ float bflo(unsigned u) { return __builtin_bit_cast(float, u << 16); }
__device__ __forceinline__ float bfhi(unsigned u) { return __builtin_bit_cast(float, u & 0xffff0000u); }
__device__ __forceinline__ void unpack8(const v4u w, float (&f)[8]) { f[0] = bflo(w.x); f[1] = bfhi(w.x); f[2] = bflo(w.y); f[3] = bfhi(w.y); f[4] = bflo(w.z); f[5] = bfhi(w.z); f[6] = bflo(w.w); f[7] = bfhi(w.w); }
__device__ __forceinline__ v4u pack8(const float (&f)[8]) { v4u w; w.x = pk2(f[0], f[1]); w.y = pk2(f[2], f[3]); w.z = pk2(f[4], f[5]); w.w = pk2(f[6], f[7]); return w; }
__device__ __forceinline__ float wave_sum(float v) {
#pragma unroll
    for (int o = 1; o < 64; o <<= 1) v += __shfl_xor(v, o);
    return v;
}
__device__ __forceinline__ float wave_max(float v) {
#pragma unroll
    for (int o = 1; o < 64; o <<= 1) v = fmaxf(v, __shfl_xor(v, o));
    return v;
}
__device__ __forceinline__ float fexp(float x) { return __builtin_amdgcn_exp2f(x * 1.4426950408889634f); }
__device__ __forceinline__ float frcp(float x) { return __builtin_amdgcn_rcpf(x); }
__device__ __forceinline__ float sigmoidf_(float x) { return frcp(1.0f + fexp(-x)); }
__device__ __forceinline__ float siluf_(float x) { return x * frcp(1.0f + fexp(-x)); }
__device__ __forceinline__ float softplusf_(float x) { return fmaxf(x, 0.f) + log1pf(expf(-fabsf(x))); }
__device__ __forceinline__ float logsigmoidf_(float x) { return fminf(x, 0.f) - log1pf(expf(-fabsf(x))); }
#define ROPE_INV(i) ((i) == 0 ? 1.0f : (i) == 1 ? 0.1939227432012558f : (i) == 2 ? 0.03760603070259094f : (i) == 3 ? 0.007292664609849453f : (i) == 4 ? 0.0014142135623842478f : (i) == 5 ? 0.00027424818836152554f : (i) == 6 ? 5.318296098266728e-05f : 1.0313386155758053e-05f)
__device__ __forceinline__ void rope_cs(int pos, float (&c)[8], float (&s)[8]) {
#pragma unroll
    for (int i = 0; i < 8; ++i) { const float ang = (float)pos * ROPE_INV(i); double rev = (double)ang * 0.15915494309189535; rev -= __builtin_rint(rev); const float fr = (float)rev;
        c[i] = __builtin_amdgcn_cosf(fr); s[i] = __builtin_amdgcn_sinf(fr); }
}

__device__ __forceinline__ int colmap(int mode, int n) {
    if (mode == 0) return n;
    if (n < 3328) return n; if (n < 5376) return n + 16; if (n < 5392) return n - 2048; if (n < 5400) return n; return -1;
}
__device__ __forceinline__ void p0_transpose_item(int mode, const float* W, int K, int Norig, int Nrows, const float* gain, bf16* WT, LAS float* scr, int item, int lane) {
    const int nblk = Nrows / 32, kb = item / nblk, nb = item % nblk, k0 = 64 * kb, n0 = 32 * nb;
    const int kr = lane >> 3, nc = lane & 7, oc = colmap(mode, n0 + 4 * nc);
    f32x4 v[8];
#pragma unroll
    for (int i = 0; i < 8; ++i) { v[i] = (f32x4){0.f, 0.f, 0.f, 0.f}; if (oc >= 0) v[i] = *(const GAS f32x4*)(W + (size_t)(k0 + kr + 8 * i) * Norig + oc); }
#pragma unroll
    for (int i = 0; i < 8; ++i) { const float gn = gain ? gain[k0 + kr + 8 * i] : 1.0f; LAS float* d = scr + (kr + 8 * i) * 33 + 4 * nc; d[0] = v[i].x * gn; d[1] = v[i].y * gn; d[2] = v[i].z * gn; d[3] = v[i].w * gn; }
    LDS_WAIT(); asm volatile("" ::: "memory");
    const int c = lane & 7;
#pragma unroll
    for (int j = 0; j < 4; ++j) { const int n = (lane >> 3) + 8 * j; const LAS float* s = scr + (8 * c) * 33 + n;
        v4u o; o.x = pk2(s[0 * 33], s[1 * 33]); o.y = pk2(s[2 * 33], s[3 * 33]); o.z = pk2(s[4 * 33], s[5 * 33]); o.w = pk2(s[6 * 33], s[7 * 33]);
        *(GAS v4u*)(WT + (size_t)(n0 + n) * K + k0 + 8 * c) = o; }
    LDS_WAIT(); asm volatile("" ::: "memory");
}
__device__ __forceinline__ void x_row_to_bf16(int lane, const float* xrow, bf16* orow, float* ssqrow) {
    const GAS f32x4* xr = (const GAS f32x4*)xrow + lane;
    f32x4 v[8]; float s = 0.f;
#pragma unroll
    for (int j = 0; j < 8; ++j) { v[j] = xr[64 * j]; s += (v[j].x * v[j].x + v[j].y * v[j].y) + (v[j].z * v[j].z + v[j].w * v[j].w); }
    s = wave_sum(s);
    GAS unsigned long long* o8 = (GAS unsigned long long*)orow + lane;
#pragma unroll
    for (int j = 0; j < 8; ++j) o8[64 * j] = (unsigned long long)pk2(v[j].x, v[j].y) | ((unsigned long long)pk2(v[j].z, v[j].w) << 32);
    if (lane < 8) ssqrow[lane] = lane == 0 ? s : 0.f;
}
__device__ __forceinline__ void p0_prologue(Frame& F, const Args& a) {
    LAS float* scr = (LAS float*)(F.lds + RING_OFF + F.wave * 16384);
    const int gw = F.vcu * NWAVES + F.wave, NGW = F.G * NWAVES;
    constexpr int I_IN = (DM / 64) * (NINP / 32), I_OUT = (DM / 64) * (DM / 32), I_UP = (DM / 64) * (FF / 32), I_DN = (FF / 64) * (DM / 32);
    constexpr int PER_L = I_IN + I_OUT + I_UP + I_DN;
    unsigned char* ws = ARGWS();
    for (int it = gw; it < DEPTH * PER_L; it += NGW) {
        const int l = it / PER_L; int r = it % PER_L;
        int mode = 0, K = DM, Norig = DM, Nrows = DM; const float* W; const float* gain = nullptr; bf16* WT;
        if (r < I_IN) { mode = 1; W = ARGIN(10) + (size_t)l * DM * NIN; Norig = NIN; Nrows = NINP; gain = ARGIN(9) + l * DM; WT = (bf16*)(ws + WS_WIN + l * WIN_BYTES); }
        else if ((r -= I_IN) < I_OUT) { W = ARGIN(21) + (size_t)l * DM * DM; WT = (bf16*)(ws + WS_WOUT + l * WOUT_BYTES); }
        else if ((r -= I_OUT) < I_UP) { W = ARGIN(23) + (size_t)l * DM * FF; Norig = FF; Nrows = FF; gain = ARGIN(22) + l * DM; WT = (bf16*)(ws + WS_WUP + l * WUP_BYTES); }
        else { r -= I_UP; W = ARGIN(24) + (size_t)l * FF * DM; K = FF; WT = (bf16*)(ws + WS_WDN + l * WDN_BYTES); }
        p0_transpose_item(mode, W, K, Norig, Nrows, gain, WT, scr, r, F.lane);
    }
    bf16* XB = (bf16*)(ws + WS_XB); float* SSQA = (float*)(ws + WS_SSQA);
    for (int m = gw; m < MPAD; m += NGW) {
        if (m < MT) x_row_to_bf16(F.lane, m < MP ? ARGIN(0) + (size_t)m * DM : ARGIN(1) + (size_t)(m - MP) * DM, XB + (size_t)m * DM, SSQA + (size_t)m * 8);
        else { GAS v4u* o = (GAS v4u*)(XB + (size_t)m * DM) + F.lane;
#pragma unroll
            for (int j = 0; j < 4; ++j) o[64 * j] = (v4u){0u, 0u, 0u, 0u};
            if (F.lane < 8) SSQA[(size_t)m * 8 + F.lane] = 1.0f; }
    }
}

template <class EP> __device__ __forceinline__ void thin_gemm(Frame& F, const bf16* A, int lda, const bf16* Bt, int N, int K, const EP& epi) {
    const int fr = F.lane & 15, fq = F.lane >> 4;
    for (int item = F.vcu; item < N / 16; item += F.G) {
        const int n0 = item * 16;
        const GAS bf16x8* ap = (const GAS bf16x8*)(A + (size_t)(16 * F.wave + fr) * lda + 8 * fq);
        const GAS bf16x8* bp = (const GAS bf16x8*)(Bt + (size_t)(n0 + fr) * K + 8 * fq);
        f32x4 acc0 = (f32x4){0.f, 0.f, 0.f, 0.f}, acc1 = acc0;
        for (int k = 0; k < K / 8; k += 32) {
            bf16x8 a[8], b[8];
#pragma unroll
            for (int u = 0; u < 8; ++u) { a[u] = ap[k + 4 * u]; b[u] = bp[k + 4 * u]; }
#pragma unroll
            for (int u = 0; u < 8; u += 2) { acc0 = __builtin_amdgcn_mfma_f32_16x16x32_bf16(b[u], a[u], acc0, 0, 0, 0); acc1 = __builtin_amdgcn_mfma_f32_16x16x32_bf16(b[u + 1], a[u + 1], acc1, 0, 0, 0); }
        }
        epi(16 * F.wave + fr, n0 + 4 * fq, acc0 + acc1);
    }
}

#define MFMA16(yf, xf, acc) __builtin_amdgcn_mfma_f32_16x16x32_bf16(yf, xf, acc, 0, 0, 0)
constexpr int TP = 136, TPB = TP * 2;
__device__ __forceinline__ bf16x8 lds_frag(const LAS unsigned char* base, int row, int k0, int lane) { return *(const LAS bf16x8*)(base + (row + (lane & 15)) * TPB + (k0 + 8 * (lane >> 4)) * 2); }
__device__ __forceinline__ float wave_incl_scan_add(float v, int lane) {
#pragma unroll
    for (int o = 1; o < 64; o <<= 1) { const float u = __shfl_up(v, o); if (lane >= o) v += u; }
    return v;
}
__device__ __forceinline__ float wave_incl_scan_max(float v, int lane) {
#pragma unroll
    for (int o = 1; o < 64; o <<= 1) { const float u = __shfl_up(v, o); if (lane >= o) v = fmaxf(v, u); }
    return v;
}
constexpr size_t WS_DCT = 190 * MiB;
constexpr size_t WS_CPT = 206 * MiB;
constexpr size_t WS_DN = 214 * MiB, WS_NP = WS_DN + 131072, WS_SC = WS_NP + 131072, WS_MPV = WS_SC + 4096;
static_assert(WS_MPV + 4096 <= WS_XRES, "mlstm workspace inside the XB region");

__device__ __forceinline__ void mlstm_gates(Frame& F, const bf16* PROJ, int row0, int l, int h, LAS float* tab, float& bcum, float& a) {
    const int tid = F.tid, lane = F.lane;
    float v = 0.f, ig = 0.f;
    if (tid < 128) { ig = bf2f(PROJ[(size_t)(row0 + tid) * NINP + C_MI + h]) + ARGIN(18)[l * 4 + h];
        v = logsigmoidf_(bf2f(PROJ[(size_t)(row0 + tid) * NINP + C_MF + h]) + ARGIN(19)[l * 4 + h]);
        v = wave_incl_scan_add(v, lane);
        if (tid == 63) tab[0] = v; }
    __syncthreads();
    if (tid >= 64 && tid < 128) v += tab[0];
    bcum = v; a = ig - v;
}

__device__ __forceinline__ void mlstm_a_item(Frame& F, int l, int b, int h, int c) {
    const bf16* PROJ = (const bf16*)(ARGWS() + WS_PROJ);
    const int tid = F.tid, lane = F.lane, w = F.wave, row0 = b * SEQL + c * 128, item = (b * 4 + h) * 16 + c;
    LAS unsigned char* KT = F.lds; LAS unsigned char* VT = F.lds + 128 * TPB;
    LAS float* tab = (LAS float*)(F.lds + 2 * 128 * TPB); LAS float* wk = tab + 16;
    __syncthreads();
    float bcum, a; mlstm_gates(F, PROJ, row0, l, h, tab, bcum, a);
    if (tid < 128) { const float mx = wave_max(a); if (lane == 0) tab[1 + w] = mx; if (tid == 127) tab[3] = bcum; }
    __syncthreads();
    const float pmax = fmaxf(tab[1], tab[2]);
    if (tid < 128) wk[tid] = fexp(a - pmax) * 0.08838834764831845f;
    __syncthreads();
#pragma unroll
    for (int rep = 0; rep < 4; ++rep) { const int task = tid + rep * NTHR, t = task & 127, ch = task >> 7;
        float f[8]; const float wt = wk[t];
        unpack8(*(const GAS v4u*)(PROJ + (size_t)(row0 + t) * NINP + C_MK + h * 128 + ch * 8), f);
#pragma unroll
        for (int i = 0; i < 8; ++i) *(LAS unsigned short*)(KT + (ch * 8 + i) * TPB + t * 2) = (unsigned short)f2bf(f[i] * wt);
        const v4u vv = *(const GAS v4u*)(PROJ + (size_t)(row0 + t) * NINP + C_MV + h * 128 + ch * 8);
        *(LAS unsigned short*)(VT + (ch * 8 + 0) * TPB + t * 2) = (unsigned short)(vv.x & 0xffffu); *(LAS unsigned short*)(VT + (ch * 8 + 1) * TPB + t * 2) = (unsigned short)(vv.x >> 16);
        *(LAS unsigned short*)(VT + (ch * 8 + 2) * TPB + t * 2) = (unsigned short)(vv.y & 0xffffu); *(LAS unsigned short*)(VT + (ch * 8 + 3) * TPB + t * 2) = (unsigned short)(vv.y >> 16);
        *(LAS unsigned short*)(VT + (ch * 8 + 4) * TPB + t * 2) = (unsigned short)(vv.z & 0xffffu); *(LAS unsigned short*)(VT + (ch * 8 + 5) * TPB + t * 2) = (unsigned short)(vv.z >> 16);
        *(LAS unsigned short*)(VT + (ch * 8 + 6) * TPB + t * 2) = (unsigned short)(vv.w & 0xffffu); *(LAS unsigned short*)(VT + (ch * 8 + 7) * TPB + t * 2) = (unsigned short)(vv.w >> 16); }
    __syncthreads();
    bf16x8 xf[4];
#pragma unroll
    for (int s = 0; s < 4; ++s) xf[s] = lds_frag(VT, 16 * w, 32 * s, lane);
    float* dct = (float*)(ARGWS() + WS_DCT) + (size_t)item * 16384;
#pragma unroll
    for (int t = 0; t < 8; ++t) { f32x4 acc = (f32x4){0.f, 0.f, 0.f, 0.f};
#pragma unroll
        for (int s = 0; s < 4; ++s) acc = MFMA16(lds_frag(KT, 16 * t, 32 * s, lane), xf[s], acc);
        *(GAS f32x4*)(dct + (size_t)(16 * w + (lane & 15)) * 128 + 16 * t + 4 * (lane >> 4)) = acc; }
    if (tid < 128) { float s = 0.f;
#pragma unroll
        for (int j = 0; j < 16; ++j) { float f[8]; unpack8(*(const LAS v4u*)(KT + tid * TPB + j * 16), f); s += ((f[0] + f[1]) + (f[2] + f[3])) + ((f[4] + f[5]) + (f[6] + f[7])); }
        ((float*)(ARGWS() + WS_DN))[(size_t)item * 128 + tid] = s; }
    if (tid == 0) { float* sc = (float*)(ARGWS() + WS_SC) + item * 2; sc[0] = tab[3]; sc[1] = pmax; }
}

__device__ __forceinline__ void mlstm_scan_phase(Frame& F, int l) {
    const int tid = F.tid;
    LAS float* coef = (LAS float*)(F.lds); LAS float* gend = coef + 16;
    for (int it = F.vcu; it < 128; it += F.G) {
        const int bh = it >> 3, b = bh >> 2, h = bh & 3, part = it & 7;
        __syncthreads();
        if (tid == 0) { const float* sc = (const float*)(ARGWS() + WS_SC) + bh * 32; float* mp = (float*)(ARGWS() + WS_MPV) + bh * 16; float m = 0.f;
            for (int c = 0; c < 16; ++c) { const float bl = sc[2 * c], pm = sc[2 * c + 1], M = fmaxf(m, pm); coef[c] = fexp(pm - M); gend[c] = fexp(m - M); if (part == 0) mp[c] = m; m = bl + M; }
            if (part == 0) ARGOUT()[O_PM + (size_t)(l * NB + b) * 4 + h] = m; }
        __syncthreads();
        const int elem = part * 512 + tid, e = elem >> 5, d4 = (elem & 31) * 4;
        const float* dct = (const float*)(ARGWS() + WS_DCT) + (size_t)bh * 16 * 16384 + (size_t)e * 128 + d4;
        bf16* cpt = (bf16*)(ARGWS() + WS_CPT) + (size_t)bh * 16 * 16384 + (size_t)e * 128 + d4;
        f32x4 dc[16];
#pragma unroll
        for (int c = 0; c < 16; ++c) dc[c] = *(const GAS f32x4*)(dct + (size_t)c * 16384);
        f32x4 C = (f32x4){0.f, 0.f, 0.f, 0.f};
#pragma unroll
        for (int c = 0; c < 16; ++c) { *(GAS unsigned long long*)(cpt + (size_t)c * 16384) = (unsigned long long)pk2(C.x, C.y) | ((unsigned long long)pk2(C.z, C.w) << 32);
            C = C * gend[c] + dc[c] * coef[c]; }
        float* pc = ARGOUT() + O_PC + ((size_t)(l * NB + b) * 4 + h) * 16384;
        pc[(size_t)(d4 + 0) * 128 + e] = C.x; pc[(size_t)(d4 + 1) * 128 + e] = C.y; pc[(size_t)(d4 + 2) * 128 + e] = C.z; pc[(size_t)(d4 + 3) * 128 + e] = C.w;
        if (part == 0 && tid < 128) { const float* dn = (const float*)(ARGWS() + WS_DN) + (size_t)bh * 16 * 128 + tid; float* np = (float*)(ARGWS() + WS_NP) + (size_t)bh * 16 * 128 + tid; float n = 0.f;
#pragma unroll
            for (int c = 0; c < 16; ++c) { np[c * 128] = n; n = n * gend[c] + dn[c * 128] * coef[c]; }
            ARGOUT()[O_PN + ((size_t)(l * NB + b) * 4 + h) * 128 + tid] = n; }
    }
}

__device__ __forceinline__ void mlstm_c_item(Frame& F, int l, int b, int h, int c) {
    const bf16* PROJ = (const bf16*)(ARGWS() + WS_PROJ); bf16* MIXED = (bf16*)(ARGWS() + WS_MIXED);
    const int tid = F.tid, lane = F.lane, w = F.wave, row0 = b * SEQL + c * 128, item = (b * 4 + h) * 16 + c, lc = lane & 15, lg = lane >> 4;
    LAS unsigned char* Kn = F.lds; LAS unsigned char* VT = F.lds + 128 * TPB; LAS unsigned char* CP = F.lds + 2 * 128 * TPB;
    LAS float* tab = (LAS float*)(F.lds + 3 * 128 * TPB); LAS float* Ak = tab + 16; LAS float* Mq = Ak + 128; LAS float* Emt = Mq + 128; LAS float* Np = Emt + 128;
    __syncthreads();
    float bcum, a; mlstm_gates(F, PROJ, row0, l, h, tab, bcum, a);
    const float mprev = ((const float*)(ARGWS() + WS_MPV))[item];
    float pm = -INFINITY;
    if (tid < 128) { pm = wave_incl_scan_max(a, lane); if (tid == 63) tab[1] = pm; }
    __syncthreads();
    if (tid < 128) { if (tid >= 64) pm = fmaxf(pm, tab[1]); const float M = fmaxf(mprev, pm); Ak[tid] = a; Mq[tid] = M; Emt[tid] = fexp(-(bcum + M)); Np[tid] = ((const float*)(ARGWS() + WS_NP))[(size_t)item * 128 + tid]; }
#pragma unroll
    for (int rep = 0; rep < 4; ++rep) { const int task = tid + rep * NTHR;
        { const int ch = task & 15, t = task >> 4; *(LAS v4u*)(Kn + t * TPB + ch * 16) = *(const GAS v4u*)(PROJ + (size_t)(row0 + t) * NINP + C_MK + h * 128 + ch * 8);
          *(LAS v4u*)(CP + t * TPB + ch * 16) = *(const GAS v4u*)((const bf16*)(ARGWS() + WS_CPT) + (size_t)item * 16384 + (size_t)t * 128 + ch * 8); }
        { const int t = task & 127, ch = task >> 7; const v4u vv = *(const GAS v4u*)(PROJ + (size_t)(row0 + t) * NINP + C_MV + h * 128 + ch * 8);
          *(LAS unsigned short*)(VT + (ch * 8 + 0) * TPB + t * 2) = (unsigned short)(vv.x & 0xffffu); *(LAS unsigned short*)(VT + (ch * 8 + 1) * TPB + t * 2) = (unsigned short)(vv.x >> 16);
          *(LAS unsigned short*)(VT + (ch * 8 + 2) * TPB + t * 2) = (unsigned short)(vv.y & 0xffffu); *(LAS unsigned short*)(VT + (ch * 8 + 3) * TPB + t * 2) = (unsigned short)(vv.y >> 16);
          *(LAS unsigned short*)(VT + (ch * 8 + 4) * TPB + t * 2) = (unsigned short)(vv.z & 0xffffu); *(LAS unsigned short*)(VT + (ch * 8 + 5) * TPB + t * 2) = (unsigned short)(vv.z >> 16);
          *(LAS unsigned short*)(VT + (ch * 8 + 6) * TPB + t * 2) = (unsigned short)(vv.w & 0xffffu); *(LAS unsigned short*)(VT + (ch * 8 + 7) * TPB + t * 2) = (unsigned short)(vv.w >> 16); } }
    bf16x8 qf[4];
#pragma unroll
    for (int s = 0; s < 4; ++s) qf[s] = *(const GAS bf16x8*)(PROJ + (size_t)(row0 + 16 * w + lc) * NINP + C_MQ + h * 128 + 32 * s + 8 * lg);
    __syncthreads();
    float qn = 0.f;
#pragma unroll
    for (int s = 0; s < 4; ++s) { float f[8]; unpack8(__builtin_bit_cast(v4u, qf[s]), f);
#pragma unroll
        for (int i = 0; i < 8; ++i) qn += f[i] * Np[32 * s + 8 * lg + i]; }
    qn += __shfl_xor(qn, 16); qn += __shfl_xor(qn, 32);
    f32x4 sacc[8];
#pragma unroll
    for (int t = 0; t < 8; ++t) { sacc[t] = (f32x4){0.f, 0.f, 0.f, 0.f};
        if (t <= w) {
#pragma unroll
            for (int s = 0; s < 4; ++s) sacc[t] = MFMA16(lds_frag(Kn, 16 * t, 32 * s, lane), qf[s], sacc[t]); } }
    __syncthreads();
    LAS unsigned char* Pw = Kn + w * 16 * TPB;
    const int q = 16 * w + lc; const float Mrow = Mq[q], gq = fexp(mprev - Mrow);
    float rsum = 0.f;
#pragma unroll
    for (int t = 0; t < 8; ++t) { if (t <= (w | 1)) { float p[4];
#pragma unroll
            for (int i = 0; i < 4; ++i) { const int k = 16 * t + 4 * lg + i; p[i] = (k <= q) ? fexp(Ak[k] - Mrow) * 0.08838834764831845f * sacc[t][i] : 0.f; rsum += p[i]; }
            *(LAS unsigned long long*)(Pw + lc * TPB + (16 * t + 4 * lg) * 2) = (unsigned long long)pk2(p[0], p[1]) | ((unsigned long long)pk2(p[2], p[3]) << 32); } }
    rsum += __shfl_xor(rsum, 16); rsum += __shfl_xor(rsum, 32);
    asm volatile("s_waitcnt lgkmcnt(0)" ::: "memory");
    f32x4 acc[8];
#pragma unroll
    for (int t = 0; t < 8; ++t) { acc[t] = (f32x4){0.f, 0.f, 0.f, 0.f};
#pragma unroll
        for (int s = 0; s < 4; ++s) acc[t] = MFMA16(lds_frag(CP, 16 * t, 32 * s, lane), qf[s], acc[t]);
        acc[t] = acc[t] * gq; }
#pragma unroll
    for (int s = 0; s < 4; ++s) { if (s <= (w >> 1)) { const bf16x8 pf = lds_frag(Pw, 0, 32 * s, lane);
#pragma unroll
            for (int t = 0; t < 8; ++t) acc[t] = MFMA16(lds_frag(VT, 16 * t, 32 * s, lane), pf, acc[t]); } }
    const float den = rsum + gq * qn, dinv = 1.0f / fmaxf(fabsf(den), Emt[q]);
    float ss = 0.f;
#pragma unroll
    for (int t = 0; t < 8; ++t) { acc[t] = acc[t] * dinv; ss += (acc[t][0] * acc[t][0] + acc[t][1] * acc[t][1]) + (acc[t][2] * acc[t][2] + acc[t][3] * acc[t][3]); }
    ss += __shfl_xor(ss, 16); ss += __shfl_xor(ss, 32);
    const float rs = __builtin_amdgcn_rsqf(ss * (1.0f / 128.0f) + 1e-6f);
    const float* wml = ARGIN(20) + (size_t)l * 512 + h * 128;
#pragma unroll
    for (int t = 0; t < 8; ++t) { const int e0 = 16 * t + 4 * lg; const f32x4 g4 = *(const GAS f32x4*)(wml + e0);
        const unsigned long long mo = *(const GAS unsigned long long*)(PROJ + (size_t)(row0 + q) * NINP + C_MO + h * 128 + e0);
        const float o0 = acc[t][0] * rs * g4.x * sigmoidf_(bflo((unsigned)mo)), o1 = acc[t][1] * rs * g4.y * sigmoidf_(bfhi((unsigned)mo)),
                    o2 = acc[t][2] * rs * g4.z * sigmoidf_(bflo((unsigned)(mo >> 32))), o3 = acc[t][3] * rs * g4.w * sigmoidf_(bfhi((unsigned)(mo >> 32)));
        *(GAS unsigned long long*)(MIXED + (size_t)(row0 + q) * DM + 1536 + h * 128 + e0) = (unsigned long long)pk2(o0, o1) | ((unsigned long long)pk2(o2, o3) << 32); }
}

constexpr size_t WS_DS = 496 * MiB;
constexpr size_t WS_SP = 528 * MiB;
constexpr size_t WS_AL = 544 * MiB;
constexpr size_t WS_END2 = 545 * MiB;

__device__ __forceinline__ void conv8(const bf16* PROJ, const float* cw, const float* cb, size_t grow, int pos, int ch0, float (&y)[8]) {
    const f32x4 b0 = *(const GAS f32x4*)(cb + ch0), b1 = *(const GAS f32x4*)(cb + ch0 + 4);
    y[0] = b0.x; y[1] = b0.y; y[2] = b0.z; y[3] = b0.w; y[4] = b1.x; y[5] = b1.y; y[6] = b1.z; y[7] = b1.w;
#pragma unroll
    for (int j = 0; j < 4; ++j) { if (pos - 3 + j >= 0) { float r[8]; unpack8(*(const GAS v4u*)(PROJ + (grow - 3 + j) * NINP + C_XBC + ch0), r);
            const f32x4 w0 = *(const GAS f32x4*)(cw + j * XCW + ch0), w1 = *(const GAS f32x4*)(cw + j * XCW + ch0 + 4);
            y[0] += w0.x * r[0]; y[1] += w0.y * r[1]; y[2] += w0.z * r[2]; y[3] += w0.w * r[3]; y[4] += w1.x * r[4]; y[5] += w1.y * r[5]; y[6] += w1.z * r[6]; y[7] += w1.w * r[7]; } }
#pragma unroll
    for (int i = 0; i < 8; ++i) y[i] = siluf_(y[i]);
}

__device__ __forceinline__ void ssd_a_item(Frame& F, int l, int b, int g, int c, int half) {
    const bf16* PROJ = (const bf16*)(ARGWS() + WS_PROJ);
    const float* cw = ARGIN(12) + (size_t)l * 4 * XCW; const float* cb = ARGIN(13) + (size_t)l * XCW;
    const int tid = F.tid, lane = F.lane, w = F.wave, row0 = b * SEQL + c * 128, h0 = g * 8 + half * 4;
    LAS unsigned char* XT = F.lds; LAS unsigned char* BT = F.lds + 256 * TPB;
    LAS float* tab = (LAS float*)(F.lds + 384 * TPB); LAS float* wt = tab + 16;
    __syncthreads();
    { const int r = tid >> 7, t = tid & 127, h = h0 + r;
      const float dt = softplusf_(bf2f(PROJ[(size_t)(row0 + t) * NINP + C_DT + h]) + ARGIN(14)[l * 16 + h]), A = -fexp(ARGIN(15)[l * 16 + h]);
      float v = wave_incl_scan_add(dt * A, lane);
      if (lane == 63 && (w & 1) == 0) tab[r] = v;
      __syncthreads();
      if (w & 1) v += tab[r];
      if (t == 127) tab[4 + r] = v;
      __syncthreads();
      const float al = tab[4 + r];
      wt[r * 128 + t] = fexp(al - v) * dt;
      if (t == 127) ((float*)(ARGWS() + WS_AL))[((b * 16 + h) * 16) + c] = al; }
    __syncthreads();
#pragma unroll 2
    for (int rep = 0; rep < 12; ++rep) { const int task = tid + rep * NTHR, t = task & 127, cj = task >> 7;
        const int ch0 = cj < 32 ? h0 * 64 + cj * 8 : 1024 + g * 128 + (cj - 32) * 8;
        float y[8]; conv8(PROJ, cw, cb, (size_t)(row0 + t), c * 128 + t, ch0, y);
        if (cj < 32) { const float wv = wt[(cj >> 3) * 128 + t];
#pragma unroll
            for (int i = 0; i < 8; ++i) *(LAS unsigned short*)(XT + (cj * 8 + i) * TPB + t * 2) = (unsigned short)f2bf(y[i] * wv); }
        else {
#pragma unroll
            for (int i = 0; i < 8; ++i) *(LAS unsigned short*)(BT + ((cj - 32) * 8 + i) * TPB + t * 2) = (unsigned short)f2bf(y[i]); } }
    __syncthreads();
    const int r = w >> 1, h = h0 + r;
    float* ds = (float*)(ARGWS() + WS_DS) + (size_t)((b * 16 + h) * 16 + c) * 8192;
#pragma unroll
    for (int ps = 0; ps < 2; ++ps) { const int prow = 2 * (w & 1) + ps;
        bf16x8 xf[4];
#pragma unroll
        for (int s = 0; s < 4; ++s) xf[s] = lds_frag(XT, r * 64 + 16 * prow, 32 * s, lane);
#pragma unroll
        for (int t = 0; t < 8; ++t) { f32x4 acc = (f32x4){0.f, 0.f, 0.f, 0.f};
#pragma unroll
            for (int s = 0; s < 4; ++s) acc = MFMA16(lds_frag(BT, 16 * t, 32 * s, lane), xf[s], acc);
            *(GAS f32x4*)(ds + (size_t)(16 * prow + (lane & 15)) * 128 + 16 * t + 4 * (lane >> 4)) = acc; } }
}

__device__ __forceinline__ void ssd_scan_phase(Frame& F, int l) {
    for (int idx = F.vcu * NTHR + F.tid; idx < 64 * 2048; idx += F.G * NTHR) {
        const int bh = idx >> 11, e4 = (idx & 2047) * 4;
        const float* al = (const float*)(ARGWS() + WS_AL) + bh * 16;
        const float* ds = (const float*)(ARGWS() + WS_DS) + (size_t)bh * 16 * 8192 + e4;
        bf16* sp = (bf16*)(ARGWS() + WS_SP) + (size_t)bh * 16 * 8192 + e4;
        f32x4 d[16]; float dec[16];
#pragma unroll
        for (int c = 0; c < 16; ++c) { d[c] = *(const GAS f32x4*)(ds + (size_t)c * 8192); dec[c] = al[c]; }
        f32x4 S = (f32x4){0.f, 0.f, 0.f, 0.f};
#pragma unroll
        for (int c = 0; c < 16; ++c) { *(GAS unsigned long long*)(sp + (size_t)c * 8192) = (unsigned long long)pk2(S.x, S.y) | ((unsigned long long)pk2(S.z, S.w) << 32);
            S = S * fexp(dec[c]) + d[c]; }
        *(GAS f32x4*)(ARGOUT() + O_PSSM + ((size_t)l * 64 + bh) * 8192 + e4) = S;
    }
}

__device__ __forceinline__ void ssd_c_item(Frame& F, int l, int b, int g, int c) {
    const bf16* PROJ = (const bf16*)(ARGWS() + WS_PROJ); bf16* MIXED = (bf16*)(ARGWS() + WS_MIXED); float* YG = (float*)(ARGWS() + WS_YG);
    const float* cw = ARGIN(12) + (size_t)l * 4 * XCW; const float* cb = ARGIN(13) + (size_t)l * XCW;
    const int tid = F.tid, lane = F.lane, w = F.wave, row0 = b * SEQL + c * 128, lc = lane & 15, lg = lane >> 4, q = 16 * w + lc;
    LAS unsigned char* Bn = F.lds; LAS unsigned char* XT = F.lds + 128 * TPB; LAS unsigned char* SP = F.lds + 256 * TPB;
    LAS float* tab = (LAS float*)(F.lds + 384 * TPB); LAS float* At = tab + 16; LAS float* Dt = At + 1024;
    __syncthreads();
    { float v[2], dtv[2];
#pragma unroll
      for (int rep = 0; rep < 2; ++rep) { const int r = (tid >> 7) + 4 * rep, t = tid & 127, h = g * 8 + r;
          dtv[rep] = softplusf_(bf2f(PROJ[(size_t)(row0 + t) * NINP + C_DT + h]) + ARGIN(14)[l * 16 + h]);
          v[rep] = wave_incl_scan_add(dtv[rep] * -fexp(ARGIN(15)[l * 16 + h]), lane);
          if (lane == 63 && (w & 1) == 0) tab[r] = v[rep]; }
      __syncthreads();
#pragma unroll
      for (int rep = 0; rep < 2; ++rep) { const int r = (tid >> 7) + 4 * rep, t = tid & 127; if (w & 1) v[rep] += tab[r]; At[r * 128 + t] = v[rep]; Dt[r * 128 + t] = dtv[rep]; } }
    bf16x8 cf[4];
#pragma unroll
    for (int s = 0; s < 4; ++s) { float y[8]; conv8(PROJ, cw, cb, (size_t)(row0 + q), c * 128 + q, 1280 + g * 128 + 32 * s + 8 * lg, y); cf[s] = __builtin_bit_cast(bf16x8, pack8(y)); }
#pragma unroll
    for (int rep = 0; rep < 4; ++rep) { const int task = tid + rep * NTHR, ch = task & 15, t = task >> 4;
        float y[8]; conv8(PROJ, cw, cb, (size_t)(row0 + t), c * 128 + t, 1024 + g * 128 + ch * 8, y); *(LAS v4u*)(Bn + t * TPB + ch * 16) = pack8(y); }
    __syncthreads();
    f32x4 cbm[8];
#pragma unroll
    for (int t = 0; t < 8; ++t) { cbm[t] = (f32x4){0.f, 0.f, 0.f, 0.f};
        if (t <= w) {
#pragma unroll
            for (int s = 0; s < 4; ++s) cbm[t] = MFMA16(lds_frag(Bn, 16 * t, 32 * s, lane), cf[s], cbm[t]); } }
    LAS unsigned char* Pw = Bn + w * 16 * TPB;
    float ssq = 0.f;
    for (int hp = 0; hp < 4; ++hp) {
        __syncthreads();
#pragma unroll
        for (int rep = 0; rep < 4; ++rep) { const int task = tid + rep * NTHR;
            { const int t = task & 127, cj = task >> 7;
              float y[8]; conv8(PROJ, cw, cb, (size_t)(row0 + t), c * 128 + t, (g * 8 + 2 * hp) * 64 + cj * 8, y);
#pragma unroll
              for (int i = 0; i < 8; ++i) *(LAS unsigned short*)(XT + (cj * 8 + i) * TPB + t * 2) = (unsigned short)f2bf(y[i]); }
            { const int ch = task & 15, pr = task >> 4;
              const int h = g * 8 + 2 * hp + (pr >> 6);
              *(LAS v4u*)(SP + pr * TPB + ch * 16) = *(const GAS v4u*)((const bf16*)(ARGWS() + WS_SP) + (size_t)((b * 16 + h) * 16 + c) * 8192 + (size_t)(pr & 63) * 128 + ch * 8); } }
        __syncthreads();
#pragma unroll
        for (int rr = 0; rr < 2; ++rr) { const int r = 2 * hp + rr, h = g * 8 + r; const float Dh = ARGIN(16)[l * 16 + h], aq = At[r * 128 + q];
#pragma unroll
            for (int t = 0; t < 8; ++t) { if (t <= (w | 1)) { float p[4];
#pragma unroll
                    for (int i = 0; i < 4; ++i) { const int k = 16 * t + 4 * lg + i; p[i] = (k <= q) ? cbm[t][i] * fexp(aq - At[r * 128 + k]) * Dt[r * 128 + k] : 0.f; if (k == q) p[i] += Dh; }
                    *(LAS unsigned long long*)(Pw + lc * TPB + (16 * t + 4 * lg) * 2) = (unsigned long long)pk2(p[0], p[1]) | ((unsigned long long)pk2(p[2], p[3]) << 32); } }
            asm volatile("s_waitcnt lgkmcnt(0)" ::: "memory");
            f32x4 acc[4]; const float eq = fexp(aq);
#pragma unroll
            for (int pt = 0; pt < 4; ++pt) { acc[pt] = (f32x4){0.f, 0.f, 0.f, 0.f};
#pragma unroll
                for (int s = 0; s < 4; ++s) acc[pt] = MFMA16(lds_frag(SP, rr * 64 + 16 * pt, 32 * s, lane), cf[s], acc[pt]);
                acc[pt] = acc[pt] * eq; }
#pragma unroll
            for (int s = 0; s < 4; ++s) { if (s <= (w >> 1)) { const bf16x8 pf = lds_frag(Pw, 0, 32 * s, lane);
#pragma unroll
                    for (int pt = 0; pt < 4; ++pt) acc[pt] = MFMA16(lds_frag(XT, rr * 64 + 16 * pt, 32 * s, lane), pf, acc[pt]); } }
            asm volatile("s_waitcnt lgkmcnt(0)" ::: "memory");
#pragma unroll
            for (int pt = 0; pt < 4; ++pt) { const int p0 = 16 * pt + 4 * lg;
                const unsigned long long zz = *(const GAS unsigned long long*)(PROJ + (size_t)(row0 + q) * NINP + C_Z + h * 64 + p0);
                f32x4 y = acc[pt]; y.x *= siluf_(bflo((unsigned)zz)); y.y *= siluf_(bfhi((unsigned)zz)); y.z *= siluf_(bflo((unsigned)(zz >> 32))); y.w *= siluf_(bfhi((unsigned)(zz >> 32)));
                ssq += (y.x * y.x + y.y * y.y) + (y.z * y.z + y.w * y.w);
                *(GAS f32x4*)(YG + (size_t)(row0 + q) * 1024 + h * 64 + p0) = y; } }
    }
    if (c == 15 && tid < 288) {
        const int j = tid / 96, kk = tid % 96, ch0 = kk < 64 ? g * 512 + kk * 8 : (kk < 80 ? 1024 + g * 128 + (kk - 64) * 8 : 1280 + g * 128 + (kk - 80) * 8);
        float r[8]; unpack8(*(const GAS v4u*)(PROJ + (size_t)(row0 + 125 + j) * NINP + C_XBC + ch0), r);
        float* o = ARGOUT() + O_PCONV + (size_t)((l * NB + b) * 3 + j) * XCW + ch0;
        *(GAS f32x4*)o = (f32x4){r[0], r[1], r[2], r[3]}; *(GAS f32x4*)(o + 4) = (f32x4){r[4], r[5], r[6], r[7]}; }
    ssq += __shfl_xor(ssq, 16); ssq += __shfl_xor(ssq, 32);
    const float rs = __builtin_amdgcn_rsqf(ssq * (1.0f / 512.0f) + 1e-6f);
    asm volatile("s_waitcnt vmcnt(0)" ::: "memory");
    const float* wn = ARGIN(17) + (size_t)l * 1024 + g * 512;
#pragma unroll 4
    for (int j = 0; j < 32; ++j) { const int col = 16 * j + 4 * lg;
        const f32x4 y = *(const GAS f32x4*)(YG + (size_t)(row0 + q) * 1024 + g * 512 + col), g4 = *(const GAS f32x4*)(wn + col);
        *(GAS unsigned long long*)(MIXED + (size_t)(row0 + q) * DM + 512 + g * 512 + col) = (unsigned long long)pk2(y.x * rs * g4.x, y.y * rs * g4.y) | ((unsigned long long)pk2(y.z * rs * g4.z, y.w * rs * g4.w) << 32); }
}

constexpr int AKP = 72 * 2, AVP = 280 * 2, APP = 168 * 2;
__device__ __forceinline__ void attn_mfma_item(Frame& F, int l, int b, int blk, int kvh) {
    const bf16* PROJ = (const bf16*)(ARGWS() + WS_PROJ); bf16* MIXED = (bf16*)(ARGWS() + WS_MIXED);
    const int tid = F.tid, lane = F.lane, w = F.wave, lc = lane & 15, lg = lane >> 4, w0 = blk * 128 - 128;
    LAS unsigned char* Ks = F.lds; LAS unsigned char* Vt = F.lds + 256 * AKP; LAS unsigned char* Pw = F.lds + 256 * AKP + 64 * AVP + w * 16 * APP;
    float* pk = ARGOUT() + O_PK + (size_t)(l * NB + b) * 128 * 128; float* pv = ARGOUT() + O_PV + (size_t)(l * NB + b) * 128 * 128;
    __syncthreads();
    if (tid < 64 * 3) { const int d = tid / 3, j = tid % 3; *(LAS v4u*)(Vt + d * AVP + 512 + j * 16) = (v4u){0u, 0u, 0u, 0u}; }
#pragma unroll
    for (int rep = 0; rep < 4; ++rep) { const int task = tid + rep * NTHR;
        { const int r = task >> 3, c = task & 7, pos = w0 + r; const bool keep = (blk == 15 && r >= 128);
          if (pos < 0) { *(LAS v4u*)(Ks + r * AKP + c * 16) = (v4u){0u, 0u, 0u, 0u}; }
          else { const size_t grow = (size_t)(b * SEQL + pos) * NINP;
            if (c >= 2) { const v4u wk = *(const GAS v4u*)(PROJ + grow + C_K + kvh * 64 + c * 8); *(LAS v4u*)(Ks + r * AKP + c * 16) = wk;
              if (keep) { float f[8]; unpack8(wk, f); float* o = pk + (size_t)((r - 128) * 2 + kvh) * 64 + c * 8; *(GAS f32x4*)o = (f32x4){f[0], f[1], f[2], f[3]}; *(GAS f32x4*)(o + 4) = (f32x4){f[4], f[5], f[6], f[7]}; } }
            else if (c == 0) { float x1[8], x2[8], cs[8], sn[8], o1[8], o2[8];
              unpack8(*(const GAS v4u*)(PROJ + grow + C_K + kvh * 64), x1); unpack8(*(const GAS v4u*)(PROJ + grow + C_K + kvh * 64 + 8), x2); rope_cs(pos, cs, sn);
#pragma unroll
              for (int i = 0; i < 8; ++i) { o1[i] = x1[i] * cs[i] - x2[i] * sn[i]; o2[i] = x2[i] * cs[i] + x1[i] * sn[i]; }
              *(LAS v4u*)(Ks + r * AKP) = pack8(o1); *(LAS v4u*)(Ks + r * AKP + 16) = pack8(o2);
              if (keep) { float* o = pk + (size_t)((r - 128) * 2 + kvh) * 64; *(GAS f32x4*)o = (f32x4){o1[0], o1[1], o1[2], o1[3]}; *(GAS f32x4*)(o + 4) = (f32x4){o1[4], o1[5], o1[6], o1[7]};
                  *(GAS f32x4*)(o + 8) = (f32x4){o2[0], o2[1], o2[2], o2[3]}; *(GAS f32x4*)(o + 12) = (f32x4){o2[4], o2[5], o2[6], o2[7]}; } } } }
        { const int r = task & 255, c = task >> 8, pos = w0 + r; const bool keep = (blk == 15 && r >= 128);
          v4u wv = (v4u){0u, 0u, 0u, 0u};
          if (pos >= 0) wv = *(const GAS v4u*)(PROJ + (size_t)(b * SEQL + pos) * NINP + C_V + kvh * 64 + c * 8);
          *(LAS unsigned short*)(Vt + (c * 8 + 0) * AVP + r * 2) = (unsigned short)(wv.x & 0xffffu); *(LAS unsigned short*)(Vt + (c * 8 + 1) * AVP + r * 2) = (unsigned short)(wv.x >> 16);
          *(LAS unsigned short*)(Vt + (c * 8 + 2) * AVP + r * 2) = (unsigned short)(wv.y & 0xffffu); *(LAS unsigned short*)(Vt + (c * 8 + 3) * AVP + r * 2) = (unsigned short)(wv.y >> 16);
          *(LAS unsigned short*)(Vt + (c * 8 + 4) * AVP + r * 2) = (unsigned short)(wv.z & 0xffffu); *(LAS unsigned short*)(Vt + (c * 8 + 5) * AVP + r * 2) = (unsigned short)(wv.z >> 16);
          *(LAS unsigned short*)(Vt + (c * 8 + 6) * AVP + r * 2) = (unsigned short)(wv.w & 0xffffu); *(LAS unsigned short*)(Vt + (c * 8 + 7) * AVP + r * 2) = (unsigned short)(wv.w >> 16);
          if (keep) { float f[8]; unpack8(wv, f); float* o = pv + (size_t)((r - 128) * 2 + kvh) * 64 + c * 8; *(GAS f32x4*)o = (f32x4){f[0], f[1], f[2], f[3]}; *(GAS f32x4*)(o + 4) = (f32x4){f[4], f[5], f[6], f[7]}; } } }
    const int qpos = blk * 128 + 16 * w + lc; const size_t qrow = (size_t)b * SEQL + qpos;
    float cs[8], sn[8]; rope_cs(qpos, cs, sn);
    __syncthreads();
    for (int g = 0; g < 4; ++g) { const int h = kvh * 4 + g;
        v4u q0 = *(const GAS v4u*)(PROJ + qrow * NINP + C_Q + h * 64 + 8 * lg); const v4u q1 = *(const GAS v4u*)(PROJ + qrow * NINP + C_Q + h * 64 + 32 + 8 * lg);
        { v4u pp; pp.x = __shfl_xor(q0.x, 16); pp.y = __shfl_xor(q0.y, 16); pp.z = __shfl_xor(q0.z, 16); pp.w = __shfl_xor(q0.w, 16);
          float own[8], oth[8], o[8]; unpack8(q0, own); unpack8(pp, oth);
#pragma unroll
          for (int i = 0; i < 8; ++i) o[i] = lg == 0 ? own[i] * cs[i] - oth[i] * sn[i] : own[i] * cs[i] + oth[i] * sn[i];
          if (lg < 2) q0 = pack8(o); }
        const bf16x8 qf0 = __builtin_bit_cast(bf16x8, q0), qf1 = __builtin_bit_cast(bf16x8, q1);
        f32x4 sc[9]; float mx = -INFINITY;
#pragma unroll
        for (int tt = 0; tt < 9; ++tt) { const LAS unsigned char* kb = Ks + (16 * (w + tt) + lc) * AKP + 16 * lg;
            f32x4 a = (f32x4){0.f, 0.f, 0.f, 0.f};
            a = MFMA16(*(const LAS bf16x8*)kb, qf0, a); a = MFMA16(*(const LAS bf16x8*)(kb + 64), qf1, a);
#pragma unroll
            for (int i = 0; i < 4; ++i) { const int kk = 16 * tt + 4 * lg + i; const bool ok = (kk >= lc) && (kk <= 128 + lc) && (w0 + 16 * w + kk >= 0);
                a[i] = ok ? a[i] * 0.125f : -INFINITY; mx = fmaxf(mx, a[i]); }
            sc[tt] = a; }
        mx = fmaxf(mx, __shfl_xor(mx, 16)); mx = fmaxf(mx, __shfl_xor(mx, 32));
        const float sink = ARGIN(11)[l * 8 + h]; mx = fmaxf(mx, sink);
        float rsum = 0.f;
#pragma unroll
        for (int tt = 0; tt < 10; ++tt) { float p[4] = {0.f, 0.f, 0.f, 0.f};
            if (tt < 9) {
#pragma unroll
                for (int i = 0; i < 4; ++i) { p[i] = fexp(sc[tt < 9 ? tt : 0][i] - mx); rsum += p[i]; } }
            *(LAS unsigned long long*)(Pw + lc * APP + (16 * tt + 4 * lg) * 2) = (unsigned long long)pk2(p[0], p[1]) | ((unsigned long long)pk2(p[2], p[3]) << 32); }
        rsum += __shfl_xor(rsum, 16); rsum += __shfl_xor(rsum, 32);
        const float inv = 1.0f / (rsum + fexp(sink - mx));
        asm volatile("s_waitcnt lgkmcnt(0)" ::: "memory");
        f32x4 acc[4];
#pragma unroll
        for (int dt = 0; dt < 4; ++dt) acc[dt] = (f32x4){0.f, 0.f, 0.f, 0.f};
#pragma unroll
        for (int s = 0; s < 5; ++s) { const bf16x8 pf = *(const LAS bf16x8*)(Pw + lc * APP + (32 * s + 8 * lg) * 2);
#pragma unroll
            for (int dt = 0; dt < 4; ++dt) acc[dt] = MFMA16(*(const LAS bf16x8*)(Vt + (16 * dt + lc) * AVP + (16 * w + 32 * s + 8 * lg) * 2), pf, acc[dt]); }
        asm volatile("s_waitcnt lgkmcnt(0)" ::: "memory");
#pragma unroll
        for (int dt = 0; dt < 4; ++dt) *(GAS unsigned long long*)(MIXED + qrow * DM + h * 64 + 16 * dt + 4 * lg) =
            (unsigned long long)pk2(acc[dt][0] * inv, acc[dt][1] * inv) | ((unsigned long long)pk2(acc[dt][2] * inv, acc[dt][3] * inv) << 32);
    }
}

__device__ __forceinline__ void conv8_sample(const bf16* PROJ, const float* cw, const float* cb, const float* sconv, float* sconv_o, int b, int ch0, float (&y)[8]) {
    float r[4][8];
#pragma unroll
    for (int j = 0; j < 3; ++j) { const f32x4 u0 = *(const GAS f32x4*)(sconv + (size_t)(b * 3 + j) * XCW + ch0), u1 = *(const GAS f32x4*)(sconv + (size_t)(b * 3 + j) * XCW + ch0 + 4);
        r[j][0] = u0.x; r[j][1] = u0.y; r[j][2] = u0.z; r[j][3] = u0.w; r[j][4] = u1.x; r[j][5] = u1.y; r[j][6] = u1.z; r[j][7] = u1.w; }
    unpack8(*(const GAS v4u*)(PROJ + (size_t)(MP + b) * NINP + C_XBC + ch0), r[3]);
#pragma unroll
    for (int i = 0; i < 8; ++i) { float acc = cb[ch0 + i];
#pragma unroll
        for (int j = 0; j < 4; ++j) acc += cw[j * XCW + ch0 + i] * r[j][i];
        y[i] = siluf_(acc); }
#pragma unroll
    for (int j = 0; j < 3; ++j) { float* o = sconv_o + (size_t)(b * 3 + j) * XCW + ch0;
        *(GAS f32x4*)o = (f32x4){r[j + 1][0], r[j + 1][1], r[j + 1][2], r[j + 1][3]}; *(GAS f32x4*)(o + 4) = (f32x4){r[j + 1][4], r[j + 1][5], r[j + 1][6], r[j + 1][7]}; }
}
__device__ __forceinline__ void ssd_sample_item(Frame& F, int l, int b, int g) {
    const bf16* PROJ = (const bf16*)(ARGWS() + WS_PROJ); bf16* MIXED = (bf16*)(ARGWS() + WS_MIXED);
    const float* cw = ARGIN(12) + (size_t)l * 4 * XCW; const float* cb = ARGIN(13) + (size_t)l * XCW; const float* sconv = ARGIN(4) + (size_t)l * MS * 3 * XCW; float* sconv_o = ARGOUT() + O_SCONV + (size_t)l * MS * 3 * XCW;
    const int tid = F.tid, lane = F.lane, w = F.wave, p = tid >> 3, nq = tid & 7;
    LAS float* xs = (LAS float*)(F.lds);
    LAS float* Bs = xs + 512;
    LAS float* Cs = Bs + 128;
    LAS float* ys = Cs + 128;
    LAS float* red = ys + 512;
    __syncthreads();
    if (tid < 96) { const int ch0 = tid < 64 ? g * 512 + tid * 8 : (tid < 80 ? 1024 + g * 128 + (tid - 64) * 8 : 1280 + g * 128 + (tid - 80) * 8);
        float y[8]; conv8_sample(PROJ, cw, cb, sconv, sconv_o, b, ch0, y);
        LAS float* dst = tid < 64 ? xs + tid * 8 : (tid < 80 ? Bs + (tid - 64) * 8 : Cs + (tid - 80) * 8);
#pragma unroll
        for (int i = 0; i < 8; ++i) dst[i] = y[i]; }
    __syncthreads();
    float Bv[16], Cv[16];
#pragma unroll
    for (int i = 0; i < 16; ++i) { Bv[i] = Bs[nq * 16 + i]; Cv[i] = Cs[nq * 16 + i]; }
    float ssq = 0.f;
#pragma unroll 2
    for (int r = 0; r < 8; ++r) { const int h = g * 8 + r;
        const float dt = softplusf_(bf2f(PROJ[(size_t)(MP + b) * NINP + C_DT + h]) + ARGIN(14)[l * 16 + h]), dA = fexp(dt * -fexp(ARGIN(15)[l * 16 + h])), x = xs[r * 64 + p], coef = dt * x;
        const float* s0 = ARGIN(5) + ((((size_t)l * MS + b) * 16 + h) * 64 + p) * 128 + nq * 16; float* so = ARGOUT() + O_SSSM + ((((size_t)l * MS + b) * 16 + h) * 64 + p) * 128 + nq * 16;
        float y = 0.f;
#pragma unroll
        for (int i = 0; i < 4; ++i) { f32x4 v = *(const GAS f32x4*)(s0 + 4 * i);
            v.x = dA * v.x + coef * Bv[4 * i]; v.y = dA * v.y + coef * Bv[4 * i + 1]; v.z = dA * v.z + coef * Bv[4 * i + 2]; v.w = dA * v.w + coef * Bv[4 * i + 3];
            y += (v.x * Cv[4 * i] + v.y * Cv[4 * i + 1]) + (v.z * Cv[4 * i + 2] + v.w * Cv[4 * i + 3]);
            *(GAS f32x4*)(so + 4 * i) = v; }
        y += __shfl_xor(y, 1); y += __shfl_xor(y, 2); y += __shfl_xor(y, 4);
        if (nq == 0) { const float z = bf2f(PROJ[(size_t)(MP + b) * NINP + C_Z + h * 64 + p]); const float yo = (y + ARGIN(16)[l * 16 + h] * x) * siluf_(z); ys[r * 64 + p] = yo; ssq += yo * yo; } }
    ssq = wave_sum(ssq); if (lane == 0) red[w] = ssq;
    __syncthreads();
    const float tot = ((red[0] + red[1]) + (red[2] + red[3])) + ((red[4] + red[5]) + (red[6] + red[7])), rs = __builtin_amdgcn_rsqf(tot * (1.0f / 512.0f) + 1e-6f);
    ((unsigned short*)MIXED)[(size_t)(MP + b) * DM + 512 + g * 512 + tid] = (unsigned short)f2bf(ys[tid] * rs * ARGIN(17)[(size_t)l * 1024 + g * 512 + tid]);
}
__device__ __forceinline__ void mlstm_sample_item(Frame& F, int l, int b, int h) {
    const bf16* PROJ = (const bf16*)(ARGWS() + WS_PROJ); bf16* MIXED = (bf16*)(ARGWS() + WS_MIXED);
    const int tid = F.tid, lane = F.lane, w = F.wave, dg = tid >> 5, e4 = (tid & 31) * 4; const size_t prow = (size_t)(MP + b) * NINP, sidx = ((size_t)l * MS + b) * 4 + h;
    LAS float* qs = (LAS float*)(F.lds);
    LAS float* ks = qs + 128;
    LAS float* part = ks + 128;
    LAS float* red = part + 1024;
    const float m0 = ARGIN(8)[sidx];
    const float ig = bf2f(PROJ[prow + C_MI + h]) + ARGIN(18)[l * 4 + h], lf = logsigmoidf_(bf2f(PROJ[prow + C_MF + h]) + ARGIN(19)[l * 4 + h]);
    const float mn = fmaxf(lf + m0, ig), fgt = fexp(lf + m0 - mn), igt = fexp(ig - mn);
    __syncthreads();
    float dpart = 0.f;
    if (tid < 128) { const float q = bf2f(PROJ[prow + C_MQ + h * 128 + tid]), k = bf2f(PROJ[prow + C_MK + h * 128 + tid]) * 0.08838834764831845f * igt;
        qs[tid] = q; ks[tid] = k;
        const float nn = fgt * ARGIN(7)[sidx * 128 + tid] + k; ARGOUT()[O_SN + sidx * 128 + tid] = nn; dpart = q * nn; }
    dpart = wave_sum(dpart); if (lane == 0) red[w] = dpart;
    __syncthreads();
    const float den = red[0] + red[1];
    f32x4 vv; { const unsigned long long u = *(const GAS unsigned long long*)(PROJ + prow + C_MV + h * 128 + e4); vv = (f32x4){bflo((unsigned)u), bfhi((unsigned)u), bflo((unsigned)(u >> 32)), bfhi((unsigned)(u >> 32))}; }
    const float* c0 = ARGIN(6) + sidx * 16384; float* co = ARGOUT() + O_SC + sidx * 16384;
    f32x4 cr[8];
#pragma unroll
    for (int j = 0; j < 8; ++j) cr[j] = *(const GAS f32x4*)(c0 + (size_t)(dg + 16 * j) * 128 + e4);
    f32x4 num = (f32x4){0.f, 0.f, 0.f, 0.f};
#pragma unroll
    for (int j = 0; j < 8; ++j) { const int d = dg + 16 * j; const f32x4 cn = cr[j] * fgt + vv * ks[d]; *(GAS f32x4*)(co + (size_t)d * 128 + e4) = cn; num = num + cn * qs[d]; }
    num.x += __shfl_xor(num.x, 32); num.y += __shfl_xor(num.y, 32); num.z += __shfl_xor(num.z, 32); num.w += __shfl_xor(num.w, 32);
    if (lane < 32) *(LAS f32x4*)(part + w * 128 + e4) = num;
    __syncthreads();
    float hv = 0.f;
    if (tid < 128) { float s = 0.f;
#pragma unroll
        for (int j = 0; j < 8; ++j) s += part[j * 128 + tid];
        hv = s / fmaxf(fabsf(den), fexp(-mn)); }
    const float s2 = wave_sum(hv * hv); if (lane == 0) red[8 + w] = s2;
    __syncthreads();
    if (tid < 128) { const float rs = __builtin_amdgcn_rsqf((red[8] + red[9]) * (1.0f / 128.0f) + 1e-6f);
        ((unsigned short*)MIXED)[(size_t)(MP + b) * DM + 1536 + h * 128 + tid] = (unsigned short)f2bf(hv * rs * ARGIN(20)[(size_t)l * 512 + h * 128 + tid] * sigmoidf_(bf2f(PROJ[prow + C_MO + h * 128 + tid]))); }
    if (tid == 0) ARGOUT()[O_SM + sidx] = mn;
}

__device__ __forceinline__ void conv_phase(Frame& F, const Args& a, int l) {
    const bf16* PROJ = (const bf16*)(ARGWS() + WS_PROJ); bf16* XC = (bf16*)(ARGWS() + WS_XC);
    const float* cw = ARGIN(12) + (size_t)l * 4 * XCW; const float* cb = ARGIN(13) + (size_t)l * XCW; const float* sconv = ARGIN(4) + (size_t)l * MS * 3 * XCW;
    float* pconv = ARGOUT() + O_PCONV + (size_t)l * NB * 3 * XCW; float* sconv_o = ARGOUT() + O_SCONV + (size_t)l * MS * 3 * XCW;
    for (int idx = F.vcu * NTHR + F.tid; idx < (MS + NB * 3) * (XCW / 8); idx += F.G * NTHR) {
        const int rr_ = idx / (XCW / 8), c0 = (idx % (XCW / 8)) * 8;
        const int row = rr_ < MS ? MP + rr_ : ((rr_ - MS) / 3) * SEQL + (SEQL - 3) + (rr_ - MS) % 3;
        float r[4][8];
        if (row < MP) { const int t = row & (SEQL - 1);
#pragma unroll
            for (int j = 0; j < 4; ++j) { const int tt = t - 3 + j;
                if (tt >= 0) { const v4u w = *(const GAS v4u*)(PROJ + (size_t)(row - 3 + j) * NINP + C_XBC + c0); unpack8(w, r[j]); }
                else {
#pragma unroll
                    for (int i = 0; i < 8; ++i) r[j][i] = 0.f; } }
        } else { const int b = row - MP;
#pragma unroll
            for (int j = 0; j < 3; ++j) { const f32x4 u0 = *(const GAS f32x4*)(sconv + (size_t)(b * 3 + j) * XCW + c0), u1 = *(const GAS f32x4*)(sconv + (size_t)(b * 3 + j) * XCW + c0 + 4);
                r[j][0] = u0.x; r[j][1] = u0.y; r[j][2] = u0.z; r[j][3] = u0.w; r[j][4] = u1.x; r[j][5] = u1.y; r[j][6] = u1.z; r[j][7] = u1.w; }
            const v4u w = *(const GAS v4u*)(PROJ + (size_t)row * NINP + C_XBC + c0); unpack8(w, r[3]);
        }
        float y[8];
#pragma unroll
        for (int i = 0; i < 8; ++i) { float acc = cb[c0 + i];
#pragma unroll
            for (int j = 0; j < 4; ++j) acc += cw[j * XCW + c0 + i] * r[j][i];
            y[i] = siluf_(acc); }
        *(GAS v4u*)(XC + (size_t)row * XCW + c0) = pack8(y);
        if (row < MP) { const int t = row & (SEQL - 1), b = row >> 11;
            if (t >= SEQL - 3) { float* o = pconv + (size_t)(b * 3 + (t - (SEQL - 3))) * XCW + c0;
                *(GAS f32x4*)o = (f32x4){r[3][0], r[3][1], r[3][2], r[3][3]}; *(GAS f32x4*)(o + 4) = (f32x4){r[3][4], r[3][5], r[3][6], r[3][7]}; }
        } else { const int b = row - MP;
#pragma unroll
            for (int j = 0; j < 3; ++j) { float* o = sconv_o + (size_t)(b * 3 + j) * XCW + c0;
                *(GAS f32x4*)o = (f32x4){r[j + 1][0], r[j + 1][1], r[j + 1][2], r[j + 1][3]}; *(GAS f32x4*)(o + 4) = (f32x4){r[j + 1][4], r[j + 1][5], r[j + 1][6], r[j + 1][7]}; }
        }
    }
}

__device__ __forceinline__ void ssd_seq_item(Frame& F, const Args& a, int l, int b, int h, bool sample) {
    const bf16* PROJ = (const bf16*)(ARGWS() + WS_PROJ); const bf16* XC = (const bf16*)(ARGWS() + WS_XC); float* YG = (float*)(ARGWS() + WS_YG);
    const int row0 = sample ? MP + b : b * SEQL, L = sample ? 1 : SEQL, g = h >> 3, tid = F.tid;
    const float A = -expf(ARGIN(15)[l * 16 + h]), dtb = ARGIN(14)[l * 16 + h], Dh = ARGIN(16)[l * 16 + h];
    const int p = tid >> 3, nq = tid & 7;
    float S[16];
    if (sample) { const float* s0 = ARGIN(5) + ((((size_t)l * MS + b) * 16 + h) * 64 + p) * 128 + nq * 16;
#pragma unroll
        for (int i = 0; i < 4; ++i) { const f32x4 v = *(const GAS f32x4*)(s0 + 4 * i); S[4 * i] = v.x; S[4 * i + 1] = v.y; S[4 * i + 2] = v.z; S[4 * i + 3] = v.w; } }
    else {
#pragma unroll
        for (int i = 0; i < 16; ++i) S[i] = 0.f; }
    LAS float* xs = (LAS float*)(F.lds);
    LAS float* Bs = (LAS float*)(F.lds + 16384);
    LAS float* Cs = (LAS float*)(F.lds + 49152);
    LAS float* ys = (LAS float*)(F.lds + 81920);
    LAS float* dts = (LAS float*)(F.lds + 98304);
    LAS float* das = (LAS float*)(F.lds + 98304 + 256);
    for (int t0 = 0; t0 < L; t0 += 64) {
        const int nb = (L - t0) < 64 ? (L - t0) : 64;
        __syncthreads();
        { const int tt = tid >> 3, ch = tid & 7;
          if (tt < nb) { float f[8]; unpack8(*(const GAS v4u*)(XC + (size_t)(row0 + t0 + tt) * XCW + h * 64 + ch * 8), f);
#pragma unroll
              for (int i = 0; i < 8; ++i) xs[tt * 64 + ch * 8 + i] = f[i]; } }
#pragma unroll
        for (int rep = 0; rep < 2; ++rep) { const int task = tid + rep * NTHR, tt = task >> 4, ch = task & 15;
          if (tt < nb) { float f[8]; unpack8(*(const GAS v4u*)(XC + (size_t)(row0 + t0 + tt) * XCW + 1024 + g * 128 + ch * 8), f);
#pragma unroll
              for (int i = 0; i < 8; ++i) Bs[tt * 128 + ch * 8 + i] = f[i];
              unpack8(*(const GAS v4u*)(XC + (size_t)(row0 + t0 + tt) * XCW + 1280 + g * 128 + ch * 8), f);
#pragma unroll
              for (int i = 0; i < 8; ++i) Cs[tt * 128 + ch * 8 + i] = f[i]; } }
        if (tid < nb) { const float dt = softplusf_(bf2f(PROJ[(size_t)(row0 + t0 + tid) * NINP + C_DT + h]) + dtb); dts[tid] = dt; das[tid] = expf(dt * A); }
        __syncthreads();
        for (int tt = 0; tt < nb; ++tt) {
            const float dt = dts[tt], dA = das[tt], x = xs[tt * 64 + p], coef = dt * x;
            float y = 0.f;
#pragma unroll
            for (int i = 0; i < 16; ++i) { S[i] = dA * S[i] + coef * Bs[tt * 128 + nq * 16 + i]; y += S[i] * Cs[tt * 128 + nq * 16 + i]; }
            y += __shfl_xor(y, 1); y += __shfl_xor(y, 2); y += __shfl_xor(y, 4);
            if (nq == 0) ys[tt * 64 + p] = y + Dh * x;
        }
        __syncthreads();
        { const int tt = tid >> 3, ch = tid & 7;
          if (tt < nb) { float z[8]; unpack8(*(const GAS v4u*)(PROJ + (size_t)(row0 + t0 + tt) * NINP + C_Z + h * 64 + ch * 8), z);
              float o[8];
#pragma unroll
              for (int i = 0; i < 8; ++i) o[i] = ys[tt * 64 + ch * 8 + i] * siluf_(z[i]);
              float* dst = YG + (size_t)(row0 + t0 + tt) * 1024 + h * 64 + ch * 8;
              *(GAS f32x4*)dst = (f32x4){o[0], o[1], o[2], o[3]}; *(GAS f32x4*)(dst + 4) = (f32x4){o[4], o[5], o[6], o[7]}; } }
    }
    float* so = ARGOUT() + (sample ? O_SSSM + ((((size_t)l * MS + b) * 16 + h) * 64 + p) * 128 : O_PSSM + ((((size_t)l * NB + b) * 16 + h) * 64 + p) * 128) + nq * 16;
#pragma unroll
    for (int i = 0; i < 4; ++i) *(GAS f32x4*)(so + 4 * i) = (f32x4){S[4 * i], S[4 * i + 1], S[4 * i + 2], S[4 * i + 3]};
}

__device__ __forceinline__ void mlstm_seq_item(Frame& F, const Args& a, int l, int b, int h, int es, bool sample) {
    const bf16* PROJ = (const bf16*)(ARGWS() + WS_PROJ); float* HR = (float*)(ARGWS() + WS_HR);
    const int row0 = sample ? MP + b : b * SEQL, L = sample ? 1 : SEQL, tid = F.tid, w = F.wave, lane = F.lane;
    const int e0 = es * 32 + w * 4, d0 = 2 * lane, Bn = sample ? MS : NB;
    const float ib = ARGIN(18)[l * 4 + h], fb = ARGIN(19)[l * 4 + h];
    float C[2][4], n[2], m;
    if (sample) {
#pragma unroll
        for (int dd = 0; dd < 2; ++dd) { const f32x4 v = *(const GAS f32x4*)(ARGIN(6) + ((((size_t)l * MS + b) * 4 + h) * 128 + d0 + dd) * 128 + e0);
            C[dd][0] = v.x; C[dd][1] = v.y; C[dd][2] = v.z; C[dd][3] = v.w; n[dd] = ARGIN(7)[(((size_t)l * MS + b) * 4 + h) * 128 + d0 + dd]; }
        m = ARGIN(8)[((size_t)l * MS + b) * 4 + h];
    } else {
#pragma unroll
        for (int dd = 0; dd < 2; ++dd) { n[dd] = 0.f;
#pragma unroll
            for (int j = 0; j < 4; ++j) C[dd][j] = 0.f; }
        m = 0.f;
    }
    LAS float* qs = (LAS float*)(F.lds);
    LAS float* ks = (LAS float*)(F.lds + 32768);
    LAS float* vs = (LAS float*)(F.lds + 65536);
    LAS float* hs = (LAS float*)(F.lds + 73728);
    LAS float* igs = (LAS float*)(F.lds + 81920);
    LAS float* lfs = (LAS float*)(F.lds + 81920 + 256);
    for (int t0 = 0; t0 < L; t0 += 64) {
        const int nb = (L - t0) < 64 ? (L - t0) : 64;
        __syncthreads();
#pragma unroll
        for (int rep = 0; rep < 2; ++rep) { const int task = tid + rep * NTHR, tt = task >> 4, ch = task & 15;
          if (tt < nb) { float f[8]; unpack8(*(const GAS v4u*)(PROJ + (size_t)(row0 + t0 + tt) * NINP + C_MQ + h * 128 + ch * 8), f);
#pragma unroll
              for (int i = 0; i < 8; ++i) qs[tt * 128 + ch * 8 + i] = f[i];
              unpack8(*(const GAS v4u*)(PROJ + (size_t)(row0 + t0 + tt) * NINP + C_MK + h * 128 + ch * 8), f);
#pragma unroll
              for (int i = 0; i < 8; ++i) ks[tt * 128 + ch * 8 + i] = f[i] * 0.08838834764831845f; } }
        if (tid < 256) { const int tt = tid >> 2, ch = tid & 3;
          if (tt < nb) { float f[8]; unpack8(*(const GAS v4u*)(PROJ + (size_t)(row0 + t0 + tt) * NINP + C_MV + h * 128 + es * 32 + ch * 8), f);
#pragma unroll
              for (int i = 0; i < 8; ++i) vs[tt * 32 + ch * 8 + i] = f[i]; } }
        if (tid < nb) { igs[tid] = bf2f(PROJ[(size_t)(row0 + t0 + tid) * NINP + C_MI + h]) + ib; lfs[tid] = logsigmoidf_(bf2f(PROJ[(size_t)(row0 + t0 + tid) * NINP + C_MF + h]) + fb); }
        __syncthreads();
        for (int tt = 0; tt < nb; ++tt) {
            const float lf = lfs[tt], ig = igs[tt];
            const float m_new = fmaxf(lf + m, ig), fgt = expf(lf + m - m_new), igt = expf(ig - m_new); m = m_new;
            const float q0 = qs[tt * 128 + d0], q1 = qs[tt * 128 + d0 + 1], k0 = ks[tt * 128 + d0] * igt, k1 = ks[tt * 128 + d0 + 1] * igt;
            n[0] = fgt * n[0] + k0; n[1] = fgt * n[1] + k1;
            float red[5]; red[4] = q0 * n[0] + q1 * n[1];
#pragma unroll
            for (int j = 0; j < 4; ++j) { const float v = vs[tt * 32 + w * 4 + j]; C[0][j] = fgt * C[0][j] + k0 * v; C[1][j] = fgt * C[1][j] + k1 * v; red[j] = q0 * C[0][j] + q1 * C[1][j]; }
#pragma unroll
            for (int j = 0; j < 5; ++j) red[j] = wave_sum(red[j]);
            const float dn = fmaxf(fabsf(red[4]), expf(-m));
            if (lane < 4) hs[tt * 32 + w * 4 + lane] = (lane == 0 ? red[0] : lane == 1 ? red[1] : lane == 2 ? red[2] : red[3]) / dn;
        }
        __syncthreads();
        { const int tt = tid >> 3, e4 = (tid & 7) * 4;
          if (tt < nb) *(GAS f32x4*)(HR + (size_t)(row0 + t0 + tt) * 512 + h * 128 + es * 32 + e4) = (f32x4){hs[tt * 32 + e4], hs[tt * 32 + e4 + 1], hs[tt * 32 + e4 + 2], hs[tt * 32 + e4 + 3]}; }
    }
    float* co = ARGOUT() + (sample ? O_SC : O_PC) + (((size_t)l * Bn + b) * 4 + h) * 128 * 128;
#pragma unroll
    for (int dd = 0; dd < 2; ++dd) *(GAS f32x4*)(co + (size_t)(d0 + dd) * 128 + e0) = (f32x4){C[dd][0], C[dd][1], C[dd][2], C[dd][3]};
    if (es == 0 && w == 0) { float* no = ARGOUT() + (sample ? O_SN : O_PN) + (((size_t)l * Bn + b) * 4 + h) * 128; no[d0] = n[0]; no[d0 + 1] = n[1];
        if (lane == 0) ARGOUT()[(sample ? O_SM : O_PM) + ((size_t)l * Bn + b) * 4 + h] = m; }
}

__device__ __forceinline__ void attn_prompt_item(Frame& F, const Args& a, int l, int b, int blk, int kvh) {
    const bf16* PROJ = (const bf16*)(ARGWS() + WS_PROJ); bf16* MIXED = (bf16*)(ARGWS() + WS_MIXED);
    constexpr int KP = 68;
    LAS unsigned short* Ks = (LAS unsigned short*)(F.lds); LAS unsigned short* Vs = (LAS unsigned short*)(F.lds + 256 * KP * 2);
    const int tid = F.tid, w0 = blk * 128 - 128;
    float* pk = ARGOUT() + O_PK + (size_t)(l * NB + b) * 128 * 128; float* pv = ARGOUT() + O_PV + (size_t)(l * NB + b) * 128 * 128;
    __syncthreads();
#pragma unroll
    for (int rep = 0; rep < 4; ++rep) { const int task = tid + rep * NTHR, r = task >> 3, c = task & 7, pos = w0 + r; const bool keep = (blk == 15 && r >= 128);
        if (pos < 0) { *(LAS v4u*)(Ks + r * KP + c * 8) = (v4u){0u, 0u, 0u, 0u}; *(LAS v4u*)(Vs + r * KP + c * 8) = (v4u){0u, 0u, 0u, 0u}; continue; }
        const size_t grow = (size_t)(b * SEQL + pos) * NINP;
        { const v4u wv = *(const GAS v4u*)(PROJ + grow + C_V + kvh * 64 + c * 8); *(LAS v4u*)(Vs + r * KP + c * 8) = wv;
          if (keep) { float f[8]; unpack8(wv, f); float* o = pv + (size_t)((r - 128) * 2 + kvh) * 64 + c * 8; *(GAS f32x4*)o = (f32x4){f[0], f[1], f[2], f[3]}; *(GAS f32x4*)(o + 4) = (f32x4){f[4], f[5], f[6], f[7]}; } }
        if (c >= 2) { const v4u wk = *(const GAS v4u*)(PROJ + grow + C_K + kvh * 64 + c * 8); *(LAS v4u*)(Ks + r * KP + c * 8) = wk;
          if (keep) { float f[8]; unpack8(wk, f); float* o = pk + (size_t)((r - 128) * 2 + kvh) * 64 + c * 8; *(GAS f32x4*)o = (f32x4){f[0], f[1], f[2], f[3]}; *(GAS f32x4*)(o + 4) = (f32x4){f[4], f[5], f[6], f[7]}; } }
        else if (c == 0) { float x1[8], x2[8], cs[8], sn[8], o1[8], o2[8];
          unpack8(*(const GAS v4u*)(PROJ + grow + C_K + kvh * 64), x1); unpack8(*(const GAS v4u*)(PROJ + grow + C_K + kvh * 64 + 8), x2); rope_cs(pos, cs, sn);
#pragma unroll
          for (int i = 0; i < 8; ++i) { o1[i] = x1[i] * cs[i] - x2[i] * sn[i]; o2[i] = x2[i] * cs[i] + x1[i] * sn[i]; }
          *(LAS v4u*)(Ks + r * KP) = pack8(o1); *(LAS v4u*)(Ks + r * KP + 8) = pack8(o2);
          if (keep) { float* o = pk + (size_t)((r - 128) * 2 + kvh) * 64; *(GAS f32x4*)o = (f32x4){o1[0], o1[1], o1[2], o1[3]}; *(GAS f32x4*)(o + 4) = (f32x4){o1[4], o1[5], o1[6], o1[7]};
              *(GAS f32x4*)(o + 8) = (f32x4){o2[0], o2[1], o2[2], o2[3]}; *(GAS f32x4*)(o + 12) = (f32x4){o2[4], o2[5], o2[6], o2[7]}; } }
    }
    __syncthreads();
    const int i = tid >> 2, g = tid & 3, h = kvh * 4 + g, qpos = blk * 128 + i; const size_t row = (size_t)b * SEQL + qpos;
    float q[64];
#pragma unroll
    for (int c = 0; c < 8; ++c) { float f[8]; unpack8(*(const GAS v4u*)(PROJ + row * NINP + C_Q + h * 64 + c * 8), f);
#pragma unroll
        for (int e = 0; e < 8; ++e) q[c * 8 + e] = f[e]; }
    { float cs[8], sn[8]; rope_cs(qpos, cs, sn);
#pragma unroll
      for (int e = 0; e < 8; ++e) { const float x1 = q[e], x2 = q[8 + e]; q[e] = x1 * cs[e] - x2 * sn[e]; q[8 + e] = x2 * cs[e] + x1 * sn[e]; } }
#pragma unroll
    for (int e = 0; e < 64; ++e) q[e] *= 0.125f;
    float acc[64], mx = -INFINITY, sum = 0.f;
#pragma unroll
    for (int e = 0; e < 64; ++e) acc[e] = 0.f;
    for (int jj = 0; jj <= 128; ++jj) { const int r = i + jj;
        if (w0 + r < 0) continue;
        float s = 0.f;
#pragma unroll
        for (int c = 0; c < 8; ++c) { float f[8]; unpack8(*(const LAS v4u*)(Ks + r * KP + c * 8), f);
#pragma unroll
            for (int e = 0; e < 8; ++e) s += q[c * 8 + e] * f[e]; }
        const float mn = fmaxf(mx, s), sc = expf(mx - mn), p = expf(s - mn); mx = mn; sum = sum * sc + p;
#pragma unroll
        for (int c = 0; c < 8; ++c) { float f[8]; unpack8(*(const LAS v4u*)(Vs + r * KP + c * 8), f);
#pragma unroll
            for (int e = 0; e < 8; ++e) acc[c * 8 + e] = acc[c * 8 + e] * sc + p * f[e]; }
    }
    const float sink = ARGIN(11)[l * 8 + h], mf = fmaxf(mx, sink), sc = expf(mx - mf), den = sum * sc + expf(sink - mf), inv = sc / den;
#pragma unroll
    for (int c = 0; c < 8; ++c) { float o[8];
#pragma unroll
        for (int e = 0; e < 8; ++e) o[e] = acc[c * 8 + e] * inv;
        *(GAS v4u*)(MIXED + row * DM + h * 64 + c * 8) = pack8(o); }
}

__device__ __forceinline__ void attn_sample_item(Frame& F, const Args& a, int l, int b) {
    const bf16* PROJ = (const bf16*)(ARGWS() + WS_PROJ); bf16* MIXED = (bf16*)(ARGWS() + WS_MIXED);
    const int tid = F.tid, h = F.wave, lane = F.lane, kvh = h >> 2; const size_t prow = (size_t)(MP + b) * NINP;
    LAS float* qs = (LAS float*)(F.lds);
    LAS float* ps = (LAS float*)(F.lds + 2048);
    LAS float* knew = (LAS float*)(F.lds + 2048 + 4224);
    LAS float* vnew = knew + 128;
    const float* ck = ARGIN(2) + (size_t)(l * MS + b) * 128 * 128; const float* cv = ARGIN(3) + (size_t)(l * MS + b) * 128 * 128;
    __syncthreads();
    { float cs[8], sn[8]; rope_cs(8192, cs, sn);
      const int d = lane; float x = bf2f(PROJ[prow + C_Q + h * 64 + d]);
      if (d < 16) { const float xp = bf2f(PROJ[prow + C_Q + h * 64 + (d ^ 8)]); const float c = (d & 7) == 0 ? cs[0] : (d & 7) == 1 ? cs[1] : (d & 7) == 2 ? cs[2] : (d & 7) == 3 ? cs[3] : (d & 7) == 4 ? cs[4] : (d & 7) == 5 ? cs[5] : (d & 7) == 6 ? cs[6] : cs[7];
          const float s = (d & 7) == 0 ? sn[0] : (d & 7) == 1 ? sn[1] : (d & 7) == 2 ? sn[2] : (d & 7) == 3 ? sn[3] : (d & 7) == 4 ? sn[4] : (d & 7) == 5 ? sn[5] : (d & 7) == 6 ? sn[6] : sn[7];
          x = d < 8 ? x * c - xp * s : x * c + xp * s; }
      qs[h * 64 + d] = x * 0.125f;
      if (h < 2) { float y = bf2f(PROJ[prow + C_K + h * 64 + d]);
          if (d < 16) { const float yp = bf2f(PROJ[prow + C_K + h * 64 + (d ^ 8)]); const float c = (d & 7) == 0 ? cs[0] : (d & 7) == 1 ? cs[1] : (d & 7) == 2 ? cs[2] : (d & 7) == 3 ? cs[3] : (d & 7) == 4 ? cs[4] : (d & 7) == 5 ? cs[5] : (d & 7) == 6 ? cs[6] : cs[7];
              const float s = (d & 7) == 0 ? sn[0] : (d & 7) == 1 ? sn[1] : (d & 7) == 2 ? sn[2] : (d & 7) == 3 ? sn[3] : (d & 7) == 4 ? sn[4] : (d & 7) == 5 ? sn[5] : (d & 7) == 6 ? sn[6] : sn[7];
              y = d < 8 ? y * c - yp * s : y * c + yp * s; }
          knew[h * 64 + d] = y; vnew[h * 64 + d] = bf2f(PROJ[prow + C_V + h * 64 + d]); } }
    __syncthreads();
    float sa = 0.f, sb = 0.f, sn_ = 0.f;
    { const float* ka = ck + (size_t)(lane * 2 + kvh) * 64; const float* kb = ck + (size_t)((lane + 64) * 2 + kvh) * 64;
#pragma unroll
      for (int c = 0; c < 16; ++c) { const f32x4 x = *(const GAS f32x4*)(ka + 4 * c), y = *(const GAS f32x4*)(kb + 4 * c); const f32x4 qv = *(const LAS f32x4*)(qs + h * 64 + 4 * c), kn = *(const LAS f32x4*)(knew + kvh * 64 + 4 * c);
          sa += (qv.x * x.x + qv.y * x.y) + (qv.z * x.z + qv.w * x.w); sb += (qv.x * y.x + qv.y * y.y) + (qv.z * y.z + qv.w * y.w); sn_ += (qv.x * kn.x + qv.y * kn.y) + (qv.z * kn.z + qv.w * kn.w); } }
    const float sink = ARGIN(11)[l * 8 + h];
    const float mx = fmaxf(fmaxf(wave_max(fmaxf(sa, sb)), sn_), sink);
    const float ea = expf(sa - mx), eb = expf(sb - mx), en = expf(sn_ - mx);
    const float inv = 1.0f / (wave_sum(ea + eb) + en + expf(sink - mx));
    ps[h * 132 + lane] = ea * inv; ps[h * 132 + 64 + lane] = eb * inv; if (lane == 0) ps[h * 132 + 128] = en * inv;
    __syncthreads();
    { float o = ps[h * 132 + 128] * vnew[kvh * 64 + lane];
      for (int j = 0; j < 128; ++j) o += ps[h * 132 + j] * cv[(size_t)(j * 2 + kvh) * 64 + lane];
      ((unsigned short*)MIXED)[(size_t)(MP + b) * DM + h * 64 + lane] = (unsigned short)f2bf(o); }
    float* sk = ARGOUT() + O_SK + (size_t)(l * MS + b) * 128 * 128; float* sv = ARGOUT() + O_SV + (size_t)(l * MS + b) * 128 * 128;
    for (int idx = tid * 4; idx < 128 * 128; idx += NTHR * 4) { const int j = idx >> 7, rem = idx & 127;
        f32x4 kk, vv;
        if (j < 127) { kk = *(const GAS f32x4*)(ck + idx + 128); vv = *(const GAS f32x4*)(cv + idx + 128); }
        else { kk = *(const LAS f32x4*)(knew + rem); vv = *(const LAS f32x4*)(vnew + rem); }
        *(GAS f32x4*)(sk + idx) = kk; *(GAS f32x4*)(sv + idx) = vv; }
}

__device__ __forceinline__ bool queue_next(Frame& F, gu32* head, int& it) {
    volatile LAS unsigned* slot = F.MISC + 16;
    __syncthreads();
    if (F.tid == 0) slot[0] = __hip_atomic_fetch_add(head, 1u, RLX_AGENT);
    __syncthreads();
    it = (int)slot[0];
    { int t_ = threadIdx.x; asm volatile("" : "+v"(t_)); F.tid = t_; F.lane = t_ & 63; F.wave = __builtin_amdgcn_readfirstlane(t_ >> 6); }
    return true;
}
__device__ __forceinline__ void mixer_phase(Frame& F, const Args& a, int l, int qslot) {
    constexpr int N_ATP = NB * 16 * 2, N_SSDA = NB * 2 * 16 * 2, N_MLA = NB * 4 * 16, N_SSDS = MS * 2, N_MLS = MS * 4, N_ATS = MS;
    constexpr int E0 = N_ATP, E1 = E0 + N_SSDA, E2 = E1 + N_MLA, E3 = E2 + N_SSDS, E4 = E3 + N_MLS, E5 = E4 + N_ATS;
    gu32* head = F.ctl + CW_QUEUE + 64 * qslot;
    for (;;) {
        int it; queue_next(F, head, it);
        if (it >= E5) break;
        if (it < E0) attn_mfma_item(F, l, it >> 5, (it >> 1) & 15, it & 1);
        else if (it < E1) { const int r = it - E0; ssd_a_item(F, l, r >> 6, (r >> 5) & 1, (r >> 1) & 15, r & 1); }
        else if (it < E2) { const int r = it - E1; mlstm_a_item(F, l, r >> 6, (r >> 4) & 3, r & 15); }
        else if (it < E3) { const int r = it - E2; ssd_sample_item(F, l, r >> 1, r & 1); }
        else if (it < E4) { const int r = it - E3; mlstm_sample_item(F, l, r >> 2, r & 3); }
        else attn_sample_item(F, a, l, it - E4);
    }
}
__device__ __forceinline__ void mixer_c_phase(Frame& F, int l, int qslot) {
    constexpr int N_SSDC = NB * 2 * 16, N_MLC = NB * 4 * 16;
    gu32* head = F.ctl + CW_QUEUE + 64 * qslot;
    for (;;) {
        int it; queue_next(F, head, it);
        if (it >= N_SSDC + N_MLC) break;
        if (it < N_SSDC) ssd_c_item(F, l, it >> 5, (it >> 4) & 1, it & 15);
        else { const int r = it - N_SSDC; mlstm_c_item(F, l, r >> 6, (r >> 4) & 3, r & 15); }
    }
}

__device__ __forceinline__ void finalize_phase(Frame& F, const Args& a, int l) {
    const bf16* PROJ = (const bf16*)(ARGWS() + WS_PROJ); bf16* MIXED = (bf16*)(ARGWS() + WS_MIXED); const float* YG = (const float*)(ARGWS() + WS_YG); const float* HR = (const float*)(ARGWS() + WS_HR);
    const float* wssm = ARGIN(17) + (size_t)l * 1024; const float* wml = ARGIN(20) + (size_t)l * 512;
    const int gw = F.vcu * NWAVES + F.wave, NGW = F.G * NWAVES, lane = F.lane;
    for (int row = MP + gw; row < MT; row += NGW) {
#pragma unroll
        for (int g = 0; g < 2; ++g) { const float* src = YG + (size_t)row * 1024 + g * 512 + lane * 8; const f32x4 u0 = *(const GAS f32x4*)src, u1 = *(const GAS f32x4*)(src + 4);
            float ss = (u0.x * u0.x + u0.y * u0.y) + (u0.z * u0.z + u0.w * u0.w) + (u1.x * u1.x + u1.y * u1.y) + (u1.z * u1.z + u1.w * u1.w);
            ss = wave_sum(ss); const float rs = 1.0f / sqrtf(ss * (1.0f / 512.0f) + 1e-6f);
            const float* wp = wssm + g * 512 + lane * 8; const f32x4 w0 = *(const GAS f32x4*)wp, w1 = *(const GAS f32x4*)(wp + 4);
            float o[8] = {u0.x * rs * w0.x, u0.y * rs * w0.y, u0.z * rs * w0.z, u0.w * rs * w0.w, u1.x * rs * w1.x, u1.y * rs * w1.y, u1.z * rs * w1.z, u1.w * rs * w1.w};
            *(GAS v4u*)(MIXED + (size_t)row * DM + 512 + g * 512 + lane * 8) = pack8(o); }
#pragma unroll
        for (int hh = 0; hh < 4; ++hh) { const float* src = HR + (size_t)row * 512 + hh * 128 + lane * 2; const float v0 = src[0], v1 = src[1];
            const float ss = wave_sum(v0 * v0 + v1 * v1), rs = 1.0f / sqrtf(ss * (1.0f / 128.0f) + 1e-6f);
            const unsigned mo = *(const GAS unsigned*)(PROJ + (size_t)row * NINP + C_MO + hh * 128 + lane * 2);
            const float o0 = v0 * rs * wml[hh * 128 + lane * 2] * sigmoidf_(bflo(mo)), o1 = v1 * rs * wml[hh * 128 + lane * 2 + 1] * sigmoidf_(bfhi(mo));
            *(GAS unsigned*)(MIXED + (size_t)row * DM + 1536 + hh * 128 + lane * 2) = pk2(o0, o1); }
    }
}

__device__ __forceinline__ void final_norm_phase(Frame& F, const Args& a) {
    const float* SSQ = (const float*)(ARGWS() + WS_SSQA); const float* wf = ARGIN(25);
    const int gw = F.vcu * NWAVES + F.wave, NGW = F.G * NWAVES, lane = F.lane;
    for (int row = gw; row < MT; row += NGW) {
        const f32x4 p0 = *(const GAS f32x4*)(SSQ + (size_t)row * 8), p1 = *(const GAS f32x4*)(SSQ + (size_t)row * 8 + 4);
        const float ss = ((p0.x + p0.y) + (p0.z + p0.w)) + ((p1.x + p1.y) + (p1.z + p1.w)), rs = 1.0f / sqrtf(ss * (1.0f / 2048.0f) + 1e-6f);
        GAS f32x4* y = (GAS f32x4*)(ARGOUT() + O_Y + (size_t)row * DM) + lane; const GAS f32x4* wv = (const GAS f32x4*)wf + lane;
#pragma unroll
        for (int j = 0; j < 8; ++j) { const f32x4 v = y[64 * j], g = wv[64 * j]; y[64 * j] = (f32x4){v.x * rs * g.x, v.y * rs * g.y, v.z * rs * g.z, v.w * rs * g.w}; }
    }
}

#ifndef MK_N_LAUNCHES
#define MK_N_LAUNCHES 1
#endif
constexpr int N_PHASES = 16;
#ifndef MK_REP_G1
#define MK_REP_G1 1
#endif
#ifndef MK_REP_G3
#define MK_REP_G3 1
#endif
#ifndef MK_REP_M1
#define MK_REP_M1 1
#endif
#ifndef MK_REP_M3
#define MK_REP_M3 1
#endif
__global__ void __launch_bounds__(NTHR, 2) mk_fwd(Args args) {
    extern __shared__ __attribute__((aligned(16))) unsigned char lds[];
    Frame F;
    F.lds = (LAS unsigned char*)lds;
    F.MISC = (volatile LAS unsigned*)(F.lds + MISC_OFF);
    F.tid = threadIdx.x; F.lane = F.tid & 63; F.wave = __builtin_amdgcn_readfirstlane(F.tid >> 6);
    F.G = gridDim.x; { const int bx = blockIdx.x; F.vcu = (F.G % 8 == 0) ? (bx % 8) * (F.G / 8) + bx / 8 : bx; }
    unsigned char* ws = ARGWS();
    F.ctl = (gu32*)(ws + WS_CTL);
    for (int u = F.tid; u < (LDS_BYTES - LDSCTL_OFF) / 4; u += NTHR) ((LAS unsigned*)(F.lds + LDSCTL_OFF))[u] = 0u;
    __syncthreads();
    const int lo = args.ph_lo, hi = args.ph_hi;
    const bool use_bar = (hi - lo) > 1;
    XcdBarrier bar; bar.bar = (unsigned*)(F.ctl + CW_BAR); bar.x = 0; bar.st = nullptr;
    if (use_bar) bar = xcd_barrier_post((unsigned*)(F.ctl + CW_BAR), F.MISC + 8);
#define IN(k) (lo <= (k) && (k) < hi)
#define PHASE_BEGIN() do { int t_ = threadIdx.x, v_ = vcu0, g_ = G0; asm volatile("" : "+v"(t_)); asm volatile("" : "+s"(v_), "+s"(g_)); F.tid = t_; F.lane = t_ & 63; F.wave = __builtin_amdgcn_readfirstlane(t_ >> 6); F.vcu = v_; F.G = g_; } while (0)
#define SEAM(k) do { if (IN(k) && IN((k) + 1)) xcd_barrier(bar); } while (0)

#define WSP(T, off) ((T*)(ARGWS() + (off)))
#define DECL_WS() bf16* XB = WSP(bf16, WS_XB); float* XRES = WSP(float, WS_XRES); bf16* HBUF = WSP(bf16, WS_HBUF); bf16* PROJ = WSP(bf16, WS_PROJ); bf16* MIXED = WSP(bf16, WS_MIXED); \
    float* SSQA = WSP(float, WS_SSQA); float* SSQB = WSP(float, WS_SSQB); \
    const bf16* Wi = WSP(const bf16, WS_WIN + l * WIN_BYTES); const bf16* Wo = WSP(const bf16, WS_WOUT + l * WOUT_BYTES); const bf16* Wu = WSP(const bf16, WS_WUP + l * WUP_BYTES); const bf16* Wd = WSP(const bf16, WS_WDN + l * WDN_BYTES); \
    (void)XB; (void)XRES; (void)HBUF; (void)PROJ; (void)MIXED; (void)SSQA; (void)SSQB; (void)Wi; (void)Wo; (void)Wu; (void)Wd

    const int vcu0 = F.vcu, G0 = F.G;
    if (IN(0)) { PHASE_BEGIN(); p0_prologue(F, args); }
    SEAM(0);
    for (int l = 0; l < DEPTH; ++l) {
        const int pb = 1 + 7 * l;
        for (int rep_ = 0; rep_ < MK_REP_G1; ++rep_) if (IN(pb)) { if (rep_) xcd_barrier(bar); PHASE_BEGIN(); DECL_WS();
            pg8::Gemm g{XB, Wi, MPAD, NINP, DM}; pg8::StaticOrder S; S.init(MPAD, NINP, F.G, (int)blockIdx.x);
            pg8::EpiScaleBf16<0> E{PROJ, NINP, SSQA};
            pg8::gemm_phase<pg8::EpiScaleBf16<0>, pg8::StaticOrder, true, true>(F.lds + RING_OFF, g, S, E, F.tid);
            if (blockIdx.x == 0) for (int i = F.tid; i < MS * 8; i += NTHR) SSQB[(size_t)MP * 8 + i] = 0.f;
        }
        SEAM(pb);
        for (int rep_ = 0; rep_ < MK_REP_M1; ++rep_) if (IN(pb + 1)) { if (rep_) xcd_barrier(bar); PHASE_BEGIN(); mixer_phase(F, args, l, l + 4 * rep_); }

        SEAM(pb + 1);
        if (IN(pb + 2)) { PHASE_BEGIN(); mlstm_scan_phase(F, l); ssd_scan_phase(F, l); }
        SEAM(pb + 2);
        for (int rep_ = 0; rep_ < MK_REP_M3; ++rep_) if (IN(pb + 3)) { if (rep_) xcd_barrier(bar); PHASE_BEGIN(); mixer_c_phase(F, l, 2 + l + 4 * rep_); }
        SEAM(pb + 3);
        if (IN(pb + 4)) { PHASE_BEGIN(); DECL_WS();
            const float* basep = l == 0 ? ARGIN(0) : XRES; const float* bases = l == 0 ? ARGIN(1) : XRES + (size_t)MP * DM;
            pg8::Gemm g{MIXED, Wo, MP, DM, DM}; pg8::StaticOrder S; S.init(MP, DM, F.G, (int)blockIdx.x);
            pg8::EpiResid E{basep, XRES, XB, SSQB, DM};
            pg8::gemm_phase<pg8::EpiResid, pg8::StaticOrder, false, true>(F.lds + RING_OFF, g, S, E, F.tid);
            float* outs = XRES + (size_t)MP * DM; bf16* xbs = XB + (size_t)MP * DM; float* sq = SSQB + (size_t)MP * 8;
            thin_gemm(F, MIXED + (size_t)MP * DM, DM, Wo, DM, DM, [&](int row, int col, f32x4 acc) {
                const f32x4 bs = *(const GAS f32x4*)(bases + (size_t)row * DM + col); const f32x4 o = bs + acc;
                *(GAS f32x4*)(outs + (size_t)row * DM + col) = o;
                *(GAS unsigned long long*)(xbs + (size_t)row * DM + col) = (unsigned long long)pk2(o.x, o.y) | ((unsigned long long)pk2(o.z, o.w) << 32);
                float s = (o.x * o.x + o.y * o.y) + (o.z * o.z + o.w * o.w); s += __shfl_xor(s, 16); s += __shfl_xor(s, 32);
                if ((F.lane >> 4) == 0) atomicAdd(sq + (size_t)row * 8 + ((col >> 4) & 7), s); });
            if (blockIdx.x == 0) for (int i = F.tid; i < MS * 8; i += NTHR) SSQA[(size_t)MP * 8 + i] = 0.f;
        }
        SEAM(pb + 4);
        for (int rep_ = 0; rep_ < MK_REP_G3; ++rep_) if (IN(pb + 5)) { if (rep_) xcd_barrier(bar); PHASE_BEGIN(); DECL_WS();
            pg8::Gemm g{XB, Wu, MP, FF, DM}; pg8::StaticOrder S; S.init(MP, FF, F.G, (int)blockIdx.x);
            pg8::EpiScaleBf16<1> E{HBUF, FF, SSQB};
            pg8::gemm_phase<pg8::EpiScaleBf16<1>, pg8::StaticOrder, true, true>(F.lds + RING_OFF, g, S, E, F.tid);
            bf16* hs = HBUF + (size_t)MP * FF; const float* sq = SSQB + (size_t)MP * 8;
            thin_gemm(F, XB + (size_t)MP * DM, DM, Wu, FF, DM, [&](int row, int col, f32x4 acc) {
                const f32x4 p0 = *(const GAS f32x4*)(sq + (size_t)row * 8), p1 = *(const GAS f32x4*)(sq + (size_t)row * 8 + 4);
                const float ss = ((p0.x + p0.y) + (p0.z + p0.w)) + ((p1.x + p1.y) + (p1.z + p1.w)), rs = 1.0f / sqrtf(ss * (1.0f / 2048.0f) + 1e-6f);
                f32x4 v = acc * rs; v.x = fmaxf(v.x, 0.f); v.y = fmaxf(v.y, 0.f); v.z = fmaxf(v.z, 0.f); v.w = fmaxf(v.w, 0.f);
                *(GAS unsigned long long*)(hs + (size_t)row * FF + col) = (unsigned long long)pk2(v.x * v.x, v.y * v.y) | ((unsigned long long)pk2(v.z * v.z, v.w * v.w) << 32); });
        }
        SEAM(pb + 5);
        if (IN(pb + 6)) { PHASE_BEGIN(); DECL_WS();
            const bool lastl = (l == DEPTH - 1);
            float* outp = lastl ? ARGOUT() + O_Y : XRES; float* outs = lastl ? ARGOUT() + O_Y + (size_t)MP * DM : XRES + (size_t)MP * DM;
            pg8::Gemm g{HBUF, Wd, MP, DM, FF}; pg8::StaticOrder S; S.init(MP, DM, F.G, (int)blockIdx.x);
            pg8::EpiResid E{XRES, outp, lastl ? (bf16*)nullptr : XB, SSQA, DM};
            pg8::gemm_phase<pg8::EpiResid, pg8::StaticOrder, false, true>(F.lds + RING_OFF, g, S, E, F.tid);
            const float* bases = XRES + (size_t)MP * DM; bf16* xbs = XB + (size_t)MP * DM; float* sq = SSQA + (size_t)MP * 8;
            thin_gemm(F, HBUF + (size_t)MP * FF, FF, Wd, DM, FF, [&](int row, int col, f32x4 acc) {
                const f32x4 bs = *(const GAS f32x4*)(bases + (size_t)row * DM + col); const f32x4 o = bs + acc;
                *(GAS f32x4*)(outs + (size_t)row * DM + col) = o;
                if (!lastl) *(GAS unsigned long long*)(xbs + (size_t)row * DM + col) = (unsigned long long)pk2(o.x, o.y) | ((unsigned long long)pk2(o.z, o.w) << 32);
                float s = (o.x * o.x + o.y * o.y) + (o.z * o.z + o.w * o.w); s += __shfl_xor(s, 16); s += __shfl_xor(s, 32);
                if ((F.lane >> 4) == 0) atomicAdd(sq + (size_t)row * 8 + ((col >> 4) & 7), s); });
        }
        SEAM(pb + 6);
    }
    if (IN(15)) { PHASE_BEGIN(); final_norm_phase(F, args); }
#undef IN
#undef SEAM
}

extern "C" void kernel_launch(void* const* d_in, const int* in_sizes, int n_in, void* d_out, int out_size, void* d_ws, size_t ws_size, hipStream_t stream) {
    static int grid = 0;
    if (grid == 0) {
        if (n_in != 26 || (size_t)out_size != O_END || ws_size < WS_END2) { fprintf(stderr, "kernel_launch: expected 26 inputs, %zu outputs, >= %zu bytes of workspace; got %d, %d, %zu\n", (size_t)O_END, (size_t)WS_END2, n_in, out_size, ws_size); grid = -1; return; }
        int dev = 0, cus = 0, per_cu = 0;
        if (hipGetDevice(&dev) != hipSuccess || hipDeviceGetAttribute(&cus, hipDeviceAttributeMultiprocessorCount, dev) != hipSuccess) { grid = -1; return; }
        if (hipFuncSetAttribute((const void*)mk_fwd, hipFuncAttributeMaxDynamicSharedMemorySize, LDS_BYTES) != hipSuccess) { fprintf(stderr, "kernel_launch: hipFuncSetAttribute failed\n"); grid = -1; return; }
        if (hipOccupancyMaxActiveBlocksPerMultiprocessor(&per_cu, (const void*)mk_fwd, NTHR, LDS_BYTES) != hipSuccess || per_cu < 1) { fprintf(stderr, "kernel_launch: occupancy query says %d blocks per CU\n", per_cu); per_cu = 1; }
        (void)hipGetLastError();
        grid = cus;
        if (grid != 256) fprintf(stderr, "kernel_launch: %d CUs; the G2/G4 phases assume 256 workgroups\n", grid);
    }
    if (grid < 0) return;
    (void)hipMemsetAsync((char*)d_ws + WS_CTL, 0, CTL_ZERO_BYTES, stream);
    Args a{};
    for (int i = 0; i < 26; ++i) a.in[i] = (const float*)d_in[i];
    a.out = (float*)d_out; a.ws = (unsigned char*)d_ws;
#if MK_N_LAUNCHES == 1
    a.ph_lo = 0; a.ph_hi = N_PHASES;
    hipLaunchKernelGGL(mk_fwd, dim3(grid), dim3(NTHR), LDS_BYTES, stream, a);
#else
    for (int p = 0; p < N_PHASES; ++p) { a.ph_lo = p; a.ph_hi = p + 1; hipLaunchKernelGGL(mk_fwd, dim3(grid), dim3(NTHR), LDS_BYTES, stream, a); }
#endif
}
```

```cpp
#include <hip/hip_runtime.h>
#include <cstdio>
#include <cstdint>
namespace pg8 {
#define PG8_LAS __attribute__((address_space(3)))
typedef unsigned short bf16_t;
typedef short bf16x8 __attribute__((ext_vector_type(8)));
typedef float f32x4 __attribute__((ext_vector_type(4)));
typedef unsigned u32x4 __attribute__((ext_vector_type(4)));
constexpr int BM = 256, BK = 64, HALF = 128, HTB = HALF * BK * 2  , STAGE_BYTES = 8 * HTB, NXCD = 8, WGM = 8;

__host__ __device__ __forceinline__ int lds_byte(int r, int c) { const int st = (r >> 4) * 2 + (c >> 5), rr = r & 15, cc = c & 31, ob = rr * 64 + cc * 2; return st * 1024 + (ob ^ (((ob >> 9) & 1) << 5)); }
__host__ __device__ __forceinline__ void stage_rc(int b, int& R, int& C) { const int st = b / 1024, sb = b % 1024, swz = sb ^ (((sb >> 9) & 1) << 5); R = (st >> 1) * 16 + swz / 64; C = (st & 1) * 32 + (swz % 64) / 2; }
__host__ __device__ __forceinline__ int perm32(int rho) { const int n = rho >> 4, i = rho & 15; return 8 * (i >> 2) + 4 * n + (i & 3); }

struct Unit { int pm, pn; };
struct Gemm { const bf16_t* A; const bf16_t* Bt; int M, N, K; };

struct StaticOrder {
    int nM, nN, nwg, G, c;
    __host__ __device__ void init(int M, int N, int G_, int c_) { nM = M / BM; nN = N / BM; nwg = nM * nN; G = G_; c = c_; }
    __host__ __device__ bool next(int i, Unit& u) const {
        const long L = (long)i * G + c; if (L >= nwg) return false;
        int wgid = (int)L; { const int q = nwg / NXCD, r = nwg % NXCD, xcd = wgid % NXCD, off = wgid / NXCD; wgid = (xcd < r ? xcd * (q + 1) : r * (q + 1) + (xcd - r) * q) + off; }
        const int nig = WGM * nN, gid = wgid / nig, fm = gid * WGM, gsz = (nM - fm) < WGM ? (nM - fm) : WGM;
        u.pm = fm + ((wgid % nig) % gsz); u.pn = (wgid % nig) / gsz; return true;
    }
    __device__ __forceinline__ void a_ready(const Unit&) const {}
    __device__ __forceinline__ void done(const Unit&) const {}
};


__device__ __forceinline__ unsigned cvt_pk_bf16(float lo, float hi) { unsigned r; asm volatile("v_cvt_pk_bf16_f32 %0, %1, %2" : "=v"(r) : "v"(lo), "v"(hi)); return r; }

template <int ACT> struct EpiScaleBf16 {
    static constexpr bool PERM = true, AFTER_DRAIN = false;
    bf16_t* O; int ldc; const float* ssq;
    __device__ __forceinline__ void operator()(const f32x4 (&acc)[2][2][4][2], const Unit& u, int wr, int wc, int fr, int fq) const {
        const int row0 = u.pm * BM + wr * 64 + fr, col0 = u.pn * BM + wc * 32 + 8 * fq;
#pragma unroll
        for (int ai = 0; ai < 2; ++ai)
#pragma unroll
            for (int m = 0; m < 4; ++m) { const int row = row0 + ai * HALF + m * 16;
                const f32x4 p0 = *(const f32x4*)(ssq + (size_t)row * 8), p1 = *(const f32x4*)(ssq + (size_t)row * 8 + 4);
                const float ss = ((p0[0] + p0[1]) + (p0[2] + p0[3])) + ((p1[0] + p1[1]) + (p1[2] + p1[3]));
                const float rs = 1.0f / sqrtf(ss * (1.0f / 2048.0f) + 1e-6f);
                bf16_t* rowp = O + (size_t)row * ldc + col0;
#pragma unroll
                for (int bj = 0; bj < 2; ++bj) { f32x4 v0 = acc[ai][bj][m][0] * rs, v1 = acc[ai][bj][m][1] * rs;
                    if (ACT == 1) {
#pragma unroll
                        for (int e = 0; e < 4; ++e) { const float a = fmaxf(v0[e], 0.f), b = fmaxf(v1[e], 0.f); v0[e] = a * a; v1[e] = b * b; } }
                    u32x4 w; w.x = cvt_pk_bf16(v0[0], v0[1]); w.y = cvt_pk_bf16(v0[2], v0[3]); w.z = cvt_pk_bf16(v1[0], v1[1]); w.w = cvt_pk_bf16(v1[2], v1[3]);
                    *(u32x4*)(rowp + bj * HALF) = w; } }
    }
};

struct EpiResid {
    static constexpr bool PERM = false, AFTER_DRAIN = true;
    const float* base; float* out; bf16_t* xb; float* ssq; int ld;
    __device__ __forceinline__ void fused(f32x4 (&acc)[2][2][4][2], const Unit& u, int wr, int wc, int fr, int fq, PG8_LAS unsigned char* lds, int wid, int lane) const {
        typedef unsigned u32x2v __attribute__((ext_vector_type(2)));
        PG8_LAS float* P = (PG8_LAS float*)lds;
        const int col0 = u.pn * BM + wc * 32 + 4 * fq;
#pragma unroll
        for (int ai = 0; ai < 2; ++ai)
#pragma unroll
            for (int m = 0; m < 4; ++m) { const int r = ai * HALF + wr * 64 + m * 16 + fr; const size_t off = (size_t)(u.pm * BM + r) * ld + col0; float s = 0.f;
#pragma unroll
                for (int bj = 0; bj < 2; ++bj)
#pragma unroll
                    for (int n = 0; n < 2; ++n) { const f32x4 bs = *(const f32x4*)(base + off + bj * HALF + n * 16); const f32x4 o = bs + acc[ai][bj][m][n];
                        *(f32x4*)(out + off + bj * HALF + n * 16) = o;
                        if (xb) { u32x2v w; w.x = cvt_pk_bf16(o[0], o[1]); w.y = cvt_pk_bf16(o[2], o[3]); *(u32x2v*)(xb + off + bj * HALF + n * 16) = w; }
                        s += (o[0] * o[0] + o[1] * o[1]) + (o[2] * o[2] + o[3] * o[3]); }
                s += __shfl_xor(s, 16); s += __shfl_xor(s, 32);
                if (fq == 0) P[r * 4 + wc] = s;
                if (m & 1) asm volatile("" ::: "memory"); }
        asm volatile("s_waitcnt lgkmcnt(0)" ::: "memory"); __builtin_amdgcn_s_barrier(); asm volatile("" ::: "memory");
        const int t = wid * 64 + lane;
        if (t < 256) { const float s = (P[t * 4 + 0] + P[t * 4 + 1]) + (P[t * 4 + 2] + P[t * 4 + 3]); ssq[(size_t)(u.pm * BM + t) * 8 + u.pn] = s; }
        asm volatile("s_waitcnt lgkmcnt(0)" ::: "memory"); __builtin_amdgcn_s_barrier(); asm volatile("" ::: "memory");
    }
};
template <class Epi, class Sched, bool ALIGN_EPI = false, bool SP2 = false>
__device__ __forceinline__ void gemm_phase(PG8_LAS unsigned char* lds, const Gemm g, const Sched& S, const Epi& E, const int tid) {
    const int  wid = __builtin_amdgcn_readfirstlane(tid >> 6), lane = tid & 63, wr = wid >> 2, wc = wid & 3, fr = lane & 15, fq = lane >> 4;
    const int K = g.K, nt = K / BK;
    unsigned voffA[2], voffB[2];
#pragma unroll
    for (int i = 0; i < 2; ++i) { int R, C; stage_rc(tid * 16 + i * 8192, R, C); const int Rb = Epi::PERM ? ((R & ~31) + perm32(R & 31)) : R;
        voffA[i] = (unsigned)(R * K + C) * 2u; voffB[i] = (unsigned)(Rb * K + C) * 2u; }
    const size_t kstep = (size_t)(BK * 2);
    const size_t hstep = (size_t)HALF * K * 2;
    const size_t tstep = 2 * hstep;
    const unsigned ldsw = (unsigned)wid * 1024u;
    const int aoff = lds_byte(wr * 64 + fr, fq * 8), boff = lds_byte(wc * 32 + fr, fq * 8);
#define PG8_SA(b, h) (((b) * 2 + (h)) * HTB)
#define PG8_SB(b, h) ((4 + (b) * 2 + (h)) * HTB)
#define PG8_STAGE(bufoff, gbase, voff) do { _Pragma("unroll") for (int _i = 0; _i < 2; ++_i) \
        __builtin_amdgcn_global_load_lds((const unsigned*)((const char*)(gbase) + (voff)[_i]), (PG8_LAS unsigned*)(lds + (bufoff) + ldsw + _i * 8192), 16, 0, 0); } while (0)
#define PG8_LDA(dst, b, h) do { _Pragma("unroll") for (int m = 0; m < 4; ++m) _Pragma("unroll") for (int k = 0; k < 2; ++k) dst[m][k] = *(const PG8_LAS bf16x8*)(lds + PG8_SA(b, h) + aoff + m * 2048 + k * 1024); } while (0)
#define PG8_LDB(dst, b, h) do { _Pragma("unroll") for (int n = 0; n < 2; ++n) _Pragma("unroll") for (int k = 0; k < 2; ++k) dst[n][k] = *(const PG8_LAS bf16x8*)(lds + PG8_SB(b, h) + boff + n * 2048 + k * 1024); } while (0)
#define PG8_MMA(ai, bj, At, Bt) do { __builtin_amdgcn_s_setprio(1); _Pragma("unroll") for (int m = 0; m < 4; ++m) _Pragma("unroll") for (int n = 0; n < 2; ++n) _Pragma("unroll") for (int k = 0; k < 2; ++k) \
        acc[ai][bj][m][n] = __builtin_amdgcn_mfma_f32_16x16x32_bf16(Bt[n][k], At[m][k], acc[ai][bj][m][n], 0, 0, 0); __builtin_amdgcn_s_setprio(0); } while (0)
#define PG8_WAIT_V(n) asm volatile("s_waitcnt vmcnt(" #n ")" ::: "memory")
#define PG8_WAIT_L(n) asm volatile("s_waitcnt lgkmcnt(" #n ")" ::: "memory")
#define PG8_BAR __builtin_amdgcn_s_barrier()
#define PG8_SCHED __builtin_amdgcn_sched_barrier(0)
    Unit cur, nxt; int ui = 0;
    if (!S.next(0, cur)) return;
    f32x4 acc[2][2][4][2];
#pragma unroll
    for (int a = 0; a < 2; ++a)
#pragma unroll
        for (int b = 0; b < 2; ++b)
#pragma unroll
            for (int m = 0; m < 4; ++m)
#pragma unroll
                for (int n = 0; n < 2; ++n) acc[a][b][m][n] = (f32x4){0.f, 0.f, 0.f, 0.f};
    bf16x8 At[4][2], B0[2][2], B1[2][2];
    const char* cA = (const char*)g.A + (size_t)cur.pm * tstep; const char* cB = (const char*)g.Bt + (size_t)cur.pn * tstep;
    S.a_ready(cur);
    if constexpr (SP2) {
        PG8_STAGE(PG8_SB(0, 0), cB, voffB); PG8_STAGE(PG8_SB(0, 1), cB + hstep, voffB); PG8_STAGE(PG8_SA(0, 0), cA, voffA); PG8_STAGE(PG8_SA(0, 1), cA + hstep, voffA);
        if (wr == 1) PG8_BAR;
        PG8_WAIT_V(2); PG8_BAR;
        PG8_STAGE(PG8_SB(1, 0), cB + kstep, voffB); PG8_STAGE(PG8_SA(1, 0), cA + kstep, voffA); PG8_STAGE(PG8_SB(1, 1), cB + hstep + kstep, voffB);
        PG8_WAIT_V(6); PG8_BAR;
    } else {
        PG8_STAGE(PG8_SB(0, 0), cB, voffB); PG8_STAGE(PG8_SA(0, 0), cA, voffA); PG8_STAGE(PG8_SB(0, 1), cB + hstep, voffB); PG8_STAGE(PG8_SA(0, 1), cA + hstep, voffA);
        if (wr == 1) PG8_BAR;
        PG8_WAIT_V(4); PG8_BAR;
        PG8_STAGE(PG8_SB(1, 0), cB + kstep, voffB); PG8_STAGE(PG8_SA(1, 0), cA + kstep, voffA); PG8_STAGE(PG8_SB(1, 1), cB + hstep + kstep, voffB);
        PG8_WAIT_V(6); PG8_BAR;
    }
    for (;;) {
        const bool has_next = S.next(ui + 1, nxt);
        const char* nA = has_next ? (const char*)g.A + (size_t)nxt.pm * tstep : cA; const char* nB = has_next ? (const char*)g.Bt + (size_t)nxt.pn * tstep : cB;
        for (int t = 0; t < nt; t += 2) {
            const bool last = (t == nt - 2);
            const char* a1 = cA + (size_t)(t + 1) * kstep;
            const char* a2 = last ? nA : cA + (size_t)(t + 2) * kstep; const char* b2 = last ? nB : cB + (size_t)(t + 2) * kstep;
            const char* a3 = a2 + kstep; const char* b3 = b2 + kstep;
            if (last && has_next) S.a_ready(nxt);
            if constexpr (SP2) {
            PG8_LDB(B0, 0, 0); PG8_LDB(B1, 0, 1); PG8_SCHED; PG8_LDA(At, 0, 0); PG8_STAGE(PG8_SA(1, 1), a1 + hstep, voffA);
            PG8_WAIT_V(8); PG8_WAIT_L(0); PG8_BAR; PG8_MMA(0, 0, At, B0); PG8_MMA(0, 1, At, B1); PG8_BAR; PG8_SCHED;
            PG8_LDA(At, 0, 1); PG8_STAGE(PG8_SB(0, 0), b2, voffB); PG8_STAGE(PG8_SB(0, 1), b2 + hstep, voffB); PG8_STAGE(PG8_SA(0, 0), a2, voffA);
            PG8_WAIT_V(8); PG8_WAIT_L(0); PG8_BAR; PG8_MMA(1, 0, At, B0); PG8_MMA(1, 1, At, B1); PG8_BAR; PG8_SCHED;
            PG8_LDB(B0, 1, 0); PG8_LDB(B1, 1, 1); PG8_SCHED; PG8_LDA(At, 1, 0); PG8_STAGE(PG8_SA(0, 1), a2 + hstep, voffA);
            PG8_WAIT_V(8); PG8_WAIT_L(0); PG8_BAR; PG8_MMA(0, 0, At, B0); PG8_MMA(0, 1, At, B1); PG8_BAR; PG8_SCHED;
            PG8_LDA(At, 1, 1); PG8_STAGE(PG8_SB(1, 0), b3, voffB); PG8_STAGE(PG8_SB(1, 1), b3 + hstep, voffB); PG8_STAGE(PG8_SA(1, 0), a3, voffA);
            PG8_WAIT_V(8); PG8_WAIT_L(0); PG8_BAR; PG8_MMA(1, 0, At, B0); PG8_MMA(1, 1, At, B1); PG8_BAR; PG8_SCHED;
            } else {
            PG8_LDB(B0, 0, 0); PG8_SCHED; PG8_LDA(At, 0, 0); PG8_STAGE(PG8_SA(1, 1), a1 + hstep, voffA);
            PG8_WAIT_L(8); PG8_BAR; PG8_WAIT_L(0); PG8_MMA(0, 0, At, B0); PG8_BAR; PG8_SCHED;
            PG8_LDB(B1, 0, 1); PG8_STAGE(PG8_SB(0, 0), b2, voffB);
            PG8_BAR; PG8_WAIT_L(0); PG8_MMA(0, 1, At, B1); PG8_BAR;
            PG8_LDA(At, 0, 1); PG8_STAGE(PG8_SA(0, 0), a2, voffA);
            PG8_BAR; PG8_WAIT_L(0); PG8_MMA(1, 0, At, B0); PG8_BAR; PG8_SCHED;
            PG8_STAGE(PG8_SB(0, 1), b2 + hstep, voffB);
            PG8_WAIT_V(6); PG8_BAR; PG8_MMA(1, 1, At, B1); PG8_BAR;
            PG8_LDB(B0, 1, 0); PG8_SCHED; PG8_LDA(At, 1, 0); PG8_STAGE(PG8_SA(0, 1), a2 + hstep, voffA);
            PG8_WAIT_L(8); PG8_BAR; PG8_WAIT_L(0); PG8_MMA(0, 0, At, B0); PG8_BAR; PG8_SCHED;
            PG8_LDB(B1, 1, 1); PG8_STAGE(PG8_SB(1, 0), b3, voffB);
            PG8_BAR; PG8_WAIT_L(0); PG8_MMA(0, 1, At, B1); PG8_BAR;
            PG8_LDA(At, 1, 1); PG8_STAGE(PG8_SA(1, 0), a3, voffA);
            PG8_BAR; PG8_WAIT_L(0); PG8_MMA(1, 0, At, B0); PG8_BAR; PG8_SCHED;
            PG8_STAGE(PG8_SB(1, 1), b3 + hstep, voffB);
            PG8_WAIT_V(6); PG8_BAR; PG8_MMA(1, 1, At, B1); PG8_BAR;
            }
        }
        if constexpr (ALIGN_EPI) { if (wr == 0) PG8_BAR; }
        if constexpr (!Epi::AFTER_DRAIN) { E(acc, cur, wr, wc, fr, fq); S.done(cur); }
        if (!has_next) break;
#pragma unroll
        for (int a = 0; a < 2; ++a)
#pragma unroll
            for (int b = 0; b < 2; ++b)
#pragma unroll
                for (int m = 0; m < 4; ++m)
#pragma unroll
                    for (int n = 0; n < 2; ++n) acc[a][b][m][n] = (f32x4){0.f, 0.f, 0.f, 0.f};
        cur = nxt; cA = nA; cB = nB; ++ui;
        if constexpr (ALIGN_EPI) { if (wr == 1) PG8_BAR; }
    }
    PG8_WAIT_V(0);
    if constexpr (!ALIGN_EPI) { if (wr == 0) PG8_BAR; }
    PG8_BAR;
    if constexpr (Epi::AFTER_DRAIN) { E.fused(acc, cur, wr, wc, fr, fq, lds, wid, lane); S.done(cur); }
#undef PG8_SA
#undef PG8_SB
#undef PG8_STAGE
#undef PG8_LDA
#undef PG8_LDB
#undef PG8_MMA
#undef PG8_WAIT_V
#undef PG8_WAIT_L
#undef PG8_BAR
#undef PG8_SCHED
}
}

#ifndef PG8_SP2
#define PG8_SP2 true
#endif
#ifndef PG8_ALIGN
#define PG8_ALIGN true
#endif
#define GAS __attribute__((address_space(1)))
#define LAS __attribute__((address_space(3)))
typedef unsigned short bf16;
typedef unsigned v4u __attribute__((ext_vector_type(4)));
typedef float f32x4 __attribute__((ext_vector_type(4)));
typedef short bf16x8 __attribute__((ext_vector_type(8)));
typedef GAS unsigned gu32;
typedef GAS unsigned long long gu64;
#define RLX_AGENT __ATOMIC_RELAXED, __HIP_MEMORY_SCOPE_AGENT
#define LDS_WAIT() asm volatile("s_waitcnt lgkmcnt(0)" ::: "memory")
#define VM_WAIT() asm volatile("s_waitcnt vmcnt(0)" ::: "memory")
__device__ __forceinline__ unsigned long long rt() { return __builtin_amdgcn_s_memrealtime(); }
__device__ __forceinline__ unsigned f2bf(float f) { unsigned u = __builtin_bit_cast(unsigned, f); return (u + 0x7fffu + ((u >> 16) & 1u)) >> 16; }
__device__ __forceinline__ unsigned pk2(float lo, float hi) { return f2bf(lo) | (f2bf(hi) << 16); }

#define XB_TMO      128
#define XB_XCNT(j)  (256  + 64 * (j))
#define XB_XSUB(j)  (1280 + 64 * (j))
#define XB_XGEN(j)  (2304 + 64 * (j))
#define XB_TOP      3328
#define XB_TOPGEN   3392
#define XCD_BAR_WORDS 3456
#define XB_SPIN_CAP (1u << 18)

__device__ __forceinline__ unsigned xb_ld(unsigned* p)              { return __hip_atomic_load(p, __ATOMIC_RELAXED, __HIP_MEMORY_SCOPE_AGENT); }
__device__ __forceinline__ unsigned xb_add(unsigned* p, unsigned v) { return __hip_atomic_fetch_add(p, v, __ATOMIC_RELAXED, __HIP_MEMORY_SCOPE_AGENT); }
__device__ __forceinline__ unsigned xb_xcc_id() { return (unsigned)__builtin_amdgcn_s_getreg((3 << 11) | 20) & 0xFu; }
#define XB_SPIN(cond, bar) do { unsigned _sp = 0; while (cond) { __builtin_amdgcn_s_sleep(1); \
    if ((++_sp & 255u) == 0u) { if (xb_ld(&(bar)[XB_TMO])) break; if (_sp > XB_SPIN_CAP) { atomicAdd(&(bar)[XB_TMO], 1u); break; } } } } while (0)

struct XcdBarrier {
    unsigned* bar; unsigned x;
    volatile LAS unsigned* st;
};

__device__ __forceinline__ XcdBarrier xcd_barrier_post(unsigned* bar, volatile LAS unsigned* st) {
    XcdBarrier b; b.bar = bar; b.x = xb_xcc_id(); b.st = st;
    if (threadIdx.x == 0) (void)xb_add(&bar[XB_XCNT(b.x)], 1u);
    return b;
}
__device__ __forceinline__ void xcd_barrier_complete(unsigned* bar, unsigned x, unsigned& nloc, unsigned& nx) {
    const unsigned G = gridDim.x * gridDim.y * gridDim.z;
    unsigned sum, cnt, mine, sp = 0u;
    for (;;) {
        sum = 0u; cnt = 0u; mine = 0u;
#pragma unroll
        for (unsigned j = 0; j < 16; ++j) { const unsigned c = xb_ld(&bar[XB_XCNT(j)]); sum += c; cnt += (c > 0u) ? 1u : 0u; mine = (j == x) ? c : mine; }
        if (sum == G) break;
        __builtin_amdgcn_s_sleep(1);
        if ((++sp & 255u) == 0u) { if (xb_ld(&bar[XB_TMO])) break; if (sp > XB_SPIN_CAP) { atomicAdd(&bar[XB_TMO], 1u); break; } }
    }
    nloc = mine > 0u ? mine : 1u; nx = cnt > 0u ? cnt : 1u;
}

__device__ __forceinline__ void xcd_barrier(const XcdBarrier& b) {
    asm volatile("s_waitcnt vmcnt(0)" ::: "memory");
    __syncthreads();
    if (threadIdx.x == 0) {
        unsigned* bar = b.bar;
        __builtin_amdgcn_s_waitcnt(0);
        unsigned nloc = b.st[0], nx = b.st[1];
        if (nloc == 0u) { xcd_barrier_complete(bar, b.x, nloc, nx); b.st[0] = nloc; b.st[1] = nx; }
        const unsigned old = xb_add(&bar[XB_XSUB(b.x)], 1u);
        const unsigned gen = old / nloc;
        if (old + 1u == (gen + 1u) * nloc) {
            __builtin_amdgcn_fence(__ATOMIC_RELEASE, "agent");
            asm volatile("s_waitcnt vmcnt(0)" ::: "memory");
            const unsigned og = xb_add(&bar[XB_TOP], 1u);
            const unsigned tg = og / nx;
            if (og + 1u == (tg + 1u) * nx) xb_add(&bar[XB_TOPGEN], 1u);
            else XB_SPIN(xb_ld(&bar[XB_TOPGEN]) == tg, bar);
            __builtin_amdgcn_fence(__ATOMIC_ACQUIRE, "agent");
            xb_add(&bar[XB_XGEN(b.x)], 1u);
            asm volatile("s_waitcnt vmcnt(0)" ::: "memory");
        } else {
            XB_SPIN(xb_ld(&bar[XB_XGEN(b.x)]) == gen, bar);
            __builtin_amdgcn_fence(__ATOMIC_ACQUIRE, "agent");
            asm volatile("s_waitcnt vmcnt(0)" ::: "memory");
        }
    }
    __syncthreads();
}

constexpr int NWAVES = 8, NTHR = 512;
constexpr int DM = 2048, SEQL = 2048, NB = 4, MP = NB * SEQL  , MS = 128  , MT = MP + MS, MPAD = 8448;
constexpr int NIN = 5400, NINP = 5632, FF = 8192, DEPTH = 2;
constexpr int C_Q = 0, C_K = 512, C_V = 640, C_Z = 768, C_XBC = 1792, C_MQ = 3328, C_MK = 3840, C_MV = 4352, C_MO = 4864, C_DT = 5376, C_MI = 5392, C_MF = 5396;
constexpr int XCW = 1536;
constexpr size_t O_Y = 0, O_PK = 17039360, O_PV = 17170432, O_PCONV = 17301504, O_PSSM = 17338368, O_PC = 18386944, O_PN = 18911232, O_PM = 18915328,
                 O_SK = 18915360, O_SV = 23109664, O_SCONV = 27303968, O_SSSM = 28483616, O_SC = 62038048, O_SN = 78815264, O_SM = 78946336, O_END = 78947360;

constexpr size_t MiB = 1u << 20;
constexpr size_t WS_CTL = 0, CTL_ZERO_BYTES = 1 * MiB;
constexpr size_t WS_SSQA = 1 * MiB, WS_SSQB = 1 * MiB + 512 * 1024;
constexpr size_t WS_WIN = 2 * MiB, WIN_BYTES = 22 * MiB;
constexpr size_t WS_WOUT = 46 * MiB, WOUT_BYTES = 8 * MiB;
constexpr size_t WS_WUP = 62 * MiB, WUP_BYTES = 32 * MiB;
constexpr size_t WS_WDN = 126 * MiB, WDN_BYTES = 32 * MiB;
constexpr size_t WS_XB = 190 * MiB;
constexpr size_t WS_XRES = 223 * MiB;
constexpr size_t WS_HBUF = 289 * MiB;
constexpr size_t WS_PROJ = 289 * MiB;
constexpr size_t WS_MIXED = 380 * MiB;
constexpr size_t WS_XC = 421 * MiB;
constexpr size_t WS_YG = 446 * MiB;
constexpr size_t WS_HR = 479 * MiB;
constexpr size_t WS_END = 496 * MiB;
static_assert(WS_PROJ + (size_t)MPAD * NINP * 2 <= WS_MIXED && WS_MIXED + (size_t)MPAD * DM * 2 <= WS_XC && WS_HBUF + (size_t)MPAD * FF * 2 <= WS_XC, "ws map");
constexpr int CW_BAR = 4096;
constexpr int CW_QUEUE = 16384;

constexpr int RING_OFF = 0, RING_BYTES = 131072;
constexpr int LDSCTL_OFF = RING_BYTES, MISC_OFF = LDSCTL_OFF + 320;
constexpr int LDS_BYTES = 147456;

struct Args { const float* in[26]; float* out; unsigned char* ws; int ph_lo, ph_hi; };
typedef const __attribute__((address_space(4))) unsigned long long* karg_t;
__device__ __forceinline__ unsigned long long karg_u64(int idx) { int j = idx; asm volatile("" : "+s"(j)); return ((karg_t)__builtin_amdgcn_kernarg_segment_ptr())[j]; }
#define ARGIN(i) ((const float*)karg_u64(i))
#define ARGOUT() ((float*)karg_u64(26))
#define ARGWS() ((unsigned char*)karg_u64(27))

struct Frame {
    LAS unsigned char* lds;
    volatile LAS unsigned* MISC;
    gu32* ctl;
    int tid, lane, wave, vcu, G;
};

__device__ __forceinline__ float bf2f(unsigned short u) { return __builtin_bit_cast(float, (unsigned)u << 16); }
__device__ __forceinline__ float bflo(unsigned u) { return __builtin_bit_cast(float, u << 16); }
__device__ __forceinline__ float bfhi(unsigned u) { return __builtin_bit_cast(float, u & 0xffff0000u); }
__device__ __forceinline__ void unpack8(const v4u w, float (&f)[8]) { f[0] = bflo(w.x); f[1] = bfhi(w.x); f[2] = bflo(w.y); f[3] = bfhi(w.y); f[4] = bflo(w.z); f[5] = bfhi(w.z); f[6] = bflo(w.w); f[7] = bfhi(w.w); }
__device__ __forceinline__ v4u pack8(const float (&f)[8]) { v4u w; w.x = pk2(f[0], f[1]); w.y = pk2(f[2], f[3]); w.z = pk2(f[4], f[5]); w.w = pk2(f[6], f[7]); return w; }
__device__ __forceinline__ float wave_sum(float v) {
#pragma unroll
    for (int o = 1; o < 64; o <<= 1) v += __shfl_xor(v, o);
    return v;
}
__device__ __forceinline__ float wave_max(float v) {
#pragma unroll
    for (int o = 1; o < 64; o <<= 1) v = fmaxf(v, __shfl_xor(v, o));
    return v;
}
__device__ __forceinline__ float fexp(float x) { return __builtin_amdgcn_exp2f(x * 1.4426950408889634f); }
__device__ __forceinline__ float frcp(float x) { return __builtin_amdgcn_rcpf(x); }
__device__ __forceinline__ float sigmoidf_(float x) { return frcp(1.0f + fexp(-x)); }
__device__ __forceinline__ float siluf_(float x) { return x * frcp(1.0f + fexp(-x)); }
__device__ __forceinline__ float softplusf_(float x) { return fmaxf(x, 0.f) + log1pf(expf(-fabsf(x))); }
__device__ __forceinline__ float logsigmoidf_(float x) { return fminf(x, 0.f) - log1pf(expf(-fabsf(x))); }
#define ROPE_INV(i) ((i) == 0 ? 1.0f : (i) == 1 ? 0.1939227432012558f : (i) == 2 ? 0.03760603070259094f : (i) == 3 ? 0.007292664609849453f : (i) == 4 ? 0.0014142135623842478f : (i) == 5 ? 0.00027424818836152554f : (i) == 6 ? 5.318296098266728e-05f : 1.0313386155758053e-05f)
__device__ __forceinline__ void rope_cs(int pos, float (&c)[8], float (&s)[8]) {
#pragma unroll
    for (int i = 0; i < 8; ++i) { const float ang = (float)pos * ROPE_INV(i); double rev = (double)ang * 0.15915494309189535; rev -= __builtin_rint(rev); const float fr = (float)rev;
        c[i] = __builtin_amdgcn_cosf(fr); s[i] = __builtin_amdgcn_sinf(fr); }
}

__device__ __forceinline__ int colmap(int mode, int n) {
    if (mode == 0) return n;
    if (n < 3328) return n; if (n < 5376) return n + 16; if (n < 5392) return n - 2048; if (n < 5400) return n; return -1;
}
struct P0Item { const float* W; const float* gain; bf16* WT; int mode, K, Norig, Nrows, r; };
__device__ __forceinline__ void p0_item_load(const P0Item& I, int lane, f32x4 (&v)[8]) {
    const int nblk = I.Nrows / 32, kb = I.r / nblk, nb = I.r % nblk, k0 = 64 * kb, n0 = 32 * nb;
    const int kr = lane >> 3, nc = lane & 7, oc = colmap(I.mode, n0 + 4 * nc);
#pragma unroll
    for (int i = 0; i < 8; ++i) { v[i] = (f32x4){0.f, 0.f, 0.f, 0.f}; if (oc >= 0) v[i] = *(const GAS f32x4*)(I.W + (size_t)(k0 + kr + 8 * i) * I.Norig + oc); }
}
__device__ __forceinline__ void p0_item_finish(const P0Item& I, int lane, const f32x4 (&v)[8], LAS float* scr) {
    const int nblk = I.Nrows / 32, kb = I.r / nblk, nb = I.r % nblk, k0 = 64 * kb, n0 = 32 * nb;
    const int kr = lane >> 3, nc = lane & 7;
#pragma unroll
    for (int i = 0; i < 8; ++i) { const float gn = I.gain ? I.gain[k0 + kr + 8 * i] : 1.0f; LAS float* d = scr + (kr + 8 * i) * 33 + 4 * nc; d[0] = v[i].x * gn; d[1] = v[i].y * gn; d[2] = v[i].z * gn; d[3] = v[i].w * gn; }
    LDS_WAIT(); asm volatile("" ::: "memory");
    const int c = lane & 7;
#pragma unroll
    for (int j = 0; j < 4; ++j) { const int n = (lane >> 3) + 8 * j; const LAS float* s = scr + (8 * c) * 33 + n;
        v4u o; o.x = pk2(s[0 * 33], s[1 * 33]); o.y = pk2(s[2 * 33], s[3 * 33]); o.z = pk2(s[4 * 33], s[5 * 33]); o.w = pk2(s[6 * 33], s[7 * 33]);
        *(GAS v4u*)(I.WT + (size_t)(n0 + n) * I.K + k0 + 8 * c) = o; }
    LDS_WAIT(); asm volatile("" ::: "memory");
}
__device__ __forceinline__ void x_row_to_bf16(int lane, const float* xrow, bf16* orow, float* ssqrow) {
    const GAS f32x4* xr = (const GAS f32x4*)xrow + lane;
    f32x4 v[8]; float s = 0.f;
#pragma unroll
    for (int j = 0; j < 8; ++j) { v[j] = xr[64 * j]; s += (v[j].x * v[j].x + v[j].y * v[j].y) + (v[j].z * v[j].z + v[j].w * v[j].w); }
    s = wave_sum(s);
    GAS unsigned long long* o8 = (GAS unsigned long long*)orow + lane;
#pragma unroll
    for (int j = 0; j < 8; ++j) o8[64 * j] = (unsigned long long)pk2(v[j].x, v[j].y) | ((unsigned long long)pk2(v[j].z, v[j].w) << 32);
    if (lane < 8) ssqrow[lane] = lane == 0 ? s : 0.f;
}
__device__ __forceinline__ void p0_prologue(Frame& F, const Args& a) {
    LAS float* scr = (LAS float*)(F.lds + RING_OFF + F.wave * 16384);
    const int gw = F.vcu * NWAVES + F.wave, NGW = F.G * NWAVES;
    constexpr int I_IN = (DM / 64) * (NINP / 32), I_OUT = (DM / 64) * (DM / 32), I_UP = (DM / 64) * (FF / 32), I_DN = (FF / 64) * (DM / 32);
    constexpr int PER_L = I_IN + I_OUT + I_UP + I_DN;
    unsigned char* ws = ARGWS();
    auto mk = [&](int it) { P0Item I; const int l = it / PER_L; int r = it % PER_L; I.mode = 0; I.K = DM; I.Norig = DM; I.Nrows = DM; I.gain = nullptr;
        if (r < I_IN) { I.mode = 1; I.W = ARGIN(10) + (size_t)l * DM * NIN; I.Norig = NIN; I.Nrows = NINP; I.gain = ARGIN(9) + l * DM; I.WT = (bf16*)(ws + WS_WIN + l * WIN_BYTES); }
        else if ((r -= I_IN) < I_OUT) { I.W = ARGIN(21) + (size_t)l * DM * DM; I.WT = (bf16*)(ws + WS_WOUT + l * WOUT_BYTES); }
        else if ((r -= I_OUT) < I_UP) { I.W = ARGIN(23) + (size_t)l * DM * FF; I.Norig = FF; I.Nrows = FF; I.gain = ARGIN(22) + l * DM; I.WT = (bf16*)(ws + WS_WUP + l * WUP_BYTES); }
        else { r -= I_UP; I.W = ARGIN(24) + (size_t)l * FF * DM; I.K = FF; I.WT = (bf16*)(ws + WS_WDN + l * WDN_BYTES); }
        I.r = r; return I; };
    {
        int it = gw; f32x4 va[8], vb[8];
        if (it < DEPTH * PER_L) { P0Item cur = mk(it); p0_item_load(cur, F.lane, va);
            for (;;) { const int nx = it + NGW; const bool more = nx < DEPTH * PER_L; P0Item nxt = cur;
                if (more) { nxt = mk(nx); p0_item_load(nxt, F.lane, vb); }
                p0_item_finish(cur, F.lane, va, scr);
                if (!more) break;
#pragma unroll
                for (int i = 0; i < 8; ++i) va[i] = vb[i];
                cur = nxt; it = nx; } }
    }
    bf16* XB = (bf16*)(ws + WS_XB); float* SSQA = (float*)(ws + WS_SSQA);
    for (int m = gw; m < MPAD; m += NGW) {
        if (m < MT) x_row_to_bf16(F.lane, m < MP ? ARGIN(0) + (size_t)m * DM : ARGIN(1) + (size_t)(m - MP) * DM, XB + (size_t)m * DM, SSQA + (size_t)m * 8);
        else { GAS v4u* o = (GAS v4u*)(XB + (size_t)m * DM) + F.lane;
#pragma unroll
            for (int j = 0; j < 4; ++j) o[64 * j] = (v4u){0u, 0u, 0u, 0u};
            if (F.lane < 8) SSQA[(size_t)m * 8 + F.lane] = 1.0f; }
    }
}

template <class EP> __device__ __forceinline__ void thin_gemm(Frame& F, const bf16* A, int lda, const bf16* Bt, int N, int K, const EP& epi) {
    const int fr = F.lane & 15, fq = F.lane >> 4, ks = K / 8;
    LAS f32x4* red = (LAS f32x4*)F.lds;
    for (int item = F.vcu; item < N / 8; item += F.G) {
        const int n0 = (item >> 1) * 16, rh = item & 1;
        const GAS bf16x8* bp = (const GAS bf16x8*)(Bt + (size_t)(n0 + fr) * K + F.wave * ks + 8 * fq);
        const GAS bf16x8* ap = (const GAS bf16x8*)(A + (size_t)(64 * rh + fr) * lda + F.wave * ks + 8 * fq);
        const size_t astep = (size_t)16 * lda / 8;
        f32x4 acc[4];
#pragma unroll
        for (int m = 0; m < 4; ++m) acc[m] = (f32x4){0.f, 0.f, 0.f, 0.f};
        for (int k = 0; k < ks / 8; k += 16) {
            bf16x8 b[4], a[4][4];
#pragma unroll
            for (int u = 0; u < 4; ++u) { b[u] = bp[k + 4 * u];
#pragma unroll
                for (int m = 0; m < 4; ++m) a[u][m] = ap[m * astep + k + 4 * u]; }
#pragma unroll
            for (int u = 0; u < 4; ++u)
#pragma unroll
                for (int m = 0; m < 4; ++m) acc[m] = __builtin_amdgcn_mfma_f32_16x16x32_bf16(b[u], a[u][m], acc[m], 0, 0, 0);
        }
        __syncthreads();
#pragma unroll
        for (int m = 0; m < 4; ++m) red[(F.wave * 4 + m) * 64 + F.lane] = acc[m];
        __syncthreads();
        if (F.wave < 4) { f32x4 s = red[(0 * 4 + F.wave) * 64 + F.lane];
#pragma unroll
            for (int w2 = 1; w2 < 8; ++w2) s = s + red[(w2 * 4 + F.wave) * 64 + F.lane];
            epi(64 * rh + 16 * F.wave + fr, n0 + 4 * fq, s); }
    }
}

#define MFMA16(yf, xf, acc) __builtin_amdgcn_mfma_f32_16x16x32_bf16(yf, xf, acc, 0, 0, 0)
constexpr int TP = 136, TPB = TP * 2;
__device__ __forceinline__ bf16x8 lds_frag(const LAS unsigned char* base, int row, int k0, int lane) { return *(const LAS bf16x8*)(base + (row + (lane & 15)) * TPB + (k0 + 8 * (lane >> 4)) * 2); }
typedef short s16x4 __attribute__((ext_vector_type(4)));
__device__ __forceinline__ bf16x8 lds_frag_tr(const LAS unsigned char* base, int pitchB, int k0, int c0, int lane) {
    const int g = lane >> 4, q = (lane >> 2) & 3, p = lane & 3;
    const LAS unsigned char* a = base + (k0 + 8 * g + q) * pitchB + (c0 + 4 * p) * 2;
    const s16x4 lo = __builtin_amdgcn_ds_read_tr16_b64_v4i16((LAS s16x4*)a), hi = __builtin_amdgcn_ds_read_tr16_b64_v4i16((LAS s16x4*)(a + 4 * pitchB));
    return (bf16x8){lo.x, lo.y, lo.z, lo.w, hi.x, hi.y, hi.z, hi.w};
}
__device__ __forceinline__ float wave_incl_scan_add(float v, int lane) {
#pragma unroll
    for (int o = 1; o < 64; o <<= 1) { const float u = __shfl_up(v, o); if (lane >= o) v += u; }
    return v;
}
__device__ __forceinline__ float wave_incl_scan_max(float v, int lane) {
#pragma unroll
    for (int o = 1; o < 64; o <<= 1) { const float u = __shfl_up(v, o); if (lane >= o) v = fmaxf(v, u); }
    return v;
}
constexpr size_t WS_DCT = 190 * MiB;
constexpr size_t WS_CPT = 206 * MiB;
constexpr size_t WS_DN = 214 * MiB, WS_NP = WS_DN + 131072, WS_SC = WS_NP + 131072, WS_MPV = WS_SC + 4096;
static_assert(WS_MPV + 4096 <= WS_XRES, "mlstm workspace inside the XB region");

__device__ __forceinline__ void mlstm_gates(Frame& F, const bf16* PROJ, int row0, int l, int h, LAS float* tab, float& bcum, float& a) {
    const int tid = F.tid, lane = F.lane;
    float v = 0.f, ig = 0.f;
    if (tid < 128) { ig = bf2f(PROJ[(size_t)(row0 + tid) * NINP + C_MI + h]) + ARGIN(18)[l * 4 + h];
        v = logsigmoidf_(bf2f(PROJ[(size_t)(row0 + tid) * NINP + C_MF + h]) + ARGIN(19)[l * 4 + h]);
        v = wave_incl_scan_add(v, lane);
        if (tid == 63) tab[0] = v; }
    __syncthreads();
    if (tid >= 64 && tid < 128) v += tab[0];
    bcum = v; a = ig - v;
}

__device__ __forceinline__ void mlstm_a_item(Frame& F, int l, int b, int h, int c) {
    const bf16* PROJ = (const bf16*)(ARGWS() + WS_PROJ);
    const int tid = F.tid, lane = F.lane, w = F.wave, row0 = b * SEQL + c * 128, item = (b * 4 + h) * 16 + c;
    LAS unsigned char* KT = F.lds; LAS unsigned char* VT = F.lds + 128 * TPB;
    LAS float* tab = (LAS float*)(F.lds + 2 * 128 * TPB); LAS float* wk = tab + 16;
    __syncthreads();
    float bcum, a; mlstm_gates(F, PROJ, row0, l, h, tab, bcum, a);
    if (tid < 128) { const float mx = wave_max(a); if (lane == 0) tab[1 + w] = mx; if (tid == 127) tab[3] = bcum; }
    __syncthreads();
    const float pmax = fmaxf(tab[1], tab[2]);
    if (tid < 128) wk[tid] = fexp(a - pmax) * 0.08838834764831845f;
    __syncthreads();
#pragma unroll
    for (int rep = 0; rep < 4; ++rep) { const int task = tid + rep * NTHR, t = task & 127, ch = task >> 7;
        float f[8]; const float wt = wk[t];
        unpack8(*(const GAS v4u*)(PROJ + (size_t)(row0 + t) * NINP + C_MK + h * 128 + ch * 8), f);
#pragma unroll
        for (int i = 0; i < 8; ++i) *(LAS unsigned short*)(KT + (ch * 8 + i) * TPB + t * 2) = (unsigned short)f2bf(f[i] * wt);
        const v4u vv = *(const GAS v4u*)(PROJ + (size_t)(row0 + t) * NINP + C_MV + h * 128 + ch * 8);
        *(LAS unsigned short*)(VT + (ch * 8 + 0) * TPB + t * 2) = (unsigned short)(vv.x & 0xffffu); *(LAS unsigned short*)(VT + (ch * 8 + 1) * TPB + t * 2) = (unsigned short)(vv.x >> 16);
        *(LAS unsigned short*)(VT + (ch * 8 + 2) * TPB + t * 2) = (unsigned short)(vv.y & 0xffffu); *(LAS unsigned short*)(VT + (ch * 8 + 3) * TPB + t * 2) = (unsigned short)(vv.y >> 16);
        *(LAS unsigned short*)(VT + (ch * 8 + 4) * TPB + t * 2) = (unsigned short)(vv.z & 0xffffu); *(LAS unsigned short*)(VT + (ch * 8 + 5) * TPB + t * 2) = (unsigned short)(vv.z >> 16);
        *(LAS unsigned short*)(VT + (ch * 8 + 6) * TPB + t * 2) = (unsigned short)(vv.w & 0xffffu); *(LAS unsigned short*)(VT + (ch * 8 + 7) * TPB + t * 2) = (unsigned short)(vv.w >> 16); }
    __syncthreads();
    bf16x8 xf[4];
#pragma unroll
    for (int s = 0; s < 4; ++s) xf[s] = lds_frag(VT, 16 * w, 32 * s, lane);
    float* dct = (float*)(ARGWS() + WS_DCT) + (size_t)item * 16384;
#pragma unroll
    for (int t = 0; t < 8; ++t) { f32x4 acc = (f32x4){0.f, 0.f, 0.f, 0.f};
#pragma unroll
        for (int s = 0; s < 4; ++s) acc = MFMA16(lds_frag(KT, 16 * t, 32 * s, lane), xf[s], acc);
        *(GAS f32x4*)(dct + (size_t)(16 * w + (lane & 15)) * 128 + 16 * t + 4 * (lane >> 4)) = acc; }
    if (tid < 128) { float s = 0.f;
#pragma unroll
        for (int j = 0; j < 16; ++j) { float f[8]; unpack8(*(const LAS v4u*)(KT + tid * TPB + j * 16), f); s += ((f[0] + f[1]) + (f[2] + f[3])) + ((f[4] + f[5]) + (f[6] + f[7])); }
        ((float*)(ARGWS() + WS_DN))[(size_t)item * 128 + tid] = s; }
    if (tid == 0) { float* sc = (float*)(ARGWS() + WS_SC) + item * 2; sc[0] = tab[3]; sc[1] = pmax; }
}

__device__ __forceinline__ void mlstm_scan_phase(Frame& F, int l) {
    const int tid = F.tid;
    LAS float* coef = (LAS float*)(F.lds); LAS float* gend = coef + 16;
    for (int it = F.vcu; it < 128; it += F.G) {
        const int bh = it >> 3, b = bh >> 2, h = bh & 3, part = it & 7;
        __syncthreads();
        if (tid == 0) { const float* sc = (const float*)(ARGWS() + WS_SC) + bh * 32; float* mp = (float*)(ARGWS() + WS_MPV) + bh * 16; float m = 0.f;
            for (int c = 0; c < 16; ++c) { const float bl = sc[2 * c], pm = sc[2 * c + 1], M = fmaxf(m, pm); coef[c] = fexp(pm - M); gend[c] = fexp(m - M); if (part == 0) mp[c] = m; m = bl + M; }
            if (part == 0) ARGOUT()[O_PM + (size_t)(l * NB + b) * 4 + h] = m; }
        __syncthreads();
        const int elem = part * 512 + tid, e = elem >> 5, d4 = (elem & 31) * 4;
        const float* dct = (const float*)(ARGWS() + WS_DCT) + (size_t)bh * 16 * 16384 + (size_t)e * 128 + d4;
        bf16* cpt = (bf16*)(ARGWS() + WS_CPT) + (size_t)bh * 16 * 16384 + (size_t)e * 128 + d4;
        f32x4 dc[16];
#pragma unroll
        for (int c = 0; c < 16; ++c) dc[c] = *(const GAS f32x4*)(dct + (size_t)c * 16384);
        f32x4 C = (f32x4){0.f, 0.f, 0.f, 0.f};
#pragma unroll
        for (int c = 0; c < 16; ++c) { *(GAS unsigned long long*)(cpt + (size_t)c * 16384) = (unsigned long long)pk2(C.x, C.y) | ((unsigned long long)pk2(C.z, C.w) << 32);
            C = C * gend[c] + dc[c] * coef[c]; }
        float* pc = ARGOUT() + O_PC + ((size_t)(l * NB + b) * 4 + h) * 16384;
        pc[(size_t)(d4 + 0) * 128 + e] = C.x; pc[(size_t)(d4 + 1) * 128 + e] = C.y; pc[(size_t)(d4 + 2) * 128 + e] = C.z; pc[(size_t)(d4 + 3) * 128 + e] = C.w;
        if (part == 0 && tid < 128) { const float* dn = (const float*)(ARGWS() + WS_DN) + (size_t)bh * 16 * 128 + tid; float* np = (float*)(ARGWS() + WS_NP) + (size_t)bh * 16 * 128 + tid; float n = 0.f;
#pragma unroll
            for (int c = 0; c < 16; ++c) { np[c * 128] = n; n = n * gend[c] + dn[c * 128] * coef[c]; }
            ARGOUT()[O_PN + ((size_t)(l * NB + b) * 4 + h) * 128 + tid] = n; }
    }
}

__device__ __forceinline__ void mlstm_c_item(Frame& F, int l, int b, int h, int c) {
    const bf16* PROJ = (const bf16*)(ARGWS() + WS_PROJ); bf16* MIXED = (bf16*)(ARGWS() + WS_MIXED);
    const int tid = F.tid, lane = F.lane, w = F.wave, row0 = b * SEQL + c * 128, item = (b * 4 + h) * 16 + c, lc = lane & 15, lg = lane >> 4;
    LAS unsigned char* Kn = F.lds; LAS unsigned char* VT = F.lds + 128 * TPB; LAS unsigned char* CP = F.lds + 2 * 128 * TPB;
    LAS float* tab = (LAS float*)(F.lds + 3 * 128 * TPB); LAS float* Ak = tab + 16; LAS float* Mq = Ak + 128; LAS float* Emt = Mq + 128; LAS float* Np = Emt + 128;
    __syncthreads();
    float bcum, a; mlstm_gates(F, PROJ, row0, l, h, tab, bcum, a);
    const float mprev = ((const float*)(ARGWS() + WS_MPV))[item];
    float pm = -INFINITY;
    if (tid < 128) { pm = wave_incl_scan_max(a, lane); if (tid == 63) tab[1] = pm; }
    __syncthreads();
    if (tid < 128) { if (tid >= 64) pm = fmaxf(pm, tab[1]); const float M = fmaxf(mprev, pm); Ak[tid] = a; Mq[tid] = M; Emt[tid] = fexp(-(bcum + M)); Np[tid] = ((const float*)(ARGWS() + WS_NP))[(size_t)item * 128 + tid]; }
#pragma unroll
    for (int rep = 0; rep < 4; ++rep) { const int task = tid + rep * NTHR;
        { const int ch = task & 15, t = task >> 4; *(LAS v4u*)(Kn + t * TPB + ch * 16) = *(const GAS v4u*)(PROJ + (size_t)(row0 + t) * NINP + C_MK + h * 128 + ch * 8);
          *(LAS v4u*)(CP + t * TPB + ch * 16) = *(const GAS v4u*)((const bf16*)(ARGWS() + WS_CPT) + (size_t)item * 16384 + (size_t)t * 128 + ch * 8); }
        { const int t = task & 127, ch = task >> 7; const v4u vv = *(const GAS v4u*)(PROJ + (size_t)(row0 + t) * NINP + C_MV + h * 128 + ch * 8);
          *(LAS unsigned short*)(VT + (ch * 8 + 0) * TPB + t * 2) = (unsigned short)(vv.x & 0xffffu); *(LAS unsigned short*)(VT + (ch * 8 + 1) * TPB + t * 2) = (unsigned short)(vv.x >> 16);
          *(LAS unsigned short*)(VT + (ch * 8 + 2) * TPB + t * 2) = (unsigned short)(vv.y & 0xffffu); *(LAS unsigned short*)(VT + (ch * 8 + 3) * TPB + t * 2) = (unsigned short)(vv.y >> 16);
          *(LAS unsigned short*)(VT + (ch * 8 + 4) * TPB + t * 2) = (unsigned short)(vv.z & 0xffffu); *(LAS unsigned short*)(VT + (ch * 8 + 5) * TPB + t * 2) = (unsigned short)(vv.z >> 16);
          *(LAS unsigned short*)(VT + (ch * 8 + 6) * TPB + t * 2) = (unsigned short)(vv.w & 0xffffu); *(LAS unsigned short*)(VT + (ch * 8 + 7) * TPB + t * 2) = (unsigned short)(vv.w >> 16); } }
    bf16x8 qf[4];
#pragma unroll
    for (int s = 0; s < 4; ++s) qf[s] = *(const GAS bf16x8*)(PROJ + (size_t)(row0 + 16 * w + lc) * NINP + C_MQ + h * 128 + 32 * s + 8 * lg);
    __syncthreads();
    float qn = 0.f;
#pragma unroll
    for (int s = 0; s < 4; ++s) { float f[8]; unpack8(__builtin_bit_cast(v4u, qf[s]), f);
#pragma unroll
        for (int i = 0; i < 8; ++i) qn += f[i] * Np[32 * s + 8 * lg + i]; }
    qn += __shfl_xor(qn, 16); qn += __shfl_xor(qn, 32);
    f32x4 sacc[8];
#pragma unroll
    for (int t = 0; t < 8; ++t) { sacc[t] = (f32x4){0.f, 0.f, 0.f, 0.f};
        if (t <= w) {
#pragma unroll
            for (int s = 0; s < 4; ++s) sacc[t] = MFMA16(lds_frag(Kn, 16 * t, 32 * s, lane), qf[s], sacc[t]); } }
    __syncthreads();
    LAS unsigned char* Pw = Kn + w * 16 * TPB;
    const int q = 16 * w + lc; const float Mrow = Mq[q], gq = fexp(mprev - Mrow);
    float rsum = 0.f;
#pragma unroll
    for (int t = 0; t < 8; ++t) { if (t <= (w | 1)) { float p[4];
#pragma unroll
            for (int i = 0; i < 4; ++i) { const int k = 16 * t + 4 * lg + i; p[i] = (k <= q) ? fexp(Ak[k] - Mrow) * 0.08838834764831845f * sacc[t][i] : 0.f; rsum += p[i]; }
            *(LAS unsigned long long*)(Pw + lc * TPB + (16 * t + 4 * lg) * 2) = (unsigned long long)pk2(p[0], p[1]) | ((unsigned long long)pk2(p[2], p[3]) << 32); } }
    rsum += __shfl_xor(rsum, 16); rsum += __shfl_xor(rsum, 32);
    asm volatile("s_waitcnt lgkmcnt(0)" ::: "memory");
    f32x4 acc[8];
#pragma unroll
    for (int t = 0; t < 8; ++t) { acc[t] = (f32x4){0.f, 0.f, 0.f, 0.f};
#pragma unroll
        for (int s = 0; s < 4; ++s) acc[t] = MFMA16(lds_frag(CP, 16 * t, 32 * s, lane), qf[s], acc[t]);
        acc[t] = acc[t] * gq; }
#pragma unroll
    for (int s = 0; s < 4; ++s) { if (s <= (w >> 1)) { const bf16x8 pf = lds_frag(Pw, 0, 32 * s, lane);
#pragma unroll
            for (int t = 0; t < 8; ++t) acc[t] = MFMA16(lds_frag(VT, 16 * t, 32 * s, lane), pf, acc[t]); } }
    const float den = rsum + gq * qn, dinv = 1.0f / fmaxf(fabsf(den), Emt[q]);
    float ss = 0.f;
#pragma unroll
    for (int t = 0; t < 8; ++t) { acc[t] = acc[t] * dinv; ss += (acc[t][0] * acc[t][0] + acc[t][1] * acc[t][1]) + (acc[t][2] * acc[t][2] + acc[t][3] * acc[t][3]); }
    ss += __shfl_xor(ss, 16); ss += __shfl_xor(ss, 32);
    const float rs = __builtin_amdgcn_rsqf(ss * (1.0f / 128.0f) + 1e-6f);
    const float* wml = ARGIN(20) + (size_t)l * 512 + h * 128;
#pragma unroll
    for (int t = 0; t < 8; ++t) { const int e0 = 16 * t + 4 * lg; const f32x4 g4 = *(const GAS f32x4*)(wml + e0);
        const unsigned long long mo = *(const GAS unsigned long long*)(PROJ + (size_t)(row0 + q) * NINP + C_MO + h * 128 + e0);
        const float o0 = acc[t][0] * rs * g4.x * sigmoidf_(bflo((unsigned)mo)), o1 = acc[t][1] * rs * g4.y * sigmoidf_(bfhi((unsigned)mo)),
                    o2 = acc[t][2] * rs * g4.z * sigmoidf_(bflo((unsigned)(mo >> 32))), o3 = acc[t][3] * rs * g4.w * sigmoidf_(bfhi((unsigned)(mo >> 32)));
        *(GAS unsigned long long*)(MIXED + (size_t)(row0 + q) * DM + 1536 + h * 128 + e0) = (unsigned long long)pk2(o0, o1) | ((unsigned long long)pk2(o2, o3) << 32); }
}

constexpr size_t WS_DS = 496 * MiB;
constexpr size_t WS_SP = 528 * MiB;
constexpr size_t WS_AL = 544 * MiB;
constexpr size_t WS_END2 = 545 * MiB;

__device__ __forceinline__ void conv8(const bf16* PROJ, const float* cw, const float* cb, size_t grow, int pos, int ch0, float (&y)[8]) {
    const f32x4 b0 = *(const GAS f32x4*)(cb + ch0), b1 = *(const GAS f32x4*)(cb + ch0 + 4);
    y[0] = b0.x; y[1] = b0.y; y[2] = b0.z; y[3] = b0.w; y[4] = b1.x; y[5] = b1.y; y[6] = b1.z; y[7] = b1.w;
#pragma unroll
    for (int j = 0; j < 4; ++j) { if (pos - 3 + j >= 0) { float r[8]; unpack8(*(const GAS v4u*)(PROJ + (grow - 3 + j) * NINP + C_XBC + ch0), r);
            const f32x4 w0 = *(const GAS f32x4*)(cw + j * XCW + ch0), w1 = *(const GAS f32x4*)(cw + j * XCW + ch0 + 4);
            y[0] += w0.x * r[0]; y[1] += w0.y * r[1]; y[2] += w0.z * r[2]; y[3] += w0.w * r[3]; y[4] += w1.x * r[4]; y[5] += w1.y * r[5]; y[6] += w1.z * r[6]; y[7] += w1.w * r[7]; } }
#pragma unroll
    for (int i = 0; i < 8; ++i) y[i] = siluf_(y[i]);
}

constexpr int XNP = 528;
__device__ __forceinline__ void ssd_a_item(Frame& F, int l, int b, int g, int c, int half) {
    const bf16* PROJ = (const bf16*)(ARGWS() + WS_PROJ); bf16* XC = (bf16*)(ARGWS() + WS_XC);
    const float* cw = ARGIN(12) + (size_t)l * 4 * XCW; const float* cb = ARGIN(13) + (size_t)l * XCW;
    const int tid = F.tid, lane = F.lane, w = F.wave, row0 = b * SEQL + c * 128, h0 = g * 8 + half * 4;
    LAS unsigned char* Xn = F.lds; LAS unsigned char* Bn = F.lds + 128 * XNP;
    LAS float* tab = (LAS float*)(F.lds + 128 * XNP + 128 * TPB); LAS float* wt = tab + 16;
    __syncthreads();
    { const int r = tid >> 7, t = tid & 127, h = h0 + r;
      const float dt = softplusf_(bf2f(PROJ[(size_t)(row0 + t) * NINP + C_DT + h]) + ARGIN(14)[l * 16 + h]), A = -expf(ARGIN(15)[l * 16 + h]);
      float v = wave_incl_scan_add(dt * A, lane);
      if (lane == 63 && (w & 1) == 0) tab[r] = v;
      __syncthreads();
      if (w & 1) v += tab[r];
      if (t == 127) tab[4 + r] = v;
      __syncthreads();
      const float al = tab[4 + r];
      wt[r * 128 + t] = fexp(al - v) * dt;
      if (t == 127) ((float*)(ARGWS() + WS_AL))[((b * 16 + h) * 16) + c] = al; }
    __syncthreads();
#pragma unroll 2
    for (int rep = 0; rep < 14; ++rep) { const int task = tid + rep * NTHR, t = task / 56, cj = task % 56;
        const int ch0 = cj < 32 ? h0 * 64 + cj * 8 : (cj < 48 ? 1024 + g * 128 + (cj - 32) * 8 : 1280 + g * 128 + half * 64 + (cj - 48) * 8);
        float y[8]; conv8(PROJ, cw, cb, (size_t)(row0 + t), c * 128 + t, ch0, y);
        *(GAS v4u*)(XC + (size_t)(row0 + t) * XCW + ch0) = pack8(y);
        if (cj < 32) { const float wv = wt[(cj >> 3) * 128 + t];
#pragma unroll
            for (int i = 0; i < 8; ++i) y[i] *= wv;
            *(LAS v4u*)(Xn + t * XNP + cj * 16) = pack8(y); }
        else if (cj < 48) *(LAS v4u*)(Bn + t * TPB + (cj - 32) * 16) = pack8(y); }
    __syncthreads();
    const int r = w >> 1, h = h0 + r;
    float* ds = (float*)(ARGWS() + WS_DS) + (size_t)((b * 16 + h) * 16 + c) * 8192;
#pragma unroll
    for (int ps = 0; ps < 2; ++ps) { const int prow = 2 * (w & 1) + ps;
        bf16x8 xf[4];
#pragma unroll
        for (int s = 0; s < 4; ++s) xf[s] = lds_frag_tr(Xn, XNP, 32 * s, r * 64 + 16 * prow, lane);
#pragma unroll
        for (int t = 0; t < 8; ++t) { f32x4 acc = (f32x4){0.f, 0.f, 0.f, 0.f};
#pragma unroll
            for (int s = 0; s < 4; ++s) acc = MFMA16(lds_frag_tr(Bn, TPB, 32 * s, 16 * t, lane), xf[s], acc);
            *(GAS f32x4*)(ds + (size_t)(16 * prow + (lane & 15)) * 128 + 16 * t + 4 * (lane >> 4)) = acc; } }
}

__device__ __forceinline__ void ssd_scan_phase(Frame& F, int l) {
    for (int idx = F.vcu * NTHR + F.tid; idx < 64 * 2048; idx += F.G * NTHR) {
        const int bh = idx >> 11, e4 = (idx & 2047) * 4;
        const float* al = (const float*)(ARGWS() + WS_AL) + bh * 16;
        const float* ds = (const float*)(ARGWS() + WS_DS) + (size_t)bh * 16 * 8192 + e4;
        bf16* sp = (bf16*)(ARGWS() + WS_SP) + (size_t)bh * 16 * 8192 + e4;
        f32x4 d[16]; float dec[16];
#pragma unroll
        for (int c = 0; c < 16; ++c) { d[c] = *(const GAS f32x4*)(ds + (size_t)c * 8192); dec[c] = al[c]; }
        f32x4 S = (f32x4){0.f, 0.f, 0.f, 0.f};
#pragma unroll
        for (int c = 0; c < 16; ++c) { *(GAS unsigned long long*)(sp + (size_t)c * 8192) = (unsigned long long)pk2(S.x, S.y) | ((unsigned long long)pk2(S.z, S.w) << 32);
            S = S * fexp(dec[c]) + d[c]; }
        *(GAS f32x4*)(ARGOUT() + O_PSSM + ((size_t)l * 64 + bh) * 8192 + e4) = S;
    }
}

__device__ __forceinline__ void ssd_c_item(Frame& F, int l, int b, int g, int c) {
    const bf16* PROJ = (const bf16*)(ARGWS() + WS_PROJ); bf16* MIXED = (bf16*)(ARGWS() + WS_MIXED); float* YG = (float*)(ARGWS() + WS_YG);
    const int tid = F.tid, lane = F.lane, w = F.wave, row0 = b * SEQL + c * 128, lc = lane & 15, lg = lane >> 4, q = 16 * w + lc;
    LAS unsigned char* Bn = F.lds; LAS unsigned char* XT = F.lds + 128 * TPB; LAS unsigned char* SP = F.lds + 256 * TPB;
    LAS float* tab = (LAS float*)(F.lds + 384 * TPB); LAS float* At = tab + 16; LAS float* Dt = At + 1024;
    __syncthreads();
    { float v[2], dtv[2];
#pragma unroll
      for (int rep = 0; rep < 2; ++rep) { const int r = (tid >> 7) + 4 * rep, t = tid & 127, h = g * 8 + r;
          dtv[rep] = softplusf_(bf2f(PROJ[(size_t)(row0 + t) * NINP + C_DT + h]) + ARGIN(14)[l * 16 + h]);
          v[rep] = wave_incl_scan_add(dtv[rep] * -fexp(ARGIN(15)[l * 16 + h]), lane);
          if (lane == 63 && (w & 1) == 0) tab[r] = v[rep]; }
      __syncthreads();
#pragma unroll
      for (int rep = 0; rep < 2; ++rep) { const int r = (tid >> 7) + 4 * rep, t = tid & 127; if (w & 1) v[rep] += tab[r]; At[r * 128 + t] = v[rep]; Dt[r * 128 + t] = dtv[rep]; } }
    const bf16* XC = (const bf16*)(ARGWS() + WS_XC);
    bf16x8 cf[4];
#pragma unroll
    for (int s = 0; s < 4; ++s) cf[s] = *(const GAS bf16x8*)(XC + (size_t)(row0 + q) * XCW + 1280 + g * 128 + 32 * s + 8 * lg);
#pragma unroll
    for (int rep = 0; rep < 4; ++rep) { const int task = tid + rep * NTHR, ch = task & 15, t = task >> 4;
        *(LAS v4u*)(Bn + t * TPB + ch * 16) = *(const GAS v4u*)(XC + (size_t)(row0 + t) * XCW + 1024 + g * 128 + ch * 8); }
    __syncthreads();
    f32x4 cbm[8];
#pragma unroll
    for (int t = 0; t < 8; ++t) { cbm[t] = (f32x4){0.f, 0.f, 0.f, 0.f};
        if (t <= w) {
#pragma unroll
            for (int s = 0; s < 4; ++s) cbm[t] = MFMA16(lds_frag(Bn, 16 * t, 32 * s, lane), cf[s], cbm[t]); } }
    LAS unsigned char* Pw = Bn + w * 16 * TPB;
    float ssq = 0.f;
    for (int hp = 0; hp < 4; ++hp) {
        __syncthreads();
#pragma unroll
        for (int rep = 0; rep < 4; ++rep) { const int task = tid + rep * NTHR;
            { const int ch = task & 15, t = task >> 4;
              *(LAS v4u*)(XT + t * TPB + ch * 16) = *(const GAS v4u*)(XC + (size_t)(row0 + t) * XCW + (g * 8 + 2 * hp) * 64 + ch * 8); }
            { const int ch = task & 15, pr = task >> 4;
              const int h = g * 8 + 2 * hp + (pr >> 6);
              *(LAS v4u*)(SP + pr * TPB + ch * 16) = *(const GAS v4u*)((const bf16*)(ARGWS() + WS_SP) + (size_t)((b * 16 + h) * 16 + c) * 8192 + (size_t)(pr & 63) * 128 + ch * 8); } }
        __syncthreads();
#pragma unroll
        for (int rr = 0; rr < 2; ++rr) { const int r = 2 * hp + rr, h = g * 8 + r; const float Dh = ARGIN(16)[l * 16 + h], aq = At[r * 128 + q];
#pragma unroll
            for (int t = 0; t < 8; ++t) { if (t <= (w | 1)) { float p[4];
#pragma unroll
                    for (int i = 0; i < 4; ++i) { const int k = 16 * t + 4 * lg + i; p[i] = (k <= q) ? cbm[t][i] * fexp(aq - At[r * 128 + k]) * Dt[r * 128 + k] : 0.f; if (k == q) p[i] += Dh; }
                    *(LAS unsigned long long*)(Pw + lc * TPB + (16 * t + 4 * lg) * 2) = (unsigned long long)pk2(p[0], p[1]) | ((unsigned long long)pk2(p[2], p[3]) << 32); } }
            asm volatile("s_waitcnt lgkmcnt(0)" ::: "memory");
            f32x4 acc[4]; const float eq = fexp(aq);
#pragma unroll
            for (int pt = 0; pt < 4; ++pt) { acc[pt] = (f32x4){0.f, 0.f, 0.f, 0.f};
#pragma unroll
                for (int s = 0; s < 4; ++s) acc[pt] = MFMA16(lds_frag(SP, rr * 64 + 16 * pt, 32 * s, lane), cf[s], acc[pt]);
                acc[pt] = acc[pt] * eq; }
#pragma unroll
            for (int s = 0; s < 4; ++s) { if (s <= (w >> 1)) { const bf16x8 pf = lds_frag(Pw, 0, 32 * s, lane);
#pragma unroll
                    for (int pt = 0; pt < 4; ++pt) acc[pt] = MFMA16(lds_frag_tr(XT, TPB, 32 * s, rr * 64 + 16 * pt, lane), pf, acc[pt]); } }
            asm volatile("s_waitcnt lgkmcnt(0)" ::: "memory");
#pragma unroll
            for (int pt = 0; pt < 4; ++pt) { const int p0 = 16 * pt + 4 * lg;
                const unsigned long long zz = *(const GAS unsigned long long*)(PROJ + (size_t)(row0 + q) * NINP + C_Z + h * 64 + p0);
                f32x4 y = acc[pt]; y.x *= siluf_(bflo((unsigned)zz)); y.y *= siluf_(bfhi((unsigned)zz)); y.z *= siluf_(bflo((unsigned)(zz >> 32))); y.w *= siluf_(bfhi((unsigned)(zz >> 32)));
                ssq += (y.x * y.x + y.y * y.y) + (y.z * y.z + y.w * y.w);
                *(GAS f32x4*)(YG + (size_t)(row0 + q) * 1024 + h * 64 + p0) = y; } }
    }
    if (c == 15 && tid < 288) {
        const int j = tid / 96, kk = tid % 96, ch0 = kk < 64 ? g * 512 + kk * 8 : (kk < 80 ? 1024 + g * 128 + (kk - 64) * 8 : 1280 + g * 128 + (kk - 80) * 8);
        float r[8]; unpack8(*(const GAS v4u*)(PROJ + (size_t)(row0 + 125 + j) * NINP + C_XBC + ch0), r);
        float* o = ARGOUT() + O_PCONV + (size_t)((l * NB + b) * 3 + j) * XCW + ch0;
        *(GAS f32x4*)o = (f32x4){r[0], r[1], r[2], r[3]}; *(GAS f32x4*)(o + 4) = (f32x4){r[4], r[5], r[6], r[7]}; }
    ssq += __shfl_xor(ssq, 16); ssq += __shfl_xor(ssq, 32);
    const float rs = __builtin_amdgcn_rsqf(ssq * (1.0f / 512.0f) + 1e-6f);
    asm volatile("s_waitcnt vmcnt(0)" ::: "memory");
    const float* wn = ARGIN(17) + (size_t)l * 1024 + g * 512;
#pragma unroll 4
    for (int j = 0; j < 32; ++j) { const int col = 16 * j + 4 * lg;
        const f32x4 y = *(const GAS f32x4*)(YG + (size_t)(row0 + q) * 1024 + g * 512 + col), g4 = *(const GAS f32x4*)(wn + col);
        *(GAS unsigned long long*)(MIXED + (size_t)(row0 + q) * DM + 512 + g * 512 + col) = (unsigned long long)pk2(y.x * rs * g4.x, y.y * rs * g4.y) | ((unsigned long long)pk2(y.z * rs * g4.z, y.w * rs * g4.w) << 32); }
}

constexpr int AKP = 72 * 2, AVP = 280 * 2, APP = 168 * 2;
__device__ __forceinline__ void attn_mfma_item(Frame& F, int l, int b, int blk, int kvh) {
    const bf16* PROJ = (const bf16*)(ARGWS() + WS_PROJ); bf16* MIXED = (bf16*)(ARGWS() + WS_MIXED);
    const int tid = F.tid, lane = F.lane, w = F.wave, lc = lane & 15, lg = lane >> 4, w0 = blk * 128 - 128;
    LAS unsigned char* Ks = F.lds; LAS unsigned char* Vt = F.lds + 256 * AKP; LAS unsigned char* Pw = F.lds + 256 * AKP + 64 * AVP + w * 16 * APP;
    float* pk = ARGOUT() + O_PK + (size_t)(l * NB + b) * 128 * 128; float* pv = ARGOUT() + O_PV + (size_t)(l * NB + b) * 128 * 128;
    __syncthreads();
    if (tid < 64 * 3) { const int d = tid / 3, j = tid % 3; *(LAS v4u*)(Vt + d * AVP + 512 + j * 16) = (v4u){0u, 0u, 0u, 0u}; }
#pragma unroll
    for (int rep = 0; rep < 4; ++rep) { const int task = tid + rep * NTHR;
        { const int r = task >> 3, c = task & 7, pos = w0 + r; const bool keep = (blk == 15 && r >= 128);
          if (pos < 0) { *(LAS v4u*)(Ks + r * AKP + c * 16) = (v4u){0u, 0u, 0u, 0u}; }
          else { const size_t grow = (size_t)(b * SEQL + pos) * NINP;
            if (c >= 2) { const v4u wk = *(const GAS v4u*)(PROJ + grow + C_K + kvh * 64 + c * 8); *(LAS v4u*)(Ks + r * AKP + c * 16) = wk;
              if (keep) { float f[8]; unpack8(wk, f); float* o = pk + (size_t)((r - 128) * 2 + kvh) * 64 + c * 8; *(GAS f32x4*)o = (f32x4){f[0], f[1], f[2], f[3]}; *(GAS f32x4*)(o + 4) = (f32x4){f[4], f[5], f[6], f[7]}; } }
            else if (c == 0) { float x1[8], x2[8], cs[8], sn[8], o1[8], o2[8];
              unpack8(*(const GAS v4u*)(PROJ + grow + C_K + kvh * 64), x1); unpack8(*(const GAS v4u*)(PROJ + grow + C_K + kvh * 64 + 8), x2); rope_cs(pos, cs, sn);
#pragma unroll
              for (int i = 0; i < 8; ++i) { o1[i] = x1[i] * cs[i] - x2[i] * sn[i]; o2[i] = x2[i] * cs[i] + x1[i] * sn[i]; }
              *(LAS v4u*)(Ks + r * AKP) = pack8(o1); *(LAS v4u*)(Ks + r * AKP + 16) = pack8(o2);
              if (keep) { float* o = pk + (size_t)((r - 128) * 2 + kvh) * 64; *(GAS f32x4*)o = (f32x4){o1[0], o1[1], o1[2], o1[3]}; *(GAS f32x4*)(o + 4) = (f32x4){o1[4], o1[5], o1[6], o1[7]};
                  *(GAS f32x4*)(o + 8) = (f32x4){o2[0], o2[1], o2[2], o2[3]}; *(GAS f32x4*)(o + 12) = (f32x4){o2[4], o2[5], o2[6], o2[7]}; } } } }
        { const int r = task & 255, c = task >> 8, pos = w0 + r; const bool keep = (blk == 15 && r >= 128);
          v4u wv = (v4u){0u, 0u, 0u, 0u};
          if (pos >= 0) wv = *(const GAS v4u*)(PROJ + (size_t)(b * SEQL + pos) * NINP + C_V + kvh * 64 + c * 8);
          *(LAS unsigned short*)(Vt + (c * 8 + 0) * AVP + r * 2) = (unsigned short)(wv.x & 0xffffu); *(LAS unsigned short*)(Vt + (c * 8 + 1) * AVP + r * 2) = (unsigned short)(wv.x >> 16);
          *(LAS unsigned short*)(Vt + (c * 8 + 2) * AVP + r * 2) = (unsigned short)(wv.y & 0xffffu); *(LAS unsigned short*)(Vt + (c * 8 + 3) * AVP + r * 2) = (unsigned short)(wv.y >> 16);
          *(LAS unsigned short*)(Vt + (c * 8 + 4) * AVP + r * 2) = (unsigned short)(wv.z & 0xffffu); *(LAS unsigned short*)(Vt + (c * 8 + 5) * AVP + r * 2) = (unsigned short)(wv.z >> 16);
          *(LAS unsigned short*)(Vt + (c * 8 + 6) * AVP + r * 2) = (unsigned short)(wv.w & 0xffffu); *(LAS unsigned short*)(Vt + (c * 8 + 7) * AVP + r * 2) = (unsigned short)(wv.w >> 16);
          if (keep) { float f[8]; unpack8(wv, f); float* o = pv + (size_t)((r - 128) * 2 + kvh) * 64 + c * 8; *(GAS f32x4*)o = (f32x4){f[0], f[1], f[2], f[3]}; *(GAS f32x4*)(o + 4) = (f32x4){f[4], f[5], f[6], f[7]}; } } }
    const int qpos = blk * 128 + 16 * w + lc; const size_t qrow = (size_t)b * SEQL + qpos;
    float cs[8], sn[8]; rope_cs(qpos, cs, sn);
    __syncthreads();
    for (int g = 0; g < 4; ++g) { const int h = kvh * 4 + g;
        v4u q0 = *(const GAS v4u*)(PROJ + qrow * NINP + C_Q + h * 64 + 8 * lg); const v4u q1 = *(const GAS v4u*)(PROJ + qrow * NINP + C_Q + h * 64 + 32 + 8 * lg);
        { v4u pp; pp.x = __shfl_xor(q0.x, 16); pp.y = __shfl_xor(q0.y, 16); pp.z = __shfl_xor(q0.z, 16); pp.w = __shfl_xor(q0.w, 16);
          float own[8], oth[8], o[8]; unpack8(q0, own); unpack8(pp, oth);
#pragma unroll
          for (int i = 0; i < 8; ++i) o[i] = lg == 0 ? own[i] * cs[i] - oth[i] * sn[i] : own[i] * cs[i] + oth[i] * sn[i];
          if (lg < 2) q0 = pack8(o); }
        const bf16x8 qf0 = __builtin_bit_cast(bf16x8, q0), qf1 = __builtin_bit_cast(bf16x8, q1);
        f32x4 sc[9]; float mx = -INFINITY;
#pragma unroll
        for (int tt = 0; tt < 9; ++tt) { const LAS unsigned char* kb = Ks + (16 * (w + tt) + lc) * AKP + 16 * lg;
            f32x4 a = (f32x4){0.f, 0.f, 0.f, 0.f};
            a = MFMA16(*(const LAS bf16x8*)kb, qf0, a); a = MFMA16(*(const LAS bf16x8*)(kb + 64), qf1, a);
#pragma unroll
            for (int i = 0; i < 4; ++i) { const int kk = 16 * tt + 4 * lg + i; const bool ok = (kk >= lc) && (kk <= 128 + lc) && (w0 + 16 * w + kk >= 0);
                a[i] = ok ? a[i] * 0.125f : -INFINITY; mx = fmaxf(mx, a[i]); }
            sc[tt] = a; }
        mx = fmaxf(mx, __shfl_xor(mx, 16)); mx = fmaxf(mx, __shfl_xor(mx, 32));
        const float sink = ARGIN(11)[l * 8 + h]; mx = fmaxf(mx, sink);
        float rsum = 0.f;
#pragma unroll
        for (int tt = 0; tt < 10; ++tt) { float p[4] = {0.f, 0.f, 0.f, 0.f};
            if (tt < 9) {
#pragma unroll
                for (int i = 0; i < 4; ++i) { p[i] = fexp(sc[tt < 9 ? tt : 0][i] - mx); rsum += p[i]; } }
            *(LAS unsigned long long*)(Pw + lc * APP + (16 * tt + 4 * lg) * 2) = (unsigned long long)pk2(p[0], p[1]) | ((unsigned long long)pk2(p[2], p[3]) << 32); }
        rsum += __shfl_xor(rsum, 16); rsum += __shfl_xor(rsum, 32);
        const float inv = 1.0f / (rsum + fexp(sink - mx));
        asm volatile("s_waitcnt lgkmcnt(0)" ::: "memory");
        f32x4 acc[4];
#pragma unroll
        for (int dt = 0; dt < 4; ++dt) acc[dt] = (f32x4){0.f, 0.f, 0.f, 0.f};
#pragma unroll
        for (int s = 0; s < 5; ++s) { const bf16x8 pf = *(const LAS bf16x8*)(Pw + lc * APP + (32 * s + 8 * lg) * 2);
#pragma unroll
            for (int dt = 0; dt < 4; ++dt) acc[dt] = MFMA16(*(const LAS bf16x8*)(Vt + (16 * dt + lc) * AVP + (16 * w + 32 * s + 8 * lg) * 2), pf, acc[dt]); }
        asm volatile("s_waitcnt lgkmcnt(0)" ::: "memory");
#pragma unroll
        for (int dt = 0; dt < 4; ++dt) *(GAS unsigned long long*)(MIXED + qrow * DM + h * 64 + 16 * dt + 4 * lg) =
            (unsigned long long)pk2(acc[dt][0] * inv, acc[dt][1] * inv) | ((unsigned long long)pk2(acc[dt][2] * inv, acc[dt][3] * inv) << 32);
    }
}

__device__ __forceinline__ void conv8_sample(const bf16* PROJ, const float* cw, const float* cb, const float* sconv, float* sconv_o, int b, int ch0, float (&y)[8]) {
    float r[4][8];
#pragma unroll
    for (int j = 0; j < 3; ++j) { const f32x4 u0 = *(const GAS f32x4*)(sconv + (size_t)(b * 3 + j) * XCW + ch0), u1 = *(const GAS f32x4*)(sconv + (size_t)(b * 3 + j) * XCW + ch0 + 4);
        r[j][0] = u0.x; r[j][1] = u0.y; r[j][2] = u0.z; r[j][3] = u0.w; r[j][4] = u1.x; r[j][5] = u1.y; r[j][6] = u1.z; r[j][7] = u1.w; }
    unpack8(*(const GAS v4u*)(PROJ + (size_t)(MP + b) * NINP + C_XBC + ch0), r[3]);
#pragma unroll
    for (int i = 0; i < 8; ++i) { float acc = cb[ch0 + i];
#pragma unroll
        for (int j = 0; j < 4; ++j) acc += cw[j * XCW + ch0 + i] * r[j][i];
        y[i] = siluf_(acc); }
#pragma unroll
    for (int j = 0; j < 3; ++j) { float* o = sconv_o + (size_t)(b * 3 + j) * XCW + ch0;
        *(GAS f32x4*)o = (f32x4){r[j + 1][0], r[j + 1][1], r[j + 1][2], r[j + 1][3]}; *(GAS f32x4*)(o + 4) = (f32x4){r[j + 1][4], r[j + 1][5], r[j + 1][6], r[j + 1][7]}; }
}
__device__ __forceinline__ void ssd_sample_item(Frame& F, int l, int b, int g) {
    const bf16* PROJ = (const bf16*)(ARGWS() + WS_PROJ); bf16* MIXED = (bf16*)(ARGWS() + WS_MIXED);
    const float* cw = ARGIN(12) + (size_t)l * 4 * XCW; const float* cb = ARGIN(13) + (size_t)l * XCW; const float* sconv = ARGIN(4) + (size_t)l * MS * 3 * XCW; float* sconv_o = ARGOUT() + O_SCONV + (size_t)l * MS * 3 * XCW;
    const int tid = F.tid, lane = F.lane, w = F.wave, p = tid >> 3, nq = tid & 7;
    LAS float* xs = (LAS float*)(F.lds);
    LAS float* Bs = xs + 512;
    LAS float* Cs = Bs + 128;
    LAS float* ys = Cs + 128;
    LAS float* red = ys + 512;
    __syncthreads();
    if (tid < 96) { const int ch0 = tid < 64 ? g * 512 + tid * 8 : (tid < 80 ? 1024 + g * 128 + (tid - 64) * 8 : 1280 + g * 128 + (tid - 80) * 8);
        float y[8]; conv8_sample(PROJ, cw, cb, sconv, sconv_o, b, ch0, y);
        LAS float* dst = tid < 64 ? xs + tid * 8 : (tid < 80 ? Bs + (tid - 64) * 8 : Cs + (tid - 80) * 8);
#pragma unroll
        for (int i = 0; i < 8; ++i) dst[i] = y[i]; }
    __syncthreads();
    float Bv[16], Cv[16];
#pragma unroll
    for (int i = 0; i < 16; ++i) { Bv[i] = Bs[nq * 16 + i]; Cv[i] = Cs[nq * 16 + i]; }
    float ssq = 0.f;
#pragma unroll 2
    for (int r = 0; r < 8; ++r) { const int h = g * 8 + r;
        const float dt = softplusf_(bf2f(PROJ[(size_t)(MP + b) * NINP + C_DT + h]) + ARGIN(14)[l * 16 + h]), dA = fexp(dt * -fexp(ARGIN(15)[l * 16 + h])), x = xs[r * 64 + p], coef = dt * x;
        const float* s0 = ARGIN(5) + ((((size_t)l * MS + b) * 16 + h) * 64 + p) * 128 + nq * 16; float* so = ARGOUT() + O_SSSM + ((((size_t)l * MS + b) * 16 + h) * 64 + p) * 128 + nq * 16;
        float y = 0.f;
#pragma unroll
        for (int i = 0; i < 4; ++i) { f32x4 v = *(const GAS f32x4*)(s0 + 4 * i);
            v.x = dA * v.x + coef * Bv[4 * i]; v.y = dA * v.y + coef * Bv[4 * i + 1]; v.z = dA * v.z + coef * Bv[4 * i + 2]; v.w = dA * v.w + coef * Bv[4 * i + 3];
            y += (v.x * Cv[4 * i] + v.y * Cv[4 * i + 1]) + (v.z * Cv[4 * i + 2] + v.w * Cv[4 * i + 3]);
            *(GAS f32x4*)(so + 4 * i) = v; }
        y += __shfl_xor(y, 1); y += __shfl_xor(y, 2); y += __shfl_xor(y, 4);
        if (nq == 0) { const float z = bf2f(PROJ[(size_t)(MP + b) * NINP + C_Z + h * 64 + p]); const float yo = (y + ARGIN(16)[l * 16 + h] * x) * siluf_(z); ys[r * 64 + p] = yo; ssq += yo * yo; } }
    ssq = wave_sum(ssq); if (lane == 0) red[w] = ssq;
    __syncthreads();
    const float tot = ((red[0] + red[1]) + (red[2] + red[3])) + ((red[4] + red[5]) + (red[6] + red[7])), rs = __builtin_amdgcn_rsqf(tot * (1.0f / 512.0f) + 1e-6f);
    ((unsigned short*)MIXED)[(size_t)(MP + b) * DM + 512 + g * 512 + tid] = (unsigned short)f2bf(ys[tid] * rs * ARGIN(17)[(size_t)l * 1024 + g * 512 + tid]);
}
__device__ __forceinline__ void mlstm_sample_item(Frame& F, int l, int b, int h) {
    const bf16* PROJ = (const bf16*)(ARGWS() + WS_PROJ); bf16* MIXED = (bf16*)(ARGWS() + WS_MIXED);
    const int tid = F.tid, lane = F.lane, w = F.wave, dg = tid >> 5, e4 = (tid & 31) * 4; const size_t prow = (size_t)(MP + b) * NINP, sidx = ((size_t)l * MS + b) * 4 + h;
    LAS float* qs = (LAS float*)(F.lds);
    LAS float* ks = qs + 128;
    LAS float* part = ks + 128;
    LAS float* red = part + 1024;
    const float m0 = ARGIN(8)[sidx];
    const float ig = bf2f(PROJ[prow + C_MI + h]) + ARGIN(18)[l * 4 + h], lf = logsigmoidf_(bf2f(PROJ[prow + C_MF + h]) + ARGIN(19)[l * 4 + h]);
    const float mn = fmaxf(lf + m0, ig), fgt = fexp(lf + m0 - mn), igt = fexp(ig - mn);
    __syncthreads();
    float dpart = 0.f;
    if (tid < 128) { const float q = bf2f(PROJ[prow + C_MQ + h * 128 + tid]), k = bf2f(PROJ[prow + C_MK + h * 128 + tid]) * 0.08838834764831845f * igt;
        qs[tid] = q; ks[tid] = k;
        const float nn = fgt * ARGIN(7)[sidx * 128 + tid] + k; ARGOUT()[O_SN + sidx * 128 + tid] = nn; dpart = q * nn; }
    dpart = wave_sum(dpart); if (lane == 0) red[w] = dpart;
    __syncthreads();
    const float den = red[0] + red[1];
    f32x4 vv; { const unsigned long long u = *(const GAS unsigned long long*)(PROJ + prow + C_MV + h * 128 + e4); vv = (f32x4){bflo((unsigned)u), bfhi((unsigned)u), bflo((unsigned)(u >> 32)), bfhi((unsigned)(u >> 32))}; }
    const float* c0 = ARGIN(6) + sidx * 16384; float* co = ARGOUT() + O_SC + sidx * 16384;
    f32x4 cr[8];
#pragma unroll
    for (int j = 0; j < 8; ++j) cr[j] = *(const GAS f32x4*)(c0 + (size_t)(dg + 16 * j) * 128 + e4);
    f32x4 num = (f32x4){0.f, 0.f, 0.f, 0.f};
#pragma unroll
    for (int j = 0; j < 8; ++j) { const int d = dg + 16 * j; const f32x4 cn = cr[j] * fgt + vv * ks[d]; *(GAS f32x4*)(co + (size_t)d * 128 + e4) = cn; num = num + cn * qs[d]; }
    num.x += __shfl_xor(num.x, 32); num.y += __shfl_xor(num.y, 32); num.z += __shfl_xor(num.z, 32); num.w += __shfl_xor(num.w, 32);
    if (lane < 32) *(LAS f32x4*)(part + w * 128 + e4) = num;
    __syncthreads();
    float hv = 0.f;
    if (tid < 128) { float s = 0.f;
#pragma unroll
        for (int j = 0; j < 8; ++j) s += part[j * 128 + tid];
        hv = s / fmaxf(fabsf(den), fexp(-mn)); }
    const float s2 = wave_sum(hv * hv); if (lane == 0) red[8 + w] = s2;
    __syncthreads();
    if (tid < 128) { const float rs = __builtin_amdgcn_rsqf((red[8] + red[9]) * (1.0f / 128.0f) + 1e-6f);
        ((unsigned short*)MIXED)[(size_t)(MP + b) * DM + 1536 + h * 128 + tid] = (unsigned short)f2bf(hv * rs * ARGIN(20)[(size_t)l * 512 + h * 128 + tid] * sigmoidf_(bf2f(PROJ[prow + C_MO + h * 128 + tid]))); }
    if (tid == 0) ARGOUT()[O_SM + sidx] = mn;
}

__device__ __forceinline__ void conv_phase(Frame& F, const Args& a, int l) {
    const bf16* PROJ = (const bf16*)(ARGWS() + WS_PROJ); bf16* XC = (bf16*)(ARGWS() + WS_XC);
    const float* cw = ARGIN(12) + (size_t)l * 4 * XCW; const float* cb = ARGIN(13) + (size_t)l * XCW; const float* sconv = ARGIN(4) + (size_t)l * MS * 3 * XCW;
    float* pconv = ARGOUT() + O_PCONV + (size_t)l * NB * 3 * XCW; float* sconv_o = ARGOUT() + O_SCONV + (size_t)l * MS * 3 * XCW;
    for (int idx = F.vcu * NTHR + F.tid; idx < (MS + NB * 3) * (XCW / 8); idx += F.G * NTHR) {
        const int rr_ = idx / (XCW / 8), c0 = (idx % (XCW / 8)) * 8;
        const int row = rr_ < MS ? MP + rr_ : ((rr_ - MS) / 3) * SEQL + (SEQL - 3) + (rr_ - MS) % 3;
        float r[4][8];
        if (row < MP) { const int t = row & (SEQL - 1);
#pragma unroll
            for (int j = 0; j < 4; ++j) { const int tt = t - 3 + j;
                if (tt >= 0) { const v4u w = *(const GAS v4u*)(PROJ + (size_t)(row - 3 + j) * NINP + C_XBC + c0); unpack8(w, r[j]); }
                else {
#pragma unroll
                    for (int i = 0; i < 8; ++i) r[j][i] = 0.f; } }
        } else { const int b = row - MP;
#pragma unroll
            for (int j = 0; j < 3; ++j) { const f32x4 u0 = *(const GAS f32x4*)(sconv + (size_t)(b * 3 + j) * XCW + c0), u1 = *(const GAS f32x4*)(sconv + (size_t)(b * 3 + j) * XCW + c0 + 4);
                r[j][0] = u0.x; r[j][1] = u0.y; r[j][2] = u0.z; r[j][3] = u0.w; r[j][4] = u1.x; r[j][5] = u1.y; r[j][6] = u1.z; r[j][7] = u1.w; }
            const v4u w = *(const GAS v4u*)(PROJ + (size_t)row * NINP + C_XBC + c0); unpack8(w, r[3]);
        }
        float y[8];
#pragma unroll
        for (int i = 0; i < 8; ++i) { float acc = cb[c0 + i];
#pragma unroll
            for (int j = 0; j < 4; ++j) acc += cw[j * XCW + c0 + i] * r[j][i];
            y[i] = siluf_(acc); }
        *(GAS v4u*)(XC + (size_t)row * XCW + c0) = pack8(y);
        if (row < MP) { const int t = row & (SEQL - 1), b = row >> 11;
            if (t >= SEQL - 3) { float* o = pconv + (size_t)(b * 3 + (t - (SEQL - 3))) * XCW + c0;
                *(GAS f32x4*)o = (f32x4){r[3][0], r[3][1], r[3][2], r[3][3]}; *(GAS f32x4*)(o + 4) = (f32x4){r[3][4], r[3][5], r[3][6], r[3][7]}; }
        } else { const int b = row - MP;
#pragma unroll
            for (int j = 0; j < 3; ++j) { float* o = sconv_o + (size_t)(b * 3 + j) * XCW + c0;
                *(GAS f32x4*)o = (f32x4){r[j + 1][0], r[j + 1][1], r[j + 1][2], r[j + 1][3]}; *(GAS f32x4*)(o + 4) = (f32x4){r[j + 1][4], r[j + 1][5], r[j + 1][6], r[j + 1][7]}; }
        }
    }
}

__device__ __forceinline__ void ssd_seq_item(Frame& F, const Args& a, int l, int b, int h, bool sample) {
    const bf16* PROJ = (const bf16*)(ARGWS() + WS_PROJ); const bf16* XC = (const bf16*)(ARGWS() + WS_XC); float* YG = (float*)(ARGWS() + WS_YG);
    const int row0 = sample ? MP + b : b * SEQL, L = sample ? 1 : SEQL, g = h >> 3, tid = F.tid;
    const float A = -expf(ARGIN(15)[l * 16 + h]), dtb = ARGIN(14)[l * 16 + h], Dh = ARGIN(16)[l * 16 + h];
    const int p = tid >> 3, nq = tid & 7;
    float S[16];
    if (sample) { const float* s0 = ARGIN(5) + ((((size_t)l * MS + b) * 16 + h) * 64 + p) * 128 + nq * 16;
#pragma unroll
        for (int i = 0; i < 4; ++i) { const f32x4 v = *(const GAS f32x4*)(s0 + 4 * i); S[4 * i] = v.x; S[4 * i + 1] = v.y; S[4 * i + 2] = v.z; S[4 * i + 3] = v.w; } }
    else {
#pragma unroll
        for (int i = 0; i < 16; ++i) S[i] = 0.f; }
    LAS float* xs = (LAS float*)(F.lds);
    LAS float* Bs = (LAS float*)(F.lds + 16384);
    LAS float* Cs = (LAS float*)(F.lds + 49152);
    LAS float* ys = (LAS float*)(F.lds + 81920);
    LAS float* dts = (LAS float*)(F.lds + 98304);
    LAS float* das = (LAS float*)(F.lds + 98304 + 256);
    for (int t0 = 0; t0 < L; t0 += 64) {
        const int nb = (L - t0) < 64 ? (L - t0) : 64;
        __syncthreads();
        { const int tt = tid >> 3, ch = tid & 7;
          if (tt < nb) { float f[8]; unpack8(*(const GAS v4u*)(XC + (size_t)(row0 + t0 + tt) * XCW + h * 64 + ch * 8), f);
#pragma unroll
              for (int i = 0; i < 8; ++i) xs[tt * 64 + ch * 8 + i] = f[i]; } }
#pragma unroll
        for (int rep = 0; rep < 2; ++rep) { const int task = tid + rep * NTHR, tt = task >> 4, ch = task & 15;
          if (tt < nb) { float f[8]; unpack8(*(const GAS v4u*)(XC + (size_t)(row0 + t0 + tt) * XCW + 1024 + g * 128 + ch * 8), f);
#pragma unroll
              for (int i = 0; i < 8; ++i) Bs[tt * 128 + ch * 8 + i] = f[i];
              unpack8(*(const GAS v4u*)(XC + (size_t)(row0 + t0 + tt) * XCW + 1280 + g * 128 + ch * 8), f);
#pragma unroll
              for (int i = 0; i < 8; ++i) Cs[tt * 128 + ch * 8 + i] = f[i]; } }
        if (tid < nb) { const float dt = softplusf_(bf2f(PROJ[(size_t)(row0 + t0 + tid) * NINP + C_DT + h]) + dtb); dts[tid] = dt; das[tid] = expf(dt * A); }
        __syncthreads();
        for (int tt = 0; tt < nb; ++tt) {
            const float dt = dts[tt], dA = das[tt], x = xs[tt * 64 + p], coef = dt * x;
            float y = 0.f;
#pragma unroll
            for (int i = 0; i < 16; ++i) { S[i] = dA * S[i] + coef * Bs[tt * 128 + nq * 16 + i]; y += S[i] * Cs[tt * 128 + nq * 16 + i]; }
            y += __shfl_xor(y, 1); y += __shfl_xor(y, 2); y += __shfl_xor(y, 4);
            if (nq == 0) ys[tt * 64 + p] = y + Dh * x;
        }
        __syncthreads();
        { const int tt = tid >> 3, ch = tid & 7;
          if (tt < nb) { float z[8]; unpack8(*(const GAS v4u*)(PROJ + (size_t)(row0 + t0 + tt) * NINP + C_Z + h * 64 + ch * 8), z);
              float o[8];
#pragma unroll
              for (int i = 0; i < 8; ++i) o[i] = ys[tt * 64 + ch * 8 + i] * siluf_(z[i]);
              float* dst = YG + (size_t)(row0 + t0 + tt) * 1024 + h * 64 + ch * 8;
              *(GAS f32x4*)dst = (f32x4){o[0], o[1], o[2], o[3]}; *(GAS f32x4*)(dst + 4) = (f32x4){o[4], o[5], o[6], o[7]}; } }
    }
    float* so = ARGOUT() + (sample ? O_SSSM + ((((size_t)l * MS + b) * 16 + h) * 64 + p) * 128 : O_PSSM + ((((size_t)l * NB + b) * 16 + h) * 64 + p) * 128) + nq * 16;
#pragma unroll
    for (int i = 0; i < 4; ++i) *(GAS f32x4*)(so + 4 * i) = (f32x4){S[4 * i], S[4 * i + 1], S[4 * i + 2], S[4 * i + 3]};
}

__device__ __forceinline__ void mlstm_seq_item(Frame& F, const Args& a, int l, int b, int h, int es, bool sample) {
    const bf16* PROJ = (const bf16*)(ARGWS() + WS_PROJ); float* HR = (float*)(ARGWS() + WS_HR);
    const int row0 = sample ? MP + b : b * SEQL, L = sample ? 1 : SEQL, tid = F.tid, w = F.wave, lane = F.lane;
    const int e0 = es * 32 + w * 4, d0 = 2 * lane, Bn = sample ? MS : NB;
    const float ib = ARGIN(18)[l * 4 + h], fb = ARGIN(19)[l * 4 + h];
    float C[2][4], n[2], m;
    if (sample) {
#pragma unroll
        for (int dd = 0; dd < 2; ++dd) { const f32x4 v = *(const GAS f32x4*)(ARGIN(6) + ((((size_t)l * MS + b) * 4 + h) * 128 + d0 + dd) * 128 + e0);
            C[dd][0] = v.x; C[dd][1] = v.y; C[dd][2] = v.z; C[dd][3] = v.w; n[dd] = ARGIN(7)[(((size_t)l * MS + b) * 4 + h) * 128 + d0 + dd]; }
        m = ARGIN(8)[((size_t)l * MS + b) * 4 + h];
    } else {
#pragma unroll
        for (int dd = 0; dd < 2; ++dd) { n[dd] = 0.f;
#pragma unroll
            for (int j = 0; j < 4; ++j) C[dd][j] = 0.f; }
        m = 0.f;
    }
    LAS float* qs = (LAS float*)(F.lds);
    LAS float* ks = (LAS float*)(F.lds + 32768);
    LAS float* vs = (LAS float*)(F.lds + 65536);
    LAS float* hs = (LAS float*)(F.lds + 73728);
    LAS float* igs = (LAS float*)(F.lds + 81920);
    LAS float* lfs = (LAS float*)(F.lds + 81920 + 256);
    for (int t0 = 0; t0 < L; t0 += 64) {
        const int nb = (L - t0) < 64 ? (L - t0) : 64;
        __syncthreads();
#pragma unroll
        for (int rep = 0; rep < 2; ++rep) { const int task = tid + rep * NTHR, tt = task >> 4, ch = task & 15;
          if (tt < nb) { float f[8]; unpack8(*(const GAS v4u*)(PROJ + (size_t)(row0 + t0 + tt) * NINP + C_MQ + h * 128 + ch * 8), f);
#pragma unroll
              for (int i = 0; i < 8; ++i) qs[tt * 128 + ch * 8 + i] = f[i];
              unpack8(*(const GAS v4u*)(PROJ + (size_t)(row0 + t0 + tt) * NINP + C_MK + h * 128 + ch * 8), f);
#pragma unroll
              for (int i = 0; i < 8; ++i) ks[tt * 128 + ch * 8 + i] = f[i] * 0.08838834764831845f; } }
        if (tid < 256) { const int tt = tid >> 2, ch = tid & 3;
          if (tt < nb) { float f[8]; unpack8(*(const GAS v4u*)(PROJ + (size_t)(row0 + t0 + tt) * NINP + C_MV + h * 128 + es * 32 + ch * 8), f);
#pragma unroll
              for (int i = 0; i < 8; ++i) vs[tt * 32 + ch * 8 + i] = f[i]; } }
        if (tid < nb) { igs[tid] = bf2f(PROJ[(size_t)(row0 + t0 + tid) * NINP + C_MI + h]) + ib; lfs[tid] = logsigmoidf_(bf2f(PROJ[(size_t)(row0 + t0 + tid) * NINP + C_MF + h]) + fb); }
        __syncthreads();
        for (int tt = 0; tt < nb; ++tt) {
            const float lf = lfs[tt], ig = igs[tt];
            const float m_new = fmaxf(lf + m, ig), fgt = expf(lf + m - m_new), igt = expf(ig - m_new); m = m_new;
            const float q0 = qs[tt * 128 + d0], q1 = qs[tt * 128 + d0 + 1], k0 = ks[tt * 128 + d0] * igt, k1 = ks[tt * 128 + d0 + 1] * igt;
            n[0] = fgt * n[0] + k0; n[1] = fgt * n[1] + k1;
            float red[5]; red[4] = q0 * n[0] + q1 * n[1];
#pragma unroll
            for (int j = 0; j < 4; ++j) { const float v = vs[tt * 32 + w * 4 + j]; C[0][j] = fgt * C[0][j] + k0 * v; C[1][j] = fgt * C[1][j] + k1 * v; red[j] = q0 * C[0][j] + q1 * C[1][j]; }
#pragma unroll
            for (int j = 0; j < 5; ++j) red[j] = wave_sum(red[j]);
            const float dn = fmaxf(fabsf(red[4]), expf(-m));
            if (lane < 4) hs[tt * 32 + w * 4 + lane] = (lane == 0 ? red[0] : lane == 1 ? red[1] : lane == 2 ? red[2] : red[3]) / dn;
        }
        __syncthreads();
        { const int tt = tid >> 3, e4 = (tid & 7) * 4;
          if (tt < nb) *(GAS f32x4*)(HR + (size_t)(row0 + t0 + tt) * 512 + h * 128 + es * 32 + e4) = (f32x4){hs[tt * 32 + e4], hs[tt * 32 + e4 + 1], hs[tt * 32 + e4 + 2], hs[tt * 32 + e4 + 3]}; }
    }
    float* co = ARGOUT() + (sample ? O_SC : O_PC) + (((size_t)l * Bn + b) * 4 + h) * 128 * 128;
#pragma unroll
    for (int dd = 0; dd < 2; ++dd) *(GAS f32x4*)(co + (size_t)(d0 + dd) * 128 + e0) = (f32x4){C[dd][0], C[dd][1], C[dd][2], C[dd][3]};
    if (es == 0 && w == 0) { float* no = ARGOUT() + (sample ? O_SN : O_PN) + (((size_t)l * Bn + b) * 4 + h) * 128; no[d0] = n[0]; no[d0 + 1] = n[1];
        if (lane == 0) ARGOUT()[(sample ? O_SM : O_PM) + ((size_t)l * Bn + b) * 4 + h] = m; }
}

__device__ __forceinline__ void attn_prompt_item(Frame& F, const Args& a, int l, int b, int blk, int kvh) {
    const bf16* PROJ = (const bf16*)(ARGWS() + WS_PROJ); bf16* MIXED = (bf16*)(ARGWS() + WS_MIXED);
    constexpr int KP = 68;
    LAS unsigned short* Ks = (LAS unsigned short*)(F.lds); LAS unsigned short* Vs = (LAS unsigned short*)(F.lds + 256 * KP * 2);
    const int tid = F.tid, w0 = blk * 128 - 128;
    float* pk = ARGOUT() + O_PK + (size_t)(l * NB + b) * 128 * 128; float* pv = ARGOUT() + O_PV + (size_t)(l * NB + b) * 128 * 128;
    __syncthreads();
#pragma unroll
    for (int rep = 0; rep < 4; ++rep) { const int task = tid + rep * NTHR, r = task >> 3, c = task & 7, pos = w0 + r; const bool keep = (blk == 15 && r >= 128);
        if (pos < 0) { *(LAS v4u*)(Ks + r * KP + c * 8) = (v4u){0u, 0u, 0u, 0u}; *(LAS v4u*)(Vs + r * KP + c * 8) = (v4u){0u, 0u, 0u, 0u}; continue; }
        const size_t grow = (size_t)(b * SEQL + pos) * NINP;
        { const v4u wv = *(const GAS v4u*)(PROJ + grow + C_V + kvh * 64 + c * 8); *(LAS v4u*)(Vs + r * KP + c * 8) = wv;
          if (keep) { float f[8]; unpack8(wv, f); float* o = pv + (size_t)((r - 128) * 2 + kvh) * 64 + c * 8; *(GAS f32x4*)o = (f32x4){f[0], f[1], f[2], f[3]}; *(GAS f32x4*)(o + 4) = (f32x4){f[4], f[5], f[6], f[7]}; } }
        if (c >= 2) { const v4u wk = *(const GAS v4u*)(PROJ + grow + C_K + kvh * 64 + c * 8); *(LAS v4u*)(Ks + r * KP + c * 8) = wk;
          if (keep) { float f[8]; unpack8(wk, f); float* o = pk + (size_t)((r - 128) * 2 + kvh) * 64 + c * 8; *(GAS f32x4*)o = (f32x4){f[0], f[1], f[2], f[3]}; *(GAS f32x4*)(o + 4) = (f32x4){f[4], f[5], f[6], f[7]}; } }
        else if (c == 0) { float x1[8], x2[8], cs[8], sn[8], o1[8], o2[8];
          unpack8(*(const GAS v4u*)(PROJ + grow + C_K + kvh * 64), x1); unpack8(*(const GAS v4u*)(PROJ + grow + C_K + kvh * 64 + 8), x2); rope_cs(pos, cs, sn);
#pragma unroll
          for (int i = 0; i < 8; ++i) { o1[i] = x1[i] * cs[i] - x2[i] * sn[i]; o2[i] = x2[i] * cs[i] + x1[i] * sn[i]; }
          *(LAS v4u*)(Ks + r * KP) = pack8(o1); *(LAS v4u*)(Ks + r * KP + 8) = pack8(o2);
          if (keep) { float* o = pk + (size_t)((r - 128) * 2 + kvh) * 64; *(GAS f32x4*)o = (f32x4){o1[0], o1[1], o1[2], o1[3]}; *(GAS f32x4*)(o + 4) = (f32x4){o1[4], o1[5], o1[6], o1[7]};
              *(GAS f32x4*)(o + 8) = (f32x4){o2[0], o2[1], o2[2], o2[3]}; *(GAS f32x4*)(o + 12) = (f32x4){o2[4], o2[5], o2[6], o2[7]}; } }
    }
    __syncthreads();
    const int i = tid >> 2, g = tid & 3, h = kvh * 4 + g, qpos = blk * 128 + i; const size_t row = (size_t)b * SEQL + qpos;
    float q[64];
#pragma unroll
    for (int c = 0; c < 8; ++c) { float f[8]; unpack8(*(const GAS v4u*)(PROJ + row * NINP + C_Q + h * 64 + c * 8), f);
#pragma unroll
        for (int e = 0; e < 8; ++e) q[c * 8 + e] = f[e]; }
    { float cs[8], sn[8]; rope_cs(qpos, cs, sn);
#pragma unroll
      for (int e = 0; e < 8; ++e) { const float x1 = q[e], x2 = q[8 + e]; q[e] = x1 * cs[e] - x2 * sn[e]; q[8 + e] = x2 * cs[e] + x1 * sn[e]; } }
#pragma unroll
    for (int e = 0; e < 64; ++e) q[e] *= 0.125f;
    float acc[64], mx = -INFINITY, sum = 0.f;
#pragma unroll
    for (int e = 0; e < 64; ++e) acc[e] = 0.f;
    for (int jj = 0; jj <= 128; ++jj) { const int r = i + jj;
        if (w0 + r < 0) continue;
        float s = 0.f;
#pragma unroll
        for (int c = 0; c < 8; ++c) { float f[8]; unpack8(*(const LAS v4u*)(Ks + r * KP + c * 8), f);
#pragma unroll
            for (int e = 0; e < 8; ++e) s += q[c * 8 + e] * f[e]; }
        const float mn = fmaxf(mx, s), sc = expf(mx - mn), p = expf(s - mn); mx = mn; sum = sum * sc + p;
#pragma unroll
        for (int c = 0; c < 8; ++c) { float f[8]; unpack8(*(const LAS v4u*)(Vs + r * KP + c * 8), f);
#pragma unroll
            for (int e = 0; e < 8; ++e) acc[c * 8 + e] = acc[c * 8 + e] * sc + p * f[e]; }
    }
    const float sink = ARGIN(11)[l * 8 + h], mf = fmaxf(mx, sink), sc = expf(mx - mf), den = sum * sc + expf(sink - mf), inv = sc / den;
#pragma unroll
    for (int c = 0; c < 8; ++c) { float o[8];
#pragma unroll
        for (int e = 0; e < 8; ++e) o[e] = acc[c * 8 + e] * inv;
        *(GAS v4u*)(MIXED + row * DM + h * 64 + c * 8) = pack8(o); }
}

__device__ __forceinline__ void attn_sample_item(Frame& F, const Args& a, int l, int b) {
    const bf16* PROJ = (const bf16*)(ARGWS() + WS_PROJ); bf16* MIXED = (bf16*)(ARGWS() + WS_MIXED);
    const int tid = F.tid, h = F.wave, lane = F.lane, kvh = h >> 2; const size_t prow = (size_t)(MP + b) * NINP;
    LAS float* qs = (LAS float*)(F.lds);
    LAS float* ps = (LAS float*)(F.lds + 2048);
    LAS float* knew = (LAS float*)(F.lds + 2048 + 4224);
    LAS float* vnew = knew + 128;
    const float* ck = ARGIN(2) + (size_t)(l * MS + b) * 128 * 128; const float* cv = ARGIN(3) + (size_t)(l * MS + b) * 128 * 128;
    __syncthreads();
    { float cs[8], sn[8]; rope_cs(8192, cs, sn);
      const int d = lane; float x = bf2f(PROJ[prow + C_Q + h * 64 + d]);
      if (d < 16) { const float xp = bf2f(PROJ[prow + C_Q + h * 64 + (d ^ 8)]); const float c = (d & 7) == 0 ? cs[0] : (d & 7) == 1 ? cs[1] : (d & 7) == 2 ? cs[2] : (d & 7) == 3 ? cs[3] : (d & 7) == 4 ? cs[4] : (d & 7) == 5 ? cs[5] : (d & 7) == 6 ? cs[6] : cs[7];
          const float s = (d & 7) == 0 ? sn[0] : (d & 7) == 1 ? sn[1] : (d & 7) == 2 ? sn[2] : (d & 7) == 3 ? sn[3] : (d & 7) == 4 ? sn[4] : (d & 7) == 5 ? sn[5] : (d & 7) == 6 ? sn[6] : sn[7];
          x = d < 8 ? x * c - xp * s : x * c + xp * s; }
      qs[h * 64 + d] = x * 0.125f;
      if (h < 2) { float y = bf2f(PROJ[prow + C_K + h * 64 + d]);
          if (d < 16) { const float yp = bf2f(PROJ[prow + C_K + h * 64 + (d ^ 8)]); const float c = (d & 7) == 0 ? cs[0] : (d & 7) == 1 ? cs[1] : (d & 7) == 2 ? cs[2] : (d & 7) == 3 ? cs[3] : (d & 7) == 4 ? cs[4] : (d & 7) == 5 ? cs[5] : (d & 7) == 6 ? cs[6] : cs[7];
              const float s = (d & 7) == 0 ? sn[0] : (d & 7) == 1 ? sn[1] : (d & 7) == 2 ? sn[2] : (d & 7) == 3 ? sn[3] : (d & 7) == 4 ? sn[4] : (d & 7) == 5 ? sn[5] : (d & 7) == 6 ? sn[6] : sn[7];
              y = d < 8 ? y * c - yp * s : y * c + yp * s; }
          knew[h * 64 + d] = y; vnew[h * 64 + d] = bf2f(PROJ[prow + C_V + h * 64 + d]); } }
    __syncthreads();
    float sa = 0.f, sb = 0.f, sn_ = 0.f;
    { const float* ka = ck + (size_t)(lane * 2 + kvh) * 64; const float* kb = ck + (size_t)((lane + 64) * 2 + kvh) * 64;
#pragma unroll
      for (int c = 0; c < 16; ++c) { const f32x4 x = *(const GAS f32x4*)(ka + 4 * c), y = *(const GAS f32x4*)(kb + 4 * c); const f32x4 qv = *(const LAS f32x4*)(qs + h * 64 + 4 * c), kn = *(const LAS f32x4*)(knew + kvh * 64 + 4 * c);
          sa += (qv.x * x.x + qv.y * x.y) + (qv.z * x.z + qv.w * x.w); sb += (qv.x * y.x + qv.y * y.y) + (qv.z * y.z + qv.w * y.w); sn_ += (qv.x * kn.x + qv.y * kn.y) + (qv.z * kn.z + qv.w * kn.w); } }
    const float sink = ARGIN(11)[l * 8 + h];
    const float mx = fmaxf(fmaxf(wave_max(fmaxf(sa, sb)), sn_), sink);
    const float ea = expf(sa - mx), eb = expf(sb - mx), en = expf(sn_ - mx);
    const float inv = 1.0f / (wave_sum(ea + eb) + en + expf(sink - mx));
    ps[h * 132 + lane] = ea * inv; ps[h * 132 + 64 + lane] = eb * inv; if (lane == 0) ps[h * 132 + 128] = en * inv;
    __syncthreads();
    { float o = ps[h * 132 + 128] * vnew[kvh * 64 + lane];
      for (int j = 0; j < 128; ++j) o += ps[h * 132 + j] * cv[(size_t)(j * 2 + kvh) * 64 + lane];
      ((unsigned short*)MIXED)[(size_t)(MP + b) * DM + h * 64 + lane] = (unsigned short)f2bf(o); }
    float* sk = ARGOUT() + O_SK + (size_t)(l * MS + b) * 128 * 128; float* sv = ARGOUT() + O_SV + (size_t)(l * MS + b) * 128 * 128;
    for (int idx = tid * 4; idx < 128 * 128; idx += NTHR * 4) { const int j = idx >> 7, rem = idx & 127;
        f32x4 kk, vv;
        if (j < 127) { kk = *(const GAS f32x4*)(ck + idx + 128); vv = *(const GAS f32x4*)(cv + idx + 128); }
        else { kk = *(const LAS f32x4*)(knew + rem); vv = *(const LAS f32x4*)(vnew + rem); }
        *(GAS f32x4*)(sk + idx) = kk; *(GAS f32x4*)(sv + idx) = vv; }
}

__device__ __forceinline__ bool queue_next(Frame& F, gu32* head, int& it) {
    volatile LAS unsigned* slot = F.MISC + 16;
    __syncthreads();
    if (F.tid == 0) slot[0] = __hip_atomic_fetch_add(head, 1u, RLX_AGENT);
    __syncthreads();
    it = (int)slot[0];
    { int t_ = threadIdx.x; asm volatile("" : "+v"(t_)); F.tid = t_; F.lane = t_ & 63; F.wave = __builtin_amdgcn_readfirstlane(t_ >> 6); }
    return true;
}
__device__ __forceinline__ void mixer_phase(Frame& F, const Args& a, int l, int qslot) {
    constexpr int N_ATP = NB * 16 * 2, N_SSDA = NB * 2 * 16 * 2, N_MLA = NB * 4 * 16, N_SSDS = MS * 2, N_MLS = MS * 4, N_ATS = MS;
#ifndef MK_R_ATP
#define MK_R_ATP 1
#define MK_R_SSDA 1
#define MK_R_MLA 1
#define MK_R_SSDS 1
#define MK_R_MLS 1
#define MK_R_ATS 1
#endif
    constexpr int E0 = N_ATP * MK_R_ATP, E1 = E0 + N_SSDA * MK_R_SSDA, E2 = E1 + N_MLA * MK_R_MLA, E3 = E2 + N_SSDS * MK_R_SSDS, E4 = E3 + N_MLS * MK_R_MLS, E5 = E4 + N_ATS * MK_R_ATS;
    gu32* head = F.ctl + CW_QUEUE + 64 * qslot;
    for (;;) {
        int it; queue_next(F, head, it);
        if (it >= E5) break;
        if (it < E0) { const int r = it % N_ATP; attn_mfma_item(F, l, r >> 5, (r >> 1) & 15, r & 1); }
        else if (it < E1) { const int r = (it - E0) % N_SSDA; ssd_a_item(F, l, r >> 6, (r >> 5) & 1, (r >> 1) & 15, r & 1); }
        else if (it < E2) { const int r = (it - E1) % N_MLA; mlstm_a_item(F, l, r >> 6, (r >> 4) & 3, r & 15); }
        else if (it < E3) { const int r = (it - E2) % N_SSDS; ssd_sample_item(F, l, r >> 1, r & 1); }
        else if (it < E4) { const int r = (it - E3) % N_MLS; mlstm_sample_item(F, l, r >> 2, r & 3); }
        else attn_sample_item(F, a, l, (it - E4) % N_ATS);
    }
}
__device__ __forceinline__ void mixer_c_phase(Frame& F, int l, int qslot) {
    constexpr int N_SSDC0 = NB * 2 * 16, N_MLC0 = NB * 4 * 16;
#ifndef MK_R_SSDC
#define MK_R_SSDC 1
#define MK_R_MLC 1
#endif
    constexpr int N_SSDC = N_SSDC0 * MK_R_SSDC, N_MLC = N_MLC0 * MK_R_MLC;
    gu32* head = F.ctl + CW_QUEUE + 64 * qslot;
    for (;;) {
        int it; queue_next(F, head, it);
        if (it >= N_SSDC + N_MLC) break;
        if (it < N_SSDC) { const int r = it % N_SSDC0; ssd_c_item(F, l, r >> 5, (r >> 4) & 1, r & 15); }
        else { const int r = (it - N_SSDC) % N_MLC0; mlstm_c_item(F, l, r >> 6, (r >> 4) & 3, r & 15); }
    }
}

__device__ __forceinline__ void finalize_phase(Frame& F, const Args& a, int l) {
    const bf16* PROJ = (const bf16*)(ARGWS() + WS_PROJ); bf16* MIXED = (bf16*)(ARGWS() + WS_MIXED); const float* YG = (const float*)(ARGWS() + WS_YG); const float* HR = (const float*)(ARGWS() + WS_HR);
    const float* wssm = ARGIN(17) + (size_t)l * 1024; const float* wml = ARGIN(20) + (size_t)l * 512;
    const int gw = F.vcu * NWAVES + F.wave, NGW = F.G * NWAVES, lane = F.lane;
    for (int row = MP + gw; row < MT; row += NGW) {
#pragma unroll
        for (int g = 0; g < 2; ++g) { const float* src = YG + (size_t)row * 1024 + g * 512 + lane * 8; const f32x4 u0 = *(const GAS f32x4*)src, u1 = *(const GAS f32x4*)(src + 4);
            float ss = (u0.x * u0.x + u0.y * u0.y) + (u0.z * u0.z + u0.w * u0.w) + (u1.x * u1.x + u1.y * u1.y) + (u1.z * u1.z + u1.w * u1.w);
            ss = wave_sum(ss); const float rs = 1.0f / sqrtf(ss * (1.0f / 512.0f) + 1e-6f);
            const float* wp = wssm + g * 512 + lane * 8; const f32x4 w0 = *(const GAS f32x4*)wp, w1 = *(const GAS f32x4*)(wp + 4);
            float o[8] = {u0.x * rs * w0.x, u0.y * rs * w0.y, u0.z * rs * w0.z, u0.w * rs * w0.w, u1.x * rs * w1.x, u1.y * rs * w1.y, u1.z * rs * w1.z, u1.w * rs * w1.w};
            *(GAS v4u*)(MIXED + (size_t)row * DM + 512 + g * 512 + lane * 8) = pack8(o); }
#pragma unroll
        for (int hh = 0; hh < 4; ++hh) { const float* src = HR + (size_t)row * 512 + hh * 128 + lane * 2; const float v0 = src[0], v1 = src[1];
            const float ss = wave_sum(v0 * v0 + v1 * v1), rs = 1.0f / sqrtf(ss * (1.0f / 128.0f) + 1e-6f);
            const unsigned mo = *(const GAS unsigned*)(PROJ + (size_t)row * NINP + C_MO + hh * 128 + lane * 2);
            const float o0 = v0 * rs * wml[hh * 128 + lane * 2] * sigmoidf_(bflo(mo)), o1 = v1 * rs * wml[hh * 128 + lane * 2 + 1] * sigmoidf_(bfhi(mo));
            *(GAS unsigned*)(MIXED + (size_t)row * DM + 1536 + hh * 128 + lane * 2) = pk2(o0, o1); }
    }
}

__device__ __forceinline__ void final_norm_phase(Frame& F, const Args& a) {
    const float* SSQ = (const float*)(ARGWS() + WS_SSQA); const float* wf = ARGIN(25);
    const int gw = F.vcu * NWAVES + F.wave, NGW = F.G * NWAVES, lane = F.lane;
    for (int row = gw; row < MT; row += NGW) {
        const f32x4 p0 = *(const GAS f32x4*)(SSQ + (size_t)row * 8), p1 = *(const GAS f32x4*)(SSQ + (size_t)row * 8 + 4);
        const float ss = ((p0.x + p0.y) + (p0.z + p0.w)) + ((p1.x + p1.y) + (p1.z + p1.w)), rs = 1.0f / sqrtf(ss * (1.0f / 2048.0f) + 1e-6f);
        GAS f32x4* y = (GAS f32x4*)(ARGOUT() + O_Y + (size_t)row * DM) + lane; const GAS f32x4* wv = (const GAS f32x4*)wf + lane;
#pragma unroll
        for (int j = 0; j < 8; ++j) { const f32x4 v = y[64 * j], g = wv[64 * j]; y[64 * j] = (f32x4){v.x * rs * g.x, v.y * rs * g.y, v.z * rs * g.z, v.w * rs * g.w}; }
    }
}

#ifndef MK_N_LAUNCHES
#define MK_N_LAUNCHES 1
#endif
constexpr int N_PHASES = 16;
#ifndef MK_REP_P0
#define MK_REP_P0 1
#endif
#ifndef MK_REP_M2
#define MK_REP_M2 1
#endif
#ifndef MK_REP_G1
#define MK_REP_G1 1
#endif
#ifndef MK_REP_G3
#define MK_REP_G3 1
#endif
#ifndef MK_REP_M1
#define MK_REP_M1 1
#endif
#ifndef MK_REP_M3
#define MK_REP_M3 1
#endif
__global__ void __launch_bounds__(NTHR, 2) mk_fwd(Args args) {
    extern __shared__ __attribute__((aligned(16))) unsigned char lds[];
    Frame F;
    F.lds = (LAS unsigned char*)lds;
    F.MISC = (volatile LAS unsigned*)(F.lds + MISC_OFF);
    F.tid = threadIdx.x; F.lane = F.tid & 63; F.wave = __builtin_amdgcn_readfirstlane(F.tid >> 6);
    F.G = gridDim.x; { const int bx = blockIdx.x; F.vcu = (F.G % 8 == 0) ? (bx % 8) * (F.G / 8) + bx / 8 : bx; }
    unsigned char* ws = ARGWS();
    F.ctl = (gu32*)(ws + WS_CTL);
    for (int u = F.tid; u < (LDS_BYTES - LDSCTL_OFF) / 4; u += NTHR) ((LAS unsigned*)(F.lds + LDSCTL_OFF))[u] = 0u;
    __syncthreads();
    const int lo = args.ph_lo, hi = args.ph_hi;
    const bool use_bar = (hi - lo) > 1;
    XcdBarrier bar; bar.bar = (unsigned*)(F.ctl + CW_BAR); bar.x = 0; bar.st = nullptr;
    if (use_bar) bar = xcd_barrier_post((unsigned*)(F.ctl + CW_BAR), F.MISC + 8);
#define IN(k) (lo <= (k) && (k) < hi)
#define PHASE_BEGIN() do { int t_ = threadIdx.x, v_ = vcu0, g_ = G0; asm volatile("" : "+v"(t_)); asm volatile("" : "+s"(v_), "+s"(g_)); F.tid = t_; F.lane = t_ & 63; F.wave = __builtin_amdgcn_readfirstlane(t_ >> 6); F.vcu = v_; F.G = g_; } while (0)
#define SEAM(k) do { if (IN(k) && IN((k) + 1)) xcd_barrier(bar); } while (0)

#define WSP(T, off) ((T*)(ARGWS() + (off)))
#define DECL_WS() bf16* XB = WSP(bf16, WS_XB); float* XRES = WSP(float, WS_XRES); bf16* HBUF = WSP(bf16, WS_HBUF); bf16* PROJ = WSP(bf16, WS_PROJ); bf16* MIXED = WSP(bf16, WS_MIXED); \
    float* SSQA = WSP(float, WS_SSQA); float* SSQB = WSP(float, WS_SSQB); \
    const bf16* Wi = WSP(const bf16, WS_WIN + l * WIN_BYTES); const bf16* Wo = WSP(const bf16, WS_WOUT + l * WOUT_BYTES); const bf16* Wu = WSP(const bf16, WS_WUP + l * WUP_BYTES); const bf16* Wd = WSP(const bf16, WS_WDN + l * WDN_BYTES); \
    (void)XB; (void)XRES; (void)HBUF; (void)PROJ; (void)MIXED; (void)SSQA; (void)SSQB; (void)Wi; (void)Wo; (void)Wu; (void)Wd

    const int vcu0 = F.vcu, G0 = F.G;
    for (int rep_ = 0; rep_ < MK_REP_P0; ++rep_) if (IN(0)) { if (rep_) xcd_barrier(bar); PHASE_BEGIN(); p0_prologue(F, args); }
    SEAM(0);
    for (int l = 0; l < DEPTH; ++l) {
        const int pb = 1 + 7 * l;
        for (int rep_ = 0; rep_ < MK_REP_G1; ++rep_) if (IN(pb)) { if (rep_) xcd_barrier(bar); PHASE_BEGIN(); DECL_WS();
            pg8::Gemm g{XB, Wi, MPAD, NINP, DM}; pg8::StaticOrder S; S.init(MPAD, NINP, F.G, (int)blockIdx.x);
            pg8::EpiScaleBf16<0> E{PROJ, NINP, SSQA};
            pg8::gemm_phase<pg8::EpiScaleBf16<0>, pg8::StaticOrder, true, true>(F.lds + RING_OFF, g, S, E, F.tid);
            if (blockIdx.x == 0) for (int i = F.tid; i < MS * 8; i += NTHR) SSQB[(size_t)MP * 8 + i] = 0.f;
        }
        SEAM(pb);
        for (int rep_ = 0; rep_ < MK_REP_M1; ++rep_) if (IN(pb + 1)) { if (rep_) xcd_barrier(bar); PHASE_BEGIN(); mixer_phase(F, args, l, l + 4 * rep_); }

        SEAM(pb + 1);
        for (int rep_ = 0; rep_ < MK_REP_M2; ++rep_) if (IN(pb + 2)) { if (rep_) xcd_barrier(bar); PHASE_BEGIN(); mlstm_scan_phase(F, l); ssd_scan_phase(F, l); }
        SEAM(pb + 2);
        for (int rep_ = 0; rep_ < MK_REP_M3; ++rep_) if (IN(pb + 3)) { if (rep_) xcd_barrier(bar); PHASE_BEGIN(); mixer_c_phase(F, l, 2 + l + 4 * rep_); }
        SEAM(pb + 3);
        if (IN(pb + 4)) { PHASE_BEGIN(); DECL_WS();
            const float* basep = l == 0 ? ARGIN(0) : XRES; const float* bases = l == 0 ? ARGIN(1) : XRES + (size_t)MP * DM;
            pg8::Gemm g{MIXED, Wo, MP, DM, DM}; pg8::StaticOrder S; S.init(MP, DM, F.G, (int)blockIdx.x);
            pg8::EpiResid E{basep, XRES, XB, SSQB, DM};
            pg8::gemm_phase<pg8::EpiResid, pg8::StaticOrder, false, true>(F.lds + RING_OFF, g, S, E, F.tid);
            float* outs = XRES + (size_t)MP * DM; bf16* xbs = XB + (size_t)MP * DM; float* sq = SSQB + (size_t)MP * 8;
            thin_gemm(F, MIXED + (size_t)MP * DM, DM, Wo, DM, DM, [&](int row, int col, f32x4 acc) {
                const f32x4 bs = *(const GAS f32x4*)(bases + (size_t)row * DM + col); const f32x4 o = bs + acc;
                *(GAS f32x4*)(outs + (size_t)row * DM + col) = o;
                *(GAS unsigned long long*)(xbs + (size_t)row * DM + col) = (unsigned long long)pk2(o.x, o.y) | ((unsigned long long)pk2(o.z, o.w) << 32);
                float s = (o.x * o.x + o.y * o.y) + (o.z * o.z + o.w * o.w); s += __shfl_xor(s, 16); s += __shfl_xor(s, 32);
                if ((F.lane >> 4) == 0) atomicAdd(sq + (size_t)row * 8 + ((col >> 4) & 7), s); });
            if (blockIdx.x == 0) for (int i = F.tid; i < MS * 8; i += NTHR) SSQA[(size_t)MP * 8 + i] = 0.f;
        }
        SEAM(pb + 4);
        for (int rep_ = 0; rep_ < MK_REP_G3; ++rep_) if (IN(pb + 5)) { if (rep_) xcd_barrier(bar); PHASE_BEGIN(); DECL_WS();
            pg8::Gemm g{XB, Wu, MP, FF, DM}; pg8::StaticOrder S; S.init(MP, FF, F.G, (int)blockIdx.x);
            pg8::EpiScaleBf16<1> E{HBUF, FF, SSQB};
            pg8::gemm_phase<pg8::EpiScaleBf16<1>, pg8::StaticOrder, true, true>(F.lds + RING_OFF, g, S, E, F.tid);
            bf16* hs = HBUF + (size_t)MP * FF; const float* sq = SSQB + (size_t)MP * 8;
            thin_gemm(F, XB + (size_t)MP * DM, DM, Wu, FF, DM, [&](int row, int col, f32x4 acc) {
                const f32x4 p0 = *(const GAS f32x4*)(sq + (size_t)row * 8), p1 = *(const GAS f32x4*)(sq + (size_t)row * 8 + 4);
                const float ss = ((p0.x + p0.y) + (p0.z + p0.w)) + ((p1.x + p1.y) + (p1.z + p1.w)), rs = 1.0f / sqrtf(ss * (1.0f / 2048.0f) + 1e-6f);
                f32x4 v = acc * rs; v.x = fmaxf(v.x, 0.f); v.y = fmaxf(v.y, 0.f); v.z = fmaxf(v.z, 0.f); v.w = fmaxf(v.w, 0.f);
                *(GAS unsigned long long*)(hs + (size_t)row * FF + col) = (unsigned long long)pk2(v.x * v.x, v.y * v.y) | ((unsigned long long)pk2(v.z * v.z, v.w * v.w) << 32); });
        }
        SEAM(pb + 5);
        if (IN(pb + 6)) { PHASE_BEGIN(); DECL_WS();
            const bool lastl = (l == DEPTH - 1);
            float* outp = lastl ? ARGOUT() + O_Y : XRES; float* outs = lastl ? ARGOUT() + O_Y + (size_t)MP * DM : XRES + (size_t)MP * DM;
            pg8::Gemm g{HBUF, Wd, MP, DM, FF}; pg8::StaticOrder S; S.init(MP, DM, F.G, (int)blockIdx.x);
            pg8::EpiResid E{XRES, outp, lastl ? (bf16*)nullptr : XB, SSQA, DM};
            pg8::gemm_phase<pg8::EpiResid, pg8::StaticOrder, false, true>(F.lds + RING_OFF, g, S, E, F.tid);
            const float* bases = XRES + (size_t)MP * DM; bf16* xbs = XB + (size_t)MP * DM; float* sq = SSQA + (size_t)MP * 8;
            thin_gemm(F, HBUF + (size_t)MP * FF, FF, Wd, DM, FF, [&](int row, int col, f32x4 acc) {
                const f32x4 bs = *(const GAS f32x4*)(bases + (size_t)row * DM + col); const f32x4 o = bs + acc;
                *(GAS f32x4*)(outs + (size_t)row * DM + col) = o;
                if (!lastl) *(GAS unsigned long long*)(xbs + (size_t)row * DM + col) = (unsigned long long)pk2(o.x, o.y) | ((unsigned long long)pk2(o.z, o.w) << 32);
                float s = (o.x * o.x + o.y * o.y) + (o.z * o.z + o.w * o.w); s += __shfl_xor(s, 16); s += __shfl_xor(s, 32);
                if ((F.lane >> 4) == 0) atomicAdd(sq + (size_t)row * 8 + ((col >> 4) & 7), s); });
        }
        SEAM(pb + 6);
    }
    if (IN(15)) { PHASE_BEGIN(); final_norm_phase(F, args); }
#undef IN
#undef SEAM
}

extern "C" void kernel_launch(void* const* d_in, const int* in_sizes, int n_in, void* d_out, int out_size, void* d_ws, size_t ws_size, hipStream_t stream) {
    static int grid = 0;
    if (grid == 0) {
        if (n_in != 26 || (size_t)out_size != O_END || ws_size < WS_END2) { fprintf(stderr, "kernel_launch: expected 26 inputs, %zu outputs, >= %zu bytes of workspace; got %d, %d, %zu\n", (size_t)O_END, (size_t)WS_END2, n_in, out_size, ws_size); grid = -1; return; }
        int dev = 0, cus = 0, per_cu = 0;
        if (hipGetDevice(&dev) != hipSuccess || hipDeviceGetAttribute(&cus, hipDeviceAttributeMultiprocessorCount, dev) != hipSuccess) { grid = -1; return; }
        if (hipFuncSetAttribute((const void*)mk_fwd, hipFuncAttributeMaxDynamicSharedMemorySize, LDS_BYTES) != hipSuccess) { fprintf(stderr, "kernel_launch: hipFuncSetAttribute failed\n"); grid = -1; return; }
        if (hipOccupancyMaxActiveBlocksPerMultiprocessor(&per_cu, (const void*)mk_fwd, NTHR, LDS_BYTES) != hipSuccess || per_cu < 1) { fprintf(stderr, "kernel_launch: occupancy query says %d blocks per CU\n", per_cu); per_cu = 1; }
        (void)hipGetLastError();
        grid = cus;
        if (grid != 256) fprintf(stderr, "kernel_launch: %d CUs; the G2/G4 phases assume 256 workgroups\n", grid);
    }
    if (grid < 0) return;
    (void)hipMemsetAsync((char*)d_ws + WS_CTL, 0, CTL_ZERO_BYTES, stream);
    Args a{};
    for (int i = 0; i < 26; ++i) a.in[i] = (const float*)d_in[i];
    a.out = (float*)d_out; a.ws = (unsigned char*)d_ws;
#if MK_N_LAUNCHES == 1
    a.ph_lo = 0; a.ph_hi = N_PHASES;
    hipLaunchKernelGGL(mk_fwd, dim3(grid), dim3(NTHR), LDS_BYTES, stream, a);
#else
    for (int p = 0; p < N_PHASES; ++p) { a.ph_lo = p; a.ph_hi = p + 1; hipLaunchKernelGGL(mk_fwd, dim3(grid), dim3(NTHR), LDS_BYTES, stream, a); }
#endif
}
```

```cpp
#include <hip/hip_runtime.h>
#include <cstdio>
#include <cstdint>
namespace pg8 {
#define PG8_LAS __attribute__((address_space(3)))
typedef unsigned short bf16_t;
typedef short bf16x8 __attribute__((ext_vector_type(8)));
typedef float f32x4 __attribute__((ext_vector_type(4)));
typedef unsigned u32x4 __attribute__((ext_vector_type(4)));
constexpr int BM = 256, BK = 64, HALF = 128, HTB = HALF * BK * 2  , STAGE_BYTES = 8 * HTB, NXCD = 8, WGM = 8;

__host__ __device__ __forceinline__ int lds_byte(int r, int c) { const int st = (r >> 4) * 2 + (c >> 5), rr = r & 15, cc = c & 31, ob = rr * 64 + cc * 2; return st * 1024 + (ob ^ (((ob >> 9) & 1) << 5)); }
__host__ __device__ __forceinline__ void stage_rc(int b, int& R, int& C) { const int st = b / 1024, sb = b % 1024, swz = sb ^ (((sb >> 9) & 1) << 5); R = (st >> 1) * 16 + swz / 64; C = (st & 1) * 32 + (swz % 64) / 2; }
__host__ __device__ __forceinline__ int perm32(int rho) { const int n = rho >> 4, i = rho & 15; return 8 * (i >> 2) + 4 * n + (i & 3); }

struct Unit { int pm, pn, idx; };
struct Gemm { const bf16_t* A; const bf16_t* Bt; int M, N, K; };

struct StaticOrder {
    int nM, nN, nwg, G, c;
    __host__ __device__ void init(int M, int N, int G_, int c_) { nM = M / BM; nN = N / BM; nwg = nM * nN; G = G_; c = c_; }
    __host__ __device__ __forceinline__ bool next(int i, Unit& u) const {
        const long L = (long)i * G + c; if (L >= nwg) return false;
        int wgid = (int)L; { const int q = nwg / NXCD, r = nwg % NXCD, xcd = wgid % NXCD, off = wgid / NXCD; wgid = (xcd < r ? xcd * (q + 1) : r * (q + 1) + (xcd - r) * q) + off; }
        const int nig = WGM * nN, gid = wgid / nig, fm = gid * WGM, gsz = (nM - fm) < WGM ? (nM - fm) : WGM;
        u.pm = fm + ((wgid % nig) % gsz); u.pn = (wgid % nig) / gsz; u.idx = i; return true;
    }
    __device__ __forceinline__ void a_ready(const Unit&) const {}
    __device__ __forceinline__ void done(const Unit&) const {}
};


__device__ __forceinline__ unsigned cvt_pk_bf16(float lo, float hi) { unsigned r; asm volatile("v_cvt_pk_bf16_f32 %0, %1, %2" : "=v"(r) : "v"(lo), "v"(hi)); return r; }

template <int ACT> struct EpiScaleBf16 {
    static constexpr bool PERM = true, AFTER_DRAIN = false;
    bf16_t* O; int ldc; const PG8_LAS float* rst;
    __device__ __forceinline__ void operator()(const f32x4 (&acc)[2][2][4][2], const Unit& u, int wr, int wc, int fr, int fq) const {
        const int row0 = u.pm * BM + wr * 64 + fr, col0 = u.pn * BM + wc * 32 + 8 * fq;
        const PG8_LAS float* rt = rst + u.idx * 256 + wr * 64 + fr;
#pragma unroll
        for (int ai = 0; ai < 2; ++ai)
#pragma unroll
            for (int m = 0; m < 4; ++m) { const int row = row0 + ai * HALF + m * 16;
                const float rs = rt[ai * HALF + m * 16];
                bf16_t* rowp = O + (size_t)row * ldc + col0;
#pragma unroll
                for (int bj = 0; bj < 2; ++bj) { f32x4 v0 = acc[ai][bj][m][0] * rs, v1 = acc[ai][bj][m][1] * rs;
                    if (ACT == 1) {
#pragma unroll
                        for (int e = 0; e < 4; ++e) { const float a = fmaxf(v0[e], 0.f), b = fmaxf(v1[e], 0.f); v0[e] = a * a; v1[e] = b * b; } }
                    u32x4 w; w.x = cvt_pk_bf16(v0[0], v0[1]); w.y = cvt_pk_bf16(v0[2], v0[3]); w.z = cvt_pk_bf16(v1[0], v1[1]); w.w = cvt_pk_bf16(v1[2], v1[3]);
                    *(u32x4*)(rowp + bj * HALF) = w; } }
    }
};

struct EpiResid {
    static constexpr bool PERM = false, AFTER_DRAIN = true;
    const float* base; float* out; bf16_t* xb; float* ssq; int ld;
    __device__ __forceinline__ void fused(f32x4 (&acc)[2][2][4][2], const Unit& u, int wr, int wc, int fr, int fq, PG8_LAS unsigned char* lds, int wid, int lane) const {
        typedef unsigned u32x2v __attribute__((ext_vector_type(2)));
        PG8_LAS float* P = (PG8_LAS float*)lds;
        const int col0 = u.pn * BM + wc * 32 + 4 * fq;
#pragma unroll
        for (int ai = 0; ai < 2; ++ai) {
            f32x4 pre[4][2][2];
#pragma unroll
            for (int m = 0; m < 4; ++m) { const size_t off = (size_t)(u.pm * BM + ai * HALF + wr * 64 + m * 16 + fr) * ld + col0;
#pragma unroll
                for (int bj = 0; bj < 2; ++bj)
#pragma unroll
                    for (int n = 0; n < 2; ++n) pre[m][bj][n] = *(const f32x4*)(base + off + bj * HALF + n * 16); }
            asm volatile("" ::: "memory");
#pragma unroll
            for (int m = 0; m < 4; ++m) { const int r = ai * HALF + wr * 64 + m * 16 + fr; const size_t off = (size_t)(u.pm * BM + r) * ld + col0; float s = 0.f;
#pragma unroll
                for (int bj = 0; bj < 2; ++bj)
#pragma unroll
                    for (int n = 0; n < 2; ++n) { const f32x4 o = pre[m][bj][n] + acc[ai][bj][m][n];
                        *(f32x4*)(out + off + bj * HALF + n * 16) = o;
                        if (xb) { u32x2v w; w.x = cvt_pk_bf16(o[0], o[1]); w.y = cvt_pk_bf16(o[2], o[3]); *(u32x2v*)(xb + off + bj * HALF + n * 16) = w; }
                        s += (o[0] * o[0] + o[1] * o[1]) + (o[2] * o[2] + o[3] * o[3]); }
                s += __shfl_xor(s, 16); s += __shfl_xor(s, 32);
                if (fq == 0) P[r * 4 + wc] = s; }
            asm volatile("" ::: "memory"); }
        asm volatile("s_waitcnt lgkmcnt(0)" ::: "memory"); __builtin_amdgcn_s_barrier(); asm volatile("" ::: "memory");
        const int t = wid * 64 + lane;
        if (t < 256) { const float s = (P[t * 4 + 0] + P[t * 4 + 1]) + (P[t * 4 + 2] + P[t * 4 + 3]); ssq[(size_t)(u.pm * BM + t) * 8 + u.pn] = s; }
        asm volatile("s_waitcnt lgkmcnt(0)" ::: "memory"); __builtin_amdgcn_s_barrier(); asm volatile("" ::: "memory");
    }
};
template <class Epi, class Sched, bool ALIGN_EPI = false, bool SP2 = false>
__device__ __forceinline__ void gemm_phase(PG8_LAS unsigned char* lds, const Gemm g, const Sched& S, const Epi& E, const int tid) {
    const int  wid = __builtin_amdgcn_readfirstlane(tid >> 6), lane = tid & 63, wr = wid >> 2, wc = wid & 3, fr = lane & 15, fq = lane >> 4;
    const int K = g.K, nt = K / BK;
    unsigned voffA[2], voffB[2];
#pragma unroll
    for (int i = 0; i < 2; ++i) { int R, C; stage_rc(tid * 16 + i * 8192, R, C); const int Rb = Epi::PERM ? ((R & ~31) + perm32(R & 31)) : R;
        voffA[i] = (unsigned)(R * K + C) * 2u; voffB[i] = (unsigned)(Rb * K + C) * 2u; }
    const size_t kstep = (size_t)(BK * 2);
    const size_t hstep = (size_t)HALF * K * 2;
    const size_t tstep = 2 * hstep;
    const unsigned ldsw = (unsigned)wid * 1024u;
    const int aoff = lds_byte(wr * 64 + fr, fq * 8), boff = lds_byte(wc * 32 + fr, fq * 8);
#define PG8_SA(b, h) (((b) * 2 + (h)) * HTB)
#define PG8_SB(b, h) ((4 + (b) * 2 + (h)) * HTB)
#define PG8_STAGE(bufoff, gbase, voff) do { _Pragma("unroll") for (int _i = 0; _i < 2; ++_i) \
        __builtin_amdgcn_global_load_lds((const unsigned*)((const char*)(gbase) + (voff)[_i]), (PG8_LAS unsigned*)(lds + (bufoff) + ldsw + _i * 8192), 16, 0, 0); } while (0)
#define PG8_LDA(dst, b, h) do { _Pragma("unroll") for (int m = 0; m < 4; ++m) _Pragma("unroll") for (int k = 0; k < 2; ++k) dst[m][k] = *(const PG8_LAS bf16x8*)(lds + PG8_SA(b, h) + aoff + m * 2048 + k * 1024); } while (0)
#define PG8_LDB(dst, b, h) do { _Pragma("unroll") for (int n = 0; n < 2; ++n) _Pragma("unroll") for (int k = 0; k < 2; ++k) dst[n][k] = *(const PG8_LAS bf16x8*)(lds + PG8_SB(b, h) + boff + n * 2048 + k * 1024); } while (0)
#define PG8_MMA(ai, bj, At, Bt) do { __builtin_amdgcn_s_setprio(1); _Pragma("unroll") for (int m = 0; m < 4; ++m) _Pragma("unroll") for (int n = 0; n < 2; ++n) _Pragma("unroll") for (int k = 0; k < 2; ++k) \
        acc[ai][bj][m][n] = __builtin_amdgcn_mfma_f32_16x16x32_bf16(Bt[n][k], At[m][k], acc[ai][bj][m][n], 0, 0, 0); __builtin_amdgcn_s_setprio(0); } while (0)
#define PG8_WAIT_V(n) asm volatile("s_waitcnt vmcnt(" #n ")" ::: "memory")
#define PG8_WAIT_L(n) asm volatile("s_waitcnt lgkmcnt(" #n ")" ::: "memory")
#define PG8_BAR __builtin_amdgcn_s_barrier()
#define PG8_SCHED __builtin_amdgcn_sched_barrier(0)
    Unit cur, nxt; int ui = 0;
    if (!S.next(0, cur)) return;
    f32x4 acc[2][2][4][2];
#pragma unroll
    for (int a = 0; a < 2; ++a)
#pragma unroll
        for (int b = 0; b < 2; ++b)
#pragma unroll
            for (int m = 0; m < 4; ++m)
#pragma unroll
                for (int n = 0; n < 2; ++n) acc[a][b][m][n] = (f32x4){0.f, 0.f, 0.f, 0.f};
    bf16x8 At[4][2], B0[2][2], B1[2][2];
    const char* cA = (const char*)g.A + (size_t)cur.pm * tstep; const char* cB = (const char*)g.Bt + (size_t)cur.pn * tstep;
    S.a_ready(cur);
    if constexpr (SP2) {
        PG8_STAGE(PG8_SB(0, 0), cB, voffB); PG8_STAGE(PG8_SB(0, 1), cB + hstep, voffB); PG8_STAGE(PG8_SA(0, 0), cA, voffA); PG8_STAGE(PG8_SA(0, 1), cA + hstep, voffA);
        if (wr == 1) PG8_BAR;
        PG8_WAIT_V(2); PG8_BAR;
        PG8_STAGE(PG8_SB(1, 0), cB + kstep, voffB); PG8_STAGE(PG8_SA(1, 0), cA + kstep, voffA); PG8_STAGE(PG8_SB(1, 1), cB + hstep + kstep, voffB);
        PG8_WAIT_V(6); PG8_BAR;
    } else {
        PG8_STAGE(PG8_SB(0, 0), cB, voffB); PG8_STAGE(PG8_SA(0, 0), cA, voffA); PG8_STAGE(PG8_SB(0, 1), cB + hstep, voffB); PG8_STAGE(PG8_SA(0, 1), cA + hstep, voffA);
        if (wr == 1) PG8_BAR;
        PG8_WAIT_V(4); PG8_BAR;
        PG8_STAGE(PG8_SB(1, 0), cB + kstep, voffB); PG8_STAGE(PG8_SA(1, 0), cA + kstep, voffA); PG8_STAGE(PG8_SB(1, 1), cB + hstep + kstep, voffB);
        PG8_WAIT_V(6); PG8_BAR;
    }
    for (;;) {
        const bool has_next = S.next(ui + 1, nxt);
        const char* nA = has_next ? (const char*)g.A + (size_t)nxt.pm * tstep : cA; const char* nB = has_next ? (const char*)g.Bt + (size_t)nxt.pn * tstep : cB;
        for (int t = 0; t < nt; t += 2) {
            const bool last = (t == nt - 2);
            const char* a1 = cA + (size_t)(t + 1) * kstep;
            const char* a2 = last ? nA : cA + (size_t)(t + 2) * kstep; const char* b2 = last ? nB : cB + (size_t)(t + 2) * kstep;
            const char* a3 = a2 + kstep; const char* b3 = b2 + kstep;
            if (last && has_next) S.a_ready(nxt);
            if constexpr (SP2) {
            PG8_LDB(B0, 0, 0); PG8_LDB(B1, 0, 1); PG8_SCHED; PG8_LDA(At, 0, 0); PG8_STAGE(PG8_SA(1, 1), a1 + hstep, voffA);
            PG8_WAIT_V(8); PG8_WAIT_L(0); PG8_BAR; PG8_MMA(0, 0, At, B0); PG8_MMA(0, 1, At, B1); PG8_BAR; PG8_SCHED;
            PG8_LDA(At, 0, 1); PG8_STAGE(PG8_SB(0, 0), b2, voffB); PG8_STAGE(PG8_SB(0, 1), b2 + hstep, voffB); PG8_STAGE(PG8_SA(0, 0), a2, voffA);
            PG8_WAIT_V(8); PG8_WAIT_L(0); PG8_BAR; PG8_MMA(1, 0, At, B0); PG8_MMA(1, 1, At, B1); PG8_BAR; PG8_SCHED;
            PG8_LDB(B0, 1, 0); PG8_LDB(B1, 1, 1); PG8_SCHED; PG8_LDA(At, 1, 0); PG8_STAGE(PG8_SA(0, 1), a2 + hstep, voffA);
            PG8_WAIT_V(8); PG8_WAIT_L(0); PG8_BAR; PG8_MMA(0, 0, At, B0); PG8_MMA(0, 1, At, B1); PG8_BAR; PG8_SCHED;
            PG8_LDA(At, 1, 1); PG8_STAGE(PG8_SB(1, 0), b3, voffB); PG8_STAGE(PG8_SB(1, 1), b3 + hstep, voffB); PG8_STAGE(PG8_SA(1, 0), a3, voffA);
            PG8_WAIT_V(8); PG8_WAIT_L(0); PG8_BAR; PG8_MMA(1, 0, At, B0); PG8_MMA(1, 1, At, B1); PG8_BAR; PG8_SCHED;
            } else {
            PG8_LDB(B0, 0, 0); PG8_SCHED; PG8_LDA(At, 0, 0); PG8_STAGE(PG8_SA(1, 1), a1 + hstep, voffA);
            PG8_WAIT_L(8); PG8_BAR; PG8_WAIT_L(0); PG8_MMA(0, 0, At, B0); PG8_BAR; PG8_SCHED;
            PG8_LDB(B1, 0, 1); PG8_STAGE(PG8_SB(0, 0), b2, voffB);
            PG8_BAR; PG8_WAIT_L(0); PG8_MMA(0, 1, At, B1); PG8_BAR;
            PG8_LDA(At, 0, 1); PG8_STAGE(PG8_SA(0, 0), a2, voffA);
            PG8_BAR; PG8_WAIT_L(0); PG8_MMA(1, 0, At, B0); PG8_BAR; PG8_SCHED;
            PG8_STAGE(PG8_SB(0, 1), b2 + hstep, voffB);
            PG8_WAIT_V(6); PG8_BAR; PG8_MMA(1, 1, At, B1); PG8_BAR;
            PG8_LDB(B0, 1, 0); PG8_SCHED; PG8_LDA(At, 1, 0); PG8_STAGE(PG8_SA(0, 1), a2 + hstep, voffA);
            PG8_WAIT_L(8); PG8_BAR; PG8_WAIT_L(0); PG8_MMA(0, 0, At, B0); PG8_BAR; PG8_SCHED;
            PG8_LDB(B1, 1, 1); PG8_STAGE(PG8_SB(1, 0), b3, voffB);
            PG8_BAR; PG8_WAIT_L(0); PG8_MMA(0, 1, At, B1); PG8_BAR;
            PG8_LDA(At, 1, 1); PG8_STAGE(PG8_SA(1, 0), a3, voffA);
            PG8_BAR; PG8_WAIT_L(0); PG8_MMA(1, 0, At, B0); PG8_BAR; PG8_SCHED;
            PG8_STAGE(PG8_SB(1, 1), b3 + hstep, voffB);
            PG8_WAIT_V(6); PG8_BAR; PG8_MMA(1, 1, At, B1); PG8_BAR;
            }
        }
        if constexpr (ALIGN_EPI) { if (wr == 0) PG8_BAR; }
        if constexpr (!Epi::AFTER_DRAIN) { E(acc, cur, wr, wc, fr, fq); S.done(cur); }
        if (!has_next) break;
#pragma unroll
        for (int a = 0; a < 2; ++a)
#pragma unroll
            for (int b = 0; b < 2; ++b)
#pragma unroll
                for (int m = 0; m < 4; ++m)
#pragma unroll
                    for (int n = 0; n < 2; ++n) acc[a][b][m][n] = (f32x4){0.f, 0.f, 0.f, 0.f};
        cur = nxt; cA = nA; cB = nB; ++ui;
        if constexpr (ALIGN_EPI) { if (wr == 1) PG8_BAR; }
    }
    PG8_WAIT_V(0);
    if constexpr (!ALIGN_EPI) { if (wr == 0) PG8_BAR; }
    PG8_BAR;
    if constexpr (Epi::AFTER_DRAIN) { E.fused(acc, cur, wr, wc, fr, fq, lds, wid, lane); S.done(cur); }
#undef PG8_SA
#undef PG8_SB
#undef PG8_STAGE
#undef PG8_LDA
#undef PG8_LDB
#undef PG8_MMA
#undef PG8_WAIT_V
#undef PG8_WAIT_L
#undef PG8_BAR
#undef PG8_SCHED
}
}

#ifndef PG8_SP2
#define PG8_SP2 true
#endif
#ifndef PG8_ALIGN
#define PG8_ALIGN true
#endif
#define GAS __attribute__((address_space(1)))
#define LAS __attribute__((address_space(3)))
typedef unsigned short bf16;
typedef unsigned v4u __attribute__((ext_vector_type(4)));
typedef float f32x4 __attribute__((ext_vector_type(4)));
typedef short bf16x8 __attribute__((ext_vector_type(8)));
typedef GAS unsigned gu32;
typedef GAS unsigned long long gu64;
#define RLX_AGENT __ATOMIC_RELAXED, __HIP_MEMORY_SCOPE_AGENT
#define LDS_WAIT() asm volatile("s_waitcnt lgkmcnt(0)" ::: "memory")
#define VM_WAIT() asm volatile("s_waitcnt vmcnt(0)" ::: "memory")
__device__ __forceinline__ unsigned long long rt() { return __builtin_amdgcn_s_memrealtime(); }
__device__ __forceinline__ unsigned f2bf(float f) { unsigned u = __builtin_bit_cast(unsigned, f); return (u + 0x7fffu + ((u >> 16) & 1u)) >> 16; }
__device__ __forceinline__ unsigned pk2(float lo, float hi) { unsigned r; asm("v_cvt_pk_bf16_f32 %0, %1, %2" : "=v"(r) : "v"(lo), "v"(hi)); return r; }

#define XB_TMO      128
#define XB_XCNT(j)  (256  + 64 * (j))
#define XB_XSUB(j)  (1280 + 64 * (j))
#define XB_XGEN(j)  (2304 + 64 * (j))
#define XB_TOP      3328
#define XB_TOPGEN   3392
#define XCD_BAR_WORDS 3456
#define XB_SPIN_CAP (1u << 18)

__device__ __forceinline__ unsigned xb_ld(unsigned* p)              { return __hip_atomic_load(p, __ATOMIC_RELAXED, __HIP_MEMORY_SCOPE_AGENT); }
__device__ __forceinline__ unsigned xb_add(unsigned* p, unsigned v) { return __hip_atomic_fetch_add(p, v, __ATOMIC_RELAXED, __HIP_MEMORY_SCOPE_AGENT); }
__device__ __forceinline__ unsigned xb_xcc_id() { return (unsigned)__builtin_amdgcn_s_getreg((3 << 11) | 20) & 0xFu; }
#define XB_SPIN(cond, bar) do { unsigned _sp = 0; while (cond) { __builtin_amdgcn_s_sleep(1); \
    if ((++_sp & 255u) == 0u) { if (xb_ld(&(bar)[XB_TMO])) break; if (_sp > XB_SPIN_CAP) { atomicAdd(&(bar)[XB_TMO], 1u); break; } } } } while (0)

struct XcdBarrier {
    unsigned* bar; unsigned x;
    volatile LAS unsigned* st;
};

__device__ __forceinline__ XcdBarrier xcd_barrier_post(unsigned* bar, volatile LAS unsigned* st) {
    XcdBarrier b; b.bar = bar; b.x = xb_xcc_id(); b.st = st;
    if (threadIdx.x == 0) (void)xb_add(&bar[XB_XCNT(b.x)], 1u);
    return b;
}
__device__ __forceinline__ void xcd_barrier_complete(unsigned* bar, unsigned x, unsigned& nloc, unsigned& nx) {
    const unsigned G = gridDim.x * gridDim.y * gridDim.z;
    unsigned sum, cnt, mine, sp = 0u;
    for (;;) {
        sum = 0u; cnt = 0u; mine = 0u;
#pragma unroll
        for (unsigned j = 0; j < 16; ++j) { const unsigned c = xb_ld(&bar[XB_XCNT(j)]); sum += c; cnt += (c > 0u) ? 1u : 0u; mine = (j == x) ? c : mine; }
        if (sum == G) break;
        __builtin_amdgcn_s_sleep(1);
        if ((++sp & 255u) == 0u) { if (xb_ld(&bar[XB_TMO])) break; if (sp > XB_SPIN_CAP) { atomicAdd(&bar[XB_TMO], 1u); break; } }
    }
    nloc = mine > 0u ? mine : 1u; nx = cnt > 0u ? cnt : 1u;
}

__device__ __forceinline__ void xcd_barrier(const XcdBarrier& b) {
    asm volatile("s_waitcnt vmcnt(0)" ::: "memory");
    __syncthreads();
    if (threadIdx.x == 0) {
        unsigned* bar = b.bar;
        __builtin_amdgcn_s_waitcnt(0);
        unsigned nloc = b.st[0], nx = b.st[1];
        if (nloc == 0u) { xcd_barrier_complete(bar, b.x, nloc, nx); b.st[0] = nloc; b.st[1] = nx; }
        const unsigned old = xb_add(&bar[XB_XSUB(b.x)], 1u);
        const unsigned gen = old / nloc;
        if (old + 1u == (gen + 1u) * nloc) {
            __builtin_amdgcn_fence(__ATOMIC_RELEASE, "agent");
            asm volatile("s_waitcnt vmcnt(0)" ::: "memory");
            const unsigned og = xb_add(&bar[XB_TOP], 1u);
            const unsigned tg = og / nx;
            if (og + 1u == (tg + 1u) * nx) xb_add(&bar[XB_TOPGEN], 1u);
            else XB_SPIN(xb_ld(&bar[XB_TOPGEN]) == tg, bar);
            __builtin_amdgcn_fence(__ATOMIC_ACQUIRE, "agent");
            xb_add(&bar[XB_XGEN(b.x)], 1u);
            asm volatile("s_waitcnt vmcnt(0)" ::: "memory");
        } else {
            XB_SPIN(xb_ld(&bar[XB_XGEN(b.x)]) == gen, bar);
            __builtin_amdgcn_fence(__ATOMIC_ACQUIRE, "agent");
            asm volatile("s_waitcnt vmcnt(0)" ::: "memory");
        }
    }
    __syncthreads();
}

constexpr int NWAVES = 8, NTHR = 512;
constexpr int DM = 2048, SEQL = 2048, NB = 4, MP = NB * SEQL  , MS = 128  , MT = MP + MS, MPAD = 8448;
constexpr int NIN = 5400, NINP = 5632, FF = 8192, DEPTH = 2;
constexpr int C_Q = 0, C_K = 512, C_V = 640, C_Z = 768, C_XBC = 1792, C_MQ = 3328, C_MK = 3840, C_MV = 4352, C_MO = 4864, C_DT = 5376, C_MI = 5392, C_MF = 5396;
constexpr int XCW = 1536;
constexpr size_t O_Y = 0, O_PK = 17039360, O_PV = 17170432, O_PCONV = 17301504, O_PSSM = 17338368, O_PC = 18386944, O_PN = 18911232, O_PM = 18915328,
                 O_SK = 18915360, O_SV = 23109664, O_SCONV = 27303968, O_SSSM = 28483616, O_SC = 62038048, O_SN = 78815264, O_SM = 78946336, O_END = 78947360;

constexpr size_t MiB = 1u << 20;
constexpr size_t WS_CTL = 0, CTL_ZERO_BYTES = 1 * MiB;
constexpr size_t WS_SSQA = 1 * MiB, WS_SSQB = 1 * MiB + 512 * 1024;
constexpr size_t WS_WIN = 2 * MiB, WIN_BYTES = 22 * MiB;
constexpr size_t WS_WOUT = 46 * MiB, WOUT_BYTES = 8 * MiB;
constexpr size_t WS_WUP = 62 * MiB, WUP_BYTES = 32 * MiB;
constexpr size_t WS_WDN = 126 * MiB, WDN_BYTES = 32 * MiB;
constexpr size_t WS_XB = 190 * MiB;
constexpr size_t WS_XRES = 223 * MiB;
constexpr size_t WS_HBUF = 289 * MiB;
constexpr size_t WS_PROJ = 289 * MiB;
constexpr size_t WS_MIXED = 380 * MiB;
constexpr size_t WS_XC = 421 * MiB;
constexpr size_t WS_YG = 446 * MiB;
constexpr size_t WS_HR = 479 * MiB;
constexpr size_t WS_END = 496 * MiB;
static_assert(WS_PROJ + (size_t)MPAD * NINP * 2 <= WS_MIXED && WS_MIXED + (size_t)MPAD * DM * 2 <= WS_XC && WS_HBUF + (size_t)MPAD * FF * 2 <= WS_XC, "ws map");
constexpr int CW_BAR = 4096;
constexpr int CW_QUEUE = 16384;

constexpr int RING_OFF = 0, RING_BYTES = 131072;
constexpr int LDSCTL_OFF = RING_BYTES, MISC_OFF = LDSCTL_OFF + 320;
constexpr int LDS_BYTES = 147456;
constexpr int RST_OFF = LDSCTL_OFF + 1024;

struct Args { const float* in[26]; float* out; unsigned char* ws; int ph_lo, ph_hi; };
typedef const __attribute__((address_space(4))) unsigned long long* karg_t;
__device__ __forceinline__ unsigned long long karg_u64(int idx) { int j = idx; asm volatile("" : "+s"(j)); return ((karg_t)__builtin_amdgcn_kernarg_segment_ptr())[j]; }
#define ARGIN(i) ((const float*)karg_u64(i))
#define ARGOUT() ((float*)karg_u64(26))
#define ARGWS() ((unsigned char*)karg_u64(27))

struct Frame {
    LAS unsigned char* lds;
    volatile LAS unsigned* MISC;
    gu32* ctl;
    int tid, lane, wave, vcu, G;
};

__device__ __forceinline__ float bf2f(unsigned short u) { return __builtin_bit_cast(float, (unsigned)u << 16); }
__device__ __forceinline__ float bflo(unsigned u) { return __builtin_bit_cast(float, u << 16); }
__device__ __forceinline__ float bfhi(unsigned u) { return __builtin_bit_cast(float, u & 0xffff0000u); }
__device__ __forceinline__ void unpack8(const v4u w, float (&f)[8]) { f[0] = bflo(w.x); f[1] = bfhi(w.x); f[2] = bflo(w.y); f[3] = bfhi(w.y); f[4] = bflo(w.z); f[5] = bfhi(w.z); f[6] = bflo(w.w); f[7] = bfhi(w.w); }
__device__ __forceinline__ v4u pack8(const float (&f)[8]) { v4u w; w.x = pk2(f[0], f[1]); w.y = pk2(f[2], f[3]); w.z = pk2(f[4], f[5]); w.w = pk2(f[6], f[7]); return w; }
__device__ __forceinline__ float wave_sum(float v) {
#pragma unroll
    for (int o = 1; o < 64; o <<= 1) v += __shfl_xor(v, o);
    return v;
}
__device__ __forceinline__ float wave_max(float v) {
#pragma unroll
    for (int o = 1; o < 64; o <<= 1) v = fmaxf(v, __shfl_xor(v, o));
    return v;
}
__device__ __forceinline__ float fexp(float x) { return __builtin_amdgcn_exp2f(x * 1.4426950408889634f); }
__device__ __forceinline__ float frcp(float x) { return __builtin_amdgcn_rcpf(x); }
__device__ __forceinline__ float sigmoidf_(float x) { return frcp(1.0f + fexp(-x)); }
__device__ __forceinline__ float siluf_(float x) { return x * frcp(1.0f + fexp(-x)); }
__device__ __forceinline__ float softplusf_(float x) { return fmaxf(x, 0.f) + log1pf(expf(-fabsf(x))); }
__device__ __forceinline__ float logsigmoidf_(float x) { return fminf(x, 0.f) - log1pf(expf(-fabsf(x))); }
#define ROPE_INV(i) ((i) == 0 ? 1.0f : (i) == 1 ? 0.1939227432012558f : (i) == 2 ? 0.03760603070259094f : (i) == 3 ? 0.007292664609849453f : (i) == 4 ? 0.0014142135623842478f : (i) == 5 ? 0.00027424818836152554f : (i) == 6 ? 5.318296098266728e-05f : 1.0313386155758053e-05f)
__device__ __forceinline__ void rope_cs(int pos, float (&c)[8], float (&s)[8]) {
#pragma unroll
    for (int i = 0; i < 8; ++i) { const float ang = (float)pos * ROPE_INV(i); double rev = (double)ang * 0.15915494309189535; rev -= __builtin_rint(rev); const float fr = (float)rev;
        c[i] = __builtin_amdgcn_cosf(fr); s[i] = __builtin_amdgcn_sinf(fr); }
}

__device__ __forceinline__ int colmap(int mode, int n) {
    if (mode == 0) return n;
    if (n < 3328) return n; if (n < 5376) return n + 16; if (n < 5392) return n - 2048; if (n < 5400) return n; return -1;
}
struct P0Item { const float* W; const float* gain; bf16* WT; int mode, K, Norig, Nrows, r; };
__device__ __forceinline__ void p0_item_load(const P0Item& I, int lane, f32x4 (&v)[8]) {
    const int nblk = I.Nrows / 32, kb = I.r / nblk, nb = I.r % nblk, k0 = 64 * kb, n0 = 32 * nb;
    const int kr = lane >> 3, nc = lane & 7, oc = colmap(I.mode, n0 + 4 * nc);
#pragma unroll
    for (int i = 0; i < 8; ++i) { v[i] = (f32x4){0.f, 0.f, 0.f, 0.f}; if (oc >= 0) v[i] = *(const GAS f32x4*)(I.W + (size_t)(k0 + kr + 8 * i) * I.Norig + oc); }
}
__device__ __forceinline__ void p0_item_finish(const P0Item& I, int lane, const f32x4 (&v)[8], LAS float* scr) {
    const int nblk = I.Nrows / 32, kb = I.r / nblk, nb = I.r % nblk, k0 = 64 * kb, n0 = 32 * nb;
    const int kr = lane >> 3, nc = lane & 7;
#pragma unroll
    for (int i = 0; i < 8; ++i) { const float gn = I.gain ? I.gain[k0 + kr + 8 * i] : 1.0f; LAS float* d = scr + (kr + 8 * i) * 33 + 4 * nc; d[0] = v[i].x * gn; d[1] = v[i].y * gn; d[2] = v[i].z * gn; d[3] = v[i].w * gn; }
    LDS_WAIT(); asm volatile("" ::: "memory");
    const int c = lane & 7;
#pragma unroll
    for (int j = 0; j < 4; ++j) { const int n = (lane >> 3) + 8 * j; const LAS float* s = scr + (8 * c) * 33 + n;
        v4u o; o.x = pk2(s[0 * 33], s[1 * 33]); o.y = pk2(s[2 * 33], s[3 * 33]); o.z = pk2(s[4 * 33], s[5 * 33]); o.w = pk2(s[6 * 33], s[7 * 33]);
        *(GAS v4u*)(I.WT + (size_t)(n0 + n) * I.K + k0 + 8 * c) = o; }
    LDS_WAIT(); asm volatile("" ::: "memory");
}
__device__ __forceinline__ void x_row_to_bf16(int lane, const float* xrow, bf16* orow, float* ssqrow) {
    const GAS f32x4* xr = (const GAS f32x4*)xrow + lane;
    f32x4 v[8]; float s = 0.f;
#pragma unroll
    for (int j = 0; j < 8; ++j) { v[j] = xr[64 * j]; s += (v[j].x * v[j].x + v[j].y * v[j].y) + (v[j].z * v[j].z + v[j].w * v[j].w); }
    s = wave_sum(s);
    GAS unsigned long long* o8 = (GAS unsigned long long*)orow + lane;
#pragma unroll
    for (int j = 0; j < 8; ++j) o8[64 * j] = (unsigned long long)pk2(v[j].x, v[j].y) | ((unsigned long long)pk2(v[j].z, v[j].w) << 32);
    if (lane < 8) ssqrow[lane] = lane == 0 ? s : 0.f;
}
__device__ __forceinline__ void p0_prologue(Frame& F, const Args& a) {
    LAS float* scr = (LAS float*)(F.lds + RING_OFF + F.wave * 16384);
    const int gw = F.vcu * NWAVES + F.wave, NGW = F.G * NWAVES;
    constexpr int I_IN = (DM / 64) * (NINP / 32), I_OUT = (DM / 64) * (DM / 32), I_UP = (DM / 64) * (FF / 32), I_DN = (FF / 64) * (DM / 32);
    constexpr int PER_L = I_IN + I_OUT + I_UP + I_DN;
    unsigned char* ws = ARGWS();
    auto mk = [&](int it) { P0Item I; const int l = it / PER_L; int r = it % PER_L; I.mode = 0; I.K = DM; I.Norig = DM; I.Nrows = DM; I.gain = nullptr;
        if (r < I_IN) { I.mode = 1; I.W = ARGIN(10) + (size_t)l * DM * NIN; I.Norig = NIN; I.Nrows = NINP; I.gain = ARGIN(9) + l * DM; I.WT = (bf16*)(ws + WS_WIN + l * WIN_BYTES); }
        else if ((r -= I_IN) < I_OUT) { I.W = ARGIN(21) + (size_t)l * DM * DM; I.WT = (bf16*)(ws + WS_WOUT + l * WOUT_BYTES); }
        else if ((r -= I_OUT) < I_UP) { I.W = ARGIN(23) + (size_t)l * DM * FF; I.Norig = FF; I.Nrows = FF; I.gain = ARGIN(22) + l * DM; I.WT = (bf16*)(ws + WS_WUP + l * WUP_BYTES); }
        else { r -= I_UP; I.W = ARGIN(24) + (size_t)l * FF * DM; I.K = FF; I.WT = (bf16*)(ws + WS_WDN + l * WDN_BYTES); }
        I.r = r; return I; };
    {
        int it = gw; f32x4 va[8], vb[8];
        if (it < DEPTH * PER_L) { P0Item cur = mk(it); p0_item_load(cur, F.lane, va);
            for (;;) { const int nx = it + NGW; const bool more = nx < DEPTH * PER_L; P0Item nxt = cur;
                if (more) { nxt = mk(nx); p0_item_load(nxt, F.lane, vb); }
                p0_item_finish(cur, F.lane, va, scr);
                if (!more) break;
#pragma unroll
                for (int i = 0; i < 8; ++i) va[i] = vb[i];
                cur = nxt; it = nx; } }
    }
    bf16* XB = (bf16*)(ws + WS_XB); float* SSQA = (float*)(ws + WS_SSQA);
    for (int m = gw; m < MPAD; m += NGW) {
        if (m < MT) x_row_to_bf16(F.lane, m < MP ? ARGIN(0) + (size_t)m * DM : ARGIN(1) + (size_t)(m - MP) * DM, XB + (size_t)m * DM, SSQA + (size_t)m * 8);
        else { GAS v4u* o = (GAS v4u*)(XB + (size_t)m * DM) + F.lane;
#pragma unroll
            for (int j = 0; j < 4; ++j) o[64 * j] = (v4u){0u, 0u, 0u, 0u};
            if (F.lane < 8) SSQA[(size_t)m * 8 + F.lane] = 1.0f; }
    }
}

template <int RM, int CN, int U, class EP> __device__ __forceinline__ void thin_gemm(Frame& F, const bf16* A, int lda, const bf16* Bt, int N, int K, const EP& epi) {
    const int fr = F.lane & 15, fq = F.lane >> 4, ks = K / 8;
    constexpr int NT = RM * CN, RH = 8 / RM;
    LAS f32x4* red = (LAS f32x4*)F.lds;
    for (int item = F.vcu; item < (N / (16 * CN)) * RH; item += F.G) {
        const int n0 = (item / RH) * 16 * CN, r0 = (item % RH) * 16 * RM;
        const GAS bf16x8* bp = (const GAS bf16x8*)(Bt + (size_t)(n0 + fr) * K + F.wave * ks + 8 * fq);
        const GAS bf16x8* ap = (const GAS bf16x8*)(A + (size_t)(r0 + fr) * lda + F.wave * ks + 8 * fq);
        const size_t astep = (size_t)16 * lda / 8, bstep = (size_t)16 * K / 8;
        f32x4 acc[RM][CN];
#pragma unroll
        for (int m = 0; m < RM; ++m)
#pragma unroll
            for (int c = 0; c < CN; ++c) acc[m][c] = (f32x4){0.f, 0.f, 0.f, 0.f};
        for (int k = 0; k < ks / 8; k += 4 * U) {
            bf16x8 b[U][CN], a[U][RM];
#pragma unroll
            for (int u = 0; u < U; ++u) {
#pragma unroll
                for (int c = 0; c < CN; ++c) b[u][c] = bp[c * bstep + k + 4 * u];
#pragma unroll
                for (int m = 0; m < RM; ++m) a[u][m] = ap[m * astep + k + 4 * u]; }
#pragma unroll
            for (int u = 0; u < U; ++u)
#pragma unroll
                for (int m = 0; m < RM; ++m)
#pragma unroll
                    for (int c = 0; c < CN; ++c) acc[m][c] = __builtin_amdgcn_mfma_f32_16x16x32_bf16(b[u][c], a[u][m], acc[m][c], 0, 0, 0);
        }
        __syncthreads();
#pragma unroll
        for (int m = 0; m < RM; ++m)
#pragma unroll
            for (int c = 0; c < CN; ++c) red[(F.wave * NT + m * CN + c) * 64 + F.lane] = acc[m][c];
        __syncthreads();
#pragma unroll
        for (int j = 0; j < (NT + 7) / 8; ++j) { const int tile = F.wave + 8 * j;
            if (tile < NT) { f32x4 s = red[(0 * NT + tile) * 64 + F.lane];
#pragma unroll
                for (int w2 = 1; w2 < 8; ++w2) s = s + red[(w2 * NT + tile) * 64 + F.lane];
                epi(r0 + 16 * (tile / CN) + fr, n0 + 16 * (tile % CN) + 4 * fq, s); } }
    }
}

#define MFMA16(yf, xf, acc) __builtin_amdgcn_mfma_f32_16x16x32_bf16(yf, xf, acc, 0, 0, 0)
constexpr int TP = 136, TPB = TP * 2;
__device__ __forceinline__ bf16x8 lds_frag(const LAS unsigned char* base, int row, int k0, int lane) { return *(const LAS bf16x8*)(base + (row + (lane & 15)) * TPB + (k0 + 8 * (lane >> 4)) * 2); }
typedef short s16x4 __attribute__((ext_vector_type(4)));
__device__ __forceinline__ bf16x8 lds_frag_tr(const LAS unsigned char* base, int pitchB, int k0, int c0, int lane) {
    const int g = lane >> 4, q = (lane >> 2) & 3, p = lane & 3;
    const LAS unsigned char* a = base + (k0 + 8 * g + q) * pitchB + (c0 + 4 * p) * 2;
    const s16x4 lo = __builtin_amdgcn_ds_read_tr16_b64_v4i16((LAS s16x4*)a), hi = __builtin_amdgcn_ds_read_tr16_b64_v4i16((LAS s16x4*)(a + 4 * pitchB));
    return (bf16x8){lo.x, lo.y, lo.z, lo.w, hi.x, hi.y, hi.z, hi.w};
}
__device__ __forceinline__ float wave_incl_scan_add(float v, int lane) {
#pragma unroll
    for (int o = 1; o < 64; o <<= 1) { const float u = __shfl_up(v, o); if (lane >= o) v += u; }
    return v;
}
__device__ __forceinline__ float wave_incl_scan_max(float v, int lane) {
#pragma unroll
    for (int o = 1; o < 64; o <<= 1) { const float u = __shfl_up(v, o); if (lane >= o) v = fmaxf(v, u); }
    return v;
}
constexpr size_t WS_DCT = 190 * MiB;
constexpr size_t WS_CPT = 206 * MiB;
constexpr size_t WS_DN = 214 * MiB, WS_NP = WS_DN + 131072, WS_SC = WS_NP + 131072, WS_MPV = WS_SC + 4096;
static_assert(WS_MPV + 4096 <= WS_XRES, "mlstm workspace inside the XB region");

__device__ __forceinline__ void mlstm_gates(Frame& F, const bf16* PROJ, int row0, int l, int h, LAS float* tab, float& bcum, float& a) {
    const int tid = F.tid, lane = F.lane;
    float v = 0.f, ig = 0.f;
    if (tid < 128) { ig = bf2f(PROJ[(size_t)(row0 + tid) * NINP + C_MI + h]) + ARGIN(18)[l * 4 + h];
        v = logsigmoidf_(bf2f(PROJ[(size_t)(row0 + tid) * NINP + C_MF + h]) + ARGIN(19)[l * 4 + h]);
        v = wave_incl_scan_add(v, lane);
        if (tid == 63) tab[0] = v; }
    __syncthreads();
    if (tid >= 64 && tid < 128) v += tab[0];
    bcum = v; a = ig - v;
}

__device__ __forceinline__ void mlstm_a_item(Frame& F, int l, int b, int h, int c) {
    const bf16* PROJ = (const bf16*)(ARGWS() + WS_PROJ);
    const int tid = F.tid, lane = F.lane, w = F.wave, row0 = b * SEQL + c * 128, item = (b * 4 + h) * 16 + c;
    LAS unsigned char* KT = F.lds; LAS unsigned char* VT = F.lds + 128 * TPB;
    LAS float* tab = (LAS float*)(F.lds + 2 * 128 * TPB); LAS float* wk = tab + 16;
    __syncthreads();
    float bcum, a; mlstm_gates(F, PROJ, row0, l, h, tab, bcum, a);
    if (tid < 128) { const float mx = wave_max(a); if (lane == 0) tab[1 + w] = mx; if (tid == 127) tab[3] = bcum; }
    __syncthreads();
    const float pmax = fmaxf(tab[1], tab[2]);
    if (tid < 128) wk[tid] = fexp(a - pmax) * 0.08838834764831845f;
    __syncthreads();
#pragma unroll
    for (int rep = 0; rep < 4; ++rep) { const int task = tid + rep * NTHR, t = task & 127, ch = task >> 7;
        float f[8]; const float wt = wk[t];
        unpack8(*(const GAS v4u*)(PROJ + (size_t)(row0 + t) * NINP + C_MK + h * 128 + ch * 8), f);
#pragma unroll
        for (int i = 0; i < 8; ++i) *(LAS unsigned short*)(KT + (ch * 8 + i) * TPB + t * 2) = (unsigned short)f2bf(f[i] * wt);
        const v4u vv = *(const GAS v4u*)(PROJ + (size_t)(row0 + t) * NINP + C_MV + h * 128 + ch * 8);
        *(LAS unsigned short*)(VT + (ch * 8 + 0) * TPB + t * 2) = (unsigned short)(vv.x & 0xffffu); *(LAS unsigned short*)(VT + (ch * 8 + 1) * TPB + t * 2) = (unsigned short)(vv.x >> 16);
        *(LAS unsigned short*)(VT + (ch * 8 + 2) * TPB + t * 2) = (unsigned short)(vv.y & 0xffffu); *(LAS unsigned short*)(VT + (ch * 8 + 3) * TPB + t * 2) = (unsigned short)(vv.y >> 16);
        *(LAS unsigned short*)(VT + (ch * 8 + 4) * TPB + t * 2) = (unsigned short)(vv.z & 0xffffu); *(LAS unsigned short*)(VT + (ch * 8 + 5) * TPB + t * 2) = (unsigned short)(vv.z >> 16);
        *(LAS unsigned short*)(VT + (ch * 8 + 6) * TPB + t * 2) = (unsigned short)(vv.w & 0xffffu); *(LAS unsigned short*)(VT + (ch * 8 + 7) * TPB + t * 2) = (unsigned short)(vv.w >> 16); }
    __syncthreads();
    bf16x8 xf[4];
#pragma unroll
    for (int s = 0; s < 4; ++s) xf[s] = lds_frag(VT, 16 * w, 32 * s, lane);
    float* dct = (float*)(ARGWS() + WS_DCT) + (size_t)item * 16384;
#pragma unroll
    for (int t = 0; t < 8; ++t) { f32x4 acc = (f32x4){0.f, 0.f, 0.f, 0.f};
#pragma unroll
        for (int s = 0; s < 4; ++s) acc = MFMA16(lds_frag(KT, 16 * t, 32 * s, lane), xf[s], acc);
        *(GAS f32x4*)(dct + (size_t)(16 * w + (lane & 15)) * 128 + 16 * t + 4 * (lane >> 4)) = acc; }
    if (tid < 128) { float s = 0.f;
#pragma unroll
        for (int j = 0; j < 16; ++j) { float f[8]; unpack8(*(const LAS v4u*)(KT + tid * TPB + j * 16), f); s += ((f[0] + f[1]) + (f[2] + f[3])) + ((f[4] + f[5]) + (f[6] + f[7])); }
        ((float*)(ARGWS() + WS_DN))[(size_t)item * 128 + tid] = s; }
    if (tid == 0) { float* sc = (float*)(ARGWS() + WS_SC) + item * 2; sc[0] = tab[3]; sc[1] = pmax; }
}

__device__ __forceinline__ void mlstm_scan_phase(Frame& F, int l) {
    const int tid = F.tid;
    LAS float* coef = (LAS float*)(F.lds); LAS float* gend = coef + 16;
    for (int it = F.vcu; it < 128; it += F.G) {
        const int bh = it >> 3, b = bh >> 2, h = bh & 3, part = it & 7;
        __syncthreads();
        if (tid == 0) { const float* sc = (const float*)(ARGWS() + WS_SC) + bh * 32; float* mp = (float*)(ARGWS() + WS_MPV) + bh * 16; float m = 0.f;
            for (int c = 0; c < 16; ++c) { const float bl = sc[2 * c], pm = sc[2 * c + 1], M = fmaxf(m, pm); coef[c] = fexp(pm - M); gend[c] = fexp(m - M); if (part == 0) mp[c] = m; m = bl + M; }
            if (part == 0) ARGOUT()[O_PM + (size_t)(l * NB + b) * 4 + h] = m; }
        __syncthreads();
        const int elem = part * 512 + tid, e = elem >> 5, d4 = (elem & 31) * 4;
        const float* dct = (const float*)(ARGWS() + WS_DCT) + (size_t)bh * 16 * 16384 + (size_t)e * 128 + d4;
        bf16* cpt = (bf16*)(ARGWS() + WS_CPT) + (size_t)bh * 16 * 16384 + (size_t)e * 128 + d4;
        f32x4 dc[16];
#pragma unroll
        for (int c = 0; c < 16; ++c) dc[c] = *(const GAS f32x4*)(dct + (size_t)c * 16384);
        f32x4 C = (f32x4){0.f, 0.f, 0.f, 0.f};
#pragma unroll
        for (int c = 0; c < 16; ++c) { *(GAS unsigned long long*)(cpt + (size_t)c * 16384) = (unsigned long long)pk2(C.x, C.y) | ((unsigned long long)pk2(C.z, C.w) << 32);
            C = C * gend[c] + dc[c] * coef[c]; }
        float* pc = ARGOUT() + O_PC + ((size_t)(l * NB + b) * 4 + h) * 16384;
        pc[(size_t)(d4 + 0) * 128 + e] = C.x; pc[(size_t)(d4 + 1) * 128 + e] = C.y; pc[(size_t)(d4 + 2) * 128 + e] = C.z; pc[(size_t)(d4 + 3) * 128 + e] = C.w;
        if (part == 0 && tid < 128) { const float* dn = (const float*)(ARGWS() + WS_DN) + (size_t)bh * 16 * 128 + tid; float* np = (float*)(ARGWS() + WS_NP) + (size_t)bh * 16 * 128 + tid; float n = 0.f;
#pragma unroll
            for (int c = 0; c < 16; ++c) { np[c * 128] = n; n = n * gend[c] + dn[c * 128] * coef[c]; }
            ARGOUT()[O_PN + ((size_t)(l * NB + b) * 4 + h) * 128 + tid] = n; }
    }
}

__device__ __forceinline__ void mlstm_c_item(Frame& F, int l, int b, int h, int c) {
    const bf16* PROJ = (const bf16*)(ARGWS() + WS_PROJ); bf16* MIXED = (bf16*)(ARGWS() + WS_MIXED);
    const int tid = F.tid, lane = F.lane, w = F.wave, row0 = b * SEQL + c * 128, item = (b * 4 + h) * 16 + c, lc = lane & 15, lg = lane >> 4;
    LAS unsigned char* Kn = F.lds; LAS unsigned char* VT = F.lds + 128 * TPB; LAS unsigned char* CP = F.lds + 2 * 128 * TPB;
    LAS float* tab = (LAS float*)(F.lds + 3 * 128 * TPB); LAS float* Ak = tab + 16; LAS float* Mq = Ak + 128; LAS float* Emt = Mq + 128; LAS float* Np = Emt + 128;
    __syncthreads();
    float bcum, a; mlstm_gates(F, PROJ, row0, l, h, tab, bcum, a);
    const float mprev = ((const float*)(ARGWS() + WS_MPV))[item];
    float pm = -INFINITY;
    if (tid < 128) { pm = wave_incl_scan_max(a, lane); if (tid == 63) tab[1] = pm; }
    __syncthreads();
    if (tid < 128) { if (tid >= 64) pm = fmaxf(pm, tab[1]); const float M = fmaxf(mprev, pm); Ak[tid] = a; Mq[tid] = M; Emt[tid] = fexp(-(bcum + M)); Np[tid] = ((const float*)(ARGWS() + WS_NP))[(size_t)item * 128 + tid]; }
#pragma unroll
    for (int rep = 0; rep < 4; ++rep) { const int task = tid + rep * NTHR;
        { const int ch = task & 15, t = task >> 4; *(LAS v4u*)(Kn + t * TPB + ch * 16) = *(const GAS v4u*)(PROJ + (size_t)(row0 + t) * NINP + C_MK + h * 128 + ch * 8);
          *(LAS v4u*)(CP + t * TPB + ch * 16) = *(const GAS v4u*)((const bf16*)(ARGWS() + WS_CPT) + (size_t)item * 16384 + (size_t)t * 128 + ch * 8); }
        { const int t = task & 127, ch = task >> 7; const v4u vv = *(const GAS v4u*)(PROJ + (size_t)(row0 + t) * NINP + C_MV + h * 128 + ch * 8);
          *(LAS unsigned short*)(VT + (ch * 8 + 0) * TPB + t * 2) = (unsigned short)(vv.x & 0xffffu); *(LAS unsigned short*)(VT + (ch * 8 + 1) * TPB + t * 2) = (unsigned short)(vv.x >> 16);
          *(LAS unsigned short*)(VT + (ch * 8 + 2) * TPB + t * 2) = (unsigned short)(vv.y & 0xffffu); *(LAS unsigned short*)(VT + (ch * 8 + 3) * TPB + t * 2) = (unsigned short)(vv.y >> 16);
          *(LAS unsigned short*)(VT + (ch * 8 + 4) * TPB + t * 2) = (unsigned short)(vv.z & 0xffffu); *(LAS unsigned short*)(VT + (ch * 8 + 5) * TPB + t * 2) = (unsigned short)(vv.z >> 16);
          *(LAS unsigned short*)(VT + (ch * 8 + 6) * TPB + t * 2) = (unsigned short)(vv.w & 0xffffu); *(LAS unsigned short*)(VT + (ch * 8 + 7) * TPB + t * 2) = (unsigned short)(vv.w >> 16); } }
    bf16x8 qf[4];
#pragma unroll
    for (int s = 0; s < 4; ++s) qf[s] = *(const GAS bf16x8*)(PROJ + (size_t)(row0 + 16 * w + lc) * NINP + C_MQ + h * 128 + 32 * s + 8 * lg);
    __syncthreads();
    float qn = 0.f;
#pragma unroll
    for (int s = 0; s < 4; ++s) { float f[8]; unpack8(__builtin_bit_cast(v4u, qf[s]), f);
#pragma unroll
        for (int i = 0; i < 8; ++i) qn += f[i] * Np[32 * s + 8 * lg + i]; }
    qn += __shfl_xor(qn, 16); qn += __shfl_xor(qn, 32);
    f32x4 sacc[8];
#pragma unroll
    for (int t = 0; t < 8; ++t) { sacc[t] = (f32x4){0.f, 0.f, 0.f, 0.f};
        if (t <= w) {
#pragma unroll
            for (int s = 0; s < 4; ++s) sacc[t] = MFMA16(lds_frag(Kn, 16 * t, 32 * s, lane), qf[s], sacc[t]); } }
    __syncthreads();
    LAS unsigned char* Pw = Kn + w * 16 * TPB;
    const int q = 16 * w + lc; const float Mrow = Mq[q], gq = fexp(mprev - Mrow);
    float rsum = 0.f;
#pragma unroll
    for (int t = 0; t < 8; ++t) { if (t <= (w | 1)) { float p[4];
#pragma unroll
            for (int i = 0; i < 4; ++i) { const int k = 16 * t + 4 * lg + i; p[i] = (k <= q) ? fexp(Ak[k] - Mrow) * 0.08838834764831845f * sacc[t][i] : 0.f; rsum += p[i]; }
            *(LAS unsigned long long*)(Pw + lc * TPB + (16 * t + 4 * lg) * 2) = (unsigned long long)pk2(p[0], p[1]) | ((unsigned long long)pk2(p[2], p[3]) << 32); } }
    rsum += __shfl_xor(rsum, 16); rsum += __shfl_xor(rsum, 32);
    asm volatile("s_waitcnt lgkmcnt(0)" ::: "memory");
    f32x4 acc[8];
#pragma unroll
    for (int t = 0; t < 8; ++t) { acc[t] = (f32x4){0.f, 0.f, 0.f, 0.f};
#pragma unroll
        for (int s = 0; s < 4; ++s) acc[t] = MFMA16(lds_frag(CP, 16 * t, 32 * s, lane), qf[s], acc[t]);
        acc[t] = acc[t] * gq; }
#pragma unroll
    for (int s = 0; s < 4; ++s) { if (s <= (w >> 1)) { const bf16x8 pf = lds_frag(Pw, 0, 32 * s, lane);
#pragma unroll
            for (int t = 0; t < 8; ++t) acc[t] = MFMA16(lds_frag(VT, 16 * t, 32 * s, lane), pf, acc[t]); } }
    const float den = rsum + gq * qn, dinv = 1.0f / fmaxf(fabsf(den), Emt[q]);
    float ss = 0.f;
#pragma unroll
    for (int t = 0; t < 8; ++t) { acc[t] = acc[t] * dinv; ss += (acc[t][0] * acc[t][0] + acc[t][1] * acc[t][1]) + (acc[t][2] * acc[t][2] + acc[t][3] * acc[t][3]); }
    ss += __shfl_xor(ss, 16); ss += __shfl_xor(ss, 32);
    const float rs = __builtin_amdgcn_rsqf(ss * (1.0f / 128.0f) + 1e-6f);
    const float* wml = ARGIN(20) + (size_t)l * 512 + h * 128;
#pragma unroll
    for (int t = 0; t < 8; ++t) { const int e0 = 16 * t + 4 * lg; const f32x4 g4 = *(const GAS f32x4*)(wml + e0);
        const unsigned long long mo = *(const GAS unsigned long long*)(PROJ + (size_t)(row0 + q) * NINP + C_MO + h * 128 + e0);
        const float o0 = acc[t][0] * rs * g4.x * sigmoidf_(bflo((unsigned)mo)), o1 = acc[t][1] * rs * g4.y * sigmoidf_(bfhi((unsigned)mo)),
                    o2 = acc[t][2] * rs * g4.z * sigmoidf_(bflo((unsigned)(mo >> 32))), o3 = acc[t][3] * rs * g4.w * sigmoidf_(bfhi((unsigned)(mo >> 32)));
        *(GAS unsigned long long*)(MIXED + (size_t)(row0 + q) * DM + 1536 + h * 128 + e0) = (unsigned long long)pk2(o0, o1) | ((unsigned long long)pk2(o2, o3) << 32); }
}

constexpr size_t WS_DS = 496 * MiB;
constexpr size_t WS_SP = 528 * MiB;
constexpr size_t WS_AL = 544 * MiB;
constexpr size_t WS_END2 = 545 * MiB;

__device__ __forceinline__ void conv8(const bf16* PROJ, const float* cw, const float* cb, size_t grow, int pos, int ch0, float (&y)[8]) {
    const f32x4 b0 = *(const GAS f32x4*)(cb + ch0), b1 = *(const GAS f32x4*)(cb + ch0 + 4);
    y[0] = b0.x; y[1] = b0.y; y[2] = b0.z; y[3] = b0.w; y[4] = b1.x; y[5] = b1.y; y[6] = b1.z; y[7] = b1.w;
#pragma unroll
    for (int j = 0; j < 4; ++j) { if (pos - 3 + j >= 0) { float r[8]; unpack8(*(const GAS v4u*)(PROJ + (grow - 3 + j) * NINP + C_XBC + ch0), r);
            const f32x4 w0 = *(const GAS f32x4*)(cw + j * XCW + ch0), w1 = *(const GAS f32x4*)(cw + j * XCW + ch0 + 4);
            y[0] += w0.x * r[0]; y[1] += w0.y * r[1]; y[2] += w0.z * r[2]; y[3] += w0.w * r[3]; y[4] += w1.x * r[4]; y[5] += w1.y * r[5]; y[6] += w1.z * r[6]; y[7] += w1.w * r[7]; } }
#pragma unroll
    for (int i = 0; i < 8; ++i) y[i] = siluf_(y[i]);
}

constexpr int XNP = 528;
__device__ __forceinline__ void ssd_a_item(Frame& F, int l, int b, int g, int c, int half) {
    const bf16* PROJ = (const bf16*)(ARGWS() + WS_PROJ); bf16* XC = (bf16*)(ARGWS() + WS_XC);
    const float* cw = ARGIN(12) + (size_t)l * 4 * XCW; const float* cb = ARGIN(13) + (size_t)l * XCW;
    const int tid = F.tid, lane = F.lane, w = F.wave, row0 = b * SEQL + c * 128, h0 = g * 8 + half * 4;
    LAS unsigned char* Xn = F.lds; LAS unsigned char* Bn = F.lds + 128 * XNP;
    LAS float* tab = (LAS float*)(F.lds + 128 * XNP + 128 * TPB); LAS float* wt = tab + 16;
    __syncthreads();
    { const int r = tid >> 7, t = tid & 127, h = h0 + r;
      const float dt = softplusf_(bf2f(PROJ[(size_t)(row0 + t) * NINP + C_DT + h]) + ARGIN(14)[l * 16 + h]), A = -expf(ARGIN(15)[l * 16 + h]);
      float v = wave_incl_scan_add(dt * A, lane);
      if (lane == 63 && (w & 1) == 0) tab[r] = v;
      __syncthreads();
      if (w & 1) v += tab[r];
      if (t == 127) tab[4 + r] = v;
      __syncthreads();
      const float al = tab[4 + r];
      wt[r * 128 + t] = fexp(al - v) * dt;
      if (t == 127) ((float*)(ARGWS() + WS_AL))[((b * 16 + h) * 16) + c] = al; }
    __syncthreads();
    if (tid < 448) {
        const int cj = tid % 56, tb = (tid / 56) * 16;
        const int ch0 = cj < 32 ? h0 * 64 + cj * 8 : (cj < 48 ? 1024 + g * 128 + (cj - 32) * 8 : 1280 + g * 128 + half * 64 + (cj - 48) * 8);
        float wv[4][8], bias[8];
        { const f32x4 b0 = *(const GAS f32x4*)(cb + ch0), b1 = *(const GAS f32x4*)(cb + ch0 + 4); bias[0] = b0.x; bias[1] = b0.y; bias[2] = b0.z; bias[3] = b0.w; bias[4] = b1.x; bias[5] = b1.y; bias[6] = b1.z; bias[7] = b1.w; }
#pragma unroll
        for (int j = 0; j < 4; ++j) { const f32x4 w0 = *(const GAS f32x4*)(cw + j * XCW + ch0), w1 = *(const GAS f32x4*)(cw + j * XCW + ch0 + 4);
            wv[j][0] = w0.x; wv[j][1] = w0.y; wv[j][2] = w0.z; wv[j][3] = w0.w; wv[j][4] = w1.x; wv[j][5] = w1.y; wv[j][6] = w1.z; wv[j][7] = w1.w; }
        v4u raw[19];
#pragma unroll
        for (int i = 0; i < 19; ++i) { raw[i] = (v4u){0u, 0u, 0u, 0u}; if (c * 128 + tb - 3 + i >= 0) raw[i] = *(const GAS v4u*)(PROJ + (size_t)(row0 + tb - 3 + i) * NINP + C_XBC + ch0); }
#pragma unroll
        for (int s = 0; s < 16; ++s) { const int t = tb + s; float y[8];
#pragma unroll
            for (int i = 0; i < 8; ++i) y[i] = bias[i];
#pragma unroll
            for (int j = 0; j < 4; ++j) { float r[8]; unpack8(raw[s + j], r);
#pragma unroll
                for (int i = 0; i < 8; ++i) y[i] += wv[j][i] * r[i]; }
#pragma unroll
            for (int i = 0; i < 8; ++i) y[i] = siluf_(y[i]);
            *(GAS v4u*)(XC + (size_t)(row0 + t) * XCW + ch0) = pack8(y);
            if (cj < 32) { const float ww = wt[(cj >> 3) * 128 + t];
#pragma unroll
                for (int i = 0; i < 8; ++i) y[i] *= ww;
                *(LAS v4u*)(Xn + t * XNP + cj * 16) = pack8(y); }
            else if (cj < 48) *(LAS v4u*)(Bn + t * TPB + (cj - 32) * 16) = pack8(y); }
    }
    __syncthreads();
    const int r = w >> 1, h = h0 + r;
    float* ds = (float*)(ARGWS() + WS_DS) + (size_t)((b * 16 + h) * 16 + c) * 8192;
#pragma unroll
    for (int ps = 0; ps < 2; ++ps) { const int prow = 2 * (w & 1) + ps;
        bf16x8 xf[4];
#pragma unroll
        for (int s = 0; s < 4; ++s) xf[s] = lds_frag_tr(Xn, XNP, 32 * s, r * 64 + 16 * prow, lane);
#pragma unroll
        for (int t = 0; t < 8; ++t) { f32x4 acc = (f32x4){0.f, 0.f, 0.f, 0.f};
#pragma unroll
            for (int s = 0; s < 4; ++s) acc = MFMA16(lds_frag_tr(Bn, TPB, 32 * s, 16 * t, lane), xf[s], acc);
            *(GAS f32x4*)(ds + (size_t)(16 * prow + (lane & 15)) * 128 + 16 * t + 4 * (lane >> 4)) = acc; } }
}

__device__ __forceinline__ void ssd_scan_phase(Frame& F, int l) {
    for (int idx = F.vcu * NTHR + F.tid; idx < 64 * 2048; idx += F.G * NTHR) {
        const int bh = idx >> 11, e4 = (idx & 2047) * 4;
        const float* al = (const float*)(ARGWS() + WS_AL) + bh * 16;
        const float* ds = (const float*)(ARGWS() + WS_DS) + (size_t)bh * 16 * 8192 + e4;
        bf16* sp = (bf16*)(ARGWS() + WS_SP) + (size_t)bh * 16 * 8192 + e4;
        f32x4 d[16]; float dec[16];
#pragma unroll
        for (int c = 0; c < 16; ++c) { d[c] = *(const GAS f32x4*)(ds + (size_t)c * 8192); dec[c] = al[c]; }
        f32x4 S = (f32x4){0.f, 0.f, 0.f, 0.f};
#pragma unroll
        for (int c = 0; c < 16; ++c) { *(GAS unsigned long long*)(sp + (size_t)c * 8192) = (unsigned long long)pk2(S.x, S.y) | ((unsigned long long)pk2(S.z, S.w) << 32);
            S = S * fexp(dec[c]) + d[c]; }
        *(GAS f32x4*)(ARGOUT() + O_PSSM + ((size_t)l * 64 + bh) * 8192 + e4) = S;
    }
}

__device__ __forceinline__ void ssd_c_item(Frame& F, int l, int b, int g, int c) {
    const bf16* PROJ = (const bf16*)(ARGWS() + WS_PROJ); bf16* MIXED = (bf16*)(ARGWS() + WS_MIXED);
    const int tid = F.tid, lane = F.lane, w = F.wave, row0 = b * SEQL + c * 128, lc = lane & 15, lg = lane >> 4, q = 16 * w + lc;
    LAS unsigned char* Bn = F.lds; LAS unsigned char* XT = F.lds + 128 * TPB; LAS unsigned char* SP = F.lds + 256 * TPB;
    LAS float* tab = (LAS float*)(F.lds + 384 * TPB); LAS float* At = tab + 16; LAS float* Dt = At + 1024;
    __syncthreads();
    { float v[2], dtv[2];
#pragma unroll
      for (int rep = 0; rep < 2; ++rep) { const int r = (tid >> 7) + 4 * rep, t = tid & 127, h = g * 8 + r;
          dtv[rep] = softplusf_(bf2f(PROJ[(size_t)(row0 + t) * NINP + C_DT + h]) + ARGIN(14)[l * 16 + h]);
          v[rep] = wave_incl_scan_add(dtv[rep] * -fexp(ARGIN(15)[l * 16 + h]), lane);
          if (lane == 63 && (w & 1) == 0) tab[r] = v[rep]; }
      __syncthreads();
#pragma unroll
      for (int rep = 0; rep < 2; ++rep) { const int r = (tid >> 7) + 4 * rep, t = tid & 127; if (w & 1) v[rep] += tab[r]; At[r * 128 + t] = v[rep]; Dt[r * 128 + t] = dtv[rep]; } }
    const bf16* XC = (const bf16*)(ARGWS() + WS_XC);
    bf16x8 cf[4];
#pragma unroll
    for (int s = 0; s < 4; ++s) cf[s] = *(const GAS bf16x8*)(XC + (size_t)(row0 + q) * XCW + 1280 + g * 128 + 32 * s + 8 * lg);
#pragma unroll
    for (int rep = 0; rep < 4; ++rep) { const int task = tid + rep * NTHR, ch = task & 15, t = task >> 4;
        *(LAS v4u*)(Bn + t * TPB + ch * 16) = *(const GAS v4u*)(XC + (size_t)(row0 + t) * XCW + 1024 + g * 128 + ch * 8); }
    __syncthreads();
    f32x4 cbm[8];
#pragma unroll
    for (int t = 0; t < 8; ++t) { cbm[t] = (f32x4){0.f, 0.f, 0.f, 0.f};
        if (t <= w) {
#pragma unroll
            for (int s = 0; s < 4; ++s) cbm[t] = MFMA16(lds_frag(Bn, 16 * t, 32 * s, lane), cf[s], cbm[t]); } }
    LAS unsigned char* Pw = Bn + w * 16 * TPB;
    float ssq = 0.f;
    const bf16* SPg = (const bf16*)(ARGWS() + WS_SP);
    v4u xr[4], sr[4];
#define SSDC_LOAD(hp_) do { _Pragma("unroll") for (int rep = 0; rep < 4; ++rep) { const int task = tid + rep * NTHR, ch = task & 15, tr_ = task >> 4; \
        xr[rep] = *(const GAS v4u*)(XC + (size_t)(row0 + tr_) * XCW + (g * 8 + 2 * (hp_)) * 64 + ch * 8); \
        sr[rep] = *(const GAS v4u*)(SPg + (size_t)((b * 16 + g * 8 + 2 * (hp_) + (tr_ >> 6)) * 16 + c) * 8192 + (size_t)(tr_ & 63) * 128 + ch * 8); } } while (0)
    SSDC_LOAD(0);
#pragma unroll 1
    for (int hp = 0; hp < 4; ++hp) {
        __syncthreads();
#pragma unroll
        for (int rep = 0; rep < 4; ++rep) { const int task = tid + rep * NTHR, ch = task & 15, tr_ = task >> 4; *(LAS v4u*)(XT + tr_ * TPB + ch * 16) = xr[rep]; *(LAS v4u*)(SP + tr_ * TPB + ch * 16) = sr[rep]; }
        unsigned long long zz[2][4];
#pragma unroll
        for (int rr = 0; rr < 2; ++rr)
#pragma unroll
            for (int pt = 0; pt < 4; ++pt) zz[rr][pt] = *(const GAS unsigned long long*)(PROJ + (size_t)(row0 + q) * NINP + C_Z + (g * 8 + 2 * hp + rr) * 64 + 16 * pt + 4 * lg);
        __syncthreads();
        if (hp < 3) SSDC_LOAD(hp + 1);
#pragma unroll
        for (int rr = 0; rr < 2; ++rr) { const int r = 2 * hp + rr, h = g * 8 + r; const float Dh = ARGIN(16)[l * 16 + h], aq = At[r * 128 + q];
#pragma unroll
            for (int t = 0; t < 8; ++t) { if (t <= (w | 1)) { float p[4];
#pragma unroll
                    for (int i = 0; i < 4; ++i) { const int k = 16 * t + 4 * lg + i; p[i] = (k <= q) ? cbm[t][i] * fexp(aq - At[r * 128 + k]) * Dt[r * 128 + k] : 0.f; if (k == q) p[i] += Dh; }
                    *(LAS unsigned long long*)(Pw + lc * TPB + (16 * t + 4 * lg) * 2) = (unsigned long long)pk2(p[0], p[1]) | ((unsigned long long)pk2(p[2], p[3]) << 32); } }
            asm volatile("s_waitcnt lgkmcnt(0)" ::: "memory");
            f32x4 acc[4]; const float eq = fexp(aq);
#pragma unroll
            for (int pt = 0; pt < 4; ++pt) { acc[pt] = (f32x4){0.f, 0.f, 0.f, 0.f};
#pragma unroll
                for (int s = 0; s < 4; ++s) acc[pt] = MFMA16(lds_frag(SP, rr * 64 + 16 * pt, 32 * s, lane), cf[s], acc[pt]);
                acc[pt] = acc[pt] * eq; }
#pragma unroll
            for (int s = 0; s < 4; ++s) { if (s <= (w >> 1)) { const bf16x8 pf = lds_frag(Pw, 0, 32 * s, lane);
#pragma unroll
                    for (int pt = 0; pt < 4; ++pt) acc[pt] = MFMA16(lds_frag_tr(XT, TPB, 32 * s, rr * 64 + 16 * pt, lane), pf, acc[pt]); } }
            asm volatile("s_waitcnt lgkmcnt(0)" ::: "memory");
#pragma unroll
            for (int pt = 0; pt < 4; ++pt) { const unsigned long long z8 = zz[rr][pt];
                f32x4 y = acc[pt]; y.x *= siluf_(bflo((unsigned)z8)); y.y *= siluf_(bfhi((unsigned)z8)); y.z *= siluf_(bflo((unsigned)(z8 >> 32))); y.w *= siluf_(bfhi((unsigned)(z8 >> 32)));
                ssq += (y.x * y.x + y.y * y.y) + (y.z * y.z + y.w * y.w);
                *(GAS unsigned long long*)(MIXED + (size_t)(row0 + q) * DM + 512 + g * 512 + r * 64 + 16 * pt + 4 * lg) = (unsigned long long)pk2(y.x, y.y) | ((unsigned long long)pk2(y.z, y.w) << 32); } }
    }
    if (c == 15 && tid < 288) {
        const int j = tid / 96, kk = tid % 96, ch0 = kk < 64 ? g * 512 + kk * 8 : (kk < 80 ? 1024 + g * 128 + (kk - 64) * 8 : 1280 + g * 128 + (kk - 80) * 8);
        float r[8]; unpack8(*(const GAS v4u*)(PROJ + (size_t)(row0 + 125 + j) * NINP + C_XBC + ch0), r);
        float* o = ARGOUT() + O_PCONV + (size_t)((l * NB + b) * 3 + j) * XCW + ch0;
        *(GAS f32x4*)o = (f32x4){r[0], r[1], r[2], r[3]}; *(GAS f32x4*)(o + 4) = (f32x4){r[4], r[5], r[6], r[7]}; }
    ssq += __shfl_xor(ssq, 16); ssq += __shfl_xor(ssq, 32);
    const float rs = __builtin_amdgcn_rsqf(ssq * (1.0f / 512.0f) + 1e-6f);
    asm volatile("s_waitcnt vmcnt(0)" ::: "memory");
    const float* wn = ARGIN(17) + (size_t)l * 1024 + g * 512;
    unsigned long long yb[32];
#pragma unroll
    for (int j = 0; j < 32; ++j) yb[j] = *(const GAS unsigned long long*)(MIXED + (size_t)(row0 + q) * DM + 512 + g * 512 + 16 * j + 4 * lg);
#pragma unroll
    for (int j = 0; j < 32; ++j) { const int col = 16 * j + 4 * lg; const f32x4 g4 = *(const GAS f32x4*)(wn + col);
        const float y0 = bflo((unsigned)yb[j]), y1 = bfhi((unsigned)yb[j]), y2 = bflo((unsigned)(yb[j] >> 32)), y3 = bfhi((unsigned)(yb[j] >> 32));
        *(GAS unsigned long long*)(MIXED + (size_t)(row0 + q) * DM + 512 + g * 512 + col) = (unsigned long long)pk2(y0 * rs * g4.x, y1 * rs * g4.y) | ((unsigned long long)pk2(y2 * rs * g4.z, y3 * rs * g4.w) << 32); }
}

constexpr int AKP = 72 * 2, AVP = 280 * 2, APP = 168 * 2;
__device__ __forceinline__ void attn_mfma_item(Frame& F, int l, int b, int blk, int kvh) {
    const bf16* PROJ = (const bf16*)(ARGWS() + WS_PROJ); bf16* MIXED = (bf16*)(ARGWS() + WS_MIXED);
    const int tid = F.tid, lane = F.lane, w = F.wave, lc = lane & 15, lg = lane >> 4, w0 = blk * 128 - 128;
    LAS unsigned char* Ks = F.lds; LAS unsigned char* Vt = F.lds + 256 * AKP; LAS unsigned char* Pw = F.lds + 256 * AKP + 64 * AVP + w * 16 * APP;
    float* pk = ARGOUT() + O_PK + (size_t)(l * NB + b) * 128 * 128; float* pv = ARGOUT() + O_PV + (size_t)(l * NB + b) * 128 * 128;
    unsigned zero_ = 0u; asm volatile("" : "+v"(zero_)); const v4u zero4 = (v4u){zero_, zero_, zero_, zero_};
    __syncthreads();
    if (tid < 64 * 3) { const int d = tid / 3, j = tid % 3; *(LAS v4u*)(Vt + d * AVP + 512 + j * 16) = zero4; }
#pragma unroll
    for (int rep = 0; rep < 4; ++rep) { const int task = tid + rep * NTHR;
        { const int r = task >> 3, c = task & 7, pos = w0 + r; const bool keep = (blk == 15 && r >= 128);
          if (pos < 0) { *(LAS v4u*)(Ks + r * AKP + c * 16) = zero4; }
          else { const size_t grow = (size_t)(b * SEQL + pos) * NINP;
            if (c >= 2) { const v4u wk = *(const GAS v4u*)(PROJ + grow + C_K + kvh * 64 + c * 8); *(LAS v4u*)(Ks + r * AKP + c * 16) = wk;
              if (keep) { float f[8]; unpack8(wk, f); float* o = pk + (size_t)((r - 128) * 2 + kvh) * 64 + c * 8; *(GAS f32x4*)o = (f32x4){f[0], f[1], f[2], f[3]}; *(GAS f32x4*)(o + 4) = (f32x4){f[4], f[5], f[6], f[7]}; } }
            else if (c == 0) { float x1[8], x2[8], cs[8], sn[8], o1[8], o2[8];
              unpack8(*(const GAS v4u*)(PROJ + grow + C_K + kvh * 64), x1); unpack8(*(const GAS v4u*)(PROJ + grow + C_K + kvh * 64 + 8), x2); rope_cs(pos, cs, sn);
#pragma unroll
              for (int i = 0; i < 8; ++i) { o1[i] = x1[i] * cs[i] - x2[i] * sn[i]; o2[i] = x2[i] * cs[i] + x1[i] * sn[i]; }
              *(LAS v4u*)(Ks + r * AKP) = pack8(o1); *(LAS v4u*)(Ks + r * AKP + 16) = pack8(o2);
              if (keep) { float* o = pk + (size_t)((r - 128) * 2 + kvh) * 64; *(GAS f32x4*)o = (f32x4){o1[0], o1[1], o1[2], o1[3]}; *(GAS f32x4*)(o + 4) = (f32x4){o1[4], o1[5], o1[6], o1[7]};
                  *(GAS f32x4*)(o + 8) = (f32x4){o2[0], o2[1], o2[2], o2[3]}; *(GAS f32x4*)(o + 12) = (f32x4){o2[4], o2[5], o2[6], o2[7]}; } } } }
        { const int r = task & 255, c = task >> 8, pos = w0 + r; const bool keep = (blk == 15 && r >= 128);
          v4u wv = zero4;
          if (pos >= 0) wv = *(const GAS v4u*)(PROJ + (size_t)(b * SEQL + pos) * NINP + C_V + kvh * 64 + c * 8);
          *(LAS unsigned short*)(Vt + (c * 8 + 0) * AVP + r * 2) = (unsigned short)(wv.x & 0xffffu); *(LAS unsigned short*)(Vt + (c * 8 + 1) * AVP + r * 2) = (unsigned short)(wv.x >> 16);
          *(LAS unsigned short*)(Vt + (c * 8 + 2) * AVP + r * 2) = (unsigned short)(wv.y & 0xffffu); *(LAS unsigned short*)(Vt + (c * 8 + 3) * AVP + r * 2) = (unsigned short)(wv.y >> 16);
          *(LAS unsigned short*)(Vt + (c * 8 + 4) * AVP + r * 2) = (unsigned short)(wv.z & 0xffffu); *(LAS unsigned short*)(Vt + (c * 8 + 5) * AVP + r * 2) = (unsigned short)(wv.z >> 16);
          *(LAS unsigned short*)(Vt + (c * 8 + 6) * AVP + r * 2) = (unsigned short)(wv.w & 0xffffu); *(LAS unsigned short*)(Vt + (c * 8 + 7) * AVP + r * 2) = (unsigned short)(wv.w >> 16);
          if (keep) { float f[8]; unpack8(wv, f); float* o = pv + (size_t)((r - 128) * 2 + kvh) * 64 + c * 8; *(GAS f32x4*)o = (f32x4){f[0], f[1], f[2], f[3]}; *(GAS f32x4*)(o + 4) = (f32x4){f[4], f[5], f[6], f[7]}; } } }
    const int qpos = blk * 128 + 16 * w + lc; const size_t qrow = (size_t)b * SEQL + qpos;
    float cs[8], sn[8]; rope_cs(qpos, cs, sn);
    __syncthreads();
    for (int g = 0; g < 4; ++g) { const int h = kvh * 4 + g;
        v4u q0 = *(const GAS v4u*)(PROJ + qrow * NINP + C_Q + h * 64 + 8 * lg); const v4u q1 = *(const GAS v4u*)(PROJ + qrow * NINP + C_Q + h * 64 + 32 + 8 * lg);
        { v4u pp; pp.x = __shfl_xor(q0.x, 16); pp.y = __shfl_xor(q0.y, 16); pp.z = __shfl_xor(q0.z, 16); pp.w = __shfl_xor(q0.w, 16);
          float own[8], oth[8], o[8]; unpack8(q0, own); unpack8(pp, oth);
#pragma unroll
          for (int i = 0; i < 8; ++i) o[i] = lg == 0 ? own[i] * cs[i] - oth[i] * sn[i] : own[i] * cs[i] + oth[i] * sn[i];
          if (lg < 2) q0 = pack8(o); }
        const bf16x8 qf0 = __builtin_bit_cast(bf16x8, q0), qf1 = __builtin_bit_cast(bf16x8, q1);
        f32x4 sc[9]; float mx = -INFINITY;
#pragma unroll
        for (int tt = 0; tt < 9; ++tt) { const LAS unsigned char* kb = Ks + (16 * (w + tt) + lc) * AKP + 16 * lg;
            f32x4 a = (f32x4){0.f, 0.f, 0.f, 0.f};
            a = MFMA16(*(const LAS bf16x8*)kb, qf0, a); a = MFMA16(*(const LAS bf16x8*)(kb + 64), qf1, a);
#pragma unroll
            for (int i = 0; i < 4; ++i) { const int kk = 16 * tt + 4 * lg + i; const bool ok = (kk >= lc) && (kk <= 128 + lc) && (w0 + 16 * w + kk >= 0);
                a[i] = ok ? a[i] * 0.125f : -INFINITY; mx = fmaxf(mx, a[i]); }
            sc[tt] = a; }
        mx = fmaxf(mx, __shfl_xor(mx, 16)); mx = fmaxf(mx, __shfl_xor(mx, 32));
        const float sink = ARGIN(11)[l * 8 + h]; mx = fmaxf(mx, sink);
        float rsum = 0.f;
#pragma unroll
        for (int tt = 0; tt < 10; ++tt) { float p[4] = {0.f, 0.f, 0.f, 0.f};
            if (tt < 9) {
#pragma unroll
                for (int i = 0; i < 4; ++i) { p[i] = fexp(sc[tt < 9 ? tt : 0][i] - mx); rsum += p[i]; } }
            *(LAS unsigned long long*)(Pw + lc * APP + (16 * tt + 4 * lg) * 2) = (unsigned long long)pk2(p[0], p[1]) | ((unsigned long long)pk2(p[2], p[3]) << 32); }
        rsum += __shfl_xor(rsum, 16); rsum += __shfl_xor(rsum, 32);
        const float inv = 1.0f / (rsum + fexp(sink - mx));
        asm volatile("s_waitcnt lgkmcnt(0)" ::: "memory");
        f32x4 acc[4];
#pragma unroll
        for (int dt = 0; dt < 4; ++dt) acc[dt] = (f32x4){0.f, 0.f, 0.f, 0.f};
#pragma unroll
        for (int s = 0; s < 5; ++s) { const bf16x8 pf = *(const LAS bf16x8*)(Pw + lc * APP + (32 * s + 8 * lg) * 2);
#pragma unroll
            for (int dt = 0; dt < 4; ++dt) acc[dt] = MFMA16(*(const LAS bf16x8*)(Vt + (16 * dt + lc) * AVP + (16 * w + 32 * s + 8 * lg) * 2), pf, acc[dt]); }
        asm volatile("s_waitcnt lgkmcnt(0)" ::: "memory");
#pragma unroll
        for (int dt = 0; dt < 4; ++dt) *(GAS unsigned long long*)(MIXED + qrow * DM + h * 64 + 16 * dt + 4 * lg) =
            (unsigned long long)pk2(acc[dt][0] * inv, acc[dt][1] * inv) | ((unsigned long long)pk2(acc[dt][2] * inv, acc[dt][3] * inv) << 32);
    }
}

__device__ __forceinline__ void conv8_sample(const bf16* PROJ, const float* cw, const float* cb, const float* sconv, float* sconv_o, int b, int ch0, float (&y)[8]) {
    float r[4][8];
#pragma unroll
    for (int j = 0; j < 3; ++j) { const f32x4 u0 = *(const GAS f32x4*)(sconv + (size_t)(b * 3 + j) * XCW + ch0), u1 = *(const GAS f32x4*)(sconv + (size_t)(b * 3 + j) * XCW + ch0 + 4);
        r[j][0] = u0.x; r[j][1] = u0.y; r[j][2] = u0.z; r[j][3] = u0.w; r[j][4] = u1.x; r[j][5] = u1.y; r[j][6] = u1.z; r[j][7] = u1.w; }
    unpack8(*(const GAS v4u*)(PROJ + (size_t)(MP + b) * NINP + C_XBC + ch0), r[3]);
#pragma unroll
    for (int i = 0; i < 8; ++i) { float acc = cb[ch0 + i];
#pragma unroll
        for (int j = 0; j < 4; ++j) acc += cw[j * XCW + ch0 + i] * r[j][i];
        y[i] = siluf_(acc); }
#pragma unroll
    for (int j = 0; j < 3; ++j) { float* o = sconv_o + (size_t)(b * 3 + j) * XCW + ch0;
        *(GAS f32x4*)o = (f32x4){r[j + 1][0], r[j + 1][1], r[j + 1][2], r[j + 1][3]}; *(GAS f32x4*)(o + 4) = (f32x4){r[j + 1][4], r[j + 1][5], r[j + 1][6], r[j + 1][7]}; }
}
__device__ __forceinline__ void ssd_sample_item(Frame& F, int l, int b, int g) {
    const bf16* PROJ = (const bf16*)(ARGWS() + WS_PROJ); bf16* MIXED = (bf16*)(ARGWS() + WS_MIXED);
    const float* cw = ARGIN(12) + (size_t)l * 4 * XCW; const float* cb = ARGIN(13) + (size_t)l * XCW; const float* sconv = ARGIN(4) + (size_t)l * MS * 3 * XCW; float* sconv_o = ARGOUT() + O_SCONV + (size_t)l * MS * 3 * XCW;
    const int tid = F.tid, lane = F.lane, w = F.wave, p = tid >> 3, nq = tid & 7;
    LAS float* xs = (LAS float*)(F.lds);
    LAS float* Bs = xs + 512;
    LAS float* Cs = Bs + 128;
    LAS float* ys = Cs + 128;
    LAS float* red = ys + 512;
    __syncthreads();
    if (tid < 96) { const int ch0 = tid < 64 ? g * 512 + tid * 8 : (tid < 80 ? 1024 + g * 128 + (tid - 64) * 8 : 1280 + g * 128 + (tid - 80) * 8);
        float y[8]; conv8_sample(PROJ, cw, cb, sconv, sconv_o, b, ch0, y);
        LAS float* dst = tid < 64 ? xs + tid * 8 : (tid < 80 ? Bs + (tid - 64) * 8 : Cs + (tid - 80) * 8);
#pragma unroll
        for (int i = 0; i < 8; ++i) dst[i] = y[i]; }
    __syncthreads();
    float Bv[16], Cv[16];
#pragma unroll
    for (int i = 0; i < 16; ++i) { Bv[i] = Bs[nq * 16 + i]; Cv[i] = Cs[nq * 16 + i]; }
    float ssq = 0.f;
    f32x4 st[8][4]; float zv[8];
    const size_t sbase = ((((size_t)l * MS + b) * 16 + g * 8) * 64 + p) * 128 + nq * 16;
#pragma unroll
    for (int r = 0; r < 8; ++r) {
#pragma unroll
        for (int i = 0; i < 4; ++i) st[r][i] = *(const GAS f32x4*)(ARGIN(5) + sbase + (size_t)r * 8192 + 4 * i);
        zv[r] = bf2f(PROJ[(size_t)(MP + b) * NINP + C_Z + (g * 8 + r) * 64 + p]); }
#pragma unroll
    for (int r = 0; r < 8; ++r) { const int h = g * 8 + r;
        const float dt = softplusf_(bf2f(PROJ[(size_t)(MP + b) * NINP + C_DT + h]) + ARGIN(14)[l * 16 + h]), dA = fexp(dt * -fexp(ARGIN(15)[l * 16 + h])), x = xs[r * 64 + p], coef = dt * x;
        float* so = ARGOUT() + O_SSSM + sbase + (size_t)r * 8192;
        float y = 0.f;
#pragma unroll
        for (int i = 0; i < 4; ++i) { f32x4 v = st[r][i];
            v.x = dA * v.x + coef * Bv[4 * i]; v.y = dA * v.y + coef * Bv[4 * i + 1]; v.z = dA * v.z + coef * Bv[4 * i + 2]; v.w = dA * v.w + coef * Bv[4 * i + 3];
            y += (v.x * Cv[4 * i] + v.y * Cv[4 * i + 1]) + (v.z * Cv[4 * i + 2] + v.w * Cv[4 * i + 3]);
            *(GAS f32x4*)(so + 4 * i) = v; }
        y += __shfl_xor(y, 1); y += __shfl_xor(y, 2); y += __shfl_xor(y, 4);
        if (nq == 0) { const float yo = (y + ARGIN(16)[l * 16 + h] * x) * siluf_(zv[r]); ys[r * 64 + p] = yo; ssq += yo * yo; } }
    ssq = wave_sum(ssq); if (lane == 0) red[w] = ssq;
    __syncthreads();
    const float tot = ((red[0] + red[1]) + (red[2] + red[3])) + ((red[4] + red[5]) + (red[6] + red[7])), rs = __builtin_amdgcn_rsqf(tot * (1.0f / 512.0f) + 1e-6f);
    ((unsigned short*)MIXED)[(size_t)(MP + b) * DM + 512 + g * 512 + tid] = (unsigned short)f2bf(ys[tid] * rs * ARGIN(17)[(size_t)l * 1024 + g * 512 + tid]);
}
__device__ __forceinline__ void mlstm_sample_item(Frame& F, int l, int b, int h) {
    const bf16* PROJ = (const bf16*)(ARGWS() + WS_PROJ); bf16* MIXED = (bf16*)(ARGWS() + WS_MIXED);
    const int tid = F.tid, lane = F.lane, w = F.wave, dg = tid >> 5, e4 = (tid & 31) * 4; const size_t prow = (size_t)(MP + b) * NINP, sidx = ((size_t)l * MS + b) * 4 + h;
    LAS float* qs = (LAS float*)(F.lds);
    LAS float* ks = qs + 128;
    LAS float* part = ks + 128;
    LAS float* red = part + 1024;
    const float m0 = ARGIN(8)[sidx];
    const float ig = bf2f(PROJ[prow + C_MI + h]) + ARGIN(18)[l * 4 + h], lf = logsigmoidf_(bf2f(PROJ[prow + C_MF + h]) + ARGIN(19)[l * 4 + h]);
    const float mn = fmaxf(lf + m0, ig), fgt = fexp(lf + m0 - mn), igt = fexp(ig - mn);
    __syncthreads();
    float dpart = 0.f;
    if (tid < 128) { const float q = bf2f(PROJ[prow + C_MQ + h * 128 + tid]), k = bf2f(PROJ[prow + C_MK + h * 128 + tid]) * 0.08838834764831845f * igt;
        qs[tid] = q; ks[tid] = k;
        const float nn = fgt * ARGIN(7)[sidx * 128 + tid] + k; ARGOUT()[O_SN + sidx * 128 + tid] = nn; dpart = q * nn; }
    dpart = wave_sum(dpart); if (lane == 0) red[w] = dpart;
    __syncthreads();
    const float den = red[0] + red[1];
    f32x4 vv; { const unsigned long long u = *(const GAS unsigned long long*)(PROJ + prow + C_MV + h * 128 + e4); vv = (f32x4){bflo((unsigned)u), bfhi((unsigned)u), bflo((unsigned)(u >> 32)), bfhi((unsigned)(u >> 32))}; }
    const float* c0 = ARGIN(6) + sidx * 16384; float* co = ARGOUT() + O_SC + sidx * 16384;
    f32x4 cr[8];
#pragma unroll
    for (int j = 0; j < 8; ++j) cr[j] = *(const GAS f32x4*)(c0 + (size_t)(dg + 16 * j) * 128 + e4);
    f32x4 num = (f32x4){0.f, 0.f, 0.f, 0.f};
#pragma unroll
    for (int j = 0; j < 8; ++j) { const int d = dg + 16 * j; const f32x4 cn = cr[j] * fgt + vv * ks[d]; *(GAS f32x4*)(co + (size_t)d * 128 + e4) = cn; num = num + cn * qs[d]; }
    num.x += __shfl_xor(num.x, 32); num.y += __shfl_xor(num.y, 32); num.z += __shfl_xor(num.z, 32); num.w += __shfl_xor(num.w, 32);
    if (lane < 32) *(LAS f32x4*)(part + w * 128 + e4) = num;
    __syncthreads();
    float hv = 0.f;
    if (tid < 128) { float s = 0.f;
#pragma unroll
        for (int j = 0; j < 8; ++j) s += part[j * 128 + tid];
        hv = s / fmaxf(fabsf(den), fexp(-mn)); }
    const float s2 = wave_sum(hv * hv); if (lane == 0) red[8 + w] = s2;
    __syncthreads();
    if (tid < 128) { const float rs = __builtin_amdgcn_rsqf((red[8] + red[9]) * (1.0f / 128.0f) + 1e-6f);
        ((unsigned short*)MIXED)[(size_t)(MP + b) * DM + 1536 + h * 128 + tid] = (unsigned short)f2bf(hv * rs * ARGIN(20)[(size_t)l * 512 + h * 128 + tid] * sigmoidf_(bf2f(PROJ[prow + C_MO + h * 128 + tid]))); }
    if (tid == 0) ARGOUT()[O_SM + sidx] = mn;
}

__device__ __forceinline__ void conv_phase(Frame& F, const Args& a, int l) {
    const bf16* PROJ = (const bf16*)(ARGWS() + WS_PROJ); bf16* XC = (bf16*)(ARGWS() + WS_XC);
    const float* cw = ARGIN(12) + (size_t)l * 4 * XCW; const float* cb = ARGIN(13) + (size_t)l * XCW; const float* sconv = ARGIN(4) + (size_t)l * MS * 3 * XCW;
    float* pconv = ARGOUT() + O_PCONV + (size_t)l * NB * 3 * XCW; float* sconv_o = ARGOUT() + O_SCONV + (size_t)l * MS * 3 * XCW;
    for (int idx = F.vcu * NTHR + F.tid; idx < (MS + NB * 3) * (XCW / 8); idx += F.G * NTHR) {
        const int rr_ = idx / (XCW / 8), c0 = (idx % (XCW / 8)) * 8;
        const int row = rr_ < MS ? MP + rr_ : ((rr_ - MS) / 3) * SEQL + (SEQL - 3) + (rr_ - MS) % 3;
        float r[4][8];
        if (row < MP) { const int t = row & (SEQL - 1);
#pragma unroll
            for (int j = 0; j < 4; ++j) { const int tt = t - 3 + j;
                if (tt >= 0) { const v4u w = *(const GAS v4u*)(PROJ + (size_t)(row - 3 + j) * NINP + C_XBC + c0); unpack8(w, r[j]); }
                else {
#pragma unroll
                    for (int i = 0; i < 8; ++i) r[j][i] = 0.f; } }
        } else { const int b = row - MP;
#pragma unroll
            for (int j = 0; j < 3; ++j) { const f32x4 u0 = *(const GAS f32x4*)(sconv + (size_t)(b * 3 + j) * XCW + c0), u1 = *(const GAS f32x4*)(sconv + (size_t)(b * 3 + j) * XCW + c0 + 4);
                r[j][0] = u0.x; r[j][1] = u0.y; r[j][2] = u0.z; r[j][3] = u0.w; r[j][4] = u1.x; r[j][5] = u1.y; r[j][6] = u1.z; r[j][7] = u1.w; }
            const v4u w = *(const GAS v4u*)(PROJ + (size_t)row * NINP + C_XBC + c0); unpack8(w, r[3]);
        }
        float y[8];
#pragma unroll
        for (int i = 0; i < 8; ++i) { float acc = cb[c0 + i];
#pragma unroll
            for (int j = 0; j < 4; ++j) acc += cw[j * XCW + c0 + i] * r[j][i];
            y[i] = siluf_(acc); }
        *(GAS v4u*)(XC + (size_t)row * XCW + c0) = pack8(y);
        if (row < MP) { const int t = row & (SEQL - 1), b = row >> 11;
            if (t >= SEQL - 3) { float* o = pconv + (size_t)(b * 3 + (t - (SEQL - 3))) * XCW + c0;
                *(GAS f32x4*)o = (f32x4){r[3][0], r[3][1], r[3][2], r[3][3]}; *(GAS f32x4*)(o + 4) = (f32x4){r[3][4], r[3][5], r[3][6], r[3][7]}; }
        } else { const int b = row - MP;
#pragma unroll
            for (int j = 0; j < 3; ++j) { float* o = sconv_o + (size_t)(b * 3 + j) * XCW + c0;
                *(GAS f32x4*)o = (f32x4){r[j + 1][0], r[j + 1][1], r[j + 1][2], r[j + 1][3]}; *(GAS f32x4*)(o + 4) = (f32x4){r[j + 1][4], r[j + 1][5], r[j + 1][6], r[j + 1][7]}; }
        }
    }
}

__device__ __forceinline__ void ssd_seq_item(Frame& F, const Args& a, int l, int b, int h, bool sample) {
    const bf16* PROJ = (const bf16*)(ARGWS() + WS_PROJ); const bf16* XC = (const bf16*)(ARGWS() + WS_XC); float* YG = (float*)(ARGWS() + WS_YG);
    const int row0 = sample ? MP + b : b * SEQL, L = sample ? 1 : SEQL, g = h >> 3, tid = F.tid;
    const float A = -expf(ARGIN(15)[l * 16 + h]), dtb = ARGIN(14)[l * 16 + h], Dh = ARGIN(16)[l * 16 + h];
    const int p = tid >> 3, nq = tid & 7;
    float S[16];
    if (sample) { const float* s0 = ARGIN(5) + ((((size_t)l * MS + b) * 16 + h) * 64 + p) * 128 + nq * 16;
#pragma unroll
        for (int i = 0; i < 4; ++i) { const f32x4 v = *(const GAS f32x4*)(s0 + 4 * i); S[4 * i] = v.x; S[4 * i + 1] = v.y; S[4 * i + 2] = v.z; S[4 * i + 3] = v.w; } }
    else {
#pragma unroll
        for (int i = 0; i < 16; ++i) S[i] = 0.f; }
    LAS float* xs = (LAS float*)(F.lds);
    LAS float* Bs = (LAS float*)(F.lds + 16384);
    LAS float* Cs = (LAS float*)(F.lds + 49152);
    LAS float* ys = (LAS float*)(F.lds + 81920);
    LAS float* dts = (LAS float*)(F.lds + 98304);
    LAS float* das = (LAS float*)(F.lds + 98304 + 256);
    for (int t0 = 0; t0 < L; t0 += 64) {
        const int nb = (L - t0) < 64 ? (L - t0) : 64;
        __syncthreads();
        { const int tt = tid >> 3, ch = tid & 7;
          if (tt < nb) { float f[8]; unpack8(*(const GAS v4u*)(XC + (size_t)(row0 + t0 + tt) * XCW + h * 64 + ch * 8), f);
#pragma unroll
              for (int i = 0; i < 8; ++i) xs[tt * 64 + ch * 8 + i] = f[i]; } }
#pragma unroll
        for (int rep = 0; rep < 2; ++rep) { const int task = tid + rep * NTHR, tt = task >> 4, ch = task & 15;
          if (tt < nb) { float f[8]; unpack8(*(const GAS v4u*)(XC + (size_t)(row0 + t0 + tt) * XCW + 1024 + g * 128 + ch * 8), f);
#pragma unroll
              for (int i = 0; i < 8; ++i) Bs[tt * 128 + ch * 8 + i] = f[i];
              unpack8(*(const GAS v4u*)(XC + (size_t)(row0 + t0 + tt) * XCW + 1280 + g * 128 + ch * 8), f);
#pragma unroll
              for (int i = 0; i < 8; ++i) Cs[tt * 128 + ch * 8 + i] = f[i]; } }
        if (tid < nb) { const float dt = softplusf_(bf2f(PROJ[(size_t)(row0 + t0 + tid) * NINP + C_DT + h]) + dtb); dts[tid] = dt; das[tid] = expf(dt * A); }
        __syncthreads();
        for (int tt = 0; tt < nb; ++tt) {
            const float dt = dts[tt], dA = das[tt], x = xs[tt * 64 + p], coef = dt * x;
            float y = 0.f;
#pragma unroll
            for (int i = 0; i < 16; ++i) { S[i] = dA * S[i] + coef * Bs[tt * 128 + nq * 16 + i]; y += S[i] * Cs[tt * 128 + nq * 16 + i]; }
            y += __shfl_xor(y, 1); y += __shfl_xor(y, 2); y += __shfl_xor(y, 4);
            if (nq == 0) ys[tt * 64 + p] = y + Dh * x;
        }
        __syncthreads();
        { const int tt = tid >> 3, ch = tid & 7;
          if (tt < nb) { float z[8]; unpack8(*(const GAS v4u*)(PROJ + (size_t)(row0 + t0 + tt) * NINP + C_Z + h * 64 + ch * 8), z);
              float o[8];
#pragma unroll
              for (int i = 0; i < 8; ++i) o[i] = ys[tt * 64 + ch * 8 + i] * siluf_(z[i]);
              float* dst = YG + (size_t)(row0 + t0 + tt) * 1024 + h * 64 + ch * 8;
              *(GAS f32x4*)dst = (f32x4){o[0], o[1], o[2], o[3]}; *(GAS f32x4*)(dst + 4) = (f32x4){o[4], o[5], o[6], o[7]}; } }
    }
    float* so = ARGOUT() + (sample ? O_SSSM + ((((size_t)l * MS + b) * 16 + h) * 64 + p) * 128 : O_PSSM + ((((size_t)l * NB + b) * 16 + h) * 64 + p) * 128) + nq * 16;
#pragma unroll
    for (int i = 0; i < 4; ++i) *(GAS f32x4*)(so + 4 * i) = (f32x4){S[4 * i], S[4 * i + 1], S[4 * i + 2], S[4 * i + 3]};
}

__device__ __forceinline__ void mlstm_seq_item(Frame& F, const Args& a, int l, int b, int h, int es, bool sample) {
    const bf16* PROJ = (const bf16*)(ARGWS() + WS_PROJ); float* HR = (float*)(ARGWS() + WS_HR);
    const int row0 = sample ? MP + b : b * SEQL, L = sample ? 1 : SEQL, tid = F.tid, w = F.wave, lane = F.lane;
    const int e0 = es * 32 + w * 4, d0 = 2 * lane, Bn = sample ? MS : NB;
    const float ib = ARGIN(18)[l * 4 + h], fb = ARGIN(19)[l * 4 + h];
    float C[2][4], n[2], m;
    if (sample) {
#pragma unroll
        for (int dd = 0; dd < 2; ++dd) { const f32x4 v = *(const GAS f32x4*)(ARGIN(6) + ((((size_t)l * MS + b) * 4 + h) * 128 + d0 + dd) * 128 + e0);
            C[dd][0] = v.x; C[dd][1] = v.y; C[dd][2] = v.z; C[dd][3] = v.w; n[dd] = ARGIN(7)[(((size_t)l * MS + b) * 4 + h) * 128 + d0 + dd]; }
        m = ARGIN(8)[((size_t)l * MS + b) * 4 + h];
    } else {
#pragma unroll
        for (int dd = 0; dd < 2; ++dd) { n[dd] = 0.f;
#pragma unroll
            for (int j = 0; j < 4; ++j) C[dd][j] = 0.f; }
        m = 0.f;
    }
    LAS float* qs = (LAS float*)(F.lds);
    LAS float* ks = (LAS float*)(F.lds + 32768);
    LAS float* vs = (LAS float*)(F.lds + 65536);
    LAS float* hs = (LAS float*)(F.lds + 73728);
    LAS float* igs = (LAS float*)(F.lds + 81920);
    LAS float* lfs = (LAS float*)(F.lds + 81920 + 256);
    for (int t0 = 0; t0 < L; t0 += 64) {
        const int nb = (L - t0) < 64 ? (L - t0) : 64;
        __syncthreads();
#pragma unroll
        for (int rep = 0; rep < 2; ++rep) { const int task = tid + rep * NTHR, tt = task >> 4, ch = task & 15;
          if (tt < nb) { float f[8]; unpack8(*(const GAS v4u*)(PROJ + (size_t)(row0 + t0 + tt) * NINP + C_MQ + h * 128 + ch * 8), f);
#pragma unroll
              for (int i = 0; i < 8; ++i) qs[tt * 128 + ch * 8 + i] = f[i];
              unpack8(*(const GAS v4u*)(PROJ + (size_t)(row0 + t0 + tt) * NINP + C_MK + h * 128 + ch * 8), f);
#pragma unroll
              for (int i = 0; i < 8; ++i) ks[tt * 128 + ch * 8 + i] = f[i] * 0.08838834764831845f; } }
        if (tid < 256) { const int tt = tid >> 2, ch = tid & 3;
          if (tt < nb) { float f[8]; unpack8(*(const GAS v4u*)(PROJ + (size_t)(row0 + t0 + tt) * NINP + C_MV + h * 128 + es * 32 + ch * 8), f);
#pragma unroll
              for (int i = 0; i < 8; ++i) vs[tt * 32 + ch * 8 + i] = f[i]; } }
        if (tid < nb) { igs[tid] = bf2f(PROJ[(size_t)(row0 + t0 + tid) * NINP + C_MI + h]) + ib; lfs[tid] = logsigmoidf_(bf2f(PROJ[(size_t)(row0 + t0 + tid) * NINP + C_MF + h]) + fb); }
        __syncthreads();
        for (int tt = 0; tt < nb; ++tt) {
            const float lf = lfs[tt], ig = igs[tt];
            const float m_new = fmaxf(lf + m, ig), fgt = expf(lf + m - m_new), igt = expf(ig - m_new); m = m_new;
            const float q0 = qs[tt * 128 + d0], q1 = qs[tt * 128 + d0 + 1], k0 = ks[tt * 128 + d0] * igt, k1 = ks[tt * 128 + d0 + 1] * igt;
            n[0] = fgt * n[0] + k0; n[1] = fgt * n[1] + k1;
            float red[5]; red[4] = q0 * n[0] + q1 * n[1];
#pragma unroll
            for (int j = 0; j < 4; ++j) { const float v = vs[tt * 32 + w * 4 + j]; C[0][j] = fgt * C[0][j] + k0 * v; C[1][j] = fgt * C[1][j] + k1 * v; red[j] = q0 * C[0][j] + q1 * C[1][j]; }
#pragma unroll
            for (int j = 0; j < 5; ++j) red[j] = wave_sum(red[j]);
            const float dn = fmaxf(fabsf(red[4]), expf(-m));
            if (lane < 4) hs[tt * 32 + w * 4 + lane] = (lane == 0 ? red[0] : lane == 1 ? red[1] : lane == 2 ? red[2] : red[3]) / dn;
        }
        __syncthreads();
        { const int tt = tid >> 3, e4 = (tid & 7) * 4;
          if (tt < nb) *(GAS f32x4*)(HR + (size_t)(row0 + t0 + tt) * 512 + h * 128 + es * 32 + e4) = (f32x4){hs[tt * 32 + e4], hs[tt * 32 + e4 + 1], hs[tt * 32 + e4 + 2], hs[tt * 32 + e4 + 3]}; }
    }
    float* co = ARGOUT() + (sample ? O_SC : O_PC) + (((size_t)l * Bn + b) * 4 + h) * 128 * 128;
#pragma unroll
    for (int dd = 0; dd < 2; ++dd) *(GAS f32x4*)(co + (size_t)(d0 + dd) * 128 + e0) = (f32x4){C[dd][0], C[dd][1], C[dd][2], C[dd][3]};
    if (es == 0 && w == 0) { float* no = ARGOUT() + (sample ? O_SN : O_PN) + (((size_t)l * Bn + b) * 4 + h) * 128; no[d0] = n[0]; no[d0 + 1] = n[1];
        if (lane == 0) ARGOUT()[(sample ? O_SM : O_PM) + ((size_t)l * Bn + b) * 4 + h] = m; }
}

__device__ __forceinline__ void attn_prompt_item(Frame& F, const Args& a, int l, int b, int blk, int kvh) {
    const bf16* PROJ = (const bf16*)(ARGWS() + WS_PROJ); bf16* MIXED = (bf16*)(ARGWS() + WS_MIXED);
    constexpr int KP = 68;
    LAS unsigned short* Ks = (LAS unsigned short*)(F.lds); LAS unsigned short* Vs = (LAS unsigned short*)(F.lds + 256 * KP * 2);
    const int tid = F.tid, w0 = blk * 128 - 128;
    float* pk = ARGOUT() + O_PK + (size_t)(l * NB + b) * 128 * 128; float* pv = ARGOUT() + O_PV + (size_t)(l * NB + b) * 128 * 128;
    __syncthreads();
#pragma unroll
    for (int rep = 0; rep < 4; ++rep) { const int task = tid + rep * NTHR, r = task >> 3, c = task & 7, pos = w0 + r; const bool keep = (blk == 15 && r >= 128);
        if (pos < 0) { *(LAS v4u*)(Ks + r * KP + c * 8) = (v4u){0u, 0u, 0u, 0u}; *(LAS v4u*)(Vs + r * KP + c * 8) = (v4u){0u, 0u, 0u, 0u}; continue; }
        const size_t grow = (size_t)(b * SEQL + pos) * NINP;
        { const v4u wv = *(const GAS v4u*)(PROJ + grow + C_V + kvh * 64 + c * 8); *(LAS v4u*)(Vs + r * KP + c * 8) = wv;
          if (keep) { float f[8]; unpack8(wv, f); float* o = pv + (size_t)((r - 128) * 2 + kvh) * 64 + c * 8; *(GAS f32x4*)o = (f32x4){f[0], f[1], f[2], f[3]}; *(GAS f32x4*)(o + 4) = (f32x4){f[4], f[5], f[6], f[7]}; } }
        if (c >= 2) { const v4u wk = *(const GAS v4u*)(PROJ + grow + C_K + kvh * 64 + c * 8); *(LAS v4u*)(Ks + r * KP + c * 8) = wk;
          if (keep) { float f[8]; unpack8(wk, f); float* o = pk + (size_t)((r - 128) * 2 + kvh) * 64 + c * 8; *(GAS f32x4*)o = (f32x4){f[0], f[1], f[2], f[3]}; *(GAS f32x4*)(o + 4) = (f32x4){f[4], f[5], f[6], f[7]}; } }
        else if (c == 0) { float x1[8], x2[8], cs[8], sn[8], o1[8], o2[8];
          unpack8(*(const GAS v4u*)(PROJ + grow + C_K + kvh * 64), x1); unpack8(*(const GAS v4u*)(PROJ + grow + C_K + kvh * 64 + 8), x2); rope_cs(pos, cs, sn);
#pragma unroll
          for (int i = 0; i < 8; ++i) { o1[i] = x1[i] * cs[i] - x2[i] * sn[i]; o2[i] = x2[i] * cs[i] + x1[i] * sn[i]; }
          *(LAS v4u*)(Ks + r * KP) = pack8(o1); *(LAS v4u*)(Ks + r * KP + 8) = pack8(o2);
          if (keep) { float* o = pk + (size_t)((r - 128) * 2 + kvh) * 64; *(GAS f32x4*)o = (f32x4){o1[0], o1[1], o1[2], o1[3]}; *(GAS f32x4*)(o + 4) = (f32x4){o1[4], o1[5], o1[6], o1[7]};
              *(GAS f32x4*)(o + 8) = (f32x4){o2[0], o2[1], o2[2], o2[3]}; *(GAS f32x4*)(o + 12) = (f32x4){o2[4], o2[5], o2[6], o2[7]}; } }
    }
    __syncthreads();
    const int i = tid >> 2, g = tid & 3, h = kvh * 4 + g, qpos = blk * 128 + i; const size_t row = (size_t)b * SEQL + qpos;
    float q[64];
#pragma unroll
    for (int c = 0; c < 8; ++c) { float f[8]; unpack8(*(const GAS v4u*)(PROJ + row * NINP + C_Q + h * 64 + c * 8), f);
#pragma unroll
        for (int e = 0; e < 8; ++e) q[c * 8 + e] = f[e]; }
    { float cs[8], sn[8]; rope_cs(qpos, cs, sn);
#pragma unroll
      for (int e = 0; e < 8; ++e) { const float x1 = q[e], x2 = q[8 + e]; q[e] = x1 * cs[e] - x2 * sn[e]; q[8 + e] = x2 * cs[e] + x1 * sn[e]; } }
#pragma unroll
    for (int e = 0; e < 64; ++e) q[e] *= 0.125f;
    float acc[64], mx = -INFINITY, sum = 0.f;
#pragma unroll
    for (int e = 0; e < 64; ++e) acc[e] = 0.f;
    for (int jj = 0; jj <= 128; ++jj) { const int r = i + jj;
        if (w0 + r < 0) continue;
        float s = 0.f;
#pragma unroll
        for (int c = 0; c < 8; ++c) { float f[8]; unpack8(*(const LAS v4u*)(Ks + r * KP + c * 8), f);
#pragma unroll
            for (int e = 0; e < 8; ++e) s += q[c * 8 + e] * f[e]; }
        const float mn = fmaxf(mx, s), sc = expf(mx - mn), p = expf(s - mn); mx = mn; sum = sum * sc + p;
#pragma unroll
        for (int c = 0; c < 8; ++c) { float f[8]; unpack8(*(const LAS v4u*)(Vs + r * KP + c * 8), f);
#pragma unroll
            for (int e = 0; e < 8; ++e) acc[c * 8 + e] = acc[c * 8 + e] * sc + p * f[e]; }
    }
    const float sink = ARGIN(11)[l * 8 + h], mf = fmaxf(mx, sink), sc = expf(mx - mf), den = sum * sc + expf(sink - mf), inv = sc / den;
#pragma unroll
    for (int c = 0; c < 8; ++c) { float o[8];
#pragma unroll
        for (int e = 0; e < 8; ++e) o[e] = acc[c * 8 + e] * inv;
        *(GAS v4u*)(MIXED + row * DM + h * 64 + c * 8) = pack8(o); }
}

__device__ __forceinline__ void attn_sample_item(Frame& F, const Args& a, int l, int b) {
    const bf16* PROJ = (const bf16*)(ARGWS() + WS_PROJ); bf16* MIXED = (bf16*)(ARGWS() + WS_MIXED);
    const int tid = F.tid, h = F.wave, lane = F.lane, kvh = h >> 2; const size_t prow = (size_t)(MP + b) * NINP;
    LAS float* qs = (LAS float*)(F.lds);
    LAS float* ps = (LAS float*)(F.lds + 2048);
    LAS float* knew = (LAS float*)(F.lds + 2048 + 4224);
    LAS float* vnew = knew + 128;
    const float* ck = ARGIN(2) + (size_t)(l * MS + b) * 128 * 128; const float* cv = ARGIN(3) + (size_t)(l * MS + b) * 128 * 128;
    __syncthreads();
    { float cs[8], sn[8]; rope_cs(8192, cs, sn);
      const int d = lane; float x = bf2f(PROJ[prow + C_Q + h * 64 + d]);
      if (d < 16) { const float xp = bf2f(PROJ[prow + C_Q + h * 64 + (d ^ 8)]); const float c = (d & 7) == 0 ? cs[0] : (d & 7) == 1 ? cs[1] : (d & 7) == 2 ? cs[2] : (d & 7) == 3 ? cs[3] : (d & 7) == 4 ? cs[4] : (d & 7) == 5 ? cs[5] : (d & 7) == 6 ? cs[6] : cs[7];
          const float s = (d & 7) == 0 ? sn[0] : (d & 7) == 1 ? sn[1] : (d & 7) == 2 ? sn[2] : (d & 7) == 3 ? sn[3] : (d & 7) == 4 ? sn[4] : (d & 7) == 5 ? sn[5] : (d & 7) == 6 ? sn[6] : sn[7];
          x = d < 8 ? x * c - xp * s : x * c + xp * s; }
      qs[h * 64 + d] = x * 0.125f;
      if (h < 2) { float y = bf2f(PROJ[prow + C_K + h * 64 + d]);
          if (d < 16) { const float yp = bf2f(PROJ[prow + C_K + h * 64 + (d ^ 8)]); const float c = (d & 7) == 0 ? cs[0] : (d & 7) == 1 ? cs[1] : (d & 7) == 2 ? cs[2] : (d & 7) == 3 ? cs[3] : (d & 7) == 4 ? cs[4] : (d & 7) == 5 ? cs[5] : (d & 7) == 6 ? cs[6] : cs[7];
              const float s = (d & 7) == 0 ? sn[0] : (d & 7) == 1 ? sn[1] : (d & 7) == 2 ? sn[2] : (d & 7) == 3 ? sn[3] : (d & 7) == 4 ? sn[4] : (d & 7) == 5 ? sn[5] : (d & 7) == 6 ? sn[6] : sn[7];
              y = d < 8 ? y * c - yp * s : y * c + yp * s; }
          knew[h * 64 + d] = y; vnew[h * 64 + d] = bf2f(PROJ[prow + C_V + h * 64 + d]); } }
    __syncthreads();
    float sa = 0.f, sb = 0.f, sn_ = 0.f;
    { const float* ka = ck + (size_t)(lane * 2 + kvh) * 64; const float* kb = ck + (size_t)((lane + 64) * 2 + kvh) * 64;
#pragma unroll
      for (int c = 0; c < 16; ++c) { const f32x4 x = *(const GAS f32x4*)(ka + 4 * c), y = *(const GAS f32x4*)(kb + 4 * c); const f32x4 qv = *(const LAS f32x4*)(qs + h * 64 + 4 * c), kn = *(const LAS f32x4*)(knew + kvh * 64 + 4 * c);
          sa += (qv.x * x.x + qv.y * x.y) + (qv.z * x.z + qv.w * x.w); sb += (qv.x * y.x + qv.y * y.y) + (qv.z * y.z + qv.w * y.w); sn_ += (qv.x * kn.x + qv.y * kn.y) + (qv.z * kn.z + qv.w * kn.w); } }
    const float sink = ARGIN(11)[l * 8 + h];
    const float mx = fmaxf(fmaxf(wave_max(fmaxf(sa, sb)), sn_), sink);
    const float ea = expf(sa - mx), eb = expf(sb - mx), en = expf(sn_ - mx);
    const float inv = 1.0f / (wave_sum(ea + eb) + en + expf(sink - mx));
    ps[h * 132 + lane] = ea * inv; ps[h * 132 + 64 + lane] = eb * inv; if (lane == 0) ps[h * 132 + 128] = en * inv;
    __syncthreads();
    { float o = ps[h * 132 + 128] * vnew[kvh * 64 + lane];
      for (int j = 0; j < 128; ++j) o += ps[h * 132 + j] * cv[(size_t)(j * 2 + kvh) * 64 + lane];
      ((unsigned short*)MIXED)[(size_t)(MP + b) * DM + h * 64 + lane] = (unsigned short)f2bf(o); }
    float* sk = ARGOUT() + O_SK + (size_t)(l * MS + b) * 128 * 128; float* sv = ARGOUT() + O_SV + (size_t)(l * MS + b) * 128 * 128;
    for (int idx = tid * 4; idx < 128 * 128; idx += NTHR * 4) { const int j = idx >> 7, rem = idx & 127;
        f32x4 kk, vv;
        if (j < 127) { kk = *(const GAS f32x4*)(ck + idx + 128); vv = *(const GAS f32x4*)(cv + idx + 128); }
        else { kk = *(const LAS f32x4*)(knew + rem); vv = *(const LAS f32x4*)(vnew + rem); }
        *(GAS f32x4*)(sk + idx) = kk; *(GAS f32x4*)(sv + idx) = vv; }
}

__device__ __forceinline__ bool queue_next(Frame& F, gu32* head, int& it) {
    volatile LAS unsigned* slot = F.MISC + 16;
    __syncthreads();
    if (F.tid == 0) slot[0] = __hip_atomic_fetch_add(head, 1u, RLX_AGENT);
    __syncthreads();
    it = (int)slot[0];
    { int t_ = threadIdx.x; asm volatile("" : "+v"(t_)); F.tid = t_; F.lane = t_ & 63; F.wave = __builtin_amdgcn_readfirstlane(t_ >> 6); }
    return true;
}
__device__ __forceinline__ void mixer_phase(Frame& F, const Args& a, int l, int qslot) {
    constexpr int E0 = 128, E1 = E0 + 256, E2 = E1 + 256, E3 = E2 + 128, E4 = E3 + 256, E5 = E4 + 512;
    gu32* head = F.ctl + CW_QUEUE + 64 * qslot;
    for (;;) {
        int it; queue_next(F, head, it);
        if (it >= E5) break;
        if (it < E0) attn_sample_item(F, a, l, it);
        else if (it < E1) { const int r = it - E0; ssd_sample_item(F, l, r >> 1, r & 1); }
        else if (it < E2) { const int r = it - E1; ssd_a_item(F, l, r >> 6, (r >> 5) & 1, (r >> 1) & 15, r & 1); }
        else if (it < E3) { const int r = it - E2; attn_mfma_item(F, l, r >> 5, (r >> 1) & 15, r & 1); }
        else if (it < E4) { const int r = it - E3; mlstm_a_item(F, l, r >> 6, (r >> 4) & 3, r & 15); }
        else { const int r = it - E4; mlstm_sample_item(F, l, r >> 2, r & 3); }
    }
}
__device__ __forceinline__ void mixer_c_phase(Frame& F, int l, int qslot) {
    constexpr int N_SSDC0 = NB * 2 * 16, N_MLC0 = NB * 4 * 16;
#ifndef MK_R_SSDC
#define MK_R_SSDC 1
#define MK_R_MLC 1
#endif
    constexpr int N_SSDC = N_SSDC0 * MK_R_SSDC, N_MLC = N_MLC0 * MK_R_MLC;
    gu32* head = F.ctl + CW_QUEUE + 64 * qslot;
    for (;;) {
        int it; queue_next(F, head, it);
        if (it >= N_SSDC + N_MLC) break;
        if (it < N_SSDC) { const int r = it % N_SSDC0; ssd_c_item(F, l, r >> 5, (r >> 4) & 1, r & 15); }
        else { const int r = (it - N_SSDC) % N_MLC0; mlstm_c_item(F, l, r >> 6, (r >> 4) & 3, r & 15); }
    }
}

__device__ __forceinline__ void finalize_phase(Frame& F, const Args& a, int l) {
    const bf16* PROJ = (const bf16*)(ARGWS() + WS_PROJ); bf16* MIXED = (bf16*)(ARGWS() + WS_MIXED); const float* YG = (const float*)(ARGWS() + WS_YG); const float* HR = (const float*)(ARGWS() + WS_HR);
    const float* wssm = ARGIN(17) + (size_t)l * 1024; const float* wml = ARGIN(20) + (size_t)l * 512;
    const int gw = F.vcu * NWAVES + F.wave, NGW = F.G * NWAVES, lane = F.lane;
    for (int row = MP + gw; row < MT; row += NGW) {
#pragma unroll
        for (int g = 0; g < 2; ++g) { const float* src = YG + (size_t)row * 1024 + g * 512 + lane * 8; const f32x4 u0 = *(const GAS f32x4*)src, u1 = *(const GAS f32x4*)(src + 4);
            float ss = (u0.x * u0.x + u0.y * u0.y) + (u0.z * u0.z + u0.w * u0.w) + (u1.x * u1.x + u1.y * u1.y) + (u1.z * u1.z + u1.w * u1.w);
            ss = wave_sum(ss); const float rs = 1.0f / sqrtf(ss * (1.0f / 512.0f) + 1e-6f);
            const float* wp = wssm + g * 512 + lane * 8; const f32x4 w0 = *(const GAS f32x4*)wp, w1 = *(const GAS f32x4*)(wp + 4);
            float o[8] = {u0.x * rs * w0.x, u0.y * rs * w0.y, u0.z * rs * w0.z, u0.w * rs * w0.w, u1.x * rs * w1.x, u1.y * rs * w1.y, u1.z * rs * w1.z, u1.w * rs * w1.w};
            *(GAS v4u*)(MIXED + (size_t)row * DM + 512 + g * 512 + lane * 8) = pack8(o); }
#pragma unroll
        for (int hh = 0; hh < 4; ++hh) { const float* src = HR + (size_t)row * 512 + hh * 128 + lane * 2; const float v0 = src[0], v1 = src[1];
            const float ss = wave_sum(v0 * v0 + v1 * v1), rs = 1.0f / sqrtf(ss * (1.0f / 128.0f) + 1e-6f);
            const unsigned mo = *(const GAS unsigned*)(PROJ + (size_t)row * NINP + C_MO + hh * 128 + lane * 2);
            const float o0 = v0 * rs * wml[hh * 128 + lane * 2] * sigmoidf_(bflo(mo)), o1 = v1 * rs * wml[hh * 128 + lane * 2 + 1] * sigmoidf_(bfhi(mo));
            *(GAS unsigned*)(MIXED + (size_t)row * DM + 1536 + hh * 128 + lane * 2) = pk2(o0, o1); }
    }
}

__device__ __forceinline__ void final_norm_phase(Frame& F, const Args& a) {
    const float* SSQ = (const float*)(ARGWS() + WS_SSQA); const float* wf = ARGIN(25);
    const int gw = F.vcu * NWAVES + F.wave, NGW = F.G * NWAVES, lane = F.lane;
    for (int row = gw; row < MT; row += NGW) {
        const f32x4 p0 = *(const GAS f32x4*)(SSQ + (size_t)row * 8), p1 = *(const GAS f32x4*)(SSQ + (size_t)row * 8 + 4);
        const float ss = ((p0.x + p0.y) + (p0.z + p0.w)) + ((p1.x + p1.y) + (p1.z + p1.w)), rs = 1.0f / sqrtf(ss * (1.0f / 2048.0f) + 1e-6f);
        GAS f32x4* y = (GAS f32x4*)(ARGOUT() + O_Y + (size_t)row * DM) + lane; const GAS f32x4* wv = (const GAS f32x4*)wf + lane;
#pragma unroll
        for (int j = 0; j < 8; ++j) { const f32x4 v = y[64 * j], g = wv[64 * j]; y[64 * j] = (f32x4){v.x * rs * g.x, v.y * rs * g.y, v.z * rs * g.z, v.w * rs * g.w}; }
    }
}

#ifndef MK_N_LAUNCHES
#define MK_N_LAUNCHES 1
#endif
constexpr int N_PHASES = 16;
#ifndef MK_REP_P0
#define MK_REP_P0 1
#endif
#ifndef MK_REP_M2
#define MK_REP_M2 1
#endif
#ifndef MK_REP_G1
#define MK_REP_G1 1
#endif
#ifndef MK_REP_G3
#define MK_REP_G3 1
#endif
#ifndef MK_REP_M1
#define MK_REP_M1 1
#endif
#ifndef MK_REP_M3
#define MK_REP_M3 1
#endif
__global__ void __launch_bounds__(NTHR, 2) mk_fwd(Args args) {
    extern __shared__ __attribute__((aligned(16))) unsigned char lds[];
    Frame F;
    F.lds = (LAS unsigned char*)lds;
    F.MISC = (volatile LAS unsigned*)(F.lds + MISC_OFF);
    F.tid = threadIdx.x; F.lane = F.tid & 63; F.wave = __builtin_amdgcn_readfirstlane(F.tid >> 6);
    F.G = gridDim.x; { const int bx = blockIdx.x; F.vcu = (F.G % 8 == 0) ? (bx % 8) * (F.G / 8) + bx / 8 : bx; }
    unsigned char* ws = ARGWS();
    F.ctl = (gu32*)(ws + WS_CTL);
    for (int u = F.tid; u < (LDS_BYTES - LDSCTL_OFF) / 4; u += NTHR) ((LAS unsigned*)(F.lds + LDSCTL_OFF))[u] = 0u;
    __syncthreads();
    const int lo = args.ph_lo, hi = args.ph_hi;
    const bool use_bar = (hi - lo) > 1;
    XcdBarrier bar; bar.bar = (unsigned*)(F.ctl + CW_BAR); bar.x = 0; bar.st = nullptr;
    if (use_bar) bar = xcd_barrier_post((unsigned*)(F.ctl + CW_BAR), F.MISC + 8);
#define IN(k) (lo <= (k) && (k) < hi)
#define PHASE_BEGIN() do { int t_ = threadIdx.x, v_ = vcu0, g_ = G0; asm volatile("" : "+v"(t_)); asm volatile("" : "+s"(v_), "+s"(g_)); F.tid = t_; F.lane = t_ & 63; F.wave = __builtin_amdgcn_readfirstlane(t_ >> 6); F.vcu = v_; F.G = g_; } while (0)
#define SEAM(k) do { if (IN(k) && IN((k) + 1)) xcd_barrier(bar); } while (0)

#define WSP(T, off) ((T*)(ARGWS() + (off)))
#define RST_FILL(S_, ssq_) do { for (int i_ = 0; i_ < 4; ++i_) { pg8::Unit u_; if (!(S_).next(i_, u_)) break; if (F.tid < 256) { const float* sp_ = (ssq_) + (size_t)(u_.pm * 256 + F.tid) * 8; \
        const f32x4 p0_ = *(const GAS f32x4*)sp_, p1_ = *(const GAS f32x4*)(sp_ + 4); const float ss_ = ((p0_.x + p0_.y) + (p0_.z + p0_.w)) + ((p1_.x + p1_.y) + (p1_.z + p1_.w)); \
        ((LAS float*)(F.lds + RST_OFF))[i_ * 256 + F.tid] = 1.0f / sqrtf(ss_ * (1.0f / 2048.0f) + 1e-6f); } } __syncthreads(); } while (0)
#define DECL_WS() bf16* XB = WSP(bf16, WS_XB); float* XRES = WSP(float, WS_XRES); bf16* HBUF = WSP(bf16, WS_HBUF); bf16* PROJ = WSP(bf16, WS_PROJ); bf16* MIXED = WSP(bf16, WS_MIXED); \
    float* SSQA = WSP(float, WS_SSQA); float* SSQB = WSP(float, WS_SSQB); \
    const bf16* Wi = WSP(const bf16, WS_WIN + l * WIN_BYTES); const bf16* Wo = WSP(const bf16, WS_WOUT + l * WOUT_BYTES); const bf16* Wu = WSP(const bf16, WS_WUP + l * WUP_BYTES); const bf16* Wd = WSP(const bf16, WS_WDN + l * WDN_BYTES); \
    (void)XB; (void)XRES; (void)HBUF; (void)PROJ; (void)MIXED; (void)SSQA; (void)SSQB; (void)Wi; (void)Wo; (void)Wu; (void)Wd

    const int vcu0 = F.vcu, G0 = F.G;
    for (int rep_ = 0; rep_ < MK_REP_P0; ++rep_) if (IN(0)) { if (rep_) xcd_barrier(bar); PHASE_BEGIN(); p0_prologue(F, args); }
    SEAM(0);
    for (int l = 0; l < DEPTH; ++l) {
        const int pb = 1 + 7 * l;
        for (int rep_ = 0; rep_ < MK_REP_G1; ++rep_) if (IN(pb)) { if (rep_) xcd_barrier(bar); PHASE_BEGIN(); DECL_WS();
            pg8::Gemm g{XB, Wi, MPAD, NINP, DM}; pg8::StaticOrder S; S.init(MPAD, NINP, F.G, (int)blockIdx.x);
            RST_FILL(S, SSQA);
            pg8::EpiScaleBf16<0> E{PROJ, NINP, (const LAS float*)(F.lds + RST_OFF)};
            pg8::gemm_phase<pg8::EpiScaleBf16<0>, pg8::StaticOrder, true, true>(F.lds + RING_OFF, g, S, E, F.tid);
            if (blockIdx.x == 0) for (int i = F.tid; i < MS * 8; i += NTHR) SSQB[(size_t)MP * 8 + i] = 0.f;
        }
        SEAM(pb);
        for (int rep_ = 0; rep_ < MK_REP_M1; ++rep_) if (IN(pb + 1)) { if (rep_) xcd_barrier(bar); PHASE_BEGIN(); mixer_phase(F, args, l, l + 4 * rep_); }

        SEAM(pb + 1);
        for (int rep_ = 0; rep_ < MK_REP_M2; ++rep_) if (IN(pb + 2)) { if (rep_) xcd_barrier(bar); PHASE_BEGIN(); mlstm_scan_phase(F, l); ssd_scan_phase(F, l); }
        SEAM(pb + 2);
        for (int rep_ = 0; rep_ < MK_REP_M3; ++rep_) if (IN(pb + 3)) { if (rep_) xcd_barrier(bar); PHASE_BEGIN(); mixer_c_phase(F, l, 2 + l + 4 * rep_); }
        SEAM(pb + 3);
        if (IN(pb + 4)) { PHASE_BEGIN(); DECL_WS();
            const float* basep = l == 0 ? ARGIN(0) : XRES; const float* bases = l == 0 ? ARGIN(1) : XRES + (size_t)MP * DM;
            pg8::Gemm g{MIXED, Wo, MP, DM, DM}; pg8::StaticOrder S; S.init(MP, DM, F.G, (int)blockIdx.x);
            pg8::EpiResid E{basep, XRES, XB, SSQB, DM};
            pg8::gemm_phase<pg8::EpiResid, pg8::StaticOrder, false, true>(F.lds + RING_OFF, g, S, E, F.tid);
            float* outs = XRES + (size_t)MP * DM; bf16* xbs = XB + (size_t)MP * DM; float* sq = SSQB + (size_t)MP * 8;
            thin_gemm<4, 1, 4>(F, MIXED + (size_t)MP * DM, DM, Wo, DM, DM, [&](int row, int col, f32x4 acc) {
                const f32x4 bs = *(const GAS f32x4*)(bases + (size_t)row * DM + col); const f32x4 o = bs + acc;
                *(GAS f32x4*)(outs + (size_t)row * DM + col) = o;
                *(GAS unsigned long long*)(xbs + (size_t)row * DM + col) = (unsigned long long)pk2(o.x, o.y) | ((unsigned long long)pk2(o.z, o.w) << 32);
                float s = (o.x * o.x + o.y * o.y) + (o.z * o.z + o.w * o.w); s += __shfl_xor(s, 16); s += __shfl_xor(s, 32);
                if ((F.lane >> 4) == 0) atomicAdd(sq + (size_t)row * 8 + ((col >> 4) & 7), s); });
            if (blockIdx.x == 0) for (int i = F.tid; i < MS * 8; i += NTHR) SSQA[(size_t)MP * 8 + i] = 0.f;
        }
        SEAM(pb + 4);
        for (int rep_ = 0; rep_ < MK_REP_G3; ++rep_) if (IN(pb + 5)) { if (rep_) xcd_barrier(bar); PHASE_BEGIN(); DECL_WS();
            pg8::Gemm g{XB, Wu, MP, FF, DM}; pg8::StaticOrder S; S.init(MP, FF, F.G, (int)blockIdx.x);
            RST_FILL(S, SSQB);
            pg8::EpiScaleBf16<1> E{HBUF, FF, (const LAS float*)(F.lds + RST_OFF)};
            pg8::gemm_phase<pg8::EpiScaleBf16<1>, pg8::StaticOrder, true, true>(F.lds + RING_OFF, g, S, E, F.tid);
            bf16* hs = HBUF + (size_t)MP * FF; const float* sq = SSQB + (size_t)MP * 8;
#ifndef MK_REP_THIN3
#define MK_REP_THIN3 1
#endif
            for (int rt_ = 0; rt_ < MK_REP_THIN3; ++rt_)
            thin_gemm<8, 2, 2>(F, XB + (size_t)MP * DM, DM, Wu, FF, DM, [&](int row, int col, f32x4 acc) {
                const f32x4 p0 = *(const GAS f32x4*)(sq + (size_t)row * 8), p1 = *(const GAS f32x4*)(sq + (size_t)row * 8 + 4);
                const float ss = ((p0.x + p0.y) + (p0.z + p0.w)) + ((p1.x + p1.y) + (p1.z + p1.w)), rs = 1.0f / sqrtf(ss * (1.0f / 2048.0f) + 1e-6f);
                f32x4 v = acc * rs; v.x = fmaxf(v.x, 0.f); v.y = fmaxf(v.y, 0.f); v.z = fmaxf(v.z, 0.f); v.w = fmaxf(v.w, 0.f);
                *(GAS unsigned long long*)(hs + (size_t)row * FF + col) = (unsigned long long)pk2(v.x * v.x, v.y * v.y) | ((unsigned long long)pk2(v.z * v.z, v.w * v.w) << 32); });
        }
        SEAM(pb + 5);
        if (IN(pb + 6)) { PHASE_BEGIN(); DECL_WS();
            const bool lastl = (l == DEPTH - 1);
            float* outp = lastl ? ARGOUT() + O_Y : XRES; float* outs = lastl ? ARGOUT() + O_Y + (size_t)MP * DM : XRES + (size_t)MP * DM;
            pg8::Gemm g{HBUF, Wd, MP, DM, FF}; pg8::StaticOrder S; S.init(MP, DM, F.G, (int)blockIdx.x);
            pg8::EpiResid E{XRES, outp, lastl ? (bf16*)nullptr : XB, SSQA, DM};
            pg8::gemm_phase<pg8::EpiResid, pg8::StaticOrder, false, true>(F.lds + RING_OFF, g, S, E, F.tid);
            const float* bases = XRES + (size_t)MP * DM; bf16* xbs = XB + (size_t)MP * DM; float* sq = SSQA + (size_t)MP * 8;
            thin_gemm<4, 1, 8>(F, HBUF + (size_t)MP * FF, FF, Wd, DM, FF, [&](int row, int col, f32x4 acc) {
                const f32x4 bs = *(const GAS f32x4*)(bases + (size_t)row * DM + col); const f32x4 o = bs + acc;
                *(GAS f32x4*)(outs + (size_t)row * DM + col) = o;
                if (!lastl) *(GAS unsigned long long*)(xbs + (size_t)row * DM + col) = (unsigned long long)pk2(o.x, o.y) | ((unsigned long long)pk2(o.z, o.w) << 32);
                float s = (o.x * o.x + o.y * o.y) + (o.z * o.z + o.w * o.w); s += __shfl_xor(s, 16); s += __shfl_xor(s, 32);
                if ((F.lane >> 4) == 0) atomicAdd(sq + (size_t)row * 8 + ((col >> 4) & 7), s); });
        }
        SEAM(pb + 6);
    }
    if (IN(15)) { PHASE_BEGIN(); final_norm_phase(F, args); }
#undef IN
#undef SEAM
}

extern "C" void kernel_launch(void* const* d_in, const int* in_sizes, int n_in, void* d_out, int out_size, void* d_ws, size_t ws_size, hipStream_t stream) {
    static int grid = 0;
    if (grid == 0) {
        if (n_in != 26 || (size_t)out_size != O_END || ws_size < WS_END2) { fprintf(stderr, "kernel_launch: expected 26 inputs, %zu outputs, >= %zu bytes of workspace; got %d, %d, %zu\n", (size_t)O_END, (size_t)WS_END2, n_in, out_size, ws_size); grid = -1; return; }
        int dev = 0, cus = 0, per_cu = 0;
        if (hipGetDevice(&dev) != hipSuccess || hipDeviceGetAttribute(&cus, hipDeviceAttributeMultiprocessorCount, dev) != hipSuccess) { grid = -1; return; }
        if (hipFuncSetAttribute((const void*)mk_fwd, hipFuncAttributeMaxDynamicSharedMemorySize, LDS_BYTES) != hipSuccess) { fprintf(stderr, "kernel_launch: hipFuncSetAttribute failed\n"); grid = -1; return; }
        if (hipOccupancyMaxActiveBlocksPerMultiprocessor(&per_cu, (const void*)mk_fwd, NTHR, LDS_BYTES) != hipSuccess || per_cu < 1) { fprintf(stderr, "kernel_launch: occupancy query says %d blocks per CU\n", per_cu); per_cu = 1; }
        (void)hipGetLastError();
        grid = cus;
        if (grid != 256) fprintf(stderr, "kernel_launch: %d CUs; the G2/G4 phases assume 256 workgroups\n", grid);
    }
    if (grid < 0) return;
    (void)hipMemsetAsync((char*)d_ws + WS_CTL, 0, CTL_ZERO_BYTES, stream);
    Args a{};
    for (int i = 0; i < 26; ++i) a.in[i] = (const float*)d_in[i];
    a.out = (float*)d_out; a.ws = (unsigned char*)d_ws;
#if MK_N_LAUNCHES == 1
    a.ph_lo = 0; a.ph_hi = N_PHASES;
    hipLaunchKernelGGL(mk_fwd, dim3(grid), dim3(NTHR), LDS_BYTES, stream, a);
#else
    for (int p = 0; p < N_PHASES; ++p) { a.ph_lo = p; a.ph_hi = p + 1; hipLaunchKernelGGL(mk_fwd, dim3(grid), dim3(NTHR), LDS_BYTES, stream, a); }
#endif
}
```
